# Optimizing an MI355X kernel written in HIP

```python
import math
import jax, jax.numpy as jnp
from jax import lax
import numpy as np

D_MODEL = 1024
BATCH = 4
SEQ = 8192
DEPTH = 1
DEC_BATCH = 8
DEC_SEQ = 64
PAST_LEN = 2048

CHUNK = 64
CONV_W = 4
FFN_CONV_W = 3
EPS = 1e-6
GDN_HEADS = 8
GDN_DK = 128
GDN_DV = 128
GDN_QK = GDN_HEADS * GDN_DK
GDN_V = GDN_HEADS * GDN_DV
SSD_INNER = 2 * D_MODEL
SSD_HEADDIM = 64
SSD_HEADS = SSD_INNER // SSD_HEADDIM
SSD_STATE = 128
SSD_GROUPS = 8
SSD_BC = SSD_GROUPS * SSD_STATE
D_FF = 2816
CONV_CH = 2 * GDN_QK + GDN_V + SSD_INNER + 2 * SSD_BC
IN_COLS = CONV_CH + GDN_V + SSD_INNER + 2 * GDN_HEADS + SSD_HEADS + 2 * D_MODEL

kernel_name = 'hybrid_gdn_ssd_convffn_stream_step'


def _split(a, sizes):
    idx = np.cumsum(sizes)[:-1].tolist()
    return jnp.split(a, idx, axis=-1)


def _rms(xf):
    return xf * lax.rsqrt(jnp.mean(xf * xf, axis=-1, keepdims=True) + EPS)


def rmsnorm(x, w):
    return (_rms(x.astype(jnp.float32)) * w.astype(jnp.float32)).astype(x.dtype)


def l2norm(x):
    xf = x.astype(jnp.float32)
    return xf * lax.rsqrt(jnp.sum(xf * xf, axis=-1, keepdims=True) + EPS)


def causal_dwconv(u, buf, w, b):
    W = w.shape[0]
    T = u.shape[1]
    full = jnp.concatenate([buf.astype(u.dtype), u], axis=1)
    y = b + sum(full[:, i:i + T] * w[i] for i in range(W))
    return y, full[:, T:]


def to_chunks(a, blk):
    bsz, t = a.shape[:2]
    return jnp.moveaxis(a.reshape((bsz, t // blk, blk) + a.shape[2:]), 1, 0)


def from_chunks(a):
    a = jnp.moveaxis(a, 0, 1)
    return a.reshape((a.shape[0], a.shape[1] * a.shape[2]) + a.shape[3:])


def gated_delta_chunked(q, k, v, g, beta, s0):
    t = q.shape[1]
    blk = min(CHUNK, t)
    xs = tuple(to_chunks(a, blk) for a in (q, k, v, g, beta))
    causal = jnp.tril(jnp.ones((blk, blk), dtype=bool))
    strict = jnp.tril(jnp.ones((blk, blk), dtype=bool), -1)
    eye = jnp.eye(blk, dtype=jnp.float32)

    def step(s, inp):
        qc, kc, vc, gc, bc = inp
        gam = jnp.moveaxis(jnp.cumsum(gc, axis=1), 1, -1)
        dec = jnp.exp(jnp.where(causal, gam[..., :, None] - gam[..., None, :], -jnp.inf))
        bt = jnp.moveaxis(bc, 1, -1)
        qh = jnp.moveaxis(qc, 1, 2)
        kh = jnp.moveaxis(kc, 1, 2)
        vh = jnp.moveaxis(vc, 1, 2)
        kk = jnp.einsum('bhik,bhjk->bhij', kh, kh)
        lhs = jnp.where(strict, kk * dec * bt[..., :, None], 0.0) + eye
        rhs = jnp.concatenate([vh * bt[..., None], kh * (bt * jnp.exp(gam))[..., None]], axis=-1)
        sol = lax.linalg.triangular_solve(lhs, rhs, left_side=True, lower=True, unit_diagonal=True)
        w_v, w_k = sol[..., :GDN_DV], sol[..., GDN_DV:]
        u = w_v - jnp.einsum('bhik,bhkv->bhiv', w_k, s)
        qk = jnp.einsum('bhik,bhjk->bhij', qh, kh) * dec
        o = jnp.exp(gam)[..., None] * jnp.einsum('bhik,bhkv->bhiv', qh, s) + jnp.einsum('bhij,bhjv->bhiv', qk, u)
        last = gam[..., -1:]
        s = jnp.exp(last)[..., None] * s + jnp.einsum('bhik,bhiv->bhkv', kh * jnp.exp(last - gam)[..., None], u)
        return s, jnp.moveaxis(o, 2, 1)

    s_fin, outs = lax.scan(step, s0.astype(jnp.float32), xs)
    return from_chunks(outs), s_fin


def ssd_chunked(x, dt, a_neg, bm, cm, h0):
    bsz, t = x.shape[:2]
    blk = min(CHUNK, t)
    hpg = SSD_HEADS // SSD_GROUPS
    f32 = jnp.float32
    xs = (to_chunks(x.astype(f32).reshape(bsz, t, SSD_GROUPS, hpg, SSD_HEADDIM), blk),
          to_chunks(dt.reshape(bsz, t, SSD_GROUPS, hpg), blk),
          to_chunks(bm.astype(f32), blk),
          to_chunks(cm.astype(f32), blk))
    a = a_neg.reshape(SSD_GROUPS, hpg)
    causal = jnp.tril(jnp.ones((blk, blk), dtype=bool))

    def step(h, inp):
        xc, dtc, bc, cc = inp
        gam = jnp.cumsum(dtc * a, axis=1)
        gam_t = jnp.moveaxis(gam, 1, -1)
        dt_t = jnp.moveaxis(dtc, 1, -1)
        dec = jnp.exp(jnp.where(causal, gam_t[..., :, None] - gam_t[..., None, :], -jnp.inf))
        cb = jnp.einsum('bign,bjgn->bgij', cc, bc)
        w = cb[:, :, None] * dec * dt_t[..., None, :]
        y = jnp.einsum('bghij,bjghp->bighp', w, xc)
        y = y + jnp.einsum('bign,bghnp->bighp', cc, h) * jnp.exp(gam)[..., None]
        last = gam_t[..., -1:]
        wj = jnp.exp(last - gam_t) * dt_t
        h = jnp.exp(last)[..., None] * h + jnp.einsum('bjgn,bghj,bjghp->bghnp', bc, wj, xc)
        return h, y

    h0g = h0.astype(f32).reshape(bsz, SSD_GROUPS, hpg, SSD_STATE, SSD_HEADDIM)
    h_fin, ys = lax.scan(step, h0g, xs)
    y = from_chunks(ys).reshape(bsz, t, SSD_HEADS, SSD_HEADDIM)
    return y, h_fin.reshape(bsz, SSD_HEADS, SSD_STATE, SSD_HEADDIM)


def trunk_layer(x, c, conv_mix0, s_gdn0, s_ssd0, conv_ffn0,
                w_ada, b_ada, w_norm_mix, w_in, w_conv_mix, b_conv_mix,
                gdn_a_log, gdn_dt_bias, gdn_norm, ssd_a_log, ssd_dt_bias, ssd_d, ssd_norm,
                w_branch_gdn, w_branch_ssd, w_out,
                w_norm_ffn, w_ffn_up, w_ffn_conv, b_ffn_conv, w_ffn_down):
    f32 = jnp.float32
    bsz, t, _ = x.shape
    mod = (jax.nn.silu(c) @ w_ada + b_ada)[:, None, :]
    sh1, sc1, gt1, sh2, sc2, gt2 = jnp.split(mod, 6, axis=-1)

    h = rmsnorm(x, w_norm_mix) * (1 + sc1) + sh1
    proj = h @ w_in
    xconv, gdn_z, ssd_z, gdn_b, gdn_a, ssd_dt, merge = _split(
        proj, [CONV_CH, GDN_V, SSD_INNER, GDN_HEADS, GDN_HEADS, SSD_HEADS, 2 * D_MODEL])
    xconv, conv_mix_new = causal_dwconv(xconv, conv_mix0, w_conv_mix, b_conv_mix)
    xconv = jax.nn.silu(xconv)
    q, k, v, xs, bm, cm = _split(xconv, [GDN_QK, GDN_QK, GDN_V, SSD_INNER, SSD_BC, SSD_BC])

    q = l2norm(q.reshape(bsz, t, GDN_HEADS, GDN_DK)) * (GDN_DK ** -0.5)
    k = l2norm(k.reshape(bsz, t, GDN_HEADS, GDN_DK))
    v = v.reshape(bsz, t, GDN_HEADS, GDN_DV).astype(f32)
    beta = jax.nn.sigmoid(gdn_b.astype(f32))
    g = -jnp.exp(gdn_a_log.astype(f32)) * jax.nn.softplus(gdn_a.astype(f32) + gdn_dt_bias.astype(f32))
    o_gdn, s_gdn_new = gated_delta_chunked(q, k, v, g, beta, s_gdn0)
    zg = gdn_z.reshape(bsz, t, GDN_HEADS, GDN_DV).astype(f32)
    o_gdn = (_rms(o_gdn) * gdn_norm.astype(f32) * jax.nn.silu(zg)).reshape(bsz, t, GDN_V).astype(x.dtype)

    xs = xs.reshape(bsz, t, SSD_HEADS, SSD_HEADDIM)
    bm = bm.reshape(bsz, t, SSD_GROUPS, SSD_STATE)
    cm = cm.reshape(bsz, t, SSD_GROUPS, SSD_STATE)
    dt = jax.nn.softplus(ssd_dt.astype(f32) + ssd_dt_bias.astype(f32))
    a_neg = -jnp.exp(ssd_a_log.astype(f32))
    y_ssd, s_ssd_new = ssd_chunked(xs, dt, a_neg, bm, cm, s_ssd0)
    y_ssd = y_ssd + ssd_d.astype(f32)[:, None] * xs.astype(f32)
    gsz = SSD_INNER // SSD_GROUPS
    yz = (y_ssd.reshape(bsz, t, SSD_INNER) * jax.nn.silu(ssd_z.astype(f32))).reshape(bsz, t, SSD_GROUPS, gsz)
    y_ssd = (_rms(yz) * ssd_norm.astype(f32).reshape(SSD_GROUPS, gsz)).reshape(bsz, t, SSD_INNER).astype(x.dtype)

    g_gdn, g_ssd = jnp.split(jax.nn.sigmoid(merge.astype(f32)).astype(x.dtype), 2, axis=-1)
    mixed = g_gdn * (o_gdn @ w_branch_gdn) + g_ssd * (y_ssd @ w_branch_ssd)
    x = x + gt1 * (mixed @ w_out)

    h2 = rmsnorm(x, w_norm_ffn) * (1 + sc2) + sh2
    u = h2 @ w_ffn_up
    u, conv_ffn_new = causal_dwconv(u, conv_ffn0, w_ffn_conv, b_ffn_conv)
    ua, uv = jnp.split(u, 2, axis=-1)
    x = x + gt2 * ((jax.nn.silu(ua) * uv) @ w_ffn_down)
    return (x, conv_mix_new, s_gdn_new.astype(x.dtype), s_ssd_new.astype(x.dtype), conv_ffn_new)


def setup_inputs(seed: int = 0) -> dict:
    key = jax.random.key(seed)
    ks = jax.random.split(key, 32)
    f32 = jnp.float32
    L = DEPTH

    def nrm(k, shape, scale):
        return scale * jax.random.normal(k, shape, f32)

    def inv_softplus_dt(k, shape):
        dt = jnp.exp(jax.random.uniform(k, shape, f32, minval=math.log(1e-3), maxval=math.log(1e-1)))
        return dt + jnp.log(-jnp.expm1(-dt))

    return {
        'x_prompt': nrm(ks[0], (BATCH, SEQ, D_MODEL), 1.0),
        'x_sample': nrm(ks[1], (DEC_BATCH, DEC_SEQ, D_MODEL), 1.0),
        'state_conv_mix': nrm(ks[2], (L, DEC_BATCH, CONV_W - 1, CONV_CH), 1.0),
        'state_gdn': nrm(ks[3], (L, DEC_BATCH, GDN_HEADS, GDN_DK, GDN_DV), 0.1),
        'state_ssd': nrm(ks[4], (L, DEC_BATCH, SSD_HEADS, SSD_STATE, SSD_HEADDIM), 0.1),
        'state_conv_ffn': nrm(ks[5], (L, DEC_BATCH, FFN_CONV_W - 1, 2 * D_FF), 1.0),
        'c_prompt': nrm(ks[6], (BATCH, D_MODEL), 1.0),
        'c_sample': nrm(ks[7], (DEC_BATCH, D_MODEL), 1.0),
        'w_ada': nrm(ks[8], (L, D_MODEL, 6 * D_MODEL), D_MODEL ** -0.5),
        'b_ada': nrm(ks[9], (L, 6 * D_MODEL), 0.02),
        'w_norm_mix': 1.0 + nrm(ks[10], (L, D_MODEL), 0.02),
        'w_in': nrm(ks[11], (L, D_MODEL, IN_COLS), D_MODEL ** -0.5),
        'w_conv_mix': nrm(ks[12], (L, CONV_W, CONV_CH), CONV_W ** -0.5),
        'b_conv_mix': nrm(ks[13], (L, CONV_CH), 0.02),
        'gdn_a_log': jnp.log(jax.random.uniform(ks[14], (L, GDN_HEADS), f32, minval=1.0, maxval=16.0)),
        'gdn_dt_bias': inv_softplus_dt(ks[15], (L, GDN_HEADS)),
        'gdn_norm': 1.0 + nrm(ks[16], (L, GDN_DV), 0.02),
        'ssd_a_log': jnp.log(jax.random.uniform(ks[17], (L, SSD_HEADS), f32, minval=1.0, maxval=16.0)),
        'ssd_dt_bias': inv_softplus_dt(ks[18], (L, SSD_HEADS)),
        'ssd_d': 1.0 + nrm(ks[19], (L, SSD_HEADS), 0.02),
        'ssd_norm': 1.0 + nrm(ks[20], (L, SSD_INNER), 0.02),
        'w_branch_gdn': nrm(ks[21], (L, GDN_V, D_MODEL), GDN_V ** -0.5),
        'w_branch_ssd': nrm(ks[22], (L, SSD_INNER, D_MODEL), SSD_INNER ** -0.5),
        'w_out': nrm(ks[23], (L, D_MODEL, D_MODEL), D_MODEL ** -0.5),
        'w_norm_ffn': 1.0 + nrm(ks[24], (L, D_MODEL), 0.02),
        'w_ffn_up': nrm(ks[25], (L, D_MODEL, 2 * D_FF), D_MODEL ** -0.5),
        'w_ffn_conv': nrm(ks[26], (L, FFN_CONV_W, 2 * D_FF), FFN_CONV_W ** -0.5),
        'b_ffn_conv': nrm(ks[27], (L, 2 * D_FF), 0.02),
        'w_ffn_down': nrm(ks[28], (L, D_FF, D_MODEL), D_FF ** -0.5),
        'w_norm_final': 1.0 + nrm(ks[29], (D_MODEL,), 0.02),
    }


def reference(x_prompt, x_sample, state_conv_mix, state_gdn, state_ssd, state_conv_ffn,
              c_prompt, c_sample,
              w_ada, b_ada, w_norm_mix, w_in, w_conv_mix, b_conv_mix,
              gdn_a_log, gdn_dt_bias, gdn_norm, ssd_a_log, ssd_dt_bias, ssd_d, ssd_norm,
              w_branch_gdn, w_branch_ssd, w_out,
              w_norm_ffn, w_ffn_up, w_ffn_conv, b_ffn_conv, w_ffn_down, w_norm_final):
    nb = x_prompt.shape[0]
    dtype = x_prompt.dtype
    xp, xsm = x_prompt, x_sample
    cm_p, gd_p, ss_p, cf_p = [], [], [], []
    cm_s, gd_s, ss_s, cf_s = [], [], [], []
    for l in range(DEPTH):
        params = (w_ada[l], b_ada[l], w_norm_mix[l], w_in[l], w_conv_mix[l], b_conv_mix[l],
                  gdn_a_log[l], gdn_dt_bias[l], gdn_norm[l], ssd_a_log[l], ssd_dt_bias[l], ssd_d[l], ssd_norm[l],
                  w_branch_gdn[l], w_branch_ssd[l], w_out[l],
                  w_norm_ffn[l], w_ffn_up[l], w_ffn_conv[l], b_ffn_conv[l], w_ffn_down[l])
        z_conv = jnp.zeros((nb, CONV_W - 1, CONV_CH), dtype)
        z_gdn = jnp.zeros((nb, GDN_HEADS, GDN_DK, GDN_DV), dtype)
        z_ssd = jnp.zeros((nb, SSD_HEADS, SSD_STATE, SSD_HEADDIM), dtype)
        z_ffn = jnp.zeros((nb, FFN_CONV_W - 1, 2 * D_FF), dtype)
        xp, a1, a2, a3, a4 = trunk_layer(xp, c_prompt, z_conv, z_gdn, z_ssd, z_ffn, *params)
        xsm, b1, b2, b3, b4 = trunk_layer(xsm, c_sample, state_conv_mix[l], state_gdn[l], state_ssd[l],
                                          state_conv_ffn[l], *params)
        cm_p.append(a1); gd_p.append(a2); ss_p.append(a3); cf_p.append(a4)
        cm_s.append(b1); gd_s.append(b2); ss_s.append(b3); cf_s.append(b4)
    y_prompt = rmsnorm(xp, w_norm_final)
    y_sample = rmsnorm(xsm, w_norm_final)
    return (y_prompt, y_sample,
            jnp.stack(cm_p), jnp.stack(gd_p), jnp.stack(ss_p), jnp.stack(cf_p),
            jnp.stack(cm_s), jnp.stack(gd_s), jnp.stack(ss_s), jnp.stack(cf_s))
```

```cpp
#include <hip/hip_runtime.h>
#include <cstdio>
#include <cstdint>

namespace pg8 {
#define PG8_LAS __attribute__((address_space(3)))
typedef unsigned short bf16_t;
typedef short bf16x8 __attribute__((ext_vector_type(8)));
typedef float f32x4 __attribute__((ext_vector_type(4)));
typedef unsigned u32x4 __attribute__((ext_vector_type(4)));
typedef unsigned u32x2 __attribute__((ext_vector_type(2)));
constexpr int BM = 256, BK = 64, HALF = 128, HTB = HALF * BK * 2, STAGE_BYTES = 8 * HTB, NXCD = 8, WGM = 8;

__host__ __device__ __forceinline__ int lds_byte(int r, int c) { const int st = (r >> 4) * 2 + (c >> 5), rr = r & 15, cc = c & 31, ob = rr * 64 + cc * 2; return st * 1024 + (ob ^ (((ob >> 9) & 1) << 5)); }
__host__ __device__ __forceinline__ void stage_rc(int b, int& R, int& C) { const int st = b / 1024, sb = b % 1024, swz = sb ^ (((sb >> 9) & 1) << 5); R = (st >> 1) * 16 + swz / 64; C = (st & 1) * 32 + (swz % 64) / 2; }
__host__ __device__ __forceinline__ int perm32(int rho) { const int n = rho >> 4, i = rho & 15; return 8 * (i >> 2) + 4 * n + (i & 3); }

struct Unit { int pm, pn; };
struct Gemm { const bf16_t* A; const bf16_t* Bt; int M, N, K; };

struct StaticOrder {
    int nM, nN, nwg, G, c;
    __host__ __device__ void init(int M, int N, int G_, int c_) { nM = M / BM; nN = N / BM; nwg = nM * nN; G = G_; c = c_; }
    __host__ __device__ bool next(int i, Unit& u) const {
        const long L = (long)i * G + c; if (L >= nwg) return false;
        int wgid = (int)L; { const int q = nwg / NXCD, r = nwg % NXCD, xcd = wgid % NXCD, off = wgid / NXCD; wgid = (xcd < r ? xcd * (q + 1) : r * (q + 1) + (xcd - r) * q) + off; }
        const int nig = WGM * nN, gid = wgid / nig, fm = gid * WGM, gsz = (nM - fm) < WGM ? (nM - fm) : WGM;
        u.pm = fm + ((wgid % nig) % gsz); u.pn = (wgid % nig) / gsz; return true;
    }
    __device__ __forceinline__ void a_ready(const Unit&) const {}
    __device__ __forceinline__ void done(const Unit&) const {}
};

__device__ __forceinline__ unsigned cvt_pk_bf16(float lo, float hi) { unsigned r; asm volatile("v_cvt_pk_bf16_f32 %0, %1, %2" : "=v"(r) : "v"(lo), "v"(hi)); return r; }

template <class Epi, class Sched, bool ALIGN_EPI = false, bool SP2 = false>
__device__ __forceinline__ void gemm_phase(PG8_LAS unsigned char* lds, const Gemm g, const Sched& S, const Epi& E, const int tid) {
    const int wid = __builtin_amdgcn_readfirstlane(tid >> 6), lane = tid & 63, wr = wid >> 2, wc = wid & 3, fr = lane & 15, fq = lane >> 4;
    const int K = g.K, nt = K / BK;
    unsigned voffA[2], voffB[2];
#pragma unroll
    for (int i = 0; i < 2; ++i) { int R, C; stage_rc(tid * 16 + i * 8192, R, C); const int Rb = Epi::PERM ? ((R & ~31) + perm32(R & 31)) : R;
        voffA[i] = (unsigned)(R * K + C) * 2u; voffB[i] = (unsigned)(Rb * K + C) * 2u; }
    const size_t kstep = (size_t)(BK * 2);
    const size_t hstep = (size_t)HALF * K * 2;
    const size_t tstep = 2 * hstep;
    const unsigned ldsw = (unsigned)wid * 1024u;
    const int aoff = lds_byte(wr * 64 + fr, fq * 8), boff = lds_byte(wc * 32 + fr, fq * 8);
#define PG8_SA(b, h) (((b) * 2 + (h)) * HTB)
#define PG8_SB(b, h) ((4 + (b) * 2 + (h)) * HTB)
#define PG8_STAGE(bufoff, gbase, voff) do { _Pragma("unroll") for (int _i = 0; _i < 2; ++_i) \
        __builtin_amdgcn_global_load_lds((const unsigned*)((const char*)(gbase) + (voff)[_i]), (PG8_LAS unsigned*)(lds + (bufoff) + ldsw + _i * 8192), 16, 0, 0); } while (0)
#define PG8_LDA(dst, b, h) do { _Pragma("unroll") for (int m = 0; m < 4; ++m) _Pragma("unroll") for (int k = 0; k < 2; ++k) dst[m][k] = *(const PG8_LAS bf16x8*)(lds + PG8_SA(b, h) + aoff + m * 2048 + k * 1024); } while (0)
#define PG8_LDB(dst, b, h) do { _Pragma("unroll") for (int n = 0; n < 2; ++n) _Pragma("unroll") for (int k = 0; k < 2; ++k) dst[n][k] = *(const PG8_LAS bf16x8*)(lds + PG8_SB(b, h) + boff + n * 2048 + k * 1024); } while (0)
#define PG8_MMA(ai, bj, At, Bt) do { __builtin_amdgcn_s_setprio(1); _Pragma("unroll") for (int m = 0; m < 4; ++m) _Pragma("unroll") for (int n = 0; n < 2; ++n) _Pragma("unroll") for (int k = 0; k < 2; ++k) \
        acc[ai][bj][m][n] = __builtin_amdgcn_mfma_f32_16x16x32_bf16(Bt[n][k], At[m][k], acc[ai][bj][m][n], 0, 0, 0); __builtin_amdgcn_s_setprio(0); } while (0)
#define PG8_WAIT_V(n) asm volatile("s_waitcnt vmcnt(" #n ")" ::: "memory")
#define PG8_WAIT_L(n) asm volatile("s_waitcnt lgkmcnt(" #n ")" ::: "memory")
#define PG8_BAR __builtin_amdgcn_s_barrier()
#define PG8_SCHED __builtin_amdgcn_sched_barrier(0)
    Unit cur, nxt; int ui = 0;
    if (!S.next(0, cur)) return;
    f32x4 acc[2][2][4][2];
#pragma unroll
    for (int a = 0; a < 2; ++a)
#pragma unroll
        for (int b = 0; b < 2; ++b)
#pragma unroll
            for (int m = 0; m < 4; ++m)
#pragma unroll
                for (int n = 0; n < 2; ++n) acc[a][b][m][n] = (f32x4){0.f, 0.f, 0.f, 0.f};
    bf16x8 At[4][2], B0[2][2], B1[2][2];
    const char* cA = (const char*)g.A + (size_t)cur.pm * tstep; const char* cB = (const char*)g.Bt + (size_t)cur.pn * tstep;
    S.a_ready(cur);
    if constexpr (SP2) {
        PG8_STAGE(PG8_SB(0, 0), cB, voffB); PG8_STAGE(PG8_SB(0, 1), cB + hstep, voffB); PG8_STAGE(PG8_SA(0, 0), cA, voffA); PG8_STAGE(PG8_SA(0, 1), cA + hstep, voffA);
        if (wr == 1) PG8_BAR;
        PG8_WAIT_V(2); PG8_BAR;
        PG8_STAGE(PG8_SB(1, 0), cB + kstep, voffB); PG8_STAGE(PG8_SA(1, 0), cA + kstep, voffA); PG8_STAGE(PG8_SB(1, 1), cB + hstep + kstep, voffB);
        PG8_WAIT_V(6); PG8_BAR;
    } else {
        PG8_STAGE(PG8_SB(0, 0), cB, voffB); PG8_STAGE(PG8_SA(0, 0), cA, voffA); PG8_STAGE(PG8_SB(0, 1), cB + hstep, voffB); PG8_STAGE(PG8_SA(0, 1), cA + hstep, voffA);
        if (wr == 1) PG8_BAR;
        PG8_WAIT_V(4); PG8_BAR;
        PG8_STAGE(PG8_SB(1, 0), cB + kstep, voffB); PG8_STAGE(PG8_SA(1, 0), cA + kstep, voffA); PG8_STAGE(PG8_SB(1, 1), cB + hstep + kstep, voffB);
        PG8_WAIT_V(6); PG8_BAR;
    }
    for (;;) {
        const bool has_next = S.next(ui + 1, nxt);
        const char* nA = has_next ? (const char*)g.A + (size_t)nxt.pm * tstep : cA; const char* nB = has_next ? (const char*)g.Bt + (size_t)nxt.pn * tstep : cB;
        for (int t = 0; t < nt; t += 2) {
            const bool last = (t == nt - 2);
            const char* a1 = cA + (size_t)(t + 1) * kstep;
            const char* a2 = last ? nA : cA + (size_t)(t + 2) * kstep; const char* b2 = last ? nB : cB + (size_t)(t + 2) * kstep;
            const char* a3 = a2 + kstep; const char* b3 = b2 + kstep;
            if (last && has_next) S.a_ready(nxt);
            if constexpr (SP2) {
            PG8_LDB(B0, 0, 0); PG8_LDB(B1, 0, 1); PG8_SCHED; PG8_LDA(At, 0, 0); PG8_STAGE(PG8_SA(1, 1), a1 + hstep, voffA);
            PG8_WAIT_V(8); PG8_WAIT_L(0); PG8_BAR; PG8_MMA(0, 0, At, B0); PG8_MMA(0, 1, At, B1); PG8_BAR; PG8_SCHED;
            PG8_LDA(At, 0, 1); PG8_STAGE(PG8_SB(0, 0), b2, voffB); PG8_STAGE(PG8_SB(0, 1), b2 + hstep, voffB); PG8_STAGE(PG8_SA(0, 0), a2, voffA);
            PG8_WAIT_V(8); PG8_WAIT_L(0); PG8_BAR; PG8_MMA(1, 0, At, B0); PG8_MMA(1, 1, At, B1); PG8_BAR; PG8_SCHED;
            PG8_LDB(B0, 1, 0); PG8_LDB(B1, 1, 1); PG8_SCHED; PG8_LDA(At, 1, 0); PG8_STAGE(PG8_SA(0, 1), a2 + hstep, voffA);
            PG8_WAIT_V(8); PG8_WAIT_L(0); PG8_BAR; PG8_MMA(0, 0, At, B0); PG8_MMA(0, 1, At, B1); PG8_BAR; PG8_SCHED;
            PG8_LDA(At, 1, 1); PG8_STAGE(PG8_SB(1, 0), b3, voffB); PG8_STAGE(PG8_SB(1, 1), b3 + hstep, voffB); PG8_STAGE(PG8_SA(1, 0), a3, voffA);
            PG8_WAIT_V(8); PG8_WAIT_L(0); PG8_BAR; PG8_MMA(1, 0, At, B0); PG8_MMA(1, 1, At, B1); PG8_BAR; PG8_SCHED;
            } else {
            PG8_LDB(B0, 0, 0); PG8_SCHED; PG8_LDA(At, 0, 0); PG8_STAGE(PG8_SA(1, 1), a1 + hstep, voffA);
            PG8_WAIT_L(8); PG8_BAR; PG8_WAIT_L(0); PG8_MMA(0, 0, At, B0); PG8_BAR; PG8_SCHED;
            PG8_LDB(B1, 0, 1); PG8_STAGE(PG8_SB(0, 0), b2, voffB);
            PG8_BAR; PG8_WAIT_L(0); PG8_MMA(0, 1, At, B1); PG8_BAR;
            PG8_LDA(At, 0, 1); PG8_STAGE(PG8_SA(0, 0), a2, voffA);
            PG8_BAR; PG8_WAIT_L(0); PG8_MMA(1, 0, At, B0); PG8_BAR; PG8_SCHED;
            PG8_STAGE(PG8_SB(0, 1), b2 + hstep, voffB);
            PG8_WAIT_V(6); PG8_BAR; PG8_MMA(1, 1, At, B1); PG8_BAR;
            PG8_LDB(B0, 1, 0); PG8_SCHED; PG8_LDA(At, 1, 0); PG8_STAGE(PG8_SA(0, 1), a2 + hstep, voffA);
            PG8_WAIT_L(8); PG8_BAR; PG8_WAIT_L(0); PG8_MMA(0, 0, At, B0); PG8_BAR; PG8_SCHED;
            PG8_LDB(B1, 1, 1); PG8_STAGE(PG8_SB(1, 0), b3, voffB);
            PG8_BAR; PG8_WAIT_L(0); PG8_MMA(0, 1, At, B1); PG8_BAR;
            PG8_LDA(At, 1, 1); PG8_STAGE(PG8_SA(1, 0), a3, voffA);
            PG8_BAR; PG8_WAIT_L(0); PG8_MMA(1, 0, At, B0); PG8_BAR; PG8_SCHED;
            PG8_STAGE(PG8_SB(1, 1), b3 + hstep, voffB);
            PG8_WAIT_V(6); PG8_BAR; PG8_MMA(1, 1, At, B1); PG8_BAR;
            }
        }
        if constexpr (ALIGN_EPI) { if (wr == 0) PG8_BAR; }
        E(acc, cur, wr, wc, fr, fq); S.done(cur);
        if (!has_next) break;
#pragma unroll
        for (int a = 0; a < 2; ++a)
#pragma unroll
            for (int b = 0; b < 2; ++b)
#pragma unroll
                for (int m = 0; m < 4; ++m)
#pragma unroll
                    for (int n = 0; n < 2; ++n) acc[a][b][m][n] = (f32x4){0.f, 0.f, 0.f, 0.f};
        cur = nxt; cA = nA; cB = nB; ++ui;
        if constexpr (ALIGN_EPI) { if (wr == 1) PG8_BAR; }
    }
    PG8_WAIT_V(0);
    if constexpr (!ALIGN_EPI) { if (wr == 0) PG8_BAR; }
    PG8_BAR;
#undef PG8_SA
#undef PG8_SB
#undef PG8_STAGE
#undef PG8_LDA
#undef PG8_LDB
#undef PG8_MMA
#undef PG8_WAIT_V
#undef PG8_WAIT_L
#undef PG8_BAR
#undef PG8_SCHED
}
}
constexpr int D = 1024, NB = 4, SEQ = 8192, DB = 8, DSEQ = 64, NMB = NB + DB;
constexpr int GH = 8, GDK = 128, GDV = 128;
constexpr int SH = 32, SP = 64, SN = 128, SG = 8;
constexpr int DFF = 2816, CONV_CH = 7168, IN_COLS = 12336;
constexpr int NPROJ = 12288;
constexpr int NIN = 12544;
constexpr int NUP = 2 * DFF;
constexpr float EPS = 1e-6f;
#ifndef SLAB_T
#define SLAB_T 1024
#endif
constexpr int NSLAB = SEQ / SLAB_T, RP = NB * SLAB_T, RS = DB * DSEQ, RMAX = RP + RS;
constexpr size_t O_YP = 0, O_YS = O_YP + (size_t)NB * SEQ * D, O_CMP = O_YS + (size_t)DB * DSEQ * D, O_GP = O_CMP + (size_t)NB * 3 * CONV_CH,
                 O_SP = O_GP + (size_t)NB * GH * GDK * GDV, O_CFP = O_SP + (size_t)NB * SH * SN * SP, O_CMS = O_CFP + (size_t)NB * 2 * NUP,
                 O_GS = O_CMS + (size_t)DB * 3 * CONV_CH, O_SS = O_GS + (size_t)DB * GH * GDK * GDV, O_CFS = O_SS + (size_t)DB * SH * SN * SP,
                 O_END = O_CFS + (size_t)DB * 2 * NUP;
constexpr size_t MiB = 1u << 20;
constexpr size_t WS_CTL = 0, CTL_ZERO_BYTES = 1 * MiB;
constexpr size_t WS_MODV = 1 * MiB;
constexpr size_t WS_G1 = WS_MODV + 512 * 1024;
constexpr size_t WS_G2 = WS_G1 + 64 * 1024;
constexpr size_t WS_SHW = WS_G2 + 64 * 1024;
constexpr size_t WS_CARRY_MIX = 2 * MiB;
constexpr size_t WS_CARRY_FFN = 3 * MiB;
constexpr size_t WS_WIN = 4 * MiB;
constexpr size_t WS_WG = WS_WIN + (size_t)NIN * D * 2;
constexpr size_t WS_WS = WS_WG + (size_t)D * D * 2;
constexpr size_t WS_WOUT = WS_WS + (size_t)D * 2048 * 2;
constexpr size_t WS_WUP = WS_WOUT + (size_t)D * D * 2;
constexpr size_t WS_WDN = WS_WUP + (size_t)NUP * D * 2;
constexpr size_t WS_SLAB = 56 * MiB;
static_assert(WS_WDN + (size_t)D * DFF * 2 <= WS_SLAB, "weights fit");
constexpr size_t SZ_HB = (size_t)RMAX * D * 2, SZ_PROJ = (size_t)RMAX * NPROJ * 2, SZ_SM = (size_t)RMAX * 64 * 4, SZ_OG = (size_t)RMAX * D * 2, SZ_YS = (size_t)RMAX * 2048 * 2,
                 SZ_T1 = (size_t)RMAX * D * 4, SZ_MIX = (size_t)RMAX * D * 2, SZ_X1 = (size_t)RMAX * D * 4, SZ_X1G = (size_t)RMAX * D * 2, SZ_SS = (size_t)RMAX * 16 * 4,
                 SZ_U = (size_t)RMAX * NUP * 2, SZ_ACT = (size_t)RMAX * DFF * 2;
constexpr size_t WS_HB = WS_SLAB, WS_PROJ = WS_HB + SZ_HB, WS_SM = WS_PROJ + SZ_PROJ, WS_OG = WS_SM + SZ_SM, WS_YS = WS_OG + SZ_OG, WS_T1 = WS_YS + SZ_YS, WS_MIX = WS_T1 + SZ_T1,
                 WS_X1 = WS_MIX + SZ_MIX, WS_X1G = WS_X1 + SZ_X1, WS_SS1 = WS_X1G + SZ_X1G, WS_SS2 = WS_SS1 + SZ_SS, WS_U = WS_SS2 + SZ_SS, WS_ACT = WS_U + SZ_U, WS_END = WS_ACT + SZ_ACT;
static_assert(WS_END <= 480 * MiB, "workspace map fits");
constexpr int RING_BYTES = 131072, LDSCTL_OFF = RING_BYTES, MISC_OFF = LDSCTL_OFF + 320, LDS_BYTES = 147456;
constexpr int NWAVES = 8, NTHR = 512;

#define GAS __attribute__((address_space(1)))
#define LAS __attribute__((address_space(3)))
typedef unsigned short bf16;
typedef unsigned v4u __attribute__((ext_vector_type(4)));
typedef unsigned v2u __attribute__((ext_vector_type(2)));
typedef float f32x4 __attribute__((ext_vector_type(4)));
typedef GAS unsigned gu32;
#define RLX_AGENT __ATOMIC_RELAXED, __HIP_MEMORY_SCOPE_AGENT
#define LDS_WAIT() asm volatile("s_waitcnt lgkmcnt(0)" ::: "memory")
#define VM_WAIT() asm volatile("s_waitcnt vmcnt(0)" ::: "memory")
__device__ __forceinline__ unsigned f2bf(float f) { unsigned u = __builtin_bit_cast(unsigned, f); return (u + 0x7fffu + ((u >> 16) & 1u)) >> 16; }
__device__ __forceinline__ unsigned pk2(float lo, float hi) { return f2bf(lo) | (f2bf(hi) << 16); }
__device__ __forceinline__ float bf2f(unsigned short h) { return __builtin_bit_cast(float, (unsigned)h << 16); }
__device__ __forceinline__ float bflo(unsigned w) { return __builtin_bit_cast(float, w << 16); }
__device__ __forceinline__ float bfhi(unsigned w) { return __builtin_bit_cast(float, w & 0xffff0000u); }
__device__ __forceinline__ float sigmoidf_(float x) { return 1.f / (1.f + __expf(-x)); }
__device__ __forceinline__ float siluf_(float x) { return x / (1.f + __expf(-x)); }
__device__ __forceinline__ float softplusf_(float x) { return x > 20.f ? x : log1pf(__expf(x)); }
__device__ __forceinline__ float wave_sum(float v) {
#pragma unroll
    for (int o = 1; o < 64; o <<= 1) v += __shfl_xor(v, o);
    return v;
}

struct Args { const float* in[30]; float* out; unsigned char* ws; int ph_lo, ph_hi; };

struct Frame {
    LAS unsigned char* lds;
    volatile LAS unsigned* MISC;
    gu32* ctl;
    int tid, lane, wave, G, bid;
    const Args& A;
    float* out; unsigned char* ws;
    __device__ __forceinline__ Frame(const Args& a) : A(a) {}
};
__device__ __forceinline__ int row_mb(int r) { return r < RP ? (r / SLAB_T) : NB + ((r - RP) / DSEQ); }
__device__ __forceinline__ size_t row_goff(int s, int r) {
    if (r < RP) { const int b = r / SLAB_T, tl = r % SLAB_T; return ((size_t)b * SEQ + (size_t)s * SLAB_T + tl) * D; }
    return (size_t)(r - RP) * D;
}
__device__ __forceinline__ int slab_rows(int s) { return s == 0 ? RMAX : RP; }
struct MapWin { __device__ __forceinline__ int operator()(int n) const { return n < 10240 ? n : (n < 12288 ? n + 48 : (n < 12336 ? n - 2048 : -1)); } };
struct MapId  { __device__ __forceinline__ int operator()(int n) const { return n; } };
struct MapUp  { __device__ __forceinline__ int operator()(int n) const { const int j = n >> 8, c = n & 255; return c < 128 ? 128 * j + c : DFF + 128 * j + (c - 128); } };
template <class Map>
__device__ __forceinline__ void p0_transpose_item(const float* W, int ldw, int K, bf16* WT, Map map, LAS float* scr, int item, int nblk, int lane) {
    const int kb = item / nblk, nb = item % nblk, k0 = 64 * kb, n0 = 32 * nb;
    const int sc = map(n0 + (lane & 31));
#pragma unroll 8
    for (int i = 0; i < 32; ++i) { const int kk = 2 * i + (lane >> 5); scr[kk * 33 + (lane & 31)] = sc >= 0 ? W[(size_t)(k0 + kk) * ldw + sc] : 0.f; }
    LDS_WAIT(); asm volatile("" ::: "memory");
    const int c = lane & 7;
#pragma unroll
    for (int j = 0; j < 4; ++j) { const int n = (lane >> 3) + 8 * j; const LAS float* s = scr + (8 * c) * 33 + n;
        v4u o; o.x = pk2(s[0 * 33], s[1 * 33]); o.y = pk2(s[2 * 33], s[3 * 33]); o.z = pk2(s[4 * 33], s[5 * 33]); o.w = pk2(s[6 * 33], s[7 * 33]);
        *(GAS v4u*)(WT + (size_t)(n0 + n) * K + k0 + 8 * c) = o; }
    LDS_WAIT(); asm volatile("" ::: "memory");
}
__device__ __forceinline__ void p0_mod_item(Frame& F, int item) {
    LAS float* sc = (LAS float*)F.lds; LAS float* red = (LAS float*)(F.lds + 49152);
    const float* cp = F.A.in[6]; const float* cs = F.A.in[7]; const float* w_ada = F.A.in[8]; const float* b_ada = F.A.in[9];
    for (int idx = F.tid; idx < NMB * D; idx += NTHR) { const int b = idx / D, k = idx % D; const float c = b < NB ? cp[b * D + k] : cs[(b - NB) * D + k]; sc[idx] = siluf_(c); }
    __syncthreads();
    float acc[NMB];
#pragma unroll
    for (int b = 0; b < NMB; ++b) acc[b] = 0.f;
    const int col = item * 64 + F.lane, kb = F.wave * 128;
    for (int k = 0; k < 128; ++k) { const float wv = w_ada[(size_t)(kb + k) * 6144 + col];
#pragma unroll
        for (int b = 0; b < NMB; ++b) acc[b] += sc[b * D + kb + k] * wv; }
#pragma unroll
    for (int b = 0; b < NMB; ++b) red[(F.wave * NMB + b) * 64 + F.lane] = acc[b];
    __syncthreads();
    float* modv = (float*)(F.ws + WS_MODV);
    for (int idx = F.tid; idx < NMB * 64; idx += NTHR) { const int b = idx / 64, l = idx % 64; float s = b_ada[item * 64 + l];
#pragma unroll
        for (int w = 0; w < 8; ++w) s += red[(w * NMB + b) * 64 + l];
        modv[b * 6144 + item * 64 + l] = s; }
    __syncthreads();
}
__device__ __forceinline__ void phase_prologue0(Frame& F) {
    for (int it = F.bid; it < 96; it += F.G) p0_mod_item(F, it);
    LAS float* scr = (LAS float*)(F.lds + F.wave * 16384);
    const int gw = F.bid * NWAVES + F.wave, NGW = F.G * NWAVES;
    constexpr int I_IN = (D / 64) * (NIN / 32), I_G = (D / 64) * (D / 32), I_S = (2048 / 64) * (D / 32), I_O = I_G, I_UP = (D / 64) * (NUP / 32), I_DN = (DFF / 64) * (D / 32);
    constexpr int NITEMS = I_IN + I_G + I_S + I_O + I_UP + I_DN;
    for (int it = gw; it < NITEMS; it += NGW) {
        int r = it;
        if (r < I_IN) { p0_transpose_item(F.A.in[11], IN_COLS, D, (bf16*)(F.ws + WS_WIN), MapWin(), scr, r, NIN / 32, F.lane); continue; } r -= I_IN;
        if (r < I_G) { p0_transpose_item(F.A.in[21], D, D, (bf16*)(F.ws + WS_WG), MapId(), scr, r, D / 32, F.lane); continue; } r -= I_G;
        if (r < I_S) { p0_transpose_item(F.A.in[22], D, 2048, (bf16*)(F.ws + WS_WS), MapId(), scr, r, D / 32, F.lane); continue; } r -= I_S;
        if (r < I_O) { p0_transpose_item(F.A.in[23], D, D, (bf16*)(F.ws + WS_WOUT), MapId(), scr, r, D / 32, F.lane); continue; } r -= I_O;
        if (r < I_UP) { p0_transpose_item(F.A.in[25], NUP, D, (bf16*)(F.ws + WS_WUP), MapUp(), scr, r, NUP / 32, F.lane); continue; } r -= I_UP;
        p0_transpose_item(F.A.in[28], D, DFF, (bf16*)(F.ws + WS_WDN), MapId(), scr, r, D / 32, F.lane);
    }
}
__device__ __forceinline__ void phase_prologue1(Frame& F) {
    const float* modv = (const float*)(F.ws + WS_MODV);
    float* g1 = (float*)(F.ws + WS_G1); float* g2 = (float*)(F.ws + WS_G2); float* shw = (float*)(F.ws + WS_SHW);
    for (int idx = F.bid * NTHR + F.tid; idx < NMB * D; idx += F.G * NTHR) { const int b = idx / D, k = idx % D;
        g1[idx] = F.A.in[10][k] * (1.f + modv[b * 6144 + 1024 + k]); g2[idx] = F.A.in[24][k] * (1.f + modv[b * 6144 + 4096 + k]); }
    LAS float* sh = (LAS float*)F.lds;
    for (int idx = F.tid; idx < NMB * D; idx += NTHR) sh[idx] = modv[(idx / D) * 6144 + 3072 + (idx % D)];
    __syncthreads();
    const bf16* wup = (const bf16*)(F.ws + WS_WUP);
    const int gw = F.bid * NWAVES + F.wave, NGW = F.G * NWAVES;
    for (int n = gw; n < NUP; n += NGW) {
        const GAS v4u* wr = (const GAS v4u*)(wup + (size_t)n * D + F.lane * 16);
        const v4u w0 = wr[0], w1 = wr[1];
        float wf[16] = {bflo(w0.x), bfhi(w0.x), bflo(w0.y), bfhi(w0.y), bflo(w0.z), bfhi(w0.z), bflo(w0.w), bfhi(w0.w), bflo(w1.x), bfhi(w1.x), bflo(w1.y), bfhi(w1.y), bflo(w1.z), bfhi(w1.z), bflo(w1.w), bfhi(w1.w)};
        float res = 0.f;
#pragma unroll
        for (int b = 0; b < NMB; ++b) { float a = 0.f;
#pragma unroll
            for (int i = 0; i < 16; ++i) a += wf[i] * sh[b * D + F.lane * 16 + i];
            a = wave_sum(a); if (F.lane == b) res = a; }
        if (F.lane < NMB) shw[F.lane * NUP + n] = res;
    }
    __syncthreads();
}
__device__ __forceinline__ void phase_norm1(Frame& F, int s) {
    const float* modv = (const float*)(F.ws + WS_MODV); const float* g1 = (const float*)(F.ws + WS_G1); bf16* hb = (bf16*)(F.ws + WS_HB);
    const int gw = F.bid * NWAVES + F.wave, NGW = F.G * NWAVES, R = slab_rows(s);
    for (int r = gw; r < R; r += NGW) {
        const float* xrow = (r < RP ? F.A.in[0] : F.A.in[1]) + row_goff(s, r); const int mb = row_mb(r);
        const GAS f32x4* xr = (const GAS f32x4*)xrow + F.lane;
        f32x4 v[4]; float ss = 0.f;
#pragma unroll
        for (int j = 0; j < 4; ++j) { v[j] = xr[64 * j]; ss += (v[j].x * v[j].x + v[j].y * v[j].y) + (v[j].z * v[j].z + v[j].w * v[j].w); }
        const float rs = rsqrtf(wave_sum(ss) * (1.f / D) + EPS);
        GAS v2u* o8 = (GAS v2u*)(hb + (size_t)r * D) + F.lane;
#pragma unroll
        for (int j = 0; j < 4; ++j) { const int k = 4 * F.lane + 256 * j; const f32x4 g = *(const GAS f32x4*)(g1 + mb * D + k); const f32x4 sh = *(const GAS f32x4*)(modv + mb * 6144 + k);
            v2u o; o.x = pk2(v[j].x * rs * g.x + sh.x, v[j].y * rs * g.y + sh.y); o.y = pk2(v[j].z * rs * g.z + sh.z, v[j].w * rs * g.w + sh.w); o8[64 * j] = o; }
    }
}
__device__ __forceinline__ void phase_final(Frame& F, int s) {
    const float* ss2 = (const float*)(F.ws + WS_SS2); const float* wf = F.A.in[29];
    const int gw = F.bid * NWAVES + F.wave, NGW = F.G * NWAVES, R = slab_rows(s);
    for (int r = gw; r < R; r += NGW) {
        float* yrow = F.out + (r < RP ? O_YP : O_YS) + row_goff(s, r);
        float t = F.lane < 16 ? ss2[(size_t)r * 16 + F.lane] : 0.f; t = wave_sum(t);
        const float rs = rsqrtf(t * (1.f / D) + EPS);
        GAS f32x4* yr = (GAS f32x4*)yrow + F.lane;
#pragma unroll
        for (int j = 0; j < 4; ++j) { f32x4 v = yr[64 * j]; const f32x4 w = *(const GAS f32x4*)(wf + 4 * F.lane + 256 * j); v.x *= rs * w.x; v.y *= rs * w.y; v.z *= rs * w.z; v.w *= rs * w.w; yr[64 * j] = v; }
    }
}
__device__ __forceinline__ void u_hist_row(Frame& F, int s, int r, int back, int c8, int j, int cc, float (&ua)[8], float (&uv)[8]) {
    const bf16* U = (const bf16*)(F.ws + WS_U);
    int tl, b; bool samp = r >= RP;
    if (!samp) { b = r / SLAB_T; tl = r % SLAB_T; } else { b = (r - RP) / DSEQ; tl = (r - RP) % DSEQ; }
    if (tl - back >= 0) {
        const bf16* p = U + (size_t)(r - back) * NUP + 256 * j + cc;
        const v4u a = *(const GAS v4u*)p, v = *(const GAS v4u*)(p + 128);
        ua[0] = bflo(a.x); ua[1] = bfhi(a.x); ua[2] = bflo(a.y); ua[3] = bfhi(a.y); ua[4] = bflo(a.z); ua[5] = bfhi(a.z); ua[6] = bflo(a.w); ua[7] = bfhi(a.w);
        uv[0] = bflo(v.x); uv[1] = bfhi(v.x); uv[2] = bflo(v.y); uv[3] = bfhi(v.y); uv[4] = bflo(v.z); uv[5] = bfhi(v.z); uv[6] = bflo(v.w); uv[7] = bfhi(v.w);
        return;
    }
    const int hi = 2 + (tl - back);
    if (samp) { const float* st = F.A.in[5] + ((size_t)b * 2 + hi) * NUP;
#pragma unroll
        for (int i = 0; i < 8; ++i) { ua[i] = st[c8 + i]; uv[i] = st[DFF + c8 + i]; } return; }
    if (s == 0) {
#pragma unroll
        for (int i = 0; i < 8; ++i) { ua[i] = 0.f; uv[i] = 0.f; } return; }
    const float* cf = (const float*)(F.ws + WS_CARRY_FFN) + (((size_t)(s & 1) * NB + b) * 2 + hi) * NUP + 256 * j + cc;
#pragma unroll
    for (int i = 0; i < 8; ++i) { ua[i] = cf[i]; uv[i] = cf[128 + i]; }
}
__device__ __forceinline__ void phase_convact(Frame& F, int s) {
    const bf16* U = (const bf16*)(F.ws + WS_U); bf16* ACT = (bf16*)(F.ws + WS_ACT);
    const float* wc = F.A.in[26]; const float* bc = F.A.in[27];
    const int R = slab_rows(s); const long total = (long)R * (DFF / 8);
    for (long idx = (long)F.bid * NTHR + F.tid; idx < total; idx += (long)F.G * NTHR) {
        const int r = (int)(idx / (DFF / 8)), c8 = (int)(idx % (DFF / 8)) * 8, j = c8 >> 7, cc = c8 & 127;
        float a0[8], v0[8], a1[8], v1[8], a2[8], v2[8];
        u_hist_row(F, s, r, 0, c8, j, cc, a2, v2); u_hist_row(F, s, r, 1, c8, j, cc, a1, v1); u_hist_row(F, s, r, 2, c8, j, cc, a0, v0);
        float o[8];
#pragma unroll
        for (int i = 0; i < 8; ++i) { const int ca = c8 + i, cv = DFF + c8 + i;
            const float xa = bc[ca] + wc[ca] * a0[i] + wc[NUP + ca] * a1[i] + wc[2 * NUP + ca] * a2[i];
            const float xv = bc[cv] + wc[cv] * v0[i] + wc[NUP + cv] * v1[i] + wc[2 * NUP + cv] * v2[i];
            o[i] = siluf_(xa) * xv; }
        v4u w; w.x = pk2(o[0], o[1]); w.y = pk2(o[2], o[3]); w.z = pk2(o[4], o[5]); w.w = pk2(o[6], o[7]);
        *(GAS v4u*)(ACT + (size_t)r * DFF + c8) = w;
    }
    float* cfn = (float*)(F.ws + WS_CARRY_FFN) + (size_t)((s + 1) & 1) * NB * 2 * NUP;
    for (int idx = F.bid * NTHR + F.tid; idx < NB * 2 * NUP; idx += F.G * NTHR) {
        const int b = idx / (2 * NUP), i = (idx / NUP) % 2, c = idx % NUP; const int r = b * SLAB_T + SLAB_T - 2 + i;
        const float v = bf2f(U[(size_t)r * NUP + c]); cfn[idx] = v;
        if (s == NSLAB - 1) { const int j = c >> 8, cc = c & 255; const int oc = cc < 128 ? 128 * j + cc : DFF + 128 * j + (cc - 128); F.out[O_CFP + ((size_t)b * 2 + i) * NUP + oc] = v; }
    }
    if (s == 0) for (int idx = F.bid * NTHR + F.tid; idx < DB * 2 * NUP; idx += F.G * NTHR) {
        const int b = idx / (2 * NUP), i = (idx / NUP) % 2, c = idx % NUP; const int r = RP + b * DSEQ + DSEQ - 2 + i;
        const int j = c >> 8, cc = c & 255; const int oc = cc < 128 ? 128 * j + cc : DFF + 128 * j + (cc - 128);
        F.out[O_CFS + ((size_t)b * 2 + i) * NUP + oc] = bf2f(U[(size_t)r * NUP + c]);
    }
}
__device__ __forceinline__ void phase_mix_carry(Frame& F, int s) {
    const bf16* P = (const bf16*)(F.ws + WS_PROJ);
    float* cmn = (float*)(F.ws + WS_CARRY_MIX) + (size_t)((s + 1) & 1) * NB * 3 * CONV_CH;
    for (int idx = F.bid * NTHR + F.tid; idx < NB * 3 * CONV_CH; idx += F.G * NTHR) {
        const int b = idx / (3 * CONV_CH), i = (idx / CONV_CH) % 3, c = idx % CONV_CH; const int r = b * SLAB_T + SLAB_T - 3 + i;
        const float v = bf2f(P[(size_t)r * NPROJ + c]); cmn[idx] = v;
        if (s == NSLAB - 1) F.out[O_CMP + idx] = v;
    }
    if (s == 0) for (int idx = F.bid * NTHR + F.tid; idx < DB * 3 * CONV_CH; idx += F.G * NTHR) {
        const int b = idx / (3 * CONV_CH), i = (idx / CONV_CH) % 3, c = idx % CONV_CH; const int r = RP + b * DSEQ + DSEQ - 3 + i;
        F.out[O_CMS + idx] = bf2f(P[(size_t)r * NPROJ + c]);
    }
}
namespace epi {
using pg8::f32x4; using pg8::Unit; using pg8::BM; using pg8::HALF; using pg8::cvt_pk_bf16; using pg8::u32x4; using pg8::u32x2;
struct EpiProj {
    static constexpr bool PERM = true;
    bf16* P; float* SM;
    __device__ __forceinline__ void operator()(const f32x4 (&acc)[2][2][4][2], const Unit& u, int wr, int wc, int fr, int fq) const {
        const int row0 = u.pm * BM + wr * 64 + fr;
        if (u.pn == 48) {
            if (wc < 2) {
#pragma unroll
                for (int ai = 0; ai < 2; ++ai)
#pragma unroll
                    for (int m = 0; m < 4; ++m) { float* rp = SM + (size_t)(row0 + ai * HALF + m * 16) * 64 + wc * 32 + 8 * fq;
                        *(f32x4*)rp = acc[ai][0][m][0]; *(f32x4*)(rp + 4) = acc[ai][0][m][1]; }
            }
            return;
        }
        const bool sg = u.pn >= 40;
        const int col0 = u.pn * BM + wc * 32 + 8 * fq;
#pragma unroll
        for (int ai = 0; ai < 2; ++ai)
#pragma unroll
            for (int m = 0; m < 4; ++m) { bf16* rowp = P + (size_t)(row0 + ai * HALF + m * 16) * NPROJ + col0;
#pragma unroll
                for (int bj = 0; bj < 2; ++bj) { f32x4 v0 = acc[ai][bj][m][0], v1 = acc[ai][bj][m][1];
                    if (sg) {
#pragma unroll
                        for (int i = 0; i < 4; ++i) { v0[i] = sigmoidf_(v0[i]); v1[i] = sigmoidf_(v1[i]); } }
                    u32x4 w; w.x = cvt_pk_bf16(v0[0], v0[1]); w.y = cvt_pk_bf16(v0[2], v0[3]); w.z = cvt_pk_bf16(v1[0], v1[1]); w.w = cvt_pk_bf16(v1[2], v1[3]);
                    *(u32x4*)(rowp + bj * HALF) = w; } }
    }
};
struct EpiGate1 {
    static constexpr bool PERM = false;
    const bf16* P; float* T1;
    __device__ __forceinline__ void operator()(const f32x4 (&acc)[2][2][4][2], const Unit& u, int wr, int wc, int fr, int fq) const {
        const int row0 = u.pm * BM + wr * 64 + fr, col0 = u.pn * BM + wc * 32 + 4 * fq;
#pragma unroll
        for (int ai = 0; ai < 2; ++ai)
#pragma unroll
            for (int m = 0; m < 4; ++m) { const size_t r = (size_t)(row0 + ai * HALF + m * 16);
#pragma unroll
                for (int bj = 0; bj < 2; ++bj)
#pragma unroll
                    for (int n = 0; n < 2; ++n) { const int c = col0 + bj * HALF + n * 16; const u32x2 g = *(const u32x2*)(P + r * NPROJ + 10240 + c); const f32x4 a = acc[ai][bj][m][n];
                        f32x4 o; o.x = a.x * bflo(g.x); o.y = a.y * bfhi(g.x); o.z = a.z * bflo(g.y); o.w = a.w * bfhi(g.y); *(f32x4*)(T1 + r * D + c) = o; } }
    }
};
struct EpiGate2 {
    static constexpr bool PERM = false;
    const bf16* P; const float* T1; bf16* MIX;
    __device__ __forceinline__ void operator()(const f32x4 (&acc)[2][2][4][2], const Unit& u, int wr, int wc, int fr, int fq) const {
        const int row0 = u.pm * BM + wr * 64 + fr, col0 = u.pn * BM + wc * 32 + 4 * fq;
#pragma unroll
        for (int ai = 0; ai < 2; ++ai)
#pragma unroll
            for (int m = 0; m < 4; ++m) { const size_t r = (size_t)(row0 + ai * HALF + m * 16);
#pragma unroll
                for (int bj = 0; bj < 2; ++bj)
#pragma unroll
                    for (int n = 0; n < 2; ++n) { const int c = col0 + bj * HALF + n * 16; const u32x2 g = *(const u32x2*)(P + r * NPROJ + 11264 + c); const f32x4 a = acc[ai][bj][m][n];
                        const f32x4 t = *(const f32x4*)(T1 + r * D + c);
                        u32x2 o; o.x = cvt_pk_bf16(t.x + a.x * bflo(g.x), t.y + a.y * bfhi(g.x)); o.y = cvt_pk_bf16(t.z + a.z * bflo(g.y), t.w + a.w * bfhi(g.y)); *(u32x2*)(MIX + r * D + c) = o; } }
    }
};
struct EpiOut {
    static constexpr bool PERM = false;
    const float* xp; const float* xs; const float* modv; const float* g2; float* X1; bf16* X1G; float* SS; int slab;
    __device__ __forceinline__ void operator()(const f32x4 (&acc)[2][2][4][2], const Unit& u, int wr, int wc, int fr, int fq) const {
        const int col0 = u.pn * BM + wc * 32 + 4 * fq;
#pragma unroll
        for (int ai = 0; ai < 2; ++ai) {
            const int rb = u.pm * BM + ai * HALF + wr * 64; const int mb = row_mb(rb);
#pragma unroll
            for (int m = 0; m < 4; ++m) { const int r = rb + m * 16 + fr; const float* xrow = (r < RP ? xp : xs) + row_goff(slab, r); float sq = 0.f;
#pragma unroll
                for (int bj = 0; bj < 2; ++bj)
#pragma unroll
                    for (int n = 0; n < 2; ++n) { const int c = col0 + bj * HALF + n * 16; const f32x4 a = acc[ai][bj][m][n];
                        const f32x4 xv = *(const f32x4*)(xrow + c), gt = *(const f32x4*)(modv + mb * 6144 + 2048 + c), gg = *(const f32x4*)(g2 + mb * D + c);
                        f32x4 o = xv + gt * a; *(f32x4*)(X1 + (size_t)r * D + c) = o; sq += (o.x * o.x + o.y * o.y) + (o.z * o.z + o.w * o.w);
                        u32x2 w; w.x = cvt_pk_bf16(o.x * gg.x, o.y * gg.y); w.y = cvt_pk_bf16(o.z * gg.z, o.w * gg.w); *(u32x2*)(X1G + (size_t)r * D + c) = w; }
                sq += __shfl_xor(sq, 16); sq += __shfl_xor(sq, 32);
                if (fq == 0) SS[(size_t)r * 16 + u.pn * 4 + wc] = sq; }
        }
    }
};
struct EpiUp {
    static constexpr bool PERM = true;
    const float* SS; const float* shw; bf16* U;
    __device__ __forceinline__ void operator()(const f32x4 (&acc)[2][2][4][2], const Unit& u, int wr, int wc, int fr, int fq) const {
        const int col0 = u.pn * BM + wc * 32 + 8 * fq;
#pragma unroll
        for (int ai = 0; ai < 2; ++ai) {
            const int rb = u.pm * BM + ai * HALF + wr * 64; const int mb = row_mb(rb);
            f32x4 sv[2][2];
#pragma unroll
            for (int bj = 0; bj < 2; ++bj)
#pragma unroll
                for (int n = 0; n < 2; ++n) sv[bj][n] = *(const f32x4*)(shw + mb * NUP + col0 + bj * HALF + 4 * n);
#pragma unroll
            for (int m = 0; m < 4; ++m) { const int r = rb + m * 16 + fr; const f32x4* sp = (const f32x4*)(SS + (size_t)r * 16);
                const f32x4 s0 = sp[0], s1 = sp[1], s2 = sp[2], s3 = sp[3];
                const float tot = ((s0.x + s0.y) + (s0.z + s0.w)) + ((s1.x + s1.y) + (s1.z + s1.w)) + ((s2.x + s2.y) + (s2.z + s2.w)) + ((s3.x + s3.y) + (s3.z + s3.w));
                const float rs = rsqrtf(tot * (1.f / D) + EPS);
#pragma unroll
                for (int bj = 0; bj < 2; ++bj) { const f32x4 v0 = acc[ai][bj][m][0] * rs + sv[bj][0], v1 = acc[ai][bj][m][1] * rs + sv[bj][1];
                    u32x4 w; w.x = cvt_pk_bf16(v0[0], v0[1]); w.y = cvt_pk_bf16(v0[2], v0[3]); w.z = cvt_pk_bf16(v1[0], v1[1]); w.w = cvt_pk_bf16(v1[2], v1[3]);
                    *(u32x4*)(U + (size_t)r * NUP + col0 + bj * HALF) = w; } }
        }
    }
};
struct EpiDown {
    static constexpr bool PERM = false;
    const float* X1; const float* modv; float* yp; float* ys; float* SS; int slab;
    __device__ __forceinline__ void operator()(const f32x4 (&acc)[2][2][4][2], const Unit& u, int wr, int wc, int fr, int fq) const {
        const int col0 = u.pn * BM + wc * 32 + 4 * fq;
#pragma unroll
        for (int ai = 0; ai < 2; ++ai) {
            const int rb = u.pm * BM + ai * HALF + wr * 64; const int mb = row_mb(rb);
#pragma unroll
            for (int m = 0; m < 4; ++m) { const int r = rb + m * 16 + fr; float* yrow = (r < RP ? yp : ys) + row_goff(slab, r); float sq = 0.f;
#pragma unroll
                for (int bj = 0; bj < 2; ++bj)
#pragma unroll
                    for (int n = 0; n < 2; ++n) { const int c = col0 + bj * HALF + n * 16; const f32x4 a = acc[ai][bj][m][n];
                        const f32x4 xv = *(const f32x4*)(X1 + (size_t)r * D + c), gt = *(const f32x4*)(modv + mb * 6144 + 5120 + c);
                        f32x4 o = xv + gt * a; *(f32x4*)(yrow + c) = o; sq += (o.x * o.x + o.y * o.y) + (o.z * o.z + o.w * o.w); }
                sq += __shfl_xor(sq, 16); sq += __shfl_xor(sq, 32);
                if (fq == 0) SS[(size_t)r * 16 + u.pn * 4 + wc] = sq; }
        }
    }
};
}
__device__ __forceinline__ void gdn_naive_job(Frame& F, int s, bool samp, int bb, int h) {
    const bf16* P = (const bf16*)(F.ws + WS_PROJ); const float* SM = (const float*)(F.ws + WS_SM); bf16* OG = (bf16*)(F.ws + WS_OG);
    LAS float* qs = (LAS float*)F.lds; LAS float* ks = qs + 128; LAS float* vs = ks + 128; LAS float* part = vs + 128;
    LAS float* red = part + 8; LAS float* red2 = red + 512; LAS float* part2 = red2 + 512;
    const int tid = F.tid, v = tid & 127, kq = tid >> 7, ntok = samp ? DSEQ : SLAB_T, row0 = samp ? RP + bb * DSEQ : bb * SLAB_T;
    float S[32];
    const size_t sbase = ((size_t)(bb * GH + h) * GDK + kq * 32) * GDV + v;
    if (samp) { const float* st = F.A.in[3] + sbase;
#pragma unroll
        for (int i = 0; i < 32; ++i) S[i] = st[(size_t)i * GDV]; }
    else if (s == 0) {
#pragma unroll
        for (int i = 0; i < 32; ++i) S[i] = 0.f; }
    else { const float* st = F.out + O_GP + sbase;
#pragma unroll
        for (int i = 0; i < 32; ++i) S[i] = st[(size_t)i * GDV]; }
    const int role = tid >> 7, ch = tid & 127, cidx = role * 1024 + h * 128 + ch;
    float h0 = 0.f, h1 = 0.f, h2 = 0.f, w0 = 0.f, w1 = 0.f, w2 = 0.f, w3 = 0.f, bias = 0.f;
    if (tid < 384) {
        const float* wcv = F.A.in[12]; w0 = wcv[cidx]; w1 = wcv[CONV_CH + cidx]; w2 = wcv[2 * CONV_CH + cidx]; w3 = wcv[3 * CONV_CH + cidx]; bias = F.A.in[13][cidx];
        if (samp) { const float* st = F.A.in[2] + (size_t)bb * 3 * CONV_CH + cidx; h0 = st[0]; h1 = st[CONV_CH]; h2 = st[2 * CONV_CH]; }
        else if (s > 0) { const float* st = (const float*)(F.ws + WS_CARRY_MIX) + ((size_t)(s & 1) * NB + bb) * 3 * CONV_CH + cidx; h0 = st[0]; h1 = st[CONV_CH]; h2 = st[2 * CONV_CH]; }
    }
    const float Aexp = __expf(F.A.in[14][h]), dtb = F.A.in[15][h], gnorm = F.A.in[16][v];
    for (int t = 0; t < ntok; ++t) {
        const size_t r = (size_t)(row0 + t);
        if (tid < 384) {
            const float raw = bf2f(P[r * NPROJ + cidx]);
            float val = bias + w0 * h0 + w1 * h1 + w2 * h2 + w3 * raw; h0 = h1; h1 = h2; h2 = raw; val = siluf_(val);
            qs[role * 128 + ch] = val;
            if (role < 2) { const float sq = wave_sum(val * val); if (F.lane == 0) part[F.wave] = sq; }
        }
        __syncthreads();
        const float qsc = rsqrtf(part[0] + part[1] + EPS) * 0.08838834764831845f, ksc = rsqrtf(part[2] + part[3] + EPS);
        const float beta = sigmoidf_(SM[r * 64 + h]); const float g = -Aexp * softplusf_(SM[r * 64 + 8 + h] + dtb); const float a = __expf(g);
        float kn[32]; float p = 0.f;
#pragma unroll
        for (int i = 0; i < 32; ++i) { kn[i] = ks[kq * 32 + i] * ksc; p += kn[i] * S[i]; }
        red[kq * 128 + v] = p;
        __syncthreads();
        const float kS = (red[v] + red[128 + v]) + (red[256 + v] + red[384 + v]);
        const float d = beta * (vs[v] - a * kS);
        float po = 0.f;
#pragma unroll
        for (int i = 0; i < 32; ++i) { S[i] = a * S[i] + kn[i] * d; po += qs[kq * 32 + i] * qsc * S[i]; }
        red2[kq * 128 + v] = po;
        __syncthreads();
        float o = 0.f;
        if (tid < 128) { o = (red2[v] + red2[128 + v]) + (red2[256 + v] + red2[384 + v]); const float sq = wave_sum(o * o); if (F.lane == 0) part2[F.wave] = sq; }
        __syncthreads();
        if (tid < 128) { const float rs = rsqrtf((part2[0] + part2[1]) * (1.f / GDV) + EPS); const float z = bf2f(P[r * NPROJ + 7168 + h * 128 + v]);
            OG[r * D + h * 128 + v] = (bf16)f2bf(o * rs * gnorm * siluf_(z)); }
    }
    float* so = F.out + (samp ? O_GS : O_GP) + sbase;
#pragma unroll
    for (int i = 0; i < 32; ++i) so[(size_t)i * GDV] = S[i];
    __syncthreads();
}
__device__ __forceinline__ void ssd_naive_job(Frame& F, int s, bool samp, int bb, int g) {
    const bf16* P = (const bf16*)(F.ws + WS_PROJ); const float* SM = (const float*)(F.ws + WS_SM); bf16* YS = (bf16*)(F.ws + WS_YS);
    LAS float* xs = (LAS float*)F.lds; LAS float* Bs = xs + 256; LAS float* Cs = Bs + 128; LAS float* red = Cs + 128; LAS float* part = red + 512;
    const int tid = F.tid, hl = tid >> 7, p = tid & 63, nh = (tid >> 6) & 1, head = 4 * g + hl, ntok = samp ? DSEQ : SLAB_T, row0 = samp ? RP + bb * DSEQ : bb * SLAB_T;
    float hr[64];
    const size_t sbase = ((size_t)(bb * SH + head) * SN + nh * 64) * SP + p;
    if (samp) { const float* st = F.A.in[4] + sbase;
#pragma unroll
        for (int i = 0; i < 64; ++i) hr[i] = st[(size_t)i * SP]; }
    else if (s == 0) {
#pragma unroll
        for (int i = 0; i < 64; ++i) hr[i] = 0.f; }
    else { const float* st = F.out + O_SP + sbase;
#pragma unroll
        for (int i = 0; i < 64; ++i) hr[i] = st[(size_t)i * SP]; }
    const int cidx = tid < 256 ? 3072 + g * 256 + tid : (tid < 384 ? 5120 + g * 128 + (tid - 256) : 6144 + g * 128 + (tid - 384));
    const float* wcv = F.A.in[12]; const float w0 = wcv[cidx], w1 = wcv[CONV_CH + cidx], w2 = wcv[2 * CONV_CH + cidx], w3 = wcv[3 * CONV_CH + cidx], bias = F.A.in[13][cidx];
    float h0 = 0.f, h1 = 0.f, h2 = 0.f;
    if (samp) { const float* st = F.A.in[2] + (size_t)bb * 3 * CONV_CH + cidx; h0 = st[0]; h1 = st[CONV_CH]; h2 = st[2 * CONV_CH]; }
    else if (s > 0) { const float* st = (const float*)(F.ws + WS_CARRY_MIX) + ((size_t)(s & 1) * NB + bb) * 3 * CONV_CH + cidx; h0 = st[0]; h1 = st[CONV_CH]; h2 = st[2 * CONV_CH]; }
    const float aneg = -__expf(F.A.in[17][head]), dtb = F.A.in[18][head], Dh = F.A.in[19][head], nw = F.A.in[20][head * 64 + p];
    for (int t = 0; t < ntok; ++t) {
        const size_t r = (size_t)(row0 + t);
        { const float raw = bf2f(P[r * NPROJ + cidx]); float val = bias + w0 * h0 + w1 * h1 + w2 * h2 + w3 * raw; h0 = h1; h1 = h2; h2 = raw; xs[tid] = siluf_(val); }
        __syncthreads();
        const float dt = softplusf_(SM[r * 64 + 16 + head] + dtb), dA = __expf(dt * aneg), x = xs[hl * 64 + p], dx = dt * x;
        float py = 0.f;
#pragma unroll
        for (int i = 0; i < 64; ++i) { hr[i] = dA * hr[i] + dx * Bs[nh * 64 + i]; py += Cs[nh * 64 + i] * hr[i]; }
        red[tid] = py;
        __syncthreads();
        float yz = 0.f;
        if (nh == 0) { const float y = red[tid] + red[tid + 64] + Dh * x; const float z = bf2f(P[r * NPROJ + 8192 + head * 64 + p]); yz = y * siluf_(z);
            const float sq = wave_sum(yz * yz); if (F.lane == 0) part[F.wave] = sq; }
        __syncthreads();
        if (nh == 0) { const float rs = rsqrtf(((part[0] + part[2]) + (part[4] + part[6])) * (1.f / 256.f) + EPS); YS[r * 2048 + head * 64 + p] = (bf16)f2bf(yz * rs * nw); }
    }
    float* so = F.out + (samp ? O_SS : O_SP) + sbase;
#pragma unroll
    for (int i = 0; i < 64; ++i) so[(size_t)i * SP] = hr[i];
    __syncthreads();
}
__device__ __forceinline__ void phase_scan_naive(Frame& F, int s) {
    const int njobs = s == 0 ? 192 : 64;
    for (int j = F.bid; j < njobs; j += F.G) {
        if (j < 32) gdn_naive_job(F, s, false, j >> 3, j & 7);
        else if (j < 64) ssd_naive_job(F, s, false, (j - 32) >> 3, (j - 32) & 7);
        else if (j < 128) gdn_naive_job(F, s, true, (j - 64) >> 3, (j - 64) & 7);
        else ssd_naive_job(F, s, true, (j - 128) >> 3, (j - 128) & 7);
    }
}
#define XB_TMO      128
#define XB_XCNT(j)  (256  + 64 * (j))
#define XB_XSUB(j)  (1280 + 64 * (j))
#define XB_XGEN(j)  (2304 + 64 * (j))
#define XB_TOP      3328
#define XB_TOPGEN   3392
#define XCD_BAR_WORDS 3456
#define XB_SPIN_CAP (1u << 18)
__device__ __forceinline__ unsigned xb_ld(unsigned* p)              { return __hip_atomic_load(p, __ATOMIC_RELAXED, __HIP_MEMORY_SCOPE_AGENT); }
__device__ __forceinline__ unsigned xb_add(unsigned* p, unsigned v) { return __hip_atomic_fetch_add(p, v, __ATOMIC_RELAXED, __HIP_MEMORY_SCOPE_AGENT); }
__device__ __forceinline__ unsigned xb_xcc_id() { return (unsigned)__builtin_amdgcn_s_getreg((3 << 11) | 20) & 0xFu; }
#define XB_SPIN(cond, bar) do { unsigned _sp = 0; while (cond) { __builtin_amdgcn_s_sleep(1); \
    if ((++_sp & 255u) == 0u) { if (xb_ld(&(bar)[XB_TMO])) break; if (_sp > XB_SPIN_CAP) { atomicAdd(&(bar)[XB_TMO], 1u); break; } } } } while (0)
struct XcdBarrier { unsigned* bar; unsigned x; volatile LAS unsigned* st; };
__device__ __forceinline__ XcdBarrier xcd_barrier_post(unsigned* bar, volatile LAS unsigned* st) {
    XcdBarrier b; b.bar = bar; b.x = xb_xcc_id(); b.st = st;
    if (threadIdx.x == 0) (void)xb_add(&bar[XB_XCNT(b.x)], 1u);
    return b;
}
__device__ __forceinline__ void xcd_barrier_complete(unsigned* bar, unsigned x, unsigned& nloc, unsigned& nx) {
    const unsigned G = gridDim.x * gridDim.y * gridDim.z;
    unsigned sum, cnt, mine, sp = 0u;
    for (;;) {
        sum = 0u; cnt = 0u; mine = 0u;
#pragma unroll
        for (unsigned j = 0; j < 16; ++j) { const unsigned c = xb_ld(&bar[XB_XCNT(j)]); sum += c; cnt += (c > 0u) ? 1u : 0u; mine = (j == x) ? c : mine; }
        if (sum == G) break;
        __builtin_amdgcn_s_sleep(1);
        if ((++sp & 255u) == 0u) { if (xb_ld(&bar[XB_TMO])) break; if (sp > XB_SPIN_CAP) { atomicAdd(&bar[XB_TMO], 1u); break; } }
    }
    nloc = mine > 0u ? mine : 1u; nx = cnt > 0u ? cnt : 1u;
}
__device__ __forceinline__ void xcd_barrier(const XcdBarrier& b) {
    asm volatile("s_waitcnt vmcnt(0)" ::: "memory");
    __syncthreads();
    if (threadIdx.x == 0) {
        unsigned* bar = b.bar;
        __builtin_amdgcn_s_waitcnt(0);
        unsigned nloc = b.st[0], nx = b.st[1];
        if (nloc == 0u) { xcd_barrier_complete(bar, b.x, nloc, nx); b.st[0] = nloc; b.st[1] = nx; }
        const unsigned old = xb_add(&bar[XB_XSUB(b.x)], 1u);
        const unsigned gen = old / nloc;
        if (old + 1u == (gen + 1u) * nloc) {
            __builtin_amdgcn_fence(__ATOMIC_RELEASE, "agent");
            asm volatile("s_waitcnt vmcnt(0)" ::: "memory");
            const unsigned og = xb_add(&bar[XB_TOP], 1u);
            const unsigned tg = og / nx;
            if (og + 1u == (tg + 1u) * nx) xb_add(&bar[XB_TOPGEN], 1u);
            else XB_SPIN(xb_ld(&bar[XB_TOPGEN]) == tg, bar);
            __builtin_amdgcn_fence(__ATOMIC_ACQUIRE, "agent");
            xb_add(&bar[XB_XGEN(b.x)], 1u);
            asm volatile("s_waitcnt vmcnt(0)" ::: "memory");
        } else {
            XB_SPIN(xb_ld(&bar[XB_XGEN(b.x)]) == gen, bar);
            __builtin_amdgcn_fence(__ATOMIC_ACQUIRE, "agent");
            asm volatile("s_waitcnt vmcnt(0)" ::: "memory");
        }
    }
    __syncthreads();
}
constexpr int CW_BAR = 4096;
#ifndef PHASE_MASK
#define PHASE_MASK 0xFFF
#endif
#define PM(k) ((PHASE_MASK >> (k)) & 1)
constexpr int STEPS_PER_SLAB = 10, NSTEPS = 2 + STEPS_PER_SLAB * NSLAB;
#define GEMM_PHASE(EPI_T, AOFF, BOFF, N_, K_, ...) do { pg8::Gemm g{(const pg8::bf16_t*)(F.ws + (AOFF)), (const pg8::bf16_t*)(F.ws + (BOFF)), R, (N_), (K_)}; \
    pg8::StaticOrder S; S.init(R, (N_), F.G, F.bid); epi::EPI_T E{__VA_ARGS__}; pg8::gemm_phase<epi::EPI_T, pg8::StaticOrder, true, true>(F.lds, g, S, E, F.tid); } while (0)
__device__ __forceinline__ void run_step(Frame& F, int st) {
    if (st == 0) { if constexpr (PM(10)) phase_prologue0(F); return; }
    if (st == 1) { if constexpr (PM(11)) phase_prologue1(F); return; }
    const int s = (st - 2) / STEPS_PER_SLAB, k = (st - 2) % STEPS_PER_SLAB, R = slab_rows(s);
    unsigned char* ws = F.ws;
    switch (k) {
    case 0: if constexpr (PM(0)) phase_norm1(F, s); break;
    case 1: if constexpr (PM(1)) GEMM_PHASE(EpiProj, WS_HB, WS_WIN, NIN, D, (bf16*)(ws + WS_PROJ), (float*)(ws + WS_SM)); break;
    case 2: if constexpr (PM(2)) phase_scan_naive(F, s); phase_mix_carry(F, s); break;
    case 3: if constexpr (PM(3)) GEMM_PHASE(EpiGate1, WS_OG, WS_WG, D, D, (const bf16*)(ws + WS_PROJ), (float*)(ws + WS_T1)); break;
    case 4: if constexpr (PM(4)) GEMM_PHASE(EpiGate2, WS_YS, WS_WS, D, 2048, (const bf16*)(ws + WS_PROJ), (const float*)(ws + WS_T1), (bf16*)(ws + WS_MIX)); break;
    case 5: if constexpr (PM(5)) GEMM_PHASE(EpiOut, WS_MIX, WS_WOUT, D, D, F.A.in[0], F.A.in[1], (const float*)(ws + WS_MODV), (const float*)(ws + WS_G2), (float*)(ws + WS_X1), (bf16*)(ws + WS_X1G), (float*)(ws + WS_SS1), s); break;
    case 6: if constexpr (PM(6)) GEMM_PHASE(EpiUp, WS_X1G, WS_WUP, NUP, D, (const float*)(ws + WS_SS1), (const float*)(ws + WS_SHW), (bf16*)(ws + WS_U)); break;
    case 7: if constexpr (PM(7)) phase_convact(F, s); break;
    case 8: if constexpr (PM(8)) GEMM_PHASE(EpiDown, WS_ACT, WS_WDN, D, DFF, (const float*)(ws + WS_X1), (const float*)(ws + WS_MODV), F.out + O_YP, F.out + O_YS, (float*)(ws + WS_SS2), s); break;
    default: if constexpr (PM(9)) phase_final(F, s); break;
    }
}
__global__ void __launch_bounds__(NTHR, 2) mk_fwd(Args a) {
    extern __shared__ __attribute__((aligned(16))) unsigned char lds[];
    Frame F(a);
    F.lds = (LAS unsigned char*)lds; F.MISC = (volatile LAS unsigned*)(F.lds + MISC_OFF);
    F.tid = threadIdx.x; F.lane = F.tid & 63; F.wave = __builtin_amdgcn_readfirstlane(F.tid >> 6); F.G = gridDim.x; F.bid = blockIdx.x;
    F.out = a.out; F.ws = a.ws; F.ctl = (gu32*)(a.ws + WS_CTL);
    for (int u = F.tid; u < (LDS_BYTES - LDSCTL_OFF) / 4; u += NTHR) ((LAS unsigned*)(F.lds + LDSCTL_OFF))[u] = 0u;
    __syncthreads();
    XcdBarrier bar; bar.bar = (unsigned*)(F.ctl + CW_BAR); bar.x = 0; bar.st = nullptr;
    const bool multi = (a.ph_hi - a.ph_lo) > 1;
    if (multi) bar = xcd_barrier_post((unsigned*)(F.ctl + CW_BAR), F.MISC + 8);
    for (int st = a.ph_lo; st < a.ph_hi; ++st) {
        { int t_ = threadIdx.x, b_ = blockIdx.x; unsigned char* w_ = a.ws; float* o_ = a.out; asm volatile("" : "+v"(t_), "+s"(b_), "+s"(w_), "+s"(o_));
          F.tid = t_; F.lane = t_ & 63; F.wave = __builtin_amdgcn_readfirstlane(t_ >> 6); F.bid = b_; F.ws = w_; F.out = o_; }
        run_step(F, st);
        if (st + 1 < a.ph_hi) xcd_barrier(bar);
    }
}
#ifndef MK_SINGLE
#define MK_SINGLE 0
#endif
extern "C" void kernel_launch(void* const* d_in, const int* in_sizes, int n_in, void* d_out, int out_size, void* d_ws, size_t ws_size, hipStream_t stream) {
    static int grid = 0;
    if (grid == 0) {
        if (n_in != 30 || (size_t)out_size != O_END || ws_size < WS_END) { fprintf(stderr, "kernel_launch: unexpected shapes: n_in %d out %d ws %zu (need %zu)\n", n_in, out_size, ws_size, (size_t)WS_END); grid = -1; return; }
        int dev = 0, cus = 0;
        if (hipGetDevice(&dev) != hipSuccess || hipDeviceGetAttribute(&cus, hipDeviceAttributeMultiprocessorCount, dev) != hipSuccess) { grid = -1; return; }
        if (hipFuncSetAttribute((const void*)mk_fwd, hipFuncAttributeMaxDynamicSharedMemorySize, LDS_BYTES) != hipSuccess) { fprintf(stderr, "kernel_launch: hipFuncSetAttribute failed\n"); grid = -1; return; }
        int per_cu = 0;
        if (hipOccupancyMaxActiveBlocksPerMultiprocessor(&per_cu, (const void*)mk_fwd, NTHR, LDS_BYTES) != hipSuccess || per_cu < 1) fprintf(stderr, "kernel_launch: occupancy query says %d\n", per_cu);
        (void)hipGetLastError();
        grid = cus;
    }
    if (grid < 0) return;
    (void)hipMemsetAsync((char*)d_ws + WS_CTL, 0, CTL_ZERO_BYTES, stream);
    Args a{};
    for (int i = 0; i < 30; ++i) a.in[i] = (const float*)d_in[i];
    a.out = (float*)d_out; a.ws = (unsigned char*)d_ws;
#if MK_SINGLE
    a.ph_lo = 0; a.ph_hi = NSTEPS;
    hipLaunchKernelGGL(mk_fwd, dim3(grid), dim3(NTHR), LDS_BYTES, stream, a);
#else
    for (int st = 0; st < NSTEPS; ++st) { a.ph_lo = st; a.ph_hi = st + 1; hipLaunchKernelGGL(mk_fwd, dim3(grid), dim3(NTHR), LDS_BYTES, stream, a); }
#endif
}
```

```cpp
#include <hip/hip_runtime.h>
#include <hip/hip_cooperative_groups.h>
#include <cstdio>
#include <cstdint>

namespace pg8 {
#define PG8_LAS __attribute__((address_space(3)))
typedef unsigned short bf16_t;
typedef short bf16x8 __attribute__((ext_vector_type(8)));
typedef float f32x4 __attribute__((ext_vector_type(4)));
typedef unsigned u32x4 __attribute__((ext_vector_type(4)));
typedef unsigned u32x2 __attribute__((ext_vector_type(2)));
constexpr int BM = 256, BK = 64, HALF = 128, HTB = HALF * BK * 2, STAGE_BYTES = 8 * HTB, NXCD = 8, WGM = 8;

__host__ __device__ __forceinline__ int lds_byte(int r, int c) { const int st = (r >> 4) * 2 + (c >> 5), rr = r & 15, cc = c & 31, ob = rr * 64 + cc * 2; return st * 1024 + (ob ^ (((ob >> 9) & 1) << 5)); }
__host__ __device__ __forceinline__ void stage_rc(int b, int& R, int& C) { const int st = b / 1024, sb = b % 1024, swz = sb ^ (((sb >> 9) & 1) << 5); R = (st >> 1) * 16 + swz / 64; C = (st & 1) * 32 + (swz % 64) / 2; }
__host__ __device__ __forceinline__ int perm32(int rho) { const int n = rho >> 4, i = rho & 15; return 8 * (i >> 2) + 4 * n + (i & 3); }

struct Unit { int pm, pn; };
struct Gemm { const bf16_t* A; const bf16_t* Bt; int M, N, K; };

struct StaticOrder {
    int nM, nN, nwg, G, c;
    __host__ __device__ void init(int M, int N, int G_, int c_) { nM = M / BM; nN = N / BM; nwg = nM * nN; G = G_; c = c_; }
    __host__ __device__ bool next(int i, Unit& u) const {
        const long L = (long)i * G + c; if (L >= nwg) return false;
        int wgid = (int)L; { const int q = nwg / NXCD, r = nwg % NXCD, xcd = wgid % NXCD, off = wgid / NXCD; wgid = (xcd < r ? xcd * (q + 1) : r * (q + 1) + (xcd - r) * q) + off; }
        const int nig = WGM * nN, gid = wgid / nig, fm = gid * WGM, gsz = (nM - fm) < WGM ? (nM - fm) : WGM;
        u.pm = fm + ((wgid % nig) % gsz); u.pn = (wgid % nig) / gsz; return true;
    }
    __device__ __forceinline__ void a_ready(const Unit&) const {}
    __device__ __forceinline__ void done(const Unit&) const {}
};

__device__ __forceinline__ unsigned cvt_pk_bf16(float lo, float hi) { unsigned r; asm volatile("v_cvt_pk_bf16_f32 %0, %1, %2" : "=v"(r) : "v"(lo), "v"(hi)); return r; }

template <class Epi, class Sched, bool ALIGN_EPI = false, bool SP2 = false>
__device__ __forceinline__ void gemm_phase(PG8_LAS unsigned char* lds, const Gemm g, const Sched& S, const Epi& E, const int tid) {
    const int wid = __builtin_amdgcn_readfirstlane(tid >> 6), lane = tid & 63, wr = wid >> 2, wc = wid & 3, fr = lane & 15, fq = lane >> 4;
    const int K = g.K, nt = K / BK;
    unsigned voffA[2], voffB[2];
#pragma unroll
    for (int i = 0; i < 2; ++i) { int R, C; stage_rc(tid * 16 + i * 8192, R, C); const int Rb = Epi::PERM ? ((R & ~31) + perm32(R & 31)) : R;
        voffA[i] = (unsigned)(R * K + C) * 2u; voffB[i] = (unsigned)(Rb * K + C) * 2u; }
    const size_t kstep = (size_t)(BK * 2);
    const size_t hstep = (size_t)HALF * K * 2;
    const size_t tstep = 2 * hstep;
    const unsigned ldsw = (unsigned)wid * 1024u;
    const int aoff = lds_byte(wr * 64 + fr, fq * 8), boff = lds_byte(wc * 32 + fr, fq * 8);
#define PG8_SA(b, h) (((b) * 2 + (h)) * HTB)
#define PG8_SB(b, h) ((4 + (b) * 2 + (h)) * HTB)
#define PG8_STAGE(bufoff, gbase, voff) do { _Pragma("unroll") for (int _i = 0; _i < 2; ++_i) \
        __builtin_amdgcn_global_load_lds((const unsigned*)((const char*)(gbase) + (voff)[_i]), (PG8_LAS unsigned*)(lds + (bufoff) + ldsw + _i * 8192), 16, 0, 0); } while (0)
#define PG8_LDA(dst, b, h) do { _Pragma("unroll") for (int m = 0; m < 4; ++m) _Pragma("unroll") for (int k = 0; k < 2; ++k) dst[m][k] = *(const PG8_LAS bf16x8*)(lds + PG8_SA(b, h) + aoff + m * 2048 + k * 1024); } while (0)
#define PG8_LDB(dst, b, h) do { _Pragma("unroll") for (int n = 0; n < 2; ++n) _Pragma("unroll") for (int k = 0; k < 2; ++k) dst[n][k] = *(const PG8_LAS bf16x8*)(lds + PG8_SB(b, h) + boff + n * 2048 + k * 1024); } while (0)
#define PG8_MMA(ai, bj, At, Bt) do { __builtin_amdgcn_s_setprio(1); _Pragma("unroll") for (int m = 0; m < 4; ++m) _Pragma("unroll") for (int n = 0; n < 2; ++n) _Pragma("unroll") for (int k = 0; k < 2; ++k) \
        acc[ai][bj][m][n] = __builtin_amdgcn_mfma_f32_16x16x32_bf16(Bt[n][k], At[m][k], acc[ai][bj][m][n], 0, 0, 0); __builtin_amdgcn_s_setprio(0); } while (0)
#define PG8_WAIT_V(n) asm volatile("s_waitcnt vmcnt(" #n ")" ::: "memory")
#define PG8_WAIT_L(n) asm volatile("s_waitcnt lgkmcnt(" #n ")" ::: "memory")
#define PG8_BAR __builtin_amdgcn_s_barrier()
#define PG8_SCHED __builtin_amdgcn_sched_barrier(0)
    Unit cur, nxt; int ui = 0;
    if (!S.next(0, cur)) return;
    f32x4 acc[2][2][4][2];
#pragma unroll
    for (int a = 0; a < 2; ++a)
#pragma unroll
        for (int b = 0; b < 2; ++b)
#pragma unroll
            for (int m = 0; m < 4; ++m)
#pragma unroll
                for (int n = 0; n < 2; ++n) acc[a][b][m][n] = (f32x4){0.f, 0.f, 0.f, 0.f};
    bf16x8 At[4][2], B0[2][2], B1[2][2];
    const char* cA = (const char*)g.A + (size_t)cur.pm * tstep; const char* cB = (const char*)g.Bt + (size_t)cur.pn * tstep;
    S.a_ready(cur);
    if constexpr (SP2) {
        PG8_STAGE(PG8_SB(0, 0), cB, voffB); PG8_STAGE(PG8_SB(0, 1), cB + hstep, voffB); PG8_STAGE(PG8_SA(0, 0), cA, voffA); PG8_STAGE(PG8_SA(0, 1), cA + hstep, voffA);
        if (wr == 1) PG8_BAR;
        PG8_WAIT_V(2); PG8_BAR;
        PG8_STAGE(PG8_SB(1, 0), cB + kstep, voffB); PG8_STAGE(PG8_SA(1, 0), cA + kstep, voffA); PG8_STAGE(PG8_SB(1, 1), cB + hstep + kstep, voffB);
        PG8_WAIT_V(6); PG8_BAR;
    } else {
        PG8_STAGE(PG8_SB(0, 0), cB, voffB); PG8_STAGE(PG8_SA(0, 0), cA, voffA); PG8_STAGE(PG8_SB(0, 1), cB + hstep, voffB); PG8_STAGE(PG8_SA(0, 1), cA + hstep, voffA);
        if (wr == 1) PG8_BAR;
        PG8_WAIT_V(4); PG8_BAR;
        PG8_STAGE(PG8_SB(1, 0), cB + kstep, voffB); PG8_STAGE(PG8_SA(1, 0), cA + kstep, voffA); PG8_STAGE(PG8_SB(1, 1), cB + hstep + kstep, voffB);
        PG8_WAIT_V(6); PG8_BAR;
    }
    for (;;) {
        const bool has_next = S.next(ui + 1, nxt);
        const char* nA = has_next ? (const char*)g.A + (size_t)nxt.pm * tstep : cA; const char* nB = has_next ? (const char*)g.Bt + (size_t)nxt.pn * tstep : cB;
        for (int t = 0; t < nt; t += 2) {
            const bool last = (t == nt - 2);
            const char* a1 = cA + (size_t)(t + 1) * kstep;
            const char* a2 = last ? nA : cA + (size_t)(t + 2) * kstep; const char* b2 = last ? nB : cB + (size_t)(t + 2) * kstep;
            const char* a3 = a2 + kstep; const char* b3 = b2 + kstep;
            if (last && has_next) S.a_ready(nxt);
            if constexpr (SP2) {
            PG8_LDB(B0, 0, 0); PG8_LDB(B1, 0, 1); PG8_SCHED; PG8_LDA(At, 0, 0); PG8_STAGE(PG8_SA(1, 1), a1 + hstep, voffA);
            PG8_WAIT_V(8); PG8_WAIT_L(0); PG8_BAR; PG8_MMA(0, 0, At, B0); PG8_MMA(0, 1, At, B1); PG8_BAR; PG8_SCHED;
            PG8_LDA(At, 0, 1); PG8_STAGE(PG8_SB(0, 0), b2, voffB); PG8_STAGE(PG8_SB(0, 1), b2 + hstep, voffB); PG8_STAGE(PG8_SA(0, 0), a2, voffA);
            PG8_WAIT_V(8); PG8_WAIT_L(0); PG8_BAR; PG8_MMA(1, 0, At, B0); PG8_MMA(1, 1, At, B1); PG8_BAR; PG8_SCHED;
            PG8_LDB(B0, 1, 0); PG8_LDB(B1, 1, 1); PG8_SCHED; PG8_LDA(At, 1, 0); PG8_STAGE(PG8_SA(0, 1), a2 + hstep, voffA);
            PG8_WAIT_V(8); PG8_WAIT_L(0); PG8_BAR; PG8_MMA(0, 0, At, B0); PG8_MMA(0, 1, At, B1); PG8_BAR; PG8_SCHED;
            PG8_LDA(At, 1, 1); PG8_STAGE(PG8_SB(1, 0), b3, voffB); PG8_STAGE(PG8_SB(1, 1), b3 + hstep, voffB); PG8_STAGE(PG8_SA(1, 0), a3, voffA);
            PG8_WAIT_V(8); PG8_WAIT_L(0); PG8_BAR; PG8_MMA(1, 0, At, B0); PG8_MMA(1, 1, At, B1); PG8_BAR; PG8_SCHED;
            } else {
            PG8_LDB(B0, 0, 0); PG8_SCHED; PG8_LDA(At, 0, 0); PG8_STAGE(PG8_SA(1, 1), a1 + hstep, voffA);
            PG8_WAIT_L(8); PG8_BAR; PG8_WAIT_L(0); PG8_MMA(0, 0, At, B0); PG8_BAR; PG8_SCHED;
            PG8_LDB(B1, 0, 1); PG8_STAGE(PG8_SB(0, 0), b2, voffB);
            PG8_BAR; PG8_WAIT_L(0); PG8_MMA(0, 1, At, B1); PG8_BAR;
            PG8_LDA(At, 0, 1); PG8_STAGE(PG8_SA(0, 0), a2, voffA);
            PG8_BAR; PG8_WAIT_L(0); PG8_MMA(1, 0, At, B0); PG8_BAR; PG8_SCHED;
            PG8_STAGE(PG8_SB(0, 1), b2 + hstep, voffB);
            PG8_WAIT_V(6); PG8_BAR; PG8_MMA(1, 1, At, B1); PG8_BAR;
            PG8_LDB(B0, 1, 0); PG8_SCHED; PG8_LDA(At, 1, 0); PG8_STAGE(PG8_SA(0, 1), a2 + hstep, voffA);
            PG8_WAIT_L(8); PG8_BAR; PG8_WAIT_L(0); PG8_MMA(0, 0, At, B0); PG8_BAR; PG8_SCHED;
            PG8_LDB(B1, 1, 1); PG8_STAGE(PG8_SB(1, 0), b3, voffB);
            PG8_BAR; PG8_WAIT_L(0); PG8_MMA(0, 1, At, B1); PG8_BAR;
            PG8_LDA(At, 1, 1); PG8_STAGE(PG8_SA(1, 0), a3, voffA);
            PG8_BAR; PG8_WAIT_L(0); PG8_MMA(1, 0, At, B0); PG8_BAR; PG8_SCHED;
            PG8_STAGE(PG8_SB(1, 1), b3 + hstep, voffB);
            PG8_WAIT_V(6); PG8_BAR; PG8_MMA(1, 1, At, B1); PG8_BAR;
            }
        }
        if constexpr (ALIGN_EPI) { if (wr == 0) PG8_BAR; }
        E(acc, cur, wr, wc, fr, fq); S.done(cur);
        if (!has_next) break;
#pragma unroll
        for (int a = 0; a < 2; ++a)
#pragma unroll
            for (int b = 0; b < 2; ++b)
#pragma unroll
                for (int m = 0; m < 4; ++m)
#pragma unroll
                    for (int n = 0; n < 2; ++n) acc[a][b][m][n] = (f32x4){0.f, 0.f, 0.f, 0.f};
        cur = nxt; cA = nA; cB = nB; ++ui;
        if constexpr (ALIGN_EPI) { if (wr == 1) PG8_BAR; }
    }
    PG8_WAIT_V(0);
    if constexpr (!ALIGN_EPI) { if (wr == 0) PG8_BAR; }
    PG8_BAR;
#undef PG8_SA
#undef PG8_SB
#undef PG8_STAGE
#undef PG8_LDA
#undef PG8_LDB
#undef PG8_MMA
#undef PG8_WAIT_V
#undef PG8_WAIT_L
#undef PG8_BAR
#undef PG8_SCHED
}
}
constexpr int D = 1024, NB = 4, SEQ = 8192, DB = 8, DSEQ = 64, NMB = NB + DB;
constexpr int GH = 8, GDK = 128, GDV = 128;
constexpr int SH = 32, SP = 64, SN = 128, SG = 8;
constexpr int DFF = 2816, CONV_CH = 7168, IN_COLS = 12336;
constexpr int NPROJ = 12288;
constexpr int NIN = 12544;
constexpr int NUP = 2 * DFF;
constexpr float EPS = 1e-6f;
#ifndef SLAB_T
#define SLAB_T 1024
#endif
constexpr int NSLAB = SEQ / SLAB_T, RP = NB * SLAB_T, RS = DB * DSEQ, RMAX = RP + RS;
constexpr size_t O_YP = 0, O_YS = O_YP + (size_t)NB * SEQ * D, O_CMP = O_YS + (size_t)DB * DSEQ * D, O_GP = O_CMP + (size_t)NB * 3 * CONV_CH,
                 O_SP = O_GP + (size_t)NB * GH * GDK * GDV, O_CFP = O_SP + (size_t)NB * SH * SN * SP, O_CMS = O_CFP + (size_t)NB * 2 * NUP,
                 O_GS = O_CMS + (size_t)DB * 3 * CONV_CH, O_SS = O_GS + (size_t)DB * GH * GDK * GDV, O_CFS = O_SS + (size_t)DB * SH * SN * SP,
                 O_END = O_CFS + (size_t)DB * 2 * NUP;
constexpr size_t MiB = 1u << 20;
constexpr size_t WS_CTL = 0, CTL_ZERO_BYTES = 1 * MiB;
constexpr size_t WS_MODV = 1 * MiB;
constexpr size_t WS_G1 = WS_MODV + 512 * 1024;
constexpr size_t WS_G2 = WS_G1 + 64 * 1024;
constexpr size_t WS_SHW = WS_G2 + 64 * 1024;
constexpr size_t WS_CARRY_MIX = 2 * MiB;
constexpr size_t WS_CARRY_FFN = 3 * MiB;
constexpr size_t WS_WIN = 4 * MiB;
constexpr size_t WS_WG = WS_WIN + (size_t)NIN * D * 2;
constexpr size_t WS_WS = WS_WG + (size_t)D * D * 2;
constexpr size_t WS_WOUT = WS_WS + (size_t)D * 2048 * 2;
constexpr size_t WS_WUP = WS_WOUT + (size_t)D * D * 2;
constexpr size_t WS_WDN = WS_WUP + (size_t)NUP * D * 2;
constexpr size_t WS_SLAB = 56 * MiB;
static_assert(WS_WDN + (size_t)D * DFF * 2 <= WS_SLAB, "weights fit");
constexpr size_t SZ_HB = (size_t)RMAX * D * 2, SZ_PROJ = (size_t)RMAX * NPROJ * 2, SZ_SM = (size_t)RMAX * 64 * 4, SZ_OG = (size_t)RMAX * D * 2, SZ_YS = (size_t)RMAX * 2048 * 2,
                 SZ_T1 = (size_t)RMAX * D * 4, SZ_MIX = (size_t)RMAX * D * 2, SZ_X1 = (size_t)RMAX * D * 4, SZ_X1G = (size_t)RMAX * D * 2, SZ_SS = (size_t)RMAX * 16 * 4,
                 SZ_U = (size_t)RMAX * NUP * 2, SZ_ACT = (size_t)RMAX * DFF * 2;
constexpr size_t WS_HB = WS_SLAB, WS_PROJ = WS_HB + SZ_HB, WS_SM = WS_PROJ + SZ_PROJ, WS_OG = WS_SM + SZ_SM, WS_YS = WS_OG + SZ_OG, WS_T1 = WS_YS + SZ_YS, WS_MIX = WS_T1 + SZ_T1,
                 WS_X1 = WS_MIX + SZ_MIX, WS_X1G = WS_X1 + SZ_X1, WS_SS1 = WS_X1G + SZ_X1G, WS_SS2 = WS_SS1 + SZ_SS, WS_U = WS_SS2 + SZ_SS, WS_ACT = WS_U + SZ_U, WS_END = WS_ACT + SZ_ACT;
static_assert(WS_END <= 480 * MiB, "workspace map fits");
constexpr int RING_BYTES = 131072, LDSCTL_OFF = RING_BYTES, MISC_OFF = LDSCTL_OFF + 320, LDS_BYTES = 147456;
constexpr int NWAVES = 8, NTHR = 512;

#define GAS __attribute__((address_space(1)))
#define LAS __attribute__((address_space(3)))
typedef unsigned short bf16;
typedef unsigned v4u __attribute__((ext_vector_type(4)));
typedef unsigned v2u __attribute__((ext_vector_type(2)));
typedef float f32x4 __attribute__((ext_vector_type(4)));
typedef GAS unsigned gu32;
#define RLX_AGENT __ATOMIC_RELAXED, __HIP_MEMORY_SCOPE_AGENT
#define LDS_WAIT() asm volatile("s_waitcnt lgkmcnt(0)" ::: "memory")
#define VM_WAIT() asm volatile("s_waitcnt vmcnt(0)" ::: "memory")
__device__ __forceinline__ unsigned f2bf(float f) { unsigned u = __builtin_bit_cast(unsigned, f); return (u + 0x7fffu + ((u >> 16) & 1u)) >> 16; }
__device__ __forceinline__ unsigned pk2(float lo, float hi) { return f2bf(lo) | (f2bf(hi) << 16); }
__device__ __forceinline__ float bf2f(unsigned short h) { return __builtin_bit_cast(float, (unsigned)h << 16); }
__device__ __forceinline__ float bflo(unsigned w) { return __builtin_bit_cast(float, w << 16); }
__device__ __forceinline__ float bfhi(unsigned w) { return __builtin_bit_cast(float, w & 0xffff0000u); }
__device__ __forceinline__ float sigmoidf_(float x) { return 1.f / (1.f + __expf(-x)); }
__device__ __forceinline__ float siluf_(float x) { return x / (1.f + __expf(-x)); }
__device__ __forceinline__ float softplusf_(float x) { return x > 20.f ? x : log1pf(__expf(x)); }
__device__ __forceinline__ float wave_sum(float v) {
#pragma unroll
    for (int o = 1; o < 64; o <<= 1) v += __shfl_xor(v, o);
    return v;
}

struct Args { const float* in[30]; float* out; unsigned char* ws; int ph_lo, ph_hi; };

struct Frame {
    LAS unsigned char* lds;
    volatile LAS unsigned* MISC;
    gu32* ctl;
    int tid, lane, wave, G, bid;
    const Args& A;
    float* out; unsigned char* ws;
    __device__ __forceinline__ Frame(const Args& a) : A(a) {}
};
__device__ __forceinline__ int row_mb(int r) { return r < RP ? (r / SLAB_T) : NB + ((r - RP) / DSEQ); }
__device__ __forceinline__ size_t row_goff(int s, int r) {
    if (r < RP) { const int b = r / SLAB_T, tl = r % SLAB_T; return ((size_t)b * SEQ + (size_t)s * SLAB_T + tl) * D; }
    return (size_t)(r - RP) * D;
}
__device__ __forceinline__ int slab_rows(int s) { return s == 0 ? RMAX : RP; }
struct MapWin { __device__ __forceinline__ int operator()(int n) const { return n < 10240 ? n : (n < 12288 ? n + 48 : (n < 12336 ? n - 2048 : -1)); } };
struct MapId  { __device__ __forceinline__ int operator()(int n) const { return n; } };
struct MapUp  { __device__ __forceinline__ int operator()(int n) const { const int j = n >> 8, c = n & 255; return c < 128 ? 128 * j + c : DFF + 128 * j + (c - 128); } };
template <class Map>
__device__ __forceinline__ void p0_transpose_item(const float* W, int ldw, int K, bf16* WT, Map map, LAS float* scr, int item, int nblk, int lane) {
    const int kb = item / nblk, nb = item % nblk, k0 = 64 * kb, n0 = 32 * nb;
    const int sc = map(n0 + (lane & 31));
#pragma unroll 8
    for (int i = 0; i < 32; ++i) { const int kk = 2 * i + (lane >> 5); scr[kk * 33 + (lane & 31)] = sc >= 0 ? W[(size_t)(k0 + kk) * ldw + sc] : 0.f; }
    LDS_WAIT(); asm volatile("" ::: "memory");
    const int c = lane & 7;
#pragma unroll
    for (int j = 0; j < 4; ++j) { const int n = (lane >> 3) + 8 * j; const LAS float* s = scr + (8 * c) * 33 + n;
        v4u o; o.x = pk2(s[0 * 33], s[1 * 33]); o.y = pk2(s[2 * 33], s[3 * 33]); o.z = pk2(s[4 * 33], s[5 * 33]); o.w = pk2(s[6 * 33], s[7 * 33]);
        *(GAS v4u*)(WT + (size_t)(n0 + n) * K + k0 + 8 * c) = o; }
    LDS_WAIT(); asm volatile("" ::: "memory");
}
__device__ __forceinline__ void p0_mod_item(Frame& F, int item) {
    LAS float* sc = (LAS float*)F.lds; LAS float* red = (LAS float*)(F.lds + 49152);
    const float* cp = F.A.in[6]; const float* cs = F.A.in[7]; const float* w_ada = F.A.in[8]; const float* b_ada = F.A.in[9];
    for (int idx = F.tid; idx < NMB * D; idx += NTHR) { const int b = idx / D, k = idx % D; const float c = b < NB ? cp[b * D + k] : cs[(b - NB) * D + k]; sc[idx] = siluf_(c); }
    __syncthreads();
    float acc[NMB];
#pragma unroll
    for (int b = 0; b < NMB; ++b) acc[b] = 0.f;
    const int col = item * 64 + F.lane, kb = F.wave * 128;
    for (int k = 0; k < 128; ++k) { const float wv = w_ada[(size_t)(kb + k) * 6144 + col];
#pragma unroll
        for (int b = 0; b < NMB; ++b) acc[b] += sc[b * D + kb + k] * wv; }
#pragma unroll
    for (int b = 0; b < NMB; ++b) red[(F.wave * NMB + b) * 64 + F.lane] = acc[b];
    __syncthreads();
    float* modv = (float*)(F.ws + WS_MODV);
    for (int idx = F.tid; idx < NMB * 64; idx += NTHR) { const int b = idx / 64, l = idx % 64; float s = b_ada[item * 64 + l];
#pragma unroll
        for (int w = 0; w < 8; ++w) s += red[(w * NMB + b) * 64 + l];
        modv[b * 6144 + item * 64 + l] = s; }
    __syncthreads();
}
__device__ __forceinline__ void phase_prologue0(Frame& F) {
    for (int it = F.bid; it < 96; it += F.G) p0_mod_item(F, it);
    LAS float* scr = (LAS float*)(F.lds + F.wave * 16384);
    const int gw = F.bid * NWAVES + F.wave, NGW = F.G * NWAVES;
    constexpr int I_IN = (D / 64) * (NIN / 32), I_G = (D / 64) * (D / 32), I_S = (2048 / 64) * (D / 32), I_O = I_G, I_UP = (D / 64) * (NUP / 32), I_DN = (DFF / 64) * (D / 32);
    constexpr int NITEMS = I_IN + I_G + I_S + I_O + I_UP + I_DN;
    for (int it = gw; it < NITEMS; it += NGW) {
        int r = it;
        if (r < I_IN) { p0_transpose_item(F.A.in[11], IN_COLS, D, (bf16*)(F.ws + WS_WIN), MapWin(), scr, r, NIN / 32, F.lane); continue; } r -= I_IN;
        if (r < I_G) { p0_transpose_item(F.A.in[21], D, D, (bf16*)(F.ws + WS_WG), MapId(), scr, r, D / 32, F.lane); continue; } r -= I_G;
        if (r < I_S) { p0_transpose_item(F.A.in[22], D, 2048, (bf16*)(F.ws + WS_WS), MapId(), scr, r, D / 32, F.lane); continue; } r -= I_S;
        if (r < I_O) { p0_transpose_item(F.A.in[23], D, D, (bf16*)(F.ws + WS_WOUT), MapId(), scr, r, D / 32, F.lane); continue; } r -= I_O;
        if (r < I_UP) { p0_transpose_item(F.A.in[25], NUP, D, (bf16*)(F.ws + WS_WUP), MapUp(), scr, r, NUP / 32, F.lane); continue; } r -= I_UP;
        p0_transpose_item(F.A.in[28], D, DFF, (bf16*)(F.ws + WS_WDN), MapId(), scr, r, D / 32, F.lane);
    }
}
__device__ __forceinline__ void phase_prologue1(Frame& F) {
    const float* modv = (const float*)(F.ws + WS_MODV);
    float* g1 = (float*)(F.ws + WS_G1); float* g2 = (float*)(F.ws + WS_G2); float* shw = (float*)(F.ws + WS_SHW);
    for (int idx = F.bid * NTHR + F.tid; idx < NMB * D; idx += F.G * NTHR) { const int b = idx / D, k = idx % D;
        g1[idx] = F.A.in[10][k] * (1.f + modv[b * 6144 + 1024 + k]); g2[idx] = F.A.in[24][k] * (1.f + modv[b * 6144 + 4096 + k]); }
    LAS float* sh = (LAS float*)F.lds;
    for (int idx = F.tid; idx < NMB * D; idx += NTHR) sh[idx] = modv[(idx / D) * 6144 + 3072 + (idx % D)];
    __syncthreads();
    const bf16* wup = (const bf16*)(F.ws + WS_WUP);
    const int gw = F.bid * NWAVES + F.wave, NGW = F.G * NWAVES;
    for (int n = gw; n < NUP; n += NGW) {
        const GAS v4u* wr = (const GAS v4u*)(wup + (size_t)n * D + F.lane * 16);
        const v4u w0 = wr[0], w1 = wr[1];
        float wf[16] = {bflo(w0.x), bfhi(w0.x), bflo(w0.y), bfhi(w0.y), bflo(w0.z), bfhi(w0.z), bflo(w0.w), bfhi(w0.w), bflo(w1.x), bfhi(w1.x), bflo(w1.y), bfhi(w1.y), bflo(w1.z), bfhi(w1.z), bflo(w1.w), bfhi(w1.w)};
        float res = 0.f;
#pragma unroll
        for (int b = 0; b < NMB; ++b) { float a = 0.f;
#pragma unroll
            for (int i = 0; i < 16; ++i) a += wf[i] * sh[b * D + F.lane * 16 + i];
            a = wave_sum(a); if (F.lane == b) res = a; }
        if (F.lane < NMB) shw[F.lane * NUP + n] = res;
    }
    __syncthreads();
}
__device__ __forceinline__ void phase_norm1(Frame& F, int s) {
    const float* modv = (const float*)(F.ws + WS_MODV); const float* g1 = (const float*)(F.ws + WS_G1); bf16* hb = (bf16*)(F.ws + WS_HB);
    const int gw = F.bid * NWAVES + F.wave, NGW = F.G * NWAVES, R = slab_rows(s);
    for (int r = gw; r < R; r += NGW) {
        const float* xrow = (r < RP ? F.A.in[0] : F.A.in[1]) + row_goff(s, r); const int mb = row_mb(r);
        const GAS f32x4* xr = (const GAS f32x4*)xrow + F.lane;
        f32x4 v[4]; float ss = 0.f;
#pragma unroll
        for (int j = 0; j < 4; ++j) { v[j] = xr[64 * j]; ss += (v[j].x * v[j].x + v[j].y * v[j].y) + (v[j].z * v[j].z + v[j].w * v[j].w); }
        const float rs = rsqrtf(wave_sum(ss) * (1.f / D) + EPS);
        GAS v2u* o8 = (GAS v2u*)(hb + (size_t)r * D) + F.lane;
#pragma unroll
        for (int j = 0; j < 4; ++j) { const int k = 4 * F.lane + 256 * j; const f32x4 g = *(const GAS f32x4*)(g1 + mb * D + k); const f32x4 sh = *(const GAS f32x4*)(modv + mb * 6144 + k);
            v2u o; o.x = pk2(v[j].x * rs * g.x + sh.x, v[j].y * rs * g.y + sh.y); o.y = pk2(v[j].z * rs * g.z + sh.z, v[j].w * rs * g.w + sh.w); o8[64 * j] = o; }
    }
}
__device__ __forceinline__ void phase_final(Frame& F, int s) {
    const float* ss2 = (const float*)(F.ws + WS_SS2); const float* wf = F.A.in[29];
    const int gw = F.bid * NWAVES + F.wave, NGW = F.G * NWAVES, R = slab_rows(s);
    for (int r = gw; r < R; r += NGW) {
        float* yrow = F.out + (r < RP ? O_YP : O_YS) + row_goff(s, r);
        float t = F.lane < 16 ? ss2[(size_t)r * 16 + F.lane] : 0.f; t = wave_sum(t);
        const float rs = rsqrtf(t * (1.f / D) + EPS);
        GAS f32x4* yr = (GAS f32x4*)yrow + F.lane;
#pragma unroll
        for (int j = 0; j < 4; ++j) { f32x4 v = yr[64 * j]; const f32x4 w = *(const GAS f32x4*)(wf + 4 * F.lane + 256 * j); v.x *= rs * w.x; v.y *= rs * w.y; v.z *= rs * w.z; v.w *= rs * w.w; yr[64 * j] = v; }
    }
}
__device__ __forceinline__ void u_hist_row(Frame& F, int s, int r, int back, int c8, int j, int cc, float (&ua)[8], float (&uv)[8]) {
    const bf16* U = (const bf16*)(F.ws + WS_U);
    int tl, b; bool samp = r >= RP;
    if (!samp) { b = r / SLAB_T; tl = r % SLAB_T; } else { b = (r - RP) / DSEQ; tl = (r - RP) % DSEQ; }
    if (tl - back >= 0) {
        const bf16* p = U + (size_t)(r - back) * NUP + 256 * j + cc;
        const v4u a = *(const GAS v4u*)p, v = *(const GAS v4u*)(p + 128);
        ua[0] = bflo(a.x); ua[1] = bfhi(a.x); ua[2] = bflo(a.y); ua[3] = bfhi(a.y); ua[4] = bflo(a.z); ua[5] = bfhi(a.z); ua[6] = bflo(a.w); ua[7] = bfhi(a.w);
        uv[0] = bflo(v.x); uv[1] = bfhi(v.x); uv[2] = bflo(v.y); uv[3] = bfhi(v.y); uv[4] = bflo(v.z); uv[5] = bfhi(v.z); uv[6] = bflo(v.w); uv[7] = bfhi(v.w);
        return;
    }
    const int hi = 2 + (tl - back);
    if (samp) { const float* st = F.A.in[5] + ((size_t)b * 2 + hi) * NUP;
#pragma unroll
        for (int i = 0; i < 8; ++i) { ua[i] = st[c8 + i]; uv[i] = st[DFF + c8 + i]; } return; }
    if (s == 0) {
#pragma unroll
        for (int i = 0; i < 8; ++i) { ua[i] = 0.f; uv[i] = 0.f; } return; }
    const float* cf = (const float*)(F.ws + WS_CARRY_FFN) + (((size_t)(s & 1) * NB + b) * 2 + hi) * NUP + 256 * j + cc;
#pragma unroll
    for (int i = 0; i < 8; ++i) { ua[i] = cf[i]; uv[i] = cf[128 + i]; }
}
__device__ __forceinline__ void phase_convact(Frame& F, int s) {
    const bf16* U = (const bf16*)(F.ws + WS_U); bf16* ACT = (bf16*)(F.ws + WS_ACT);
    const float* wc = F.A.in[26]; const float* bc = F.A.in[27];
    const int R = slab_rows(s); const long total = (long)R * (DFF / 8);
    for (long idx = (long)F.bid * NTHR + F.tid; idx < total; idx += (long)F.G * NTHR) {
        const int r = (int)(idx / (DFF / 8)), c8 = (int)(idx % (DFF / 8)) * 8, j = c8 >> 7, cc = c8 & 127;
        float a0[8], v0[8], a1[8], v1[8], a2[8], v2[8];
        u_hist_row(F, s, r, 0, c8, j, cc, a2, v2); u_hist_row(F, s, r, 1, c8, j, cc, a1, v1); u_hist_row(F, s, r, 2, c8, j, cc, a0, v0);
        float o[8];
#pragma unroll
        for (int i = 0; i < 8; ++i) { const int ca = c8 + i, cv = DFF + c8 + i;
            const float xa = bc[ca] + wc[ca] * a0[i] + wc[NUP + ca] * a1[i] + wc[2 * NUP + ca] * a2[i];
            const float xv = bc[cv] + wc[cv] * v0[i] + wc[NUP + cv] * v1[i] + wc[2 * NUP + cv] * v2[i];
            o[i] = siluf_(xa) * xv; }
        v4u w; w.x = pk2(o[0], o[1]); w.y = pk2(o[2], o[3]); w.z = pk2(o[4], o[5]); w.w = pk2(o[6], o[7]);
        *(GAS v4u*)(ACT + (size_t)r * DFF + c8) = w;
    }
    float* cfn = (float*)(F.ws + WS_CARRY_FFN) + (size_t)((s + 1) & 1) * NB * 2 * NUP;
    for (int idx = F.bid * NTHR + F.tid; idx < NB * 2 * NUP; idx += F.G * NTHR) {
        const int b = idx / (2 * NUP), i = (idx / NUP) % 2, c = idx % NUP; const int r = b * SLAB_T + SLAB_T - 2 + i;
        const float v = bf2f(U[(size_t)r * NUP + c]); cfn[idx] = v;
        if (s == NSLAB - 1) { const int j = c >> 8, cc = c & 255; const int oc = cc < 128 ? 128 * j + cc : DFF + 128 * j + (cc - 128); F.out[O_CFP + ((size_t)b * 2 + i) * NUP + oc] = v; }
    }
    if (s == 0) for (int idx = F.bid * NTHR + F.tid; idx < DB * 2 * NUP; idx += F.G * NTHR) {
        const int b = idx / (2 * NUP), i = (idx / NUP) % 2, c = idx % NUP; const int r = RP + b * DSEQ + DSEQ - 2 + i;
        const int j = c >> 8, cc = c & 255; const int oc = cc < 128 ? 128 * j + cc : DFF + 128 * j + (cc - 128);
        F.out[O_CFS + ((size_t)b * 2 + i) * NUP + oc] = bf2f(U[(size_t)r * NUP + c]);
    }
}
__device__ __forceinline__ void phase_mix_carry(Frame& F, int s) {
    const bf16* P = (const bf16*)(F.ws + WS_PROJ);
    float* cmn = (float*)(F.ws + WS_CARRY_MIX) + (size_t)((s + 1) & 1) * NB * 3 * CONV_CH;
    for (int idx = F.bid * NTHR + F.tid; idx < NB * 3 * CONV_CH; idx += F.G * NTHR) {
        const int b = idx / (3 * CONV_CH), i = (idx / CONV_CH) % 3, c = idx % CONV_CH; const int r = b * SLAB_T + SLAB_T - 3 + i;
        const float v = bf2f(P[(size_t)r * NPROJ + c]); cmn[idx] = v;
        if (s == NSLAB - 1) F.out[O_CMP + idx] = v;
    }
    if (s == 0) for (int idx = F.bid * NTHR + F.tid; idx < DB * 3 * CONV_CH; idx += F.G * NTHR) {
        const int b = idx / (3 * CONV_CH), i = (idx / CONV_CH) % 3, c = idx % CONV_CH; const int r = RP + b * DSEQ + DSEQ - 3 + i;
        F.out[O_CMS + idx] = bf2f(P[(size_t)r * NPROJ + c]);
    }
}
namespace epi {
using pg8::f32x4; using pg8::Unit; using pg8::BM; using pg8::HALF; using pg8::cvt_pk_bf16; using pg8::u32x4; using pg8::u32x2;
struct EpiProj {
    static constexpr bool PERM = true;
    bf16* P; float* SM;
    __device__ __forceinline__ void operator()(const f32x4 (&acc)[2][2][4][2], const Unit& u, int wr, int wc, int fr, int fq) const {
        const int row0 = u.pm * BM + wr * 64 + fr;
        if (u.pn == 48) {
            if (wc < 2) {
#pragma unroll
                for (int ai = 0; ai < 2; ++ai)
#pragma unroll
                    for (int m = 0; m < 4; ++m) { float* rp = SM + (size_t)(row0 + ai * HALF + m * 16) * 64 + wc * 32 + 8 * fq;
                        *(f32x4*)rp = acc[ai][0][m][0]; *(f32x4*)(rp + 4) = acc[ai][0][m][1]; }
            }
            return;
        }
        const bool sg = u.pn >= 40;
        const int col0 = u.pn * BM + wc * 32 + 8 * fq;
#pragma unroll
        for (int ai = 0; ai < 2; ++ai)
#pragma unroll
            for (int m = 0; m < 4; ++m) { bf16* rowp = P + (size_t)(row0 + ai * HALF + m * 16) * NPROJ + col0;
#pragma unroll
                for (int bj = 0; bj < 2; ++bj) { f32x4 v0 = acc[ai][bj][m][0], v1 = acc[ai][bj][m][1];
                    if (sg) {
#pragma unroll
                        for (int i = 0; i < 4; ++i) { v0[i] = sigmoidf_(v0[i]); v1[i] = sigmoidf_(v1[i]); } }
                    u32x4 w; w.x = cvt_pk_bf16(v0[0], v0[1]); w.y = cvt_pk_bf16(v0[2], v0[3]); w.z = cvt_pk_bf16(v1[0], v1[1]); w.w = cvt_pk_bf16(v1[2], v1[3]);
                    *(u32x4*)(rowp + bj * HALF) = w; } }
    }
};
struct EpiGate1 {
    static constexpr bool PERM = false;
    const bf16* P; float* T1;
    __device__ __forceinline__ void operator()(const f32x4 (&acc)[2][2][4][2], const Unit& u, int wr, int wc, int fr, int fq) const {
        const int row0 = u.pm * BM + wr * 64 + fr, col0 = u.pn * BM + wc * 32 + 4 * fq;
#pragma unroll
        for (int ai = 0; ai < 2; ++ai)
#pragma unroll
            for (int m = 0; m < 4; ++m) { const size_t r = (size_t)(row0 + ai * HALF + m * 16);
#pragma unroll
                for (int bj = 0; bj < 2; ++bj)
#pragma unroll
                    for (int n = 0; n < 2; ++n) { const int c = col0 + bj * HALF + n * 16; const u32x2 g = *(const u32x2*)(P + r * NPROJ + 10240 + c); const f32x4 a = acc[ai][bj][m][n];
                        f32x4 o; o.x = a.x * bflo(g.x); o.y = a.y * bfhi(g.x); o.z = a.z * bflo(g.y); o.w = a.w * bfhi(g.y); *(f32x4*)(T1 + r * D + c) = o; } }
    }
};
struct EpiGate2 {
    static constexpr bool PERM = false;
    const bf16* P; const float* T1; bf16* MIX;
    __device__ __forceinline__ void operator()(const f32x4 (&acc)[2][2][4][2], const Unit& u, int wr, int wc, int fr, int fq) const {
        const int row0 = u.pm * BM + wr * 64 + fr, col0 = u.pn * BM + wc * 32 + 4 * fq;
#pragma unroll
        for (int ai = 0; ai < 2; ++ai)
#pragma unroll
            for (int m = 0; m < 4; ++m) { const size_t r = (size_t)(row0 + ai * HALF + m * 16);
#pragma unroll
                for (int bj = 0; bj < 2; ++bj)
#pragma unroll
                    for (int n = 0; n < 2; ++n) { const int c = col0 + bj * HALF + n * 16; const u32x2 g = *(const u32x2*)(P + r * NPROJ + 11264 + c); const f32x4 a = acc[ai][bj][m][n];
                        const f32x4 t = *(const f32x4*)(T1 + r * D + c);
                        u32x2 o; o.x = cvt_pk_bf16(t.x + a.x * bflo(g.x), t.y + a.y * bfhi(g.x)); o.y = cvt_pk_bf16(t.z + a.z * bflo(g.y), t.w + a.w * bfhi(g.y)); *(u32x2*)(MIX + r * D + c) = o; } }
    }
};
struct EpiOut {
    static constexpr bool PERM = false;
    const float* xp; const float* xs; const float* modv; const float* g2; float* X1; bf16* X1G; float* SS; int slab;
    __device__ __forceinline__ void operator()(const f32x4 (&acc)[2][2][4][2], const Unit& u, int wr, int wc, int fr, int fq) const {
        const int col0 = u.pn * BM + wc * 32 + 4 * fq;
#pragma unroll
        for (int ai = 0; ai < 2; ++ai) {
            const int rb = u.pm * BM + ai * HALF + wr * 64; const int mb = row_mb(rb);
#pragma unroll
            for (int m = 0; m < 4; ++m) { const int r = rb + m * 16 + fr; const float* xrow = (r < RP ? xp : xs) + row_goff(slab, r); float sq = 0.f;
#pragma unroll
                for (int bj = 0; bj < 2; ++bj)
#pragma unroll
                    for (int n = 0; n < 2; ++n) { const int c = col0 + bj * HALF + n * 16; const f32x4 a = acc[ai][bj][m][n];
                        const f32x4 xv = *(const f32x4*)(xrow + c), gt = *(const f32x4*)(modv + mb * 6144 + 2048 + c), gg = *(const f32x4*)(g2 + mb * D + c);
                        f32x4 o = xv + gt * a; *(f32x4*)(X1 + (size_t)r * D + c) = o; sq += (o.x * o.x + o.y * o.y) + (o.z * o.z + o.w * o.w);
                        u32x2 w; w.x = cvt_pk_bf16(o.x * gg.x, o.y * gg.y); w.y = cvt_pk_bf16(o.z * gg.z, o.w * gg.w); *(u32x2*)(X1G + (size_t)r * D + c) = w; }
                sq += __shfl_xor(sq, 16); sq += __shfl_xor(sq, 32);
                if (fq == 0) SS[(size_t)r * 16 + u.pn * 4 + wc] = sq; }
        }
    }
};
struct EpiUp {
    static constexpr bool PERM = true;
    const float* SS; const float* shw; bf16* U;
    __device__ __forceinline__ void operator()(const f32x4 (&acc)[2][2][4][2], const Unit& u, int wr, int wc, int fr, int fq) const {
        const int col0 = u.pn * BM + wc * 32 + 8 * fq;
#pragma unroll
        for (int ai = 0; ai < 2; ++ai) {
            const int rb = u.pm * BM + ai * HALF + wr * 64; const int mb = row_mb(rb);
            f32x4 sv[2][2];
#pragma unroll
            for (int bj = 0; bj < 2; ++bj)
#pragma unroll
                for (int n = 0; n < 2; ++n) sv[bj][n] = *(const f32x4*)(shw + mb * NUP + col0 + bj * HALF + 4 * n);
#pragma unroll
            for (int m = 0; m < 4; ++m) { const int r = rb + m * 16 + fr; const f32x4* sp = (const f32x4*)(SS + (size_t)r * 16);
                const f32x4 s0 = sp[0], s1 = sp[1], s2 = sp[2], s3 = sp[3];
                const float tot = ((s0.x + s0.y) + (s0.z + s0.w)) + ((s1.x + s1.y) + (s1.z + s1.w)) + ((s2.x + s2.y) + (s2.z + s2.w)) + ((s3.x + s3.y) + (s3.z + s3.w));
                const float rs = rsqrtf(tot * (1.f / D) + EPS);
#pragma unroll
                for (int bj = 0; bj < 2; ++bj) { const f32x4 v0 = acc[ai][bj][m][0] * rs + sv[bj][0], v1 = acc[ai][bj][m][1] * rs + sv[bj][1];
                    u32x4 w; w.x = cvt_pk_bf16(v0[0], v0[1]); w.y = cvt_pk_bf16(v0[2], v0[3]); w.z = cvt_pk_bf16(v1[0], v1[1]); w.w = cvt_pk_bf16(v1[2], v1[3]);
                    *(u32x4*)(U + (size_t)r * NUP + col0 + bj * HALF) = w; } }
        }
    }
};
struct EpiDown {
    static constexpr bool PERM = false;
    const float* X1; const float* modv; float* yp; float* ys; float* SS; int slab;
    __device__ __forceinline__ void operator()(const f32x4 (&acc)[2][2][4][2], const Unit& u, int wr, int wc, int fr, int fq) const {
        const int col0 = u.pn * BM + wc * 32 + 4 * fq;
#pragma unroll
        for (int ai = 0; ai < 2; ++ai) {
            const int rb = u.pm * BM + ai * HALF + wr * 64; const int mb = row_mb(rb);
#pragma unroll
            for (int m = 0; m < 4; ++m) { const int r = rb + m * 16 + fr; float* yrow = (r < RP ? yp : ys) + row_goff(slab, r); float sq = 0.f;
#pragma unroll
                for (int bj = 0; bj < 2; ++bj)
#pragma unroll
                    for (int n = 0; n < 2; ++n) { const int c = col0 + bj * HALF + n * 16; const f32x4 a = acc[ai][bj][m][n];
                        const f32x4 xv = *(const f32x4*)(X1 + (size_t)r * D + c), gt = *(const f32x4*)(modv + mb * 6144 + 5120 + c);
                        f32x4 o = xv + gt * a; *(f32x4*)(yrow + c) = o; sq += (o.x * o.x + o.y * o.y) + (o.z * o.z + o.w * o.w); }
                sq += __shfl_xor(sq, 16); sq += __shfl_xor(sq, 32);
                if (fq == 0) SS[(size_t)r * 16 + u.pn * 4 + wc] = sq; }
        }
    }
};
}
__device__ __forceinline__ void gdn_naive_job(Frame& F, int s, bool samp, int bb, int h) {
    const bf16* P = (const bf16*)(F.ws + WS_PROJ); const float* SM = (const float*)(F.ws + WS_SM); bf16* OG = (bf16*)(F.ws + WS_OG);
    LAS float* qs = (LAS float*)F.lds; LAS float* ks = qs + 128; LAS float* vs = ks + 128; LAS float* part = vs + 128;
    LAS float* red = part + 8; LAS float* red2 = red + 512; LAS float* part2 = red2 + 512;
    const int tid = F.tid, v = tid & 127, kq = tid >> 7, ntok = samp ? DSEQ : SLAB_T, row0 = samp ? RP + bb * DSEQ : bb * SLAB_T;
    float S[32];
    const size_t sbase = ((size_t)(bb * GH + h) * GDK + kq * 32) * GDV + v;
    if (samp) { const float* st = F.A.in[3] + sbase;
#pragma unroll
        for (int i = 0; i < 32; ++i) S[i] = st[(size_t)i * GDV]; }
    else if (s == 0) {
#pragma unroll
        for (int i = 0; i < 32; ++i) S[i] = 0.f; }
    else { const float* st = F.out + O_GP + sbase;
#pragma unroll
        for (int i = 0; i < 32; ++i) S[i] = st[(size_t)i * GDV]; }
    const int role = tid >> 7, ch = tid & 127, cidx = role * 1024 + h * 128 + ch;
    float h0 = 0.f, h1 = 0.f, h2 = 0.f, w0 = 0.f, w1 = 0.f, w2 = 0.f, w3 = 0.f, bias = 0.f;
    if (tid < 384) {
        const float* wcv = F.A.in[12]; w0 = wcv[cidx]; w1 = wcv[CONV_CH + cidx]; w2 = wcv[2 * CONV_CH + cidx]; w3 = wcv[3 * CONV_CH + cidx]; bias = F.A.in[13][cidx];
        if (samp) { const float* st = F.A.in[2] + (size_t)bb * 3 * CONV_CH + cidx; h0 = st[0]; h1 = st[CONV_CH]; h2 = st[2 * CONV_CH]; }
        else if (s > 0) { const float* st = (const float*)(F.ws + WS_CARRY_MIX) + ((size_t)(s & 1) * NB + bb) * 3 * CONV_CH + cidx; h0 = st[0]; h1 = st[CONV_CH]; h2 = st[2 * CONV_CH]; }
    }
    const float Aexp = __expf(F.A.in[14][h]), dtb = F.A.in[15][h], gnorm = F.A.in[16][v];
    for (int t = 0; t < ntok; ++t) {
        const size_t r = (size_t)(row0 + t);
        if (tid < 384) {
            const float raw = bf2f(P[r * NPROJ + cidx]);
            float val = bias + w0 * h0 + w1 * h1 + w2 * h2 + w3 * raw; h0 = h1; h1 = h2; h2 = raw; val = siluf_(val);
            qs[role * 128 + ch] = val;
            if (role < 2) { const float sq = wave_sum(val * val); if (F.lane == 0) part[F.wave] = sq; }
        }
        __syncthreads();
        const float qsc = rsqrtf(part[0] + part[1] + EPS) * 0.08838834764831845f, ksc = rsqrtf(part[2] + part[3] + EPS);
        const float beta = sigmoidf_(SM[r * 64 + h]); const float g = -Aexp * softplusf_(SM[r * 64 + 8 + h] + dtb); const float a = __expf(g);
        float kn[32]; float p = 0.f;
#pragma unroll
        for (int i = 0; i < 32; ++i) { kn[i] = ks[kq * 32 + i] * ksc; p += kn[i] * S[i]; }
        red[kq * 128 + v] = p;
        __syncthreads();
        const float kS = (red[v] + red[128 + v]) + (red[256 + v] + red[384 + v]);
        const float d = beta * (vs[v] - a * kS);
        float po = 0.f;
#pragma unroll
        for (int i = 0; i < 32; ++i) { S[i] = a * S[i] + kn[i] * d; po += qs[kq * 32 + i] * qsc * S[i]; }
        red2[kq * 128 + v] = po;
        __syncthreads();
        float o = 0.f;
        if (tid < 128) { o = (red2[v] + red2[128 + v]) + (red2[256 + v] + red2[384 + v]); const float sq = wave_sum(o * o); if (F.lane == 0) part2[F.wave] = sq; }
        __syncthreads();
        if (tid < 128) { const float rs = rsqrtf((part2[0] + part2[1]) * (1.f / GDV) + EPS); const float z = bf2f(P[r * NPROJ + 7168 + h * 128 + v]);
            OG[r * D + h * 128 + v] = (bf16)f2bf(o * rs * gnorm * siluf_(z)); }
    }
    float* so = F.out + (samp ? O_GS : O_GP) + sbase;
#pragma unroll
    for (int i = 0; i < 32; ++i) so[(size_t)i * GDV] = S[i];
    __syncthreads();
}
__device__ __forceinline__ void ssd_naive_job(Frame& F, int s, bool samp, int bb, int g) {
    const bf16* P = (const bf16*)(F.ws + WS_PROJ); const float* SM = (const float*)(F.ws + WS_SM); bf16* YS = (bf16*)(F.ws + WS_YS);
    LAS float* xs = (LAS float*)F.lds; LAS float* Bs = xs + 256; LAS float* Cs = Bs + 128; LAS float* red = Cs + 128; LAS float* part = red + 512;
    const int tid = F.tid, hl = tid >> 7, p = tid & 63, nh = (tid >> 6) & 1, head = 4 * g + hl, ntok = samp ? DSEQ : SLAB_T, row0 = samp ? RP + bb * DSEQ : bb * SLAB_T;
    float hr[64];
    const size_t sbase = ((size_t)(bb * SH + head) * SN + nh * 64) * SP + p;
    if (samp) { const float* st = F.A.in[4] + sbase;
#pragma unroll
        for (int i = 0; i < 64; ++i) hr[i] = st[(size_t)i * SP]; }
    else if (s == 0) {
#pragma unroll
        for (int i = 0; i < 64; ++i) hr[i] = 0.f; }
    else { const float* st = F.out + O_SP + sbase;
#pragma unroll
        for (int i = 0; i < 64; ++i) hr[i] = st[(size_t)i * SP]; }
    const int cidx = tid < 256 ? 3072 + g * 256 + tid : (tid < 384 ? 5120 + g * 128 + (tid - 256) : 6144 + g * 128 + (tid - 384));
    const float* wcv = F.A.in[12]; const float w0 = wcv[cidx], w1 = wcv[CONV_CH + cidx], w2 = wcv[2 * CONV_CH + cidx], w3 = wcv[3 * CONV_CH + cidx], bias = F.A.in[13][cidx];
    float h0 = 0.f, h1 = 0.f, h2 = 0.f;
    if (samp) { const float* st = F.A.in[2] + (size_t)bb * 3 * CONV_CH + cidx; h0 = st[0]; h1 = st[CONV_CH]; h2 = st[2 * CONV_CH]; }
    else if (s > 0) { const float* st = (const float*)(F.ws + WS_CARRY_MIX) + ((size_t)(s & 1) * NB + bb) * 3 * CONV_CH + cidx; h0 = st[0]; h1 = st[CONV_CH]; h2 = st[2 * CONV_CH]; }
    const float aneg = -__expf(F.A.in[17][head]), dtb = F.A.in[18][head], Dh = F.A.in[19][head], nw = F.A.in[20][head * 64 + p];
    for (int t = 0; t < ntok; ++t) {
        const size_t r = (size_t)(row0 + t);
        { const float raw = bf2f(P[r * NPROJ + cidx]); float val = bias + w0 * h0 + w1 * h1 + w2 * h2 + w3 * raw; h0 = h1; h1 = h2; h2 = raw; xs[tid] = siluf_(val); }
        __syncthreads();
        const float dt = softplusf_(SM[r * 64 + 16 + head] + dtb), dA = __expf(dt * aneg), x = xs[hl * 64 + p], dx = dt * x;
        float py = 0.f;
#pragma unroll
        for (int i = 0; i < 64; ++i) { hr[i] = dA * hr[i] + dx * Bs[nh * 64 + i]; py += Cs[nh * 64 + i] * hr[i]; }
        red[tid] = py;
        __syncthreads();
        float yz = 0.f;
        if (nh == 0) { const float y = red[tid] + red[tid + 64] + Dh * x; const float z = bf2f(P[r * NPROJ + 8192 + head * 64 + p]); yz = y * siluf_(z);
            const float sq = wave_sum(yz * yz); if (F.lane == 0) part[F.wave] = sq; }
        __syncthreads();
        if (nh == 0) { const float rs = rsqrtf(((part[0] + part[2]) + (part[4] + part[6])) * (1.f / 256.f) + EPS); YS[r * 2048 + head * 64 + p] = (bf16)f2bf(yz * rs * nw); }
    }
    float* so = F.out + (samp ? O_SS : O_SP) + sbase;
#pragma unroll
    for (int i = 0; i < 64; ++i) so[(size_t)i * SP] = hr[i];
    __syncthreads();
}
__device__ __forceinline__ void phase_scan_naive(Frame& F, int s) {
    const int njobs = s == 0 ? 192 : 64;
    for (int j = F.bid; j < njobs; j += F.G) {
        if (j < 32) gdn_naive_job(F, s, false, j >> 3, j & 7);
        else if (j < 64) ssd_naive_job(F, s, false, (j - 32) >> 3, (j - 32) & 7);
        else if (j < 128) gdn_naive_job(F, s, true, (j - 64) >> 3, (j - 64) & 7);
        else ssd_naive_job(F, s, true, (j - 128) >> 3, (j - 128) & 7);
    }
}
#define XB_TMO      128
#define XB_XCNT(j)  (256  + 64 * (j))
#define XB_XSUB(j)  (1280 + 64 * (j))
#define XB_XGEN(j)  (2304 + 64 * (j))
#define XB_TOP      3328
#define XB_TOPGEN   3392
#define XCD_BAR_WORDS 3456
#define XB_SPIN_CAP (1u << 18)
__device__ __forceinline__ unsigned xb_ld(unsigned* p)              { return __hip_atomic_load(p, __ATOMIC_RELAXED, __HIP_MEMORY_SCOPE_AGENT); }
__device__ __forceinline__ unsigned xb_add(unsigned* p, unsigned v) { return __hip_atomic_fetch_add(p, v, __ATOMIC_RELAXED, __HIP_MEMORY_SCOPE_AGENT); }
__device__ __forceinline__ unsigned xb_xcc_id() { return (unsigned)__builtin_amdgcn_s_getreg((3 << 11) | 20) & 0xFu; }
#define XB_SPIN(cond, bar) do { unsigned _sp = 0; while (cond) { __builtin_amdgcn_s_sleep(1); \
    if ((++_sp & 255u) == 0u) { if (xb_ld(&(bar)[XB_TMO])) break; if (_sp > XB_SPIN_CAP) { atomicAdd(&(bar)[XB_TMO], 1u); break; } } } } while (0)
struct XcdBarrier { unsigned* bar; unsigned x; volatile LAS unsigned* st; };
__device__ __forceinline__ XcdBarrier xcd_barrier_post(unsigned* bar, volatile LAS unsigned* st) {
    XcdBarrier b; b.bar = bar; b.x = xb_xcc_id(); b.st = st;
    if (threadIdx.x == 0) (void)xb_add(&bar[XB_XCNT(b.x)], 1u);
    return b;
}
__device__ __forceinline__ void xcd_barrier_complete(unsigned* bar, unsigned x, unsigned& nloc, unsigned& nx) {
    const unsigned G = gridDim.x * gridDim.y * gridDim.z;
    unsigned sum, cnt, mine, sp = 0u;
    for (;;) {
        sum = 0u; cnt = 0u; mine = 0u;
#pragma unroll
        for (unsigned j = 0; j < 16; ++j) { const unsigned c = xb_ld(&bar[XB_XCNT(j)]); sum += c; cnt += (c > 0u) ? 1u : 0u; mine = (j == x) ? c : mine; }
        if (sum == G) break;
        __builtin_amdgcn_s_sleep(1);
        if ((++sp & 255u) == 0u) { if (xb_ld(&bar[XB_TMO])) break; if (sp > XB_SPIN_CAP) { atomicAdd(&bar[XB_TMO], 1u); break; } }
    }
    nloc = mine > 0u ? mine : 1u; nx = cnt > 0u ? cnt : 1u;
}
__device__ __forceinline__ void xcd_barrier(const XcdBarrier& b) {
    asm volatile("s_waitcnt vmcnt(0)" ::: "memory");
    __syncthreads();
    if (threadIdx.x == 0) {
        unsigned* bar = b.bar;
        __builtin_amdgcn_s_waitcnt(0);
        unsigned nloc = b.st[0], nx = b.st[1];
        if (nloc == 0u) { xcd_barrier_complete(bar, b.x, nloc, nx); b.st[0] = nloc; b.st[1] = nx; }
        const unsigned old = xb_add(&bar[XB_XSUB(b.x)], 1u);
        const unsigned gen = old / nloc;
        if (old + 1u == (gen + 1u) * nloc) {
            __builtin_amdgcn_fence(__ATOMIC_RELEASE, "agent");
            asm volatile("s_waitcnt vmcnt(0)" ::: "memory");
            const unsigned og = xb_add(&bar[XB_TOP], 1u);
            const unsigned tg = og / nx;
            if (og + 1u == (tg + 1u) * nx) xb_add(&bar[XB_TOPGEN], 1u);
            else XB_SPIN(xb_ld(&bar[XB_TOPGEN]) == tg, bar);
            __builtin_amdgcn_fence(__ATOMIC_ACQUIRE, "agent");
            xb_add(&bar[XB_XGEN(b.x)], 1u);
            asm volatile("s_waitcnt vmcnt(0)" ::: "memory");
        } else {
            XB_SPIN(xb_ld(&bar[XB_XGEN(b.x)]) == gen, bar);
            __builtin_amdgcn_fence(__ATOMIC_ACQUIRE, "agent");
            asm volatile("s_waitcnt vmcnt(0)" ::: "memory");
        }
    }
    __syncthreads();
}
constexpr int CW_BAR = 4096;
#ifndef PHASE_MASK
#define PHASE_MASK 0xFFF
#endif
#define PM(k) ((PHASE_MASK >> (k)) & 1)
constexpr int STEPS_PER_SLAB = 10, NSTEPS = 2 + STEPS_PER_SLAB * NSLAB;
#define GEMM_PHASE(EPI_T, AOFF, BOFF, N_, K_, ...) do { pg8::Gemm g{(const pg8::bf16_t*)(F.ws + (AOFF)), (const pg8::bf16_t*)(F.ws + (BOFF)), R, (N_), (K_)}; \
    pg8::StaticOrder S; S.init(R, (N_), F.G, F.bid); epi::EPI_T E{__VA_ARGS__}; pg8::gemm_phase<epi::EPI_T, pg8::StaticOrder, true, true>(F.lds, g, S, E, F.tid); } while (0)
__device__ __forceinline__ void run_step(Frame& F, int st) {
    if (st == 0) { if constexpr (PM(10)) phase_prologue0(F); return; }
    if (st == 1) { if constexpr (PM(11)) phase_prologue1(F); return; }
    const int s = (st - 2) / STEPS_PER_SLAB, k = (st - 2) % STEPS_PER_SLAB, R = slab_rows(s);
    unsigned char* ws = F.ws;
    switch (k) {
    case 0: if constexpr (PM(0)) phase_norm1(F, s); break;
    case 1: if constexpr (PM(1)) GEMM_PHASE(EpiProj, WS_HB, WS_WIN, NIN, D, (bf16*)(ws + WS_PROJ), (float*)(ws + WS_SM)); break;
    case 2: if constexpr (PM(2)) phase_scan_naive(F, s); phase_mix_carry(F, s); break;
    case 3: if constexpr (PM(3)) GEMM_PHASE(EpiGate1, WS_OG, WS_WG, D, D, (const bf16*)(ws + WS_PROJ), (float*)(ws + WS_T1)); break;
    case 4: if constexpr (PM(4)) GEMM_PHASE(EpiGate2, WS_YS, WS_WS, D, 2048, (const bf16*)(ws + WS_PROJ), (const float*)(ws + WS_T1), (bf16*)(ws + WS_MIX)); break;
    case 5: if constexpr (PM(5)) GEMM_PHASE(EpiOut, WS_MIX, WS_WOUT, D, D, F.A.in[0], F.A.in[1], (const float*)(ws + WS_MODV), (const float*)(ws + WS_G2), (float*)(ws + WS_X1), (bf16*)(ws + WS_X1G), (float*)(ws + WS_SS1), s); break;
    case 6: if constexpr (PM(6)) GEMM_PHASE(EpiUp, WS_X1G, WS_WUP, NUP, D, (const float*)(ws + WS_SS1), (const float*)(ws + WS_SHW), (bf16*)(ws + WS_U)); break;
    case 7: if constexpr (PM(7)) phase_convact(F, s); break;
    case 8: if constexpr (PM(8)) GEMM_PHASE(EpiDown, WS_ACT, WS_WDN, D, DFF, (const float*)(ws + WS_X1), (const float*)(ws + WS_MODV), F.out + O_YP, F.out + O_YS, (float*)(ws + WS_SS2), s); break;
    default: if constexpr (PM(9)) phase_final(F, s); break;
    }
}
__global__ void __launch_bounds__(NTHR, 2) mk_fwd(Args a) {
    extern __shared__ __attribute__((aligned(16))) unsigned char lds[];
    Frame F(a);
    F.lds = (LAS unsigned char*)lds; F.MISC = (volatile LAS unsigned*)(F.lds + MISC_OFF);
    F.tid = threadIdx.x; F.lane = F.tid & 63; F.wave = __builtin_amdgcn_readfirstlane(F.tid >> 6); F.G = gridDim.x; F.bid = blockIdx.x;
    F.out = a.out; F.ws = a.ws; F.ctl = (gu32*)(a.ws + WS_CTL);
    for (int u = F.tid; u < (LDS_BYTES - LDSCTL_OFF) / 4; u += NTHR) ((LAS unsigned*)(F.lds + LDSCTL_OFF))[u] = 0u;
    __syncthreads();
    XcdBarrier bar; bar.bar = (unsigned*)(F.ctl + CW_BAR); bar.x = 0; bar.st = nullptr;
    const bool multi = (a.ph_hi - a.ph_lo) > 1;
    if (multi) bar = xcd_barrier_post((unsigned*)(F.ctl + CW_BAR), F.MISC + 8);
    for (int st = a.ph_lo; st < a.ph_hi; ++st) {
        { int t_ = threadIdx.x, b_ = blockIdx.x; unsigned char* w_ = a.ws; float* o_ = a.out; asm volatile("" : "+v"(t_), "+s"(b_), "+s"(w_), "+s"(o_));
          F.tid = t_; F.lane = t_ & 63; F.wave = __builtin_amdgcn_readfirstlane(t_ >> 6); F.bid = b_; F.ws = w_; F.out = o_; }
        run_step(F, st);
        if (st + 1 < a.ph_hi) { if (st == a.ph_lo) cooperative_groups::this_grid().sync(); else xcd_barrier(bar); }
    }
}
#ifndef MK_SINGLE
#define MK_SINGLE 1
#endif
extern "C" void kernel_launch(void* const* d_in, const int* in_sizes, int n_in, void* d_out, int out_size, void* d_ws, size_t ws_size, hipStream_t stream) {
    static int grid = 0;
    if (grid == 0) {
        if (n_in != 30 || (size_t)out_size != O_END || ws_size < WS_END) { fprintf(stderr, "kernel_launch: unexpected shapes: n_in %d out %d ws %zu (need %zu)\n", n_in, out_size, ws_size, (size_t)WS_END); grid = -1; return; }
        int dev = 0, cus = 0;
        if (hipGetDevice(&dev) != hipSuccess || hipDeviceGetAttribute(&cus, hipDeviceAttributeMultiprocessorCount, dev) != hipSuccess) { grid = -1; return; }
        if (hipFuncSetAttribute((const void*)mk_fwd, hipFuncAttributeMaxDynamicSharedMemorySize, LDS_BYTES) != hipSuccess) { fprintf(stderr, "kernel_launch: hipFuncSetAttribute failed\n"); grid = -1; return; }
        int per_cu = 0;
        if (hipOccupancyMaxActiveBlocksPerMultiprocessor(&per_cu, (const void*)mk_fwd, NTHR, LDS_BYTES) != hipSuccess || per_cu < 1) fprintf(stderr, "kernel_launch: occupancy query says %d\n", per_cu);
        (void)hipGetLastError();
        grid = cus * (per_cu < 1 ? 1 : per_cu);
    }
    if (grid < 0) return;
    (void)hipMemsetAsync((char*)d_ws + WS_CTL, 0, CTL_ZERO_BYTES, stream);
    Args a{};
    for (int i = 0; i < 30; ++i) a.in[i] = (const float*)d_in[i];
    a.out = (float*)d_out; a.ws = (unsigned char*)d_ws;
#if MK_SINGLE
    a.ph_lo = 0; a.ph_hi = NSTEPS;
    void* kargs[] = {(void*)&a};
    hipError_t le = hipLaunchCooperativeKernel((const void*)mk_fwd, dim3(grid), dim3(NTHR), kargs, LDS_BYTES, stream);
    if (le != hipSuccess) fprintf(stderr, "kernel_launch: cooperative launch failed: %s (grid %d)\n", hipGetErrorString(le), grid);
#else
    for (int st = 0; st < NSTEPS; ++st) { a.ph_lo = st; a.ph_hi = st + 1; hipLaunchKernelGGL(mk_fwd, dim3(grid), dim3(NTHR), LDS_BYTES, stream, a); }
#endif
}
```

```cpp
#include <hip/hip_runtime.h>
#include <hip/hip_cooperative_groups.h>
#include <cstdio>
#include <cstdint>

namespace pg8 {
#define PG8_LAS __attribute__((address_space(3)))
typedef unsigned short bf16_t;
typedef short bf16x8 __attribute__((ext_vector_type(8)));
typedef float f32x4 __attribute__((ext_vector_type(4)));
typedef unsigned u32x4 __attribute__((ext_vector_type(4)));
typedef unsigned u32x2 __attribute__((ext_vector_type(2)));
constexpr int BM = 256, BK = 64, HALF = 128, HTB = HALF * BK * 2, STAGE_BYTES = 8 * HTB, NXCD = 8, WGM = 8;

__host__ __device__ __forceinline__ int lds_byte(int r, int c) { const int st = (r >> 4) * 2 + (c >> 5), rr = r & 15, cc = c & 31, ob = rr * 64 + cc * 2; return st * 1024 + (ob ^ (((ob >> 9) & 1) << 5)); }
__host__ __device__ __forceinline__ void stage_rc(int b, int& R, int& C) { const int st = b / 1024, sb = b % 1024, swz = sb ^ (((sb >> 9) & 1) << 5); R = (st >> 1) * 16 + swz / 64; C = (st & 1) * 32 + (swz % 64) / 2; }
__host__ __device__ __forceinline__ int perm32(int rho) { const int n = rho >> 4, i = rho & 15; return 8 * (i >> 2) + 4 * n + (i & 3); }

struct Unit { int pm, pn; };
struct Gemm { const bf16_t* A; const bf16_t* Bt; int M, N, K; };

struct StaticOrder {
    int nM, nN, nwg, G, c;
    __host__ __device__ void init(int M, int N, int G_, int c_) { nM = M / BM; nN = N / BM; nwg = nM * nN; G = G_; c = c_; }
    __host__ __device__ bool next(int i, Unit& u) const {
        const long L = (long)i * G + c; if (L >= nwg) return false;
        int wgid = (int)L; { const int q = nwg / NXCD, r = nwg % NXCD, xcd = wgid % NXCD, off = wgid / NXCD; wgid = (xcd < r ? xcd * (q + 1) : r * (q + 1) + (xcd - r) * q) + off; }
        const int nig = WGM * nN, gid = wgid / nig, fm = gid * WGM, gsz = (nM - fm) < WGM ? (nM - fm) : WGM;
        u.pm = fm + ((wgid % nig) % gsz); u.pn = (wgid % nig) / gsz; return true;
    }
    __device__ __forceinline__ void a_ready(const Unit&) const {}
    __device__ __forceinline__ void done(const Unit&) const {}
};

__device__ __forceinline__ unsigned cvt_pk_bf16(float lo, float hi) { unsigned r; asm volatile("v_cvt_pk_bf16_f32 %0, %1, %2" : "=v"(r) : "v"(lo), "v"(hi)); return r; }

template <class Epi, class Sched, bool ALIGN_EPI = false, bool SP2 = false>
__device__ __forceinline__ void gemm_phase(PG8_LAS unsigned char* lds, const Gemm g, const Sched& S, const Epi& E, const int tid) {
    const int wid = __builtin_amdgcn_readfirstlane(tid >> 6), lane = tid & 63, wr = wid >> 2, wc = wid & 3, fr = lane & 15, fq = lane >> 4;
    const int K = g.K, nt = K / BK;
    unsigned voffA[2], voffB[2];
#pragma unroll
    for (int i = 0; i < 2; ++i) { int R, C; stage_rc(tid * 16 + i * 8192, R, C); const int Rb = Epi::PERM ? ((R & ~31) + perm32(R & 31)) : R;
        voffA[i] = (unsigned)(R * K + C) * 2u; voffB[i] = (unsigned)(Rb * K + C) * 2u; }
    const size_t kstep = (size_t)(BK * 2);
    const size_t hstep = (size_t)HALF * K * 2;
    const size_t tstep = 2 * hstep;
    const unsigned ldsw = (unsigned)wid * 1024u;
    const int aoff = lds_byte(wr * 64 + fr, fq * 8), boff = lds_byte(wc * 32 + fr, fq * 8);
#define PG8_SA(b, h) (((b) * 2 + (h)) * HTB)
#define PG8_SB(b, h) ((4 + (b) * 2 + (h)) * HTB)
#define PG8_STAGE(bufoff, gbase, voff) do { _Pragma("unroll") for (int _i = 0; _i < 2; ++_i) \
        __builtin_amdgcn_global_load_lds((const unsigned*)((const char*)(gbase) + (voff)[_i]), (PG8_LAS unsigned*)(lds + (bufoff) + ldsw + _i * 8192), 16, 0, 0); } while (0)
#define PG8_LDA(dst, b, h) do { _Pragma("unroll") for (int m = 0; m < 4; ++m) _Pragma("unroll") for (int k = 0; k < 2; ++k) dst[m][k] = *(const PG8_LAS bf16x8*)(lds + PG8_SA(b, h) + aoff + m * 2048 + k * 1024); } while (0)
#define PG8_LDB(dst, b, h) do { _Pragma("unroll") for (int n = 0; n < 2; ++n) _Pragma("unroll") for (int k = 0; k < 2; ++k) dst[n][k] = *(const PG8_LAS bf16x8*)(lds + PG8_SB(b, h) + boff + n * 2048 + k * 1024); } while (0)
#define PG8_MMA(ai, bj, At, Bt) do { __builtin_amdgcn_s_setprio(1); _Pragma("unroll") for (int m = 0; m < 4; ++m) _Pragma("unroll") for (int n = 0; n < 2; ++n) _Pragma("unroll") for (int k = 0; k < 2; ++k) \
        acc[ai][bj][m][n] = __builtin_amdgcn_mfma_f32_16x16x32_bf16(Bt[n][k], At[m][k], acc[ai][bj][m][n], 0, 0, 0); __builtin_amdgcn_s_setprio(0); } while (0)
#define PG8_WAIT_V(n) asm volatile("s_waitcnt vmcnt(" #n ")" ::: "memory")
#define PG8_WAIT_L(n) asm volatile("s_waitcnt lgkmcnt(" #n ")" ::: "memory")
#define PG8_BAR __builtin_amdgcn_s_barrier()
#define PG8_SCHED __builtin_amdgcn_sched_barrier(0)
    Unit cur, nxt; int ui = 0;
    if (!S.next(0, cur)) return;
    f32x4 acc[2][2][4][2];
#pragma unroll
    for (int a = 0; a < 2; ++a)
#pragma unroll
        for (int b = 0; b < 2; ++b)
#pragma unroll
            for (int m = 0; m < 4; ++m)
#pragma unroll
                for (int n = 0; n < 2; ++n) acc[a][b][m][n] = (f32x4){0.f, 0.f, 0.f, 0.f};
    bf16x8 At[4][2], B0[2][2], B1[2][2];
    const char* cA = (const char*)g.A + (size_t)cur.pm * tstep; const char* cB = (const char*)g.Bt + (size_t)cur.pn * tstep;
    S.a_ready(cur);
    if constexpr (SP2) {
        PG8_STAGE(PG8_SB(0, 0), cB, voffB); PG8_STAGE(PG8_SB(0, 1), cB + hstep, voffB); PG8_STAGE(PG8_SA(0, 0), cA, voffA); PG8_STAGE(PG8_SA(0, 1), cA + hstep, voffA);
        if (wr == 1) PG8_BAR;
        PG8_WAIT_V(2); PG8_BAR;
        PG8_STAGE(PG8_SB(1, 0), cB + kstep, voffB); PG8_STAGE(PG8_SA(1, 0), cA + kstep, voffA); PG8_STAGE(PG8_SB(1, 1), cB + hstep + kstep, voffB);
        PG8_WAIT_V(6); PG8_BAR;
    } else {
        PG8_STAGE(PG8_SB(0, 0), cB, voffB); PG8_STAGE(PG8_SA(0, 0), cA, voffA); PG8_STAGE(PG8_SB(0, 1), cB + hstep, voffB); PG8_STAGE(PG8_SA(0, 1), cA + hstep, voffA);
        if (wr == 1) PG8_BAR;
        PG8_WAIT_V(4); PG8_BAR;
        PG8_STAGE(PG8_SB(1, 0), cB + kstep, voffB); PG8_STAGE(PG8_SA(1, 0), cA + kstep, voffA); PG8_STAGE(PG8_SB(1, 1), cB + hstep + kstep, voffB);
        PG8_WAIT_V(6); PG8_BAR;
    }
    for (;;) {
        const bool has_next = S.next(ui + 1, nxt);
        const char* nA = has_next ? (const char*)g.A + (size_t)nxt.pm * tstep : cA; const char* nB = has_next ? (const char*)g.Bt + (size_t)nxt.pn * tstep : cB;
        for (int t = 0; t < nt; t += 2) {
            const bool last = (t == nt - 2);
            const char* a1 = cA + (size_t)(t + 1) * kstep;
            const char* a2 = last ? nA : cA + (size_t)(t + 2) * kstep; const char* b2 = last ? nB : cB + (size_t)(t + 2) * kstep;
            const char* a3 = a2 + kstep; const char* b3 = b2 + kstep;
            if (last && has_next) S.a_ready(nxt);
            if constexpr (SP2) {
            PG8_LDB(B0, 0, 0); PG8_LDB(B1, 0, 1); PG8_SCHED; PG8_LDA(At, 0, 0); PG8_STAGE(PG8_SA(1, 1), a1 + hstep, voffA);
            PG8_WAIT_V(8); PG8_WAIT_L(0); PG8_BAR; PG8_MMA(0, 0, At, B0); PG8_MMA(0, 1, At, B1); PG8_BAR; PG8_SCHED;
            PG8_LDA(At, 0, 1); PG8_STAGE(PG8_SB(0, 0), b2, voffB); PG8_STAGE(PG8_SB(0, 1), b2 + hstep, voffB); PG8_STAGE(PG8_SA(0, 0), a2, voffA);
            PG8_WAIT_V(8); PG8_WAIT_L(0); PG8_BAR; PG8_MMA(1, 0, At, B0); PG8_MMA(1, 1, At, B1); PG8_BAR; PG8_SCHED;
            PG8_LDB(B0, 1, 0); PG8_LDB(B1, 1, 1); PG8_SCHED; PG8_LDA(At, 1, 0); PG8_STAGE(PG8_SA(0, 1), a2 + hstep, voffA);
            PG8_WAIT_V(8); PG8_WAIT_L(0); PG8_BAR; PG8_MMA(0, 0, At, B0); PG8_MMA(0, 1, At, B1); PG8_BAR; PG8_SCHED;
            PG8_LDA(At, 1, 1); PG8_STAGE(PG8_SB(1, 0), b3, voffB); PG8_STAGE(PG8_SB(1, 1), b3 + hstep, voffB); PG8_STAGE(PG8_SA(1, 0), a3, voffA);
            PG8_WAIT_V(8); PG8_WAIT_L(0); PG8_BAR; PG8_MMA(1, 0, At, B0); PG8_MMA(1, 1, At, B1); PG8_BAR; PG8_SCHED;
            } else {
            PG8_LDB(B0, 0, 0); PG8_SCHED; PG8_LDA(At, 0, 0); PG8_STAGE(PG8_SA(1, 1), a1 + hstep, voffA);
            PG8_WAIT_L(8); PG8_BAR; PG8_WAIT_L(0); PG8_MMA(0, 0, At, B0); PG8_BAR; PG8_SCHED;
            PG8_LDB(B1, 0, 1); PG8_STAGE(PG8_SB(0, 0), b2, voffB);
            PG8_BAR; PG8_WAIT_L(0); PG8_MMA(0, 1, At, B1); PG8_BAR;
            PG8_LDA(At, 0, 1); PG8_STAGE(PG8_SA(0, 0), a2, voffA);
            PG8_BAR; PG8_WAIT_L(0); PG8_MMA(1, 0, At, B0); PG8_BAR; PG8_SCHED;
            PG8_STAGE(PG8_SB(0, 1), b2 + hstep, voffB);
            PG8_WAIT_V(6); PG8_BAR; PG8_MMA(1, 1, At, B1); PG8_BAR;
            PG8_LDB(B0, 1, 0); PG8_SCHED; PG8_LDA(At, 1, 0); PG8_STAGE(PG8_SA(0, 1), a2 + hstep, voffA);
            PG8_WAIT_L(8); PG8_BAR; PG8_WAIT_L(0); PG8_MMA(0, 0, At, B0); PG8_BAR; PG8_SCHED;
            PG8_LDB(B1, 1, 1); PG8_STAGE(PG8_SB(1, 0), b3, voffB);
            PG8_BAR; PG8_WAIT_L(0); PG8_MMA(0, 1, At, B1); PG8_BAR;
            PG8_LDA(At, 1, 1); PG8_STAGE(PG8_SA(1, 0), a3, voffA);
            PG8_BAR; PG8_WAIT_L(0); PG8_MMA(1, 0, At, B0); PG8_BAR; PG8_SCHED;
            PG8_STAGE(PG8_SB(1, 1), b3 + hstep, voffB);
            PG8_WAIT_V(6); PG8_BAR; PG8_MMA(1, 1, At, B1); PG8_BAR;
            }
        }
        if constexpr (ALIGN_EPI) { if (wr == 0) PG8_BAR; }
        E(acc, cur, wr, wc, fr, fq); S.done(cur);
        if (!has_next) break;
#pragma unroll
        for (int a = 0; a < 2; ++a)
#pragma unroll
            for (int b = 0; b < 2; ++b)
#pragma unroll
                for (int m = 0; m < 4; ++m)
#pragma unroll
                    for (int n = 0; n < 2; ++n) acc[a][b][m][n] = (f32x4){0.f, 0.f, 0.f, 0.f};
        cur = nxt; cA = nA; cB = nB; ++ui;
        if constexpr (ALIGN_EPI) { if (wr == 1) PG8_BAR; }
    }
    PG8_WAIT_V(0);
    if constexpr (!ALIGN_EPI) { if (wr == 0) PG8_BAR; }
    PG8_BAR;
#undef PG8_SA
#undef PG8_SB
#undef PG8_STAGE
#undef PG8_LDA
#undef PG8_LDB
#undef PG8_MMA
#undef PG8_WAIT_V
#undef PG8_WAIT_L
#undef PG8_BAR
#undef PG8_SCHED
}
}
constexpr int D = 1024, NB = 4, SEQ = 8192, DB = 8, DSEQ = 64, NMB = NB + DB;
constexpr int GH = 8, GDK = 128, GDV = 128;
constexpr int SH = 32, SP = 64, SN = 128, SG = 8;
constexpr int DFF = 2816, CONV_CH = 7168, IN_COLS = 12336;
constexpr int NPROJ = 12288;
constexpr int NIN = 12544;
constexpr int NUP = 2 * DFF;
constexpr float EPS = 1e-6f;
#ifndef SLAB_T
#define SLAB_T 1024
#endif
constexpr int NSLAB = SEQ / SLAB_T, RP = NB * SLAB_T, RS = DB * DSEQ, RMAX = RP + RS;
constexpr size_t O_YP = 0, O_YS = O_YP + (size_t)NB * SEQ * D, O_CMP = O_YS + (size_t)DB * DSEQ * D, O_GP = O_CMP + (size_t)NB * 3 * CONV_CH,
                 O_SP = O_GP + (size_t)NB * GH * GDK * GDV, O_CFP = O_SP + (size_t)NB * SH * SN * SP, O_CMS = O_CFP + (size_t)NB * 2 * NUP,
                 O_GS = O_CMS + (size_t)DB * 3 * CONV_CH, O_SS = O_GS + (size_t)DB * GH * GDK * GDV, O_CFS = O_SS + (size_t)DB * SH * SN * SP,
                 O_END = O_CFS + (size_t)DB * 2 * NUP;
constexpr size_t MiB = 1u << 20;
constexpr size_t WS_CTL = 0, CTL_ZERO_BYTES = 1 * MiB;
constexpr size_t WS_MODV = 1 * MiB;
constexpr size_t WS_G1 = WS_MODV + 512 * 1024;
constexpr size_t WS_G2 = WS_G1 + 64 * 1024;
constexpr size_t WS_SHW = WS_G2 + 64 * 1024;
constexpr size_t WS_CARRY_MIX = 2 * MiB;
constexpr size_t WS_CARRY_FFN = 3 * MiB;
constexpr size_t WS_WIN = 4 * MiB;
constexpr size_t WS_WG = WS_WIN + (size_t)NIN * D * 2;
constexpr size_t WS_WS = WS_WG + (size_t)D * D * 2;
constexpr size_t WS_WOUT = WS_WS + (size_t)D * 2048 * 2;
constexpr size_t WS_WUP = WS_WOUT + (size_t)D * D * 2;
constexpr size_t WS_WDN = WS_WUP + (size_t)NUP * D * 2;
constexpr size_t WS_SLAB = 56 * MiB;
static_assert(WS_WDN + (size_t)D * DFF * 2 <= WS_SLAB, "weights fit");
constexpr size_t SZ_HB = (size_t)RMAX * D * 2, SZ_PROJ = (size_t)RMAX * NPROJ * 2, SZ_SM = (size_t)RMAX * 64 * 4, SZ_OG = (size_t)RMAX * D * 2, SZ_YS = (size_t)RMAX * 2048 * 2,
                 SZ_T1 = (size_t)RMAX * D * 4, SZ_MIX = (size_t)RMAX * D * 2, SZ_X1 = (size_t)RMAX * D * 4, SZ_X1G = (size_t)RMAX * D * 2, SZ_SS = (size_t)RMAX * 16 * 4,
                 SZ_U = (size_t)RMAX * NUP * 2, SZ_ACT = (size_t)RMAX * DFF * 2;
constexpr size_t WS_HB = WS_SLAB, WS_PROJ = WS_HB + SZ_HB, WS_SM = WS_PROJ + SZ_PROJ, WS_OG = WS_SM + SZ_SM, WS_YS = WS_OG + SZ_OG, WS_T1 = WS_YS + SZ_YS, WS_MIX = WS_T1 + SZ_T1,
                 WS_X1 = WS_MIX + SZ_MIX, WS_X1G = WS_X1 + SZ_X1, WS_SS1 = WS_X1G + SZ_X1G, WS_SS2 = WS_SS1 + SZ_SS, WS_U = WS_SS2 + SZ_SS, WS_ACT = WS_U + SZ_U, WS_END = WS_ACT + SZ_ACT;
static_assert(WS_END <= 480 * MiB, "workspace map fits");
constexpr int LDS_BYTES = 147456, LDSCTL_OFF = LDS_BYTES - 512, MISC_OFF = LDSCTL_OFF + 320, RING_BYTES = LDSCTL_OFF;
constexpr int NWAVES = 8, NTHR = 512;

#define GAS __attribute__((address_space(1)))
#define LAS __attribute__((address_space(3)))
typedef unsigned short bf16;
typedef unsigned v4u __attribute__((ext_vector_type(4)));
typedef unsigned v2u __attribute__((ext_vector_type(2)));
typedef float f32x4 __attribute__((ext_vector_type(4)));
typedef GAS unsigned gu32;
#define RLX_AGENT __ATOMIC_RELAXED, __HIP_MEMORY_SCOPE_AGENT
#define LDS_WAIT() asm volatile("s_waitcnt lgkmcnt(0)" ::: "memory")
#define VM_WAIT() asm volatile("s_waitcnt vmcnt(0)" ::: "memory")
__device__ __forceinline__ unsigned f2bf(float f) { unsigned u = __builtin_bit_cast(unsigned, f); return (u + 0x7fffu + ((u >> 16) & 1u)) >> 16; }
__device__ __forceinline__ unsigned pk2(float lo, float hi) { return f2bf(lo) | (f2bf(hi) << 16); }
__device__ __forceinline__ float bf2f(unsigned short h) { return __builtin_bit_cast(float, (unsigned)h << 16); }
__device__ __forceinline__ float bflo(unsigned w) { return __builtin_bit_cast(float, w << 16); }
__device__ __forceinline__ float bfhi(unsigned w) { return __builtin_bit_cast(float, w & 0xffff0000u); }
__device__ __forceinline__ float sigmoidf_(float x) { return 1.f / (1.f + __expf(-x)); }
__device__ __forceinline__ float siluf_(float x) { return x / (1.f + __expf(-x)); }
__device__ __forceinline__ float softplusf_(float x) { const float e = __expf(-fabsf(x)), u = 1.f + e, d = u - 1.f; const float l = (d == 0.f) ? e : __logf(u) * (e / d); return fmaxf(x, 0.f) + l; }
__device__ __forceinline__ float wave_sum(float v) {
#pragma unroll
    for (int o = 1; o < 64; o <<= 1) v += __shfl_xor(v, o);
    return v;
}

struct Args { const float* in[30]; float* out; unsigned char* ws; int ph_lo, ph_hi; };

struct Frame {
    LAS unsigned char* lds;
    volatile LAS unsigned* MISC;
    gu32* ctl;
    int tid, lane, wave, G, bid;
    const Args& A;
    float* out; unsigned char* ws;
    __device__ __forceinline__ Frame(const Args& a) : A(a) {}
};
__device__ __forceinline__ int row_mb(int r) { return r < RP ? (r / SLAB_T) : NB + ((r - RP) / DSEQ); }
__device__ __forceinline__ size_t row_goff(int s, int r) {
    if (r < RP) { const int b = r / SLAB_T, tl = r % SLAB_T; return ((size_t)b * SEQ + (size_t)s * SLAB_T + tl) * D; }
    return (size_t)(r - RP) * D;
}
__device__ __forceinline__ int slab_rows(int s) { return s == 0 ? RMAX : RP; }
struct MapWin { __device__ __forceinline__ int operator()(int n) const { return n < 10240 ? n : (n < 12288 ? n + 48 : (n < 12336 ? n - 2048 : -1)); } };
struct MapId  { __device__ __forceinline__ int operator()(int n) const { return n; } };
struct MapUp  { __device__ __forceinline__ int operator()(int n) const { const int j = n >> 8, c = n & 255; return c < 128 ? 128 * j + c : DFF + 128 * j + (c - 128); } };
template <class Map>
__device__ __forceinline__ void p0_transpose_item(const float* W, int ldw, int K, bf16* WT, Map map, LAS float* scr, int item, int nblk, int lane) {
    const int kb = item / nblk, nb = item % nblk, k0 = 64 * kb, n0 = 32 * nb;
    const int sc = map(n0 + (lane & 31));
#pragma unroll 8
    for (int i = 0; i < 32; ++i) { const int kk = 2 * i + (lane >> 5); scr[kk * 33 + (lane & 31)] = sc >= 0 ? W[(size_t)(k0 + kk) * ldw + sc] : 0.f; }
    LDS_WAIT(); asm volatile("" ::: "memory");
    const int c = lane & 7;
#pragma unroll
    for (int j = 0; j < 4; ++j) { const int n = (lane >> 3) + 8 * j; const LAS float* s = scr + (8 * c) * 33 + n;
        v4u o; o.x = pk2(s[0 * 33], s[1 * 33]); o.y = pk2(s[2 * 33], s[3 * 33]); o.z = pk2(s[4 * 33], s[5 * 33]); o.w = pk2(s[6 * 33], s[7 * 33]);
        *(GAS v4u*)(WT + (size_t)(n0 + n) * K + k0 + 8 * c) = o; }
    LDS_WAIT(); asm volatile("" ::: "memory");
}
__device__ __forceinline__ void p0_mod_item(Frame& F, int item) {
    LAS float* sc = (LAS float*)F.lds; LAS float* red = (LAS float*)(F.lds + 49152);
    const float* cp = F.A.in[6]; const float* cs = F.A.in[7]; const float* w_ada = F.A.in[8]; const float* b_ada = F.A.in[9];
    for (int idx = F.tid; idx < NMB * D; idx += NTHR) { const int b = idx / D, k = idx % D; const float c = b < NB ? cp[b * D + k] : cs[(b - NB) * D + k]; sc[idx] = siluf_(c); }
    __syncthreads();
    float acc[NMB];
#pragma unroll
    for (int b = 0; b < NMB; ++b) acc[b] = 0.f;
    const int col = item * 64 + F.lane, kb = F.wave * 128;
    for (int k = 0; k < 128; ++k) { const float wv = w_ada[(size_t)(kb + k) * 6144 + col];
#pragma unroll
        for (int b = 0; b < NMB; ++b) acc[b] += sc[b * D + kb + k] * wv; }
#pragma unroll
    for (int b = 0; b < NMB; ++b) red[(F.wave * NMB + b) * 64 + F.lane] = acc[b];
    __syncthreads();
    float* modv = (float*)(F.ws + WS_MODV);
    for (int idx = F.tid; idx < NMB * 64; idx += NTHR) { const int b = idx / 64, l = idx % 64; float s = b_ada[item * 64 + l];
#pragma unroll
        for (int w = 0; w < 8; ++w) s += red[(w * NMB + b) * 64 + l];
        modv[b * 6144 + item * 64 + l] = s; }
    __syncthreads();
}
__device__ __forceinline__ void phase_prologue0(Frame& F) {
    for (int it = F.bid; it < 96; it += F.G) p0_mod_item(F, it);
    LAS float* scr = (LAS float*)(F.lds + F.wave * 16384);
    const int gw = F.bid * NWAVES + F.wave, NGW = F.G * NWAVES;
    constexpr int I_IN = (D / 64) * (NIN / 32), I_G = (D / 64) * (D / 32), I_S = (2048 / 64) * (D / 32), I_O = I_G, I_UP = (D / 64) * (NUP / 32), I_DN = (DFF / 64) * (D / 32);
    constexpr int NITEMS = I_IN + I_G + I_S + I_O + I_UP + I_DN;
    for (int it = gw; it < NITEMS; it += NGW) {
        int r = it;
        if (r < I_IN) { p0_transpose_item(F.A.in[11], IN_COLS, D, (bf16*)(F.ws + WS_WIN), MapWin(), scr, r, NIN / 32, F.lane); continue; } r -= I_IN;
        if (r < I_G) { p0_transpose_item(F.A.in[21], D, D, (bf16*)(F.ws + WS_WG), MapId(), scr, r, D / 32, F.lane); continue; } r -= I_G;
        if (r < I_S) { p0_transpose_item(F.A.in[22], D, 2048, (bf16*)(F.ws + WS_WS), MapId(), scr, r, D / 32, F.lane); continue; } r -= I_S;
        if (r < I_O) { p0_transpose_item(F.A.in[23], D, D, (bf16*)(F.ws + WS_WOUT), MapId(), scr, r, D / 32, F.lane); continue; } r -= I_O;
        if (r < I_UP) { p0_transpose_item(F.A.in[25], NUP, D, (bf16*)(F.ws + WS_WUP), MapUp(), scr, r, NUP / 32, F.lane); continue; } r -= I_UP;
        p0_transpose_item(F.A.in[28], D, DFF, (bf16*)(F.ws + WS_WDN), MapId(), scr, r, D / 32, F.lane);
    }
}
__device__ __forceinline__ void phase_prologue1(Frame& F) {
    const float* modv = (const float*)(F.ws + WS_MODV);
    float* g1 = (float*)(F.ws + WS_G1); float* g2 = (float*)(F.ws + WS_G2); float* shw = (float*)(F.ws + WS_SHW);
    for (int idx = F.bid * NTHR + F.tid; idx < NMB * D; idx += F.G * NTHR) { const int b = idx / D, k = idx % D;
        g1[idx] = F.A.in[10][k] * (1.f + modv[b * 6144 + 1024 + k]); g2[idx] = F.A.in[24][k] * (1.f + modv[b * 6144 + 4096 + k]); }
    LAS float* sh = (LAS float*)F.lds;
    for (int idx = F.tid; idx < NMB * D; idx += NTHR) sh[idx] = modv[(idx / D) * 6144 + 3072 + (idx % D)];
    __syncthreads();
    const bf16* wup = (const bf16*)(F.ws + WS_WUP);
    const int gw = F.bid * NWAVES + F.wave, NGW = F.G * NWAVES;
    for (int n = gw; n < NUP; n += NGW) {
        const GAS v4u* wr = (const GAS v4u*)(wup + (size_t)n * D + F.lane * 16);
        const v4u w0 = wr[0], w1 = wr[1];
        float wf[16] = {bflo(w0.x), bfhi(w0.x), bflo(w0.y), bfhi(w0.y), bflo(w0.z), bfhi(w0.z), bflo(w0.w), bfhi(w0.w), bflo(w1.x), bfhi(w1.x), bflo(w1.y), bfhi(w1.y), bflo(w1.z), bfhi(w1.z), bflo(w1.w), bfhi(w1.w)};
        float res = 0.f;
#pragma unroll 1
        for (int b = 0; b < NMB; ++b) { float a = 0.f;
#pragma unroll
            for (int i = 0; i < 16; ++i) a += wf[i] * sh[b * D + F.lane * 16 + i];
            a = wave_sum(a); if (F.lane == b) res = a; }
        if (F.lane < NMB) shw[F.lane * NUP + n] = res;
    }
    __syncthreads();
}
__device__ __forceinline__ void phase_norm1(Frame& F, int s) {
    const float* modv = (const float*)(F.ws + WS_MODV); const float* g1 = (const float*)(F.ws + WS_G1); bf16* hb = (bf16*)(F.ws + WS_HB);
    const int gw = F.bid * NWAVES + F.wave, NGW = F.G * NWAVES, R = slab_rows(s);
    for (int r = gw; r < R; r += NGW) {
        const float* xrow = (r < RP ? F.A.in[0] : F.A.in[1]) + row_goff(s, r); const int mb = row_mb(r);
        const GAS f32x4* xr = (const GAS f32x4*)xrow + F.lane;
        f32x4 v[4]; float ss = 0.f;
#pragma unroll
        for (int j = 0; j < 4; ++j) { v[j] = xr[64 * j]; ss += (v[j].x * v[j].x + v[j].y * v[j].y) + (v[j].z * v[j].z + v[j].w * v[j].w); }
        const float rs = rsqrtf(wave_sum(ss) * (1.f / D) + EPS);
        GAS v2u* o8 = (GAS v2u*)(hb + (size_t)r * D) + F.lane;
#pragma unroll
        for (int j = 0; j < 4; ++j) { const int k = 4 * F.lane + 256 * j; const f32x4 g = *(const GAS f32x4*)(g1 + mb * D + k); const f32x4 sh = *(const GAS f32x4*)(modv + mb * 6144 + k);
            v2u o; o.x = pk2(v[j].x * rs * g.x + sh.x, v[j].y * rs * g.y + sh.y); o.y = pk2(v[j].z * rs * g.z + sh.z, v[j].w * rs * g.w + sh.w); o8[64 * j] = o; }
    }
}
__device__ __forceinline__ void phase_final(Frame& F, int s) {
    const float* ss2 = (const float*)(F.ws + WS_SS2); const float* wf = F.A.in[29];
    const int gw = F.bid * NWAVES + F.wave, NGW = F.G * NWAVES, R = slab_rows(s);
    for (int r = gw; r < R; r += NGW) {
        float* yrow = F.out + (r < RP ? O_YP : O_YS) + row_goff(s, r);
        float t = F.lane < 16 ? ss2[(size_t)r * 16 + F.lane] : 0.f; t = wave_sum(t);
        const float rs = rsqrtf(t * (1.f / D) + EPS);
        GAS f32x4* yr = (GAS f32x4*)yrow + F.lane;
#pragma unroll
        for (int j = 0; j < 4; ++j) { f32x4 v = yr[64 * j]; const f32x4 w = *(const GAS f32x4*)(wf + 4 * F.lane + 256 * j); v.x *= rs * w.x; v.y *= rs * w.y; v.z *= rs * w.z; v.w *= rs * w.w; yr[64 * j] = v; }
    }
}
__device__ __forceinline__ void u_hist_row(Frame& F, int s, int r, int back, int c8, int j, int cc, float (&ua)[8], float (&uv)[8]) {
    const bf16* U = (const bf16*)(F.ws + WS_U);
    int tl, b; bool samp = r >= RP;
    if (!samp) { b = r / SLAB_T; tl = r % SLAB_T; } else { b = (r - RP) / DSEQ; tl = (r - RP) % DSEQ; }
    if (tl - back >= 0) {
        const bf16* p = U + (size_t)(r - back) * NUP + 256 * j + cc;
        const v4u a = *(const GAS v4u*)p, v = *(const GAS v4u*)(p + 128);
        ua[0] = bflo(a.x); ua[1] = bfhi(a.x); ua[2] = bflo(a.y); ua[3] = bfhi(a.y); ua[4] = bflo(a.z); ua[5] = bfhi(a.z); ua[6] = bflo(a.w); ua[7] = bfhi(a.w);
        uv[0] = bflo(v.x); uv[1] = bfhi(v.x); uv[2] = bflo(v.y); uv[3] = bfhi(v.y); uv[4] = bflo(v.z); uv[5] = bfhi(v.z); uv[6] = bflo(v.w); uv[7] = bfhi(v.w);
        return;
    }
    const int hi = 2 + (tl - back);
    if (samp) { const float* st = F.A.in[5] + ((size_t)b * 2 + hi) * NUP;
#pragma unroll
        for (int i = 0; i < 8; ++i) { ua[i] = st[c8 + i]; uv[i] = st[DFF + c8 + i]; } return; }
    if (s == 0) {
#pragma unroll
        for (int i = 0; i < 8; ++i) { ua[i] = 0.f; uv[i] = 0.f; } return; }
    const float* cf = (const float*)(F.ws + WS_CARRY_FFN) + (((size_t)(s & 1) * NB + b) * 2 + hi) * NUP + 256 * j + cc;
#pragma unroll
    for (int i = 0; i < 8; ++i) { ua[i] = cf[i]; uv[i] = cf[128 + i]; }
}
__device__ __forceinline__ void phase_convact(Frame& F, int s) {
    const bf16* U = (const bf16*)(F.ws + WS_U); bf16* ACT = (bf16*)(F.ws + WS_ACT);
    const float* wc = F.A.in[26]; const float* bc = F.A.in[27];
    const int R = slab_rows(s); const long total = (long)R * (DFF / 8);
    for (long idx = (long)F.bid * NTHR + F.tid; idx < total; idx += (long)F.G * NTHR) {
        const int r = (int)(idx / (DFF / 8)), c8 = (int)(idx % (DFF / 8)) * 8, j = c8 >> 7, cc = c8 & 127;
        float a0[8], v0[8], a1[8], v1[8], a2[8], v2[8];
        u_hist_row(F, s, r, 0, c8, j, cc, a2, v2); u_hist_row(F, s, r, 1, c8, j, cc, a1, v1); u_hist_row(F, s, r, 2, c8, j, cc, a0, v0);
        float o[8];
#pragma unroll
        for (int i = 0; i < 8; ++i) { const int ca = c8 + i, cv = DFF + c8 + i;
            const float xa = bc[ca] + wc[ca] * a0[i] + wc[NUP + ca] * a1[i] + wc[2 * NUP + ca] * a2[i];
            const float xv = bc[cv] + wc[cv] * v0[i] + wc[NUP + cv] * v1[i] + wc[2 * NUP + cv] * v2[i];
            o[i] = siluf_(xa) * xv; }
        v4u w; w.x = pk2(o[0], o[1]); w.y = pk2(o[2], o[3]); w.z = pk2(o[4], o[5]); w.w = pk2(o[6], o[7]);
        *(GAS v4u*)(ACT + (size_t)r * DFF + c8) = w;
    }
    float* cfn = (float*)(F.ws + WS_CARRY_FFN) + (size_t)((s + 1) & 1) * NB * 2 * NUP;
    for (int idx = F.bid * NTHR + F.tid; idx < NB * 2 * NUP; idx += F.G * NTHR) {
        const int b = idx / (2 * NUP), i = (idx / NUP) % 2, c = idx % NUP; const int r = b * SLAB_T + SLAB_T - 2 + i;
        const float v = bf2f(U[(size_t)r * NUP + c]); cfn[idx] = v;
        if (s == NSLAB - 1) { const int j = c >> 8, cc = c & 255; const int oc = cc < 128 ? 128 * j + cc : DFF + 128 * j + (cc - 128); F.out[O_CFP + ((size_t)b * 2 + i) * NUP + oc] = v; }
    }
    if (s == 0) for (int idx = F.bid * NTHR + F.tid; idx < DB * 2 * NUP; idx += F.G * NTHR) {
        const int b = idx / (2 * NUP), i = (idx / NUP) % 2, c = idx % NUP; const int r = RP + b * DSEQ + DSEQ - 2 + i;
        const int j = c >> 8, cc = c & 255; const int oc = cc < 128 ? 128 * j + cc : DFF + 128 * j + (cc - 128);
        F.out[O_CFS + ((size_t)b * 2 + i) * NUP + oc] = bf2f(U[(size_t)r * NUP + c]);
    }
}
__device__ __forceinline__ void phase_mix_carry(Frame& F, int s) {
    const bf16* P = (const bf16*)(F.ws + WS_PROJ);
    float* cmn = (float*)(F.ws + WS_CARRY_MIX) + (size_t)((s + 1) & 1) * NB * 3 * CONV_CH;
    for (int idx = F.bid * NTHR + F.tid; idx < NB * 3 * CONV_CH; idx += F.G * NTHR) {
        const int b = idx / (3 * CONV_CH), i = (idx / CONV_CH) % 3, c = idx % CONV_CH; const int r = b * SLAB_T + SLAB_T - 3 + i;
        const float v = bf2f(P[(size_t)r * NPROJ + c]); cmn[idx] = v;
        if (s == NSLAB - 1) F.out[O_CMP + idx] = v;
    }
    if (s == 0) for (int idx = F.bid * NTHR + F.tid; idx < DB * 3 * CONV_CH; idx += F.G * NTHR) {
        const int b = idx / (3 * CONV_CH), i = (idx / CONV_CH) % 3, c = idx % CONV_CH; const int r = RP + b * DSEQ + DSEQ - 3 + i;
        F.out[O_CMS + idx] = bf2f(P[(size_t)r * NPROJ + c]);
    }
}
namespace epi {
using pg8::f32x4; using pg8::Unit; using pg8::BM; using pg8::HALF; using pg8::cvt_pk_bf16; using pg8::u32x4; using pg8::u32x2;
struct EpiProj {
    static constexpr bool PERM = true;
    bf16* P; float* SM;
    __device__ __forceinline__ void operator()(const f32x4 (&acc)[2][2][4][2], const Unit& u, int wr, int wc, int fr, int fq) const {
        const int row0 = u.pm * BM + wr * 64 + fr;
        if (u.pn == 48) {
            if (wc < 2) {
#pragma unroll
                for (int ai = 0; ai < 2; ++ai)
#pragma unroll
                    for (int m = 0; m < 4; ++m) { float* rp = SM + (size_t)(row0 + ai * HALF + m * 16) * 64 + wc * 32 + 8 * fq;
                        *(f32x4*)rp = acc[ai][0][m][0]; *(f32x4*)(rp + 4) = acc[ai][0][m][1]; }
            }
            return;
        }
        const bool sg = u.pn >= 40;
        const int col0 = u.pn * BM + wc * 32 + 8 * fq;
#pragma unroll
        for (int ai = 0; ai < 2; ++ai)
#pragma unroll
            for (int m = 0; m < 4; ++m) { bf16* rowp = P + (size_t)(row0 + ai * HALF + m * 16) * NPROJ + col0;
#pragma unroll
                for (int bj = 0; bj < 2; ++bj) { f32x4 v0 = acc[ai][bj][m][0], v1 = acc[ai][bj][m][1];
                    if (sg) {
#pragma unroll
                        for (int i = 0; i < 4; ++i) { v0[i] = sigmoidf_(v0[i]); v1[i] = sigmoidf_(v1[i]); } }
                    u32x4 w; w.x = cvt_pk_bf16(v0[0], v0[1]); w.y = cvt_pk_bf16(v0[2], v0[3]); w.z = cvt_pk_bf16(v1[0], v1[1]); w.w = cvt_pk_bf16(v1[2], v1[3]);
                    *(u32x4*)(rowp + bj * HALF) = w; } }
    }
};
struct EpiGate1 {
    static constexpr bool PERM = false;
    const bf16* P; float* T1;
    __device__ __forceinline__ void operator()(const f32x4 (&acc)[2][2][4][2], const Unit& u, int wr, int wc, int fr, int fq) const {
        const int row0 = u.pm * BM + wr * 64 + fr, col0 = u.pn * BM + wc * 32 + 4 * fq;
#pragma unroll
        for (int ai = 0; ai < 2; ++ai)
#pragma unroll
            for (int m = 0; m < 4; ++m) { const size_t r = (size_t)(row0 + ai * HALF + m * 16);
#pragma unroll
                for (int bj = 0; bj < 2; ++bj)
#pragma unroll
                    for (int n = 0; n < 2; ++n) { const int c = col0 + bj * HALF + n * 16; const u32x2 g = *(const u32x2*)(P + r * NPROJ + 10240 + c); const f32x4 a = acc[ai][bj][m][n];
                        f32x4 o; o.x = a.x * bflo(g.x); o.y = a.y * bfhi(g.x); o.z = a.z * bflo(g.y); o.w = a.w * bfhi(g.y); *(f32x4*)(T1 + r * D + c) = o; } }
    }
};
struct EpiGate2 {
    static constexpr bool PERM = false;
    const bf16* P; const float* T1; bf16* MIX;
    __device__ __forceinline__ void operator()(const f32x4 (&acc)[2][2][4][2], const Unit& u, int wr, int wc, int fr, int fq) const {
        const int row0 = u.pm * BM + wr * 64 + fr, col0 = u.pn * BM + wc * 32 + 4 * fq;
#pragma unroll
        for (int ai = 0; ai < 2; ++ai)
#pragma unroll
            for (int m = 0; m < 4; ++m) { const size_t r = (size_t)(row0 + ai * HALF + m * 16);
#pragma unroll
                for (int bj = 0; bj < 2; ++bj)
#pragma unroll
                    for (int n = 0; n < 2; ++n) { const int c = col0 + bj * HALF + n * 16; const u32x2 g = *(const u32x2*)(P + r * NPROJ + 11264 + c); const f32x4 a = acc[ai][bj][m][n];
                        const f32x4 t = *(const f32x4*)(T1 + r * D + c);
                        u32x2 o; o.x = cvt_pk_bf16(t.x + a.x * bflo(g.x), t.y + a.y * bfhi(g.x)); o.y = cvt_pk_bf16(t.z + a.z * bflo(g.y), t.w + a.w * bfhi(g.y)); *(u32x2*)(MIX + r * D + c) = o; } }
    }
};
struct EpiOut {
    static constexpr bool PERM = false;
    const float* xp; const float* xs; const float* modv; const float* g2; float* X1; bf16* X1G; float* SS; int slab;
    __device__ __forceinline__ void operator()(const f32x4 (&acc)[2][2][4][2], const Unit& u, int wr, int wc, int fr, int fq) const {
        const int col0 = u.pn * BM + wc * 32 + 4 * fq;
#pragma unroll
        for (int ai = 0; ai < 2; ++ai) {
            const int rb = u.pm * BM + ai * HALF + wr * 64; const int mb = row_mb(rb);
#pragma unroll
            for (int m = 0; m < 4; ++m) { const int r = rb + m * 16 + fr; const float* xrow = (r < RP ? xp : xs) + row_goff(slab, r); float sq = 0.f;
#pragma unroll
                for (int bj = 0; bj < 2; ++bj)
#pragma unroll
                    for (int n = 0; n < 2; ++n) { const int c = col0 + bj * HALF + n * 16; const f32x4 a = acc[ai][bj][m][n];
                        const f32x4 xv = *(const f32x4*)(xrow + c), gt = *(const f32x4*)(modv + mb * 6144 + 2048 + c), gg = *(const f32x4*)(g2 + mb * D + c);
                        f32x4 o = xv + gt * a; *(f32x4*)(X1 + (size_t)r * D + c) = o; sq += (o.x * o.x + o.y * o.y) + (o.z * o.z + o.w * o.w);
                        u32x2 w; w.x = cvt_pk_bf16(o.x * gg.x, o.y * gg.y); w.y = cvt_pk_bf16(o.z * gg.z, o.w * gg.w); *(u32x2*)(X1G + (size_t)r * D + c) = w; }
                sq += __shfl_xor(sq, 16); sq += __shfl_xor(sq, 32);
                if (fq == 0) SS[(size_t)r * 16 + u.pn * 4 + wc] = sq; }
        }
    }
};
struct EpiUp {
    static constexpr bool PERM = true;
    const float* SS; const float* shw; bf16* U;
    __device__ __forceinline__ void operator()(const f32x4 (&acc)[2][2][4][2], const Unit& u, int wr, int wc, int fr, int fq) const {
        const int col0 = u.pn * BM + wc * 32 + 8 * fq;
#pragma unroll
        for (int ai = 0; ai < 2; ++ai) {
            const int rb = u.pm * BM + ai * HALF + wr * 64; const int mb = row_mb(rb);
            f32x4 sv[2][2];
#pragma unroll
            for (int bj = 0; bj < 2; ++bj)
#pragma unroll
                for (int n = 0; n < 2; ++n) sv[bj][n] = *(const f32x4*)(shw + mb * NUP + col0 + bj * HALF + 4 * n);
#pragma unroll
            for (int m = 0; m < 4; ++m) { const int r = rb + m * 16 + fr; const f32x4* sp = (const f32x4*)(SS + (size_t)r * 16);
                const f32x4 s0 = sp[0], s1 = sp[1], s2 = sp[2], s3 = sp[3];
                const float tot = ((s0.x + s0.y) + (s0.z + s0.w)) + ((s1.x + s1.y) + (s1.z + s1.w)) + ((s2.x + s2.y) + (s2.z + s2.w)) + ((s3.x + s3.y) + (s3.z + s3.w));
                const float rs = rsqrtf(tot * (1.f / D) + EPS);
#pragma unroll
                for (int bj = 0; bj < 2; ++bj) { const f32x4 v0 = acc[ai][bj][m][0] * rs + sv[bj][0], v1 = acc[ai][bj][m][1] * rs + sv[bj][1];
                    u32x4 w; w.x = cvt_pk_bf16(v0[0], v0[1]); w.y = cvt_pk_bf16(v0[2], v0[3]); w.z = cvt_pk_bf16(v1[0], v1[1]); w.w = cvt_pk_bf16(v1[2], v1[3]);
                    *(u32x4*)(U + (size_t)r * NUP + col0 + bj * HALF) = w; } }
        }
    }
};
struct EpiDown {
    static constexpr bool PERM = false;
    const float* X1; const float* modv; float* yp; float* ys; float* SS; int slab;
    __device__ __forceinline__ void operator()(const f32x4 (&acc)[2][2][4][2], const Unit& u, int wr, int wc, int fr, int fq) const {
        const int col0 = u.pn * BM + wc * 32 + 4 * fq;
#pragma unroll
        for (int ai = 0; ai < 2; ++ai) {
            const int rb = u.pm * BM + ai * HALF + wr * 64; const int mb = row_mb(rb);
#pragma unroll
            for (int m = 0; m < 4; ++m) { const int r = rb + m * 16 + fr; float* yrow = (r < RP ? yp : ys) + row_goff(slab, r); float sq = 0.f;
#pragma unroll
                for (int bj = 0; bj < 2; ++bj)
#pragma unroll
                    for (int n = 0; n < 2; ++n) { const int c = col0 + bj * HALF + n * 16; const f32x4 a = acc[ai][bj][m][n];
                        const f32x4 xv = *(const f32x4*)(X1 + (size_t)r * D + c), gt = *(const f32x4*)(modv + mb * 6144 + 5120 + c);
                        f32x4 o = xv + gt * a; *(f32x4*)(yrow + c) = o; sq += (o.x * o.x + o.y * o.y) + (o.z * o.z + o.w * o.w); }
                sq += __shfl_xor(sq, 16); sq += __shfl_xor(sq, 32);
                if (fq == 0) SS[(size_t)r * 16 + u.pn * 4 + wc] = sq; }
        }
    }
};
}
typedef short bf16x8 __attribute__((ext_vector_type(8)));
#define MFMA16(a, b, c) __builtin_amdgcn_mfma_f32_16x16x32_bf16((a), (b), (c), 0, 0, 0)
__device__ __forceinline__ bf16x8 ldfrag(const LAS bf16* base, int ld, int row0, int k0, int lane) {
    return *(const LAS bf16x8*)(base + (row0 + (lane & 15)) * ld + k0 + 8 * (lane >> 4));
}
__device__ __forceinline__ bf16x8 ldfrag_perm(const LAS bf16* base, int ld, int row0, int k0, int lane) {
    const LAS v2u* p = (const LAS v2u*)(base + (row0 + (lane & 15)) * ld + k0 + 4 * (lane >> 4));
    const v2u a = p[0], b = p[4];
    v4u w; w.x = a.x; w.y = a.y; w.z = b.x; w.w = b.y; return __builtin_bit_cast(bf16x8, w);
}
__device__ __forceinline__ bf16x8 acc2frag(f32x4 t0, f32x4 t1) {
    v4u w; w.x = pg8::cvt_pk_bf16(t0.x, t0.y); w.y = pg8::cvt_pk_bf16(t0.z, t0.w); w.z = pg8::cvt_pk_bf16(t1.x, t1.y); w.w = pg8::cvt_pk_bf16(t1.z, t1.w); return __builtin_bit_cast(bf16x8, w);
}
__device__ __forceinline__ float wave_incl_scan(float v, int lane) {
#pragma unroll
    for (int o = 1; o < 64; o <<= 1) { const float t = __shfl_up(v, o); if (lane >= o) v += t; }
    return v;
}
__device__ __forceinline__ float row16_sum(float v) { v += __shfl_xor(v, 1); v += __shfl_xor(v, 2); v += __shfl_xor(v, 4); v += __shfl_xor(v, 8); return v; }

constexpr int SL_CS = 0, SL_BS = 17408, SL_BT = 34816, SL_XT = 53248, SL_CB = 90112, SL_DT = 99328, SL_GAM = 100352, SL_PS = 101376, SL_ZS = 103424;
__device__ __forceinline__ void ssd_fast_job(Frame& F, int s, bool samp, int bb, int g) {
    const bf16* P = (const bf16*)(F.ws + WS_PROJ); const float* SM = (const float*)(F.ws + WS_SM); bf16* YS = (bf16*)(F.ws + WS_YS);
    LAS bf16* CS = (LAS bf16*)(F.lds + SL_CS); LAS bf16* BS = (LAS bf16*)(F.lds + SL_BS); LAS bf16* BT = (LAS bf16*)(F.lds + SL_BT); LAS bf16* XT = (LAS bf16*)(F.lds + SL_XT);
    LAS bf16* CBS = (LAS bf16*)(F.lds + SL_CB); LAS float* DTV = (LAS float*)(F.lds + SL_DT); LAS float* GAM = (LAS float*)(F.lds + SL_GAM); LAS float* PS = (LAS float*)(F.lds + SL_PS); LAS bf16* ZS = (LAS bf16*)(F.lds + SL_ZS) + F.wave * 2048;
    const int tid = F.tid, w = F.wave;
    int lane = F.lane; asm volatile("" : "+v"(lane)); int quad = lane >> 4, l15 = lane & 15;
    const int hl = w >> 1, ph = w & 1, head = 4 * g + hl;
    const int nchunk = samp ? 1 : SLAB_T / 64, row0 = samp ? RP + bb * DSEQ : bb * SLAB_T;
    f32x4 hacc[8][2];
    {
        const float* st = samp ? F.A.in[4] : F.out + O_SP;
        const size_t sb = (size_t)(bb * SH + head) * SN * SP;
#pragma unroll
        for (int mt = 0; mt < 8; ++mt)
#pragma unroll
            for (int nt = 0; nt < 2; ++nt)
#pragma unroll
                for (int r = 0; r < 4; ++r) { const int n = 16 * mt + 4 * quad + r, p = 32 * ph + 16 * nt + l15; hacc[mt][nt][r] = (samp || s > 0) ? st[sb + (size_t)n * SP + p] : 0.f; }
    }
    const int cidx = tid < 256 ? 3072 + g * 256 + tid : (tid < 384 ? 5120 + g * 128 + (tid - 256) : 6144 + g * 128 + (tid - 384));
    const float* wcv = F.A.in[12]; const float w0 = wcv[cidx], w1 = wcv[CONV_CH + cidx], w2 = wcv[2 * CONV_CH + cidx], w3 = wcv[3 * CONV_CH + cidx], bias = F.A.in[13][cidx];
    float h0 = 0.f, h1 = 0.f, h2 = 0.f;
    if (samp) { const float* st = F.A.in[2] + (size_t)bb * 3 * CONV_CH + cidx; h0 = st[0]; h1 = st[CONV_CH]; h2 = st[2 * CONV_CH]; }
    else if (s > 0) { const float* st = (const float*)(F.ws + WS_CARRY_MIX) + ((size_t)(s & 1) * NB + bb) * 3 * CONV_CH + cidx; h0 = st[0]; h1 = st[CONV_CH]; h2 = st[2 * CONV_CH]; }
    const float aneg = -__expf(F.A.in[17][head]), Dh = F.A.in[19][head];
    for (int c = 0; c < nchunk; ++c) {
        const int r0 = row0 + 64 * c;
        asm volatile("" : "+v"(lane)); quad = lane >> 4; l15 = lane & 15;
        v4u zr[4];
        { const GAS v4u* zp = (const GAS v4u*)(P + (size_t)(r0 + lane) * NPROJ + 8192 + head * 64 + 32 * ph);
#pragma unroll
          for (int i = 0; i < 4; ++i) zr[i] = zp[i]; }
        if (tid < 256) { const int hh = 4 * g + (tid >> 6); const float dt = softplusf_(SM[(size_t)(r0 + lane) * 64 + 16 + hh] + F.A.in[18][hh]);
            const float ga = wave_incl_scan(dt * (-__expf(F.A.in[17][hh])), lane); DTV[(tid >> 6) * 64 + lane] = dt; GAM[(tid >> 6) * 64 + lane] = ga; }
        __syncthreads();
        {
            unsigned colp2[32];
            const bf16* pc = P + (size_t)r0 * NPROJ + cidx;
            const LAS float* dtp = DTV + (tid < 256 ? (tid >> 6) * 64 : 0);
#pragma unroll
            for (int tb = 0; tb < 4; ++tb) { float raw[16];
#pragma unroll
                for (int t = 0; t < 16; ++t) raw[t] = bf2f(pc[(size_t)(16 * tb + t) * NPROJ]);
#pragma unroll
                for (int t = 0; t < 16; t += 2) { float va = bias + w0 * h0 + w1 * h1 + w2 * h2 + w3 * raw[t]; float vb = bias + w0 * h1 + w1 * h2 + w2 * raw[t] + w3 * raw[t + 1]; h0 = h2; h1 = raw[t]; h2 = raw[t + 1];
                    va = siluf_(va); vb = siluf_(vb); if (tid < 256) { va *= dtp[16 * tb + t]; vb *= dtp[16 * tb + t + 1]; }
                    colp2[8 * tb + (t >> 1)] = pk2(va, vb); }
                asm volatile("" ::: "memory"); }
            if (tid < 384) {
                LAS bf16* rowp = tid < 256 ? XT + tid * 72 : BT + (tid - 256) * 72;
#pragma unroll
                for (int i = 0; i < 8; ++i) { v4u o; o.x = colp2[4 * i]; o.y = colp2[4 * i + 1]; o.z = colp2[4 * i + 2]; o.w = colp2[4 * i + 3]; *(LAS v4u*)(rowp + 8 * i) = o; }
            }
            if (tid >= 256) {
                LAS bf16* colp = tid < 384 ? BS + (tid - 256) : CS + (tid - 384);
#pragma unroll
                for (int t = 0; t < 32; ++t) { colp[(2 * t) * 136] = (bf16)(colp2[t] & 0xffffu); colp[(2 * t + 1) * 136] = (bf16)(colp2[t] >> 16); }
            }
        }
#pragma unroll
        for (int i = 0; i < 4; ++i) *(LAS v4u*)(ZS + lane * 32 + 8 * i) = zr[i];
        __syncthreads();
        {
            const int mt = w >> 1;
#pragma unroll
            for (int q = 0; q < 2; ++q) { const int nt = 2 * (w & 1) + q; f32x4 acc = {0.f, 0.f, 0.f, 0.f};
#pragma unroll
                for (int ks = 0; ks < 4; ++ks) acc = MFMA16(ldfrag(CS, 136, 16 * mt, 32 * ks, lane), ldfrag(BS, 136, 16 * nt, 32 * ks, lane), acc);
#pragma unroll
                for (int r = 0; r < 4; ++r) CBS[(16 * mt + 4 * quad + r) * 72 + 16 * nt + l15] = (bf16)f2bf(acc[r]); }
        }
        __syncthreads();
        const LAS float* gm = GAM + hl * 64; const LAS float* dv = DTV + hl * 64;
        const float last = gm[63];
        f32x4 y[4][2];
        {
            bf16x8 hb[4][2];
#pragma unroll
            for (int ks = 0; ks < 4; ++ks)
#pragma unroll
                for (int nt = 0; nt < 2; ++nt) hb[ks][nt] = acc2frag(hacc[2 * ks][nt], hacc[2 * ks + 1][nt]);
#pragma unroll
            for (int mt = 0; mt < 4; ++mt) {
#pragma unroll
                for (int nt = 0; nt < 2; ++nt) y[mt][nt] = (f32x4){0.f, 0.f, 0.f, 0.f};
#pragma unroll
                for (int ks = 0; ks < 4; ++ks) { const bf16x8 a = ldfrag_perm(CS, 136, 16 * mt, 32 * ks, lane);
#pragma unroll
                    for (int nt = 0; nt < 2; ++nt) y[mt][nt] = MFMA16(a, hb[ks][nt], y[mt][nt]); }
#pragma unroll
                for (int r = 0; r < 4; ++r) { const float eg = __expf(gm[16 * mt + 4 * quad + r]); y[mt][0][r] *= eg; y[mt][1][r] *= eg; }
                __builtin_amdgcn_sched_barrier(0);
            }
        }
        {
            const int prow = hl * 64 + 32 * ph;
#pragma unroll
            for (int mt = 0; mt < 4; ++mt) { const int i = 16 * mt + l15; const float gi = gm[i], ddt = Dh / dv[i];
#pragma unroll
                for (int ks = 0; ks < 2; ++ks) { if (32 * ks > 16 * mt + 15) continue;
                    const bf16x8 a0 = ldfrag(CBS, 72, 16 * mt, 32 * ks, lane); const v4u aw = __builtin_bit_cast(v4u, a0);
                    const f32x4 g0 = *(const LAS f32x4*)(gm + 32 * ks + 8 * quad), g1 = *(const LAS f32x4*)(gm + 32 * ks + 8 * quad + 4);
                    float cv[8] = {bflo(aw.x), bfhi(aw.x), bflo(aw.y), bfhi(aw.y), bflo(aw.z), bfhi(aw.z), bflo(aw.w), bfhi(aw.w)};
                    const float gj[8] = {g0.x, g0.y, g0.z, g0.w, g1.x, g1.y, g1.z, g1.w};
#pragma unroll
                    for (int jj = 0; jj < 8; ++jj) { const int j = 32 * ks + 8 * quad + jj; float v = i >= j ? cv[jj] * __expf(gi - gj[jj]) : 0.f; if (i == j) v += ddt; cv[jj] = v; }
                    v4u bw; bw.x = pk2(cv[0], cv[1]); bw.y = pk2(cv[2], cv[3]); bw.z = pk2(cv[4], cv[5]); bw.w = pk2(cv[6], cv[7]); const bf16x8 a1 = __builtin_bit_cast(bf16x8, bw);
#pragma unroll
                    for (int nt = 0; nt < 2; ++nt) y[mt][nt] = MFMA16(a1, ldfrag(XT, 72, prow + 16 * nt, 32 * ks, lane), y[mt][nt]); }
                __builtin_amdgcn_sched_barrier(0); }
#pragma unroll
            for (int mt = 0; mt < 4; ++mt)
#pragma unroll
                for (int r = 0; r < 4; ++r) { const int i = 16 * mt + 4 * quad + r; float sq = 0.f;
#pragma unroll
                    for (int nt = 0; nt < 2; ++nt) { const float z = bf2f(ZS[i * 32 + 16 * nt + l15]); const float yz = y[mt][nt][r] * siluf_(z); y[mt][nt][r] = yz; sq += yz * yz; }
                    sq = row16_sum(sq); if (l15 == 0) PS[i * 8 + w] = sq; __builtin_amdgcn_sched_barrier(0); }
            const float el = __expf(last);
            bf16x8 xw[2][2];
#pragma unroll
            for (int ks = 0; ks < 2; ++ks) { const f32x4 g0 = *(const LAS f32x4*)(gm + 32 * ks + 8 * quad), g1 = *(const LAS f32x4*)(gm + 32 * ks + 8 * quad + 4);
                const float ed[8] = {__expf(last - g0.x), __expf(last - g0.y), __expf(last - g0.z), __expf(last - g0.w), __expf(last - g1.x), __expf(last - g1.y), __expf(last - g1.z), __expf(last - g1.w)};
#pragma unroll
                for (int nt = 0; nt < 2; ++nt) { const v4u xv = __builtin_bit_cast(v4u, ldfrag(XT, 72, prow + 16 * nt, 32 * ks, lane));
                    v4u o; o.x = pk2(bflo(xv.x) * ed[0], bfhi(xv.x) * ed[1]); o.y = pk2(bflo(xv.y) * ed[2], bfhi(xv.y) * ed[3]); o.z = pk2(bflo(xv.z) * ed[4], bfhi(xv.z) * ed[5]); o.w = pk2(bflo(xv.w) * ed[6], bfhi(xv.w) * ed[7]);
                    xw[ks][nt] = __builtin_bit_cast(bf16x8, o); } }
#pragma unroll
            for (int mt = 0; mt < 8; ++mt) {
#pragma unroll
                for (int nt = 0; nt < 2; ++nt) hacc[mt][nt] = hacc[mt][nt] * el;
#pragma unroll
                for (int ks = 0; ks < 2; ++ks) { const bf16x8 a = ldfrag(BT, 72, 16 * mt, 32 * ks, lane);
#pragma unroll
                    for (int nt = 0; nt < 2; ++nt) hacc[mt][nt] = MFMA16(a, xw[ks][nt], hacc[mt][nt]); }
                __builtin_amdgcn_sched_barrier(0); }
        }
        __syncthreads();
#pragma unroll
        for (int mt = 0; mt < 4; ++mt)
#pragma unroll
            for (int r = 0; r < 4; ++r) { const int i = 16 * mt + 4 * quad + r; const f32x4 p0 = *(const LAS f32x4*)(PS + i * 8), p1 = *(const LAS f32x4*)(PS + i * 8 + 4);
                const float rs = rsqrtf((((p0.x + p0.y) + (p0.z + p0.w)) + ((p1.x + p1.y) + (p1.z + p1.w))) * (1.f / 256.f) + EPS);
#pragma unroll
                for (int nt = 0; nt < 2; ++nt) { const int ch = head * 64 + 32 * ph + 16 * nt + l15; YS[(size_t)(r0 + i) * 2048 + ch] = (bf16)f2bf(y[mt][nt][r] * rs * F.A.in[20][ch]); } }
    }
    {
        float* so = F.out + (samp ? O_SS : O_SP) + (size_t)(bb * SH + head) * SN * SP;
#pragma unroll
        for (int mt = 0; mt < 8; ++mt)
#pragma unroll
            for (int nt = 0; nt < 2; ++nt)
#pragma unroll
                for (int r = 0; r < 4; ++r) so[(size_t)(16 * mt + 4 * quad + r) * SP + 32 * ph + 16 * nt + l15] = hacc[mt][nt][r];
    }
    __syncthreads();
}
__device__ __forceinline__ void gdn_naive_job(Frame& F, int s, bool samp, int bb, int h) {
    const bf16* P = (const bf16*)(F.ws + WS_PROJ); const float* SM = (const float*)(F.ws + WS_SM); bf16* OG = (bf16*)(F.ws + WS_OG);
    LAS float* qs = (LAS float*)F.lds; LAS float* ks = qs + 128; LAS float* vs = ks + 128; LAS float* part = vs + 128;
    LAS float* red = part + 8; LAS float* red2 = red + 512; LAS float* part2 = red2 + 512;
    const int tid = F.tid, v = tid & 127, kq = tid >> 7, ntok = samp ? DSEQ : SLAB_T, row0 = samp ? RP + bb * DSEQ : bb * SLAB_T;
    float S[32];
    const size_t sbase = ((size_t)(bb * GH + h) * GDK + kq * 32) * GDV + v;
    if (samp) { const float* st = F.A.in[3] + sbase;
#pragma unroll
        for (int i = 0; i < 32; ++i) S[i] = st[(size_t)i * GDV]; }
    else if (s == 0) {
#pragma unroll
        for (int i = 0; i < 32; ++i) S[i] = 0.f; }
    else { const float* st = F.out + O_GP + sbase;
#pragma unroll
        for (int i = 0; i < 32; ++i) S[i] = st[(size_t)i * GDV]; }
    const int role = tid >> 7, ch = tid & 127, cidx = role * 1024 + h * 128 + ch;
    float h0 = 0.f, h1 = 0.f, h2 = 0.f, w0 = 0.f, w1 = 0.f, w2 = 0.f, w3 = 0.f, bias = 0.f;
    if (tid < 384) {
        const float* wcv = F.A.in[12]; w0 = wcv[cidx]; w1 = wcv[CONV_CH + cidx]; w2 = wcv[2 * CONV_CH + cidx]; w3 = wcv[3 * CONV_CH + cidx]; bias = F.A.in[13][cidx];
        if (samp) { const float* st = F.A.in[2] + (size_t)bb * 3 * CONV_CH + cidx; h0 = st[0]; h1 = st[CONV_CH]; h2 = st[2 * CONV_CH]; }
        else if (s > 0) { const float* st = (const float*)(F.ws + WS_CARRY_MIX) + ((size_t)(s & 1) * NB + bb) * 3 * CONV_CH + cidx; h0 = st[0]; h1 = st[CONV_CH]; h2 = st[2 * CONV_CH]; }
    }
    const float Aexp = __expf(F.A.in[14][h]), dtb = F.A.in[15][h], gnorm = F.A.in[16][v];
    for (int t = 0; t < ntok; ++t) {
        const size_t r = (size_t)(row0 + t);
        if (tid < 384) {
            const float raw = bf2f(P[r * NPROJ + cidx]);
            float val = bias + w0 * h0 + w1 * h1 + w2 * h2 + w3 * raw; h0 = h1; h1 = h2; h2 = raw; val = siluf_(val);
            qs[role * 128 + ch] = val;
            if (role < 2) { const float sq = wave_sum(val * val); if (F.lane == 0) part[F.wave] = sq; }
        }
        __syncthreads();
        const float qsc = rsqrtf(part[0] + part[1] + EPS) * 0.08838834764831845f, ksc = rsqrtf(part[2] + part[3] + EPS);
        const float beta = sigmoidf_(SM[r * 64 + h]); const float g = -Aexp * softplusf_(SM[r * 64 + 8 + h] + dtb); const float a = __expf(g);
        float kn[32]; float p = 0.f;
#pragma unroll
        for (int i = 0; i < 32; ++i) { kn[i] = ks[kq * 32 + i] * ksc; p += kn[i] * S[i]; }
        red[kq * 128 + v] = p;
        __syncthreads();
        const float kS = (red[v] + red[128 + v]) + (red[256 + v] + red[384 + v]);
        const float d = beta * (vs[v] - a * kS);
        float po = 0.f;
#pragma unroll
        for (int i = 0; i < 32; ++i) { S[i] = a * S[i] + kn[i] * d; po += qs[kq * 32 + i] * qsc * S[i]; }
        red2[kq * 128 + v] = po;
        __syncthreads();
        float o = 0.f;
        if (tid < 128) { o = (red2[v] + red2[128 + v]) + (red2[256 + v] + red2[384 + v]); const float sq = wave_sum(o * o); if (F.lane == 0) part2[F.wave] = sq; }
        __syncthreads();
        if (tid < 128) { const float rs = rsqrtf((part2[0] + part2[1]) * (1.f / GDV) + EPS); const float z = bf2f(P[r * NPROJ + 7168 + h * 128 + v]);
            OG[r * D + h * 128 + v] = (bf16)f2bf(o * rs * gnorm * siluf_(z)); }
    }
    float* so = F.out + (samp ? O_GS : O_GP) + sbase;
#pragma unroll
    for (int i = 0; i < 32; ++i) so[(size_t)i * GDV] = S[i];
    __syncthreads();
}
__device__ __forceinline__ void ssd_naive_job(Frame& F, int s, bool samp, int bb, int g) {
    const bf16* P = (const bf16*)(F.ws + WS_PROJ); const float* SM = (const float*)(F.ws + WS_SM); bf16* YS = (bf16*)(F.ws + WS_YS);
    LAS float* xs = (LAS float*)F.lds; LAS float* Bs = xs + 256; LAS float* Cs = Bs + 128; LAS float* red = Cs + 128; LAS float* part = red + 512;
    const int tid = F.tid, hl = tid >> 7, p = tid & 63, nh = (tid >> 6) & 1, head = 4 * g + hl, ntok = samp ? DSEQ : SLAB_T, row0 = samp ? RP + bb * DSEQ : bb * SLAB_T;
    float hr[64];
    const size_t sbase = ((size_t)(bb * SH + head) * SN + nh * 64) * SP + p;
    if (samp) { const float* st = F.A.in[4] + sbase;
#pragma unroll
        for (int i = 0; i < 64; ++i) hr[i] = st[(size_t)i * SP]; }
    else if (s == 0) {
#pragma unroll
        for (int i = 0; i < 64; ++i) hr[i] = 0.f; }
    else { const float* st = F.out + O_SP + sbase;
#pragma unroll
        for (int i = 0; i < 64; ++i) hr[i] = st[(size_t)i * SP]; }
    const int cidx = tid < 256 ? 3072 + g * 256 + tid : (tid < 384 ? 5120 + g * 128 + (tid - 256) : 6144 + g * 128 + (tid - 384));
    const float* wcv = F.A.in[12]; const float w0 = wcv[cidx], w1 = wcv[CONV_CH + cidx], w2 = wcv[2 * CONV_CH + cidx], w3 = wcv[3 * CONV_CH + cidx], bias = F.A.in[13][cidx];
    float h0 = 0.f, h1 = 0.f, h2 = 0.f;
    if (samp) { const float* st = F.A.in[2] + (size_t)bb * 3 * CONV_CH + cidx; h0 = st[0]; h1 = st[CONV_CH]; h2 = st[2 * CONV_CH]; }
    else if (s > 0) { const float* st = (const float*)(F.ws + WS_CARRY_MIX) + ((size_t)(s & 1) * NB + bb) * 3 * CONV_CH + cidx; h0 = st[0]; h1 = st[CONV_CH]; h2 = st[2 * CONV_CH]; }
    const float aneg = -__expf(F.A.in[17][head]), dtb = F.A.in[18][head], Dh = F.A.in[19][head], nw = F.A.in[20][head * 64 + p];
    for (int t = 0; t < ntok; ++t) {
        const size_t r = (size_t)(row0 + t);
        { const float raw = bf2f(P[r * NPROJ + cidx]); float val = bias + w0 * h0 + w1 * h1 + w2 * h2 + w3 * raw; h0 = h1; h1 = h2; h2 = raw; xs[tid] = siluf_(val); }
        __syncthreads();
        const float dt = softplusf_(SM[r * 64 + 16 + head] + dtb), dA = __expf(dt * aneg), x = xs[hl * 64 + p], dx = dt * x;
        float py = 0.f;
#pragma unroll
        for (int i = 0; i < 64; ++i) { hr[i] = dA * hr[i] + dx * Bs[nh * 64 + i]; py += Cs[nh * 64 + i] * hr[i]; }
        red[tid] = py;
        __syncthreads();
        float yz = 0.f;
        if (nh == 0) { const float y = red[tid] + red[tid + 64] + Dh * x; const float z = bf2f(P[r * NPROJ + 8192 + head * 64 + p]); yz = y * siluf_(z);
            const float sq = wave_sum(yz * yz); if (F.lane == 0) part[F.wave] = sq; }
        __syncthreads();
        if (nh == 0) { const float rs = rsqrtf(((part[0] + part[2]) + (part[4] + part[6])) * (1.f / 256.f) + EPS); YS[r * 2048 + head * 64 + p] = (bf16)f2bf(yz * rs * nw); }
    }
    float* so = F.out + (samp ? O_SS : O_SP) + sbase;
#pragma unroll
    for (int i = 0; i < 64; ++i) so[(size_t)i * SP] = hr[i];
    __syncthreads();
}
__device__ __forceinline__ void phase_scan_naive(Frame& F, int s) {
    const int njobs = s == 0 ? 192 : 64;
    for (int j = F.bid; j < njobs; j += F.G) {
#ifndef NO_GDN
        if (j < 32) gdn_naive_job(F, s, false, j >> 3, j & 7); else
#endif
#ifndef NO_SSD

        if (j >= 32 && j < 64) ssd_fast_job(F, s, false, (j - 32) >> 3, (j - 32) & 7); else
#endif
#ifndef NO_GDN
        if (j >= 64 && j < 128) gdn_naive_job(F, s, true, (j - 64) >> 3, (j - 64) & 7); else
#endif
#ifndef NO_SSD
        if (j >= 128) ssd_fast_job(F, s, true, (j - 128) >> 3, (j - 128) & 7);
#endif
        {}
    }
}
#define XB_TMO      128
#define XB_XCNT(j)  (256  + 64 * (j))
#define XB_XSUB(j)  (1280 + 64 * (j))
#define XB_XGEN(j)  (2304 + 64 * (j))
#define XB_TOP      3328
#define XB_TOPGEN   3392
#define XCD_BAR_WORDS 3456
#define XB_SPIN_CAP (1u << 18)
__device__ __forceinline__ unsigned xb_ld(unsigned* p)              { return __hip_atomic_load(p, __ATOMIC_RELAXED, __HIP_MEMORY_SCOPE_AGENT); }
__device__ __forceinline__ unsigned xb_add(unsigned* p, unsigned v) { return __hip_atomic_fetch_add(p, v, __ATOMIC_RELAXED, __HIP_MEMORY_SCOPE_AGENT); }
__device__ __forceinline__ unsigned xb_xcc_id() { return (unsigned)__builtin_amdgcn_s_getreg((3 << 11) | 20) & 0xFu; }
#define XB_SPIN(cond, bar) do { unsigned _sp = 0; while (cond) { __builtin_amdgcn_s_sleep(1); \
    if ((++_sp & 255u) == 0u) { if (xb_ld(&(bar)[XB_TMO])) break; if (_sp > XB_SPIN_CAP) { atomicAdd(&(bar)[XB_TMO], 1u); break; } } } } while (0)
struct XcdBarrier { unsigned* bar; unsigned x; volatile LAS unsigned* st; };
__device__ __forceinline__ XcdBarrier xcd_barrier_post(unsigned* bar, volatile LAS unsigned* st) {
    XcdBarrier b; b.bar = bar; b.x = xb_xcc_id(); b.st = st;
    if (threadIdx.x == 0) (void)xb_add(&bar[XB_XCNT(b.x)], 1u);
    return b;
}
__device__ __forceinline__ void xcd_barrier_complete(unsigned* bar, unsigned x, unsigned& nloc, unsigned& nx) {
    const unsigned G = gridDim.x * gridDim.y * gridDim.z;
    unsigned sum, cnt, mine, sp = 0u;
    for (;;) {
        sum = 0u; cnt = 0u; mine = 0u;
#pragma unroll
        for (unsigned j = 0; j < 16; ++j) { const unsigned c = xb_ld(&bar[XB_XCNT(j)]); sum += c; cnt += (c > 0u) ? 1u : 0u; mine = (j == x) ? c : mine; }
        if (sum == G) break;
        __builtin_amdgcn_s_sleep(1);
        if ((++sp & 255u) == 0u) { if (xb_ld(&bar[XB_TMO])) break; if (sp > XB_SPIN_CAP) { atomicAdd(&bar[XB_TMO], 1u); break; } }
    }
    nloc = mine > 0u ? mine : 1u; nx = cnt > 0u ? cnt : 1u;
}
__device__ __forceinline__ void xcd_barrier(const XcdBarrier& b) {
    asm volatile("s_waitcnt vmcnt(0)" ::: "memory");
    __syncthreads();
    if (threadIdx.x == 0) {
        unsigned* bar = b.bar;
        __builtin_amdgcn_s_waitcnt(0);
        unsigned nloc = b.st[0], nx = b.st[1];
        if (nloc == 0u) { xcd_barrier_complete(bar, b.x, nloc, nx); b.st[0] = nloc; b.st[1] = nx; }
        const unsigned old = xb_add(&bar[XB_XSUB(b.x)], 1u);
        const unsigned gen = old / nloc;
        if (old + 1u == (gen + 1u) * nloc) {
            __builtin_amdgcn_fence(__ATOMIC_RELEASE, "agent");
            asm volatile("s_waitcnt vmcnt(0)" ::: "memory");
            const unsigned og = xb_add(&bar[XB_TOP], 1u);
            const unsigned tg = og / nx;
            if (og + 1u == (tg + 1u) * nx) xb_add(&bar[XB_TOPGEN], 1u);
            else XB_SPIN(xb_ld(&bar[XB_TOPGEN]) == tg, bar);
            __builtin_amdgcn_fence(__ATOMIC_ACQUIRE, "agent");
            xb_add(&bar[XB_XGEN(b.x)], 1u);
            asm volatile("s_waitcnt vmcnt(0)" ::: "memory");
        } else {
            XB_SPIN(xb_ld(&bar[XB_XGEN(b.x)]) == gen, bar);
            __builtin_amdgcn_fence(__ATOMIC_ACQUIRE, "agent");
            asm volatile("s_waitcnt vmcnt(0)" ::: "memory");
        }
    }
    __syncthreads();
}
constexpr int CW_BAR = 4096;
#ifndef PHASE_MASK
#define PHASE_MASK 0xFFF
#endif
#define PM(k) ((PHASE_MASK >> (k)) & 1)
constexpr int STEPS_PER_SLAB = 10, NSTEPS = 2 + STEPS_PER_SLAB * NSLAB;
#define GEMM_PHASE(EPI_T, AOFF, BOFF, N_, K_, ...) do { pg8::Gemm g{(const pg8::bf16_t*)(F.ws + (AOFF)), (const pg8::bf16_t*)(F.ws + (BOFF)), R, (N_), (K_)}; \
    pg8::StaticOrder S; S.init(R, (N_), F.G, F.bid); epi::EPI_T E{__VA_ARGS__}; pg8::gemm_phase<epi::EPI_T, pg8::StaticOrder, true, true>(F.lds, g, S, E, F.tid); } while (0)
__device__ __forceinline__ void run_step(Frame& F, int st) {
    if (st == 0) { if constexpr (PM(10)) phase_prologue0(F); return; }
    if (st == 1) { if constexpr (PM(11)) phase_prologue1(F); return; }
    const int s = (st - 2) / STEPS_PER_SLAB, k = (st - 2) % STEPS_PER_SLAB, R = slab_rows(s);
    unsigned char* ws = F.ws;
    switch (k) {
    case 0: if constexpr (PM(0)) phase_norm1(F, s); break;
    case 1: if constexpr (PM(1)) GEMM_PHASE(EpiProj, WS_HB, WS_WIN, NIN, D, (bf16*)(ws + WS_PROJ), (float*)(ws + WS_SM)); break;
    case 2: if constexpr (PM(2)) phase_scan_naive(F, s); phase_mix_carry(F, s); break;
    case 3: if constexpr (PM(3)) GEMM_PHASE(EpiGate1, WS_OG, WS_WG, D, D, (const bf16*)(ws + WS_PROJ), (float*)(ws + WS_T1)); break;
    case 4: if constexpr (PM(4)) GEMM_PHASE(EpiGate2, WS_YS, WS_WS, D, 2048, (const bf16*)(ws + WS_PROJ), (const float*)(ws + WS_T1), (bf16*)(ws + WS_MIX)); break;
    case 5: if constexpr (PM(5)) GEMM_PHASE(EpiOut, WS_MIX, WS_WOUT, D, D, F.A.in[0], F.A.in[1], (const float*)(ws + WS_MODV), (const float*)(ws + WS_G2), (float*)(ws + WS_X1), (bf16*)(ws + WS_X1G), (float*)(ws + WS_SS1), s); break;
    case 6: if constexpr (PM(6)) GEMM_PHASE(EpiUp, WS_X1G, WS_WUP, NUP, D, (const float*)(ws + WS_SS1), (const float*)(ws + WS_SHW), (bf16*)(ws + WS_U)); break;
    case 7: if constexpr (PM(7)) phase_convact(F, s); break;
    case 8: if constexpr (PM(8)) GEMM_PHASE(EpiDown, WS_ACT, WS_WDN, D, DFF, (const float*)(ws + WS_X1), (const float*)(ws + WS_MODV), F.out + O_YP, F.out + O_YS, (float*)(ws + WS_SS2), s); break;
    default: if constexpr (PM(9)) phase_final(F, s); break;
    }
}
__global__ void __launch_bounds__(NTHR, 2) mk_fwd(Args a) {
    extern __shared__ __attribute__((aligned(16))) unsigned char lds[];
    Frame F(a);
    F.lds = (LAS unsigned char*)lds; F.MISC = (volatile LAS unsigned*)(F.lds + MISC_OFF);
    F.tid = threadIdx.x; F.lane = F.tid & 63; F.wave = __builtin_amdgcn_readfirstlane(F.tid >> 6); F.G = gridDim.x; F.bid = blockIdx.x;
    F.out = a.out; F.ws = a.ws; F.ctl = (gu32*)(a.ws + WS_CTL);
    for (int u = F.tid; u < (LDS_BYTES - LDSCTL_OFF) / 4; u += NTHR) ((LAS unsigned*)(F.lds + LDSCTL_OFF))[u] = 0u;
    __syncthreads();
    XcdBarrier bar; bar.bar = (unsigned*)(F.ctl + CW_BAR); bar.x = 0; bar.st = nullptr;
    const bool multi = (a.ph_hi - a.ph_lo) > 1;
    if (multi) bar = xcd_barrier_post((unsigned*)(F.ctl + CW_BAR), F.MISC + 8);
    for (int st = a.ph_lo; st < a.ph_hi; ++st) {
        { int t_ = threadIdx.x, b_ = blockIdx.x; unsigned char* w_ = a.ws; float* o_ = a.out; asm volatile("" : "+v"(t_), "+s"(b_), "+s"(w_), "+s"(o_));
          F.tid = t_; F.lane = t_ & 63; F.wave = __builtin_amdgcn_readfirstlane(t_ >> 6); F.bid = b_; F.ws = w_; F.out = o_; }
        run_step(F, st);
        if (st + 1 < a.ph_hi) { if (st == a.ph_lo) cooperative_groups::this_grid().sync(); else xcd_barrier(bar); }
    }
}
#ifndef MK_SINGLE
#define MK_SINGLE 1
#endif
extern "C" void kernel_launch(void* const* d_in, const int* in_sizes, int n_in, void* d_out, int out_size, void* d_ws, size_t ws_size, hipStream_t stream) {
    static int grid = 0;
    if (grid == 0) {
        if (n_in != 30 || (size_t)out_size != O_END || ws_size < WS_END) { fprintf(stderr, "kernel_launch: unexpected shapes: n_in %d out %d ws %zu (need %zu)\n", n_in, out_size, ws_size, (size_t)WS_END); grid = -1; return; }
        int dev = 0, cus = 0;
        if (hipGetDevice(&dev) != hipSuccess || hipDeviceGetAttribute(&cus, hipDeviceAttributeMultiprocessorCount, dev) != hipSuccess) { grid = -1; return; }
        if (hipFuncSetAttribute((const void*)mk_fwd, hipFuncAttributeMaxDynamicSharedMemorySize, LDS_BYTES) != hipSuccess) { fprintf(stderr, "kernel_launch: hipFuncSetAttribute failed\n"); grid = -1; return; }
        int per_cu = 0;
        if (hipOccupancyMaxActiveBlocksPerMultiprocessor(&per_cu, (const void*)mk_fwd, NTHR, LDS_BYTES) != hipSuccess || per_cu < 1) fprintf(stderr, "kernel_launch: occupancy query says %d\n", per_cu);
        (void)hipGetLastError();
        grid = cus * (per_cu < 1 ? 1 : per_cu);
    }
    if (grid < 0) return;
    (void)hipMemsetAsync((char*)d_ws + WS_CTL, 0, CTL_ZERO_BYTES, stream);
    Args a{};
    for (int i = 0; i < 30; ++i) a.in[i] = (const float*)d_in[i];
    a.out = (float*)d_out; a.ws = (unsigned char*)d_ws;
#if MK_SINGLE
    a.ph_lo = 0; a.ph_hi = NSTEPS;
    void* kargs[] = {(void*)&a};
    hipError_t le = hipLaunchCooperativeKernel((const void*)mk_fwd, dim3(grid), dim3(NTHR), kargs, LDS_BYTES, stream);
    if (le != hipSuccess) fprintf(stderr, "kernel_launch: cooperative launch failed: %s (grid %d)\n", hipGetErrorString(le), grid);
#else
    for (int st = 0; st < NSTEPS; ++st) { a.ph_lo = st; a.ph_hi = st + 1; hipLaunchKernelGGL(mk_fwd, dim3(grid), dim3(NTHR), LDS_BYTES, stream, a); }
#endif
}
```

```cpp
#include <hip/hip_runtime.h>
#include <hip/hip_cooperative_groups.h>
#include <cstdio>
#include <cstdint>

namespace pg8 {
#define PG8_LAS __attribute__((address_space(3)))
typedef unsigned short bf16_t;
typedef short bf16x8 __attribute__((ext_vector_type(8)));
typedef float f32x4 __attribute__((ext_vector_type(4)));
typedef unsigned u32x4 __attribute__((ext_vector_type(4)));
typedef unsigned u32x2 __attribute__((ext_vector_type(2)));
constexpr int BM = 256, BK = 64, HALF = 128, HTB = HALF * BK * 2, STAGE_BYTES = 8 * HTB, NXCD = 8, WGM = 8;

__host__ __device__ __forceinline__ int lds_byte(int r, int c) { const int st = (r >> 4) * 2 + (c >> 5), rr = r & 15, cc = c & 31, ob = rr * 64 + cc * 2; return st * 1024 + (ob ^ (((ob >> 9) & 1) << 5)); }
__host__ __device__ __forceinline__ void stage_rc(int b, int& R, int& C) { const int st = b / 1024, sb = b % 1024, swz = sb ^ (((sb >> 9) & 1) << 5); R = (st >> 1) * 16 + swz / 64; C = (st & 1) * 32 + (swz % 64) / 2; }
__host__ __device__ __forceinline__ int perm32(int rho) { const int n = rho >> 4, i = rho & 15; return 8 * (i >> 2) + 4 * n + (i & 3); }

struct Unit { int pm, pn; };
struct Gemm { const bf16_t* A; const bf16_t* Bt; int M, N, K; };

struct StaticOrder {
    int nM, nN, nwg, G, c;
    __host__ __device__ void init(int M, int N, int G_, int c_) { nM = M / BM; nN = N / BM; nwg = nM * nN; G = G_; c = c_; }
    __host__ __device__ bool next(int i, Unit& u) const {
        const long L = (long)i * G + c; if (L >= nwg) return false;
        int wgid = (int)L; { const int q = nwg / NXCD, r = nwg % NXCD, xcd = wgid % NXCD, off = wgid / NXCD; wgid = (xcd < r ? xcd * (q + 1) : r * (q + 1) + (xcd - r) * q) + off; }
        const int nig = WGM * nN, gid = wgid / nig, fm = gid * WGM, gsz = (nM - fm) < WGM ? (nM - fm) : WGM;
        u.pm = fm + ((wgid % nig) % gsz); u.pn = (wgid % nig) / gsz; return true;
    }
    __device__ __forceinline__ void a_ready(const Unit&) const {}
    __device__ __forceinline__ void done(const Unit&) const {}
};

__device__ __forceinline__ unsigned cvt_pk_bf16(float lo, float hi) { unsigned r; asm volatile("v_cvt_pk_bf16_f32 %0, %1, %2" : "=v"(r) : "v"(lo), "v"(hi)); return r; }

template <class Epi, class Sched, bool ALIGN_EPI = false, bool SP2 = false>
__device__ __forceinline__ void gemm_phase(PG8_LAS unsigned char* lds, const Gemm g, const Sched& S, const Epi& E, const int tid) {
    const int wid = __builtin_amdgcn_readfirstlane(tid >> 6), lane = tid & 63, wr = wid >> 2, wc = wid & 3, fr = lane & 15, fq = lane >> 4;
    const int K = g.K, nt = K / BK;
    unsigned voffA[2], voffB[2];
#pragma unroll
    for (int i = 0; i < 2; ++i) { int R, C; stage_rc(tid * 16 + i * 8192, R, C); const int Rb = Epi::PERM ? ((R & ~31) + perm32(R & 31)) : R;
        voffA[i] = (unsigned)(R * K + C) * 2u; voffB[i] = (unsigned)(Rb * K + C) * 2u; }
    const size_t kstep = (size_t)(BK * 2);
    const size_t hstep = (size_t)HALF * K * 2;
    const size_t tstep = 2 * hstep;
    const unsigned ldsw = (unsigned)wid * 1024u;
    const int aoff = lds_byte(wr * 64 + fr, fq * 8), boff = lds_byte(wc * 32 + fr, fq * 8);
#define PG8_SA(b, h) (((b) * 2 + (h)) * HTB)
#define PG8_SB(b, h) ((4 + (b) * 2 + (h)) * HTB)
#define PG8_STAGE(bufoff, gbase, voff) do { _Pragma("unroll") for (int _i = 0; _i < 2; ++_i) \
        __builtin_amdgcn_global_load_lds((const unsigned*)((const char*)(gbase) + (voff)[_i]), (PG8_LAS unsigned*)(lds + (bufoff) + ldsw + _i * 8192), 16, 0, 0); } while (0)
#define PG8_LDA(dst, b, h) do { _Pragma("unroll") for (int m = 0; m < 4; ++m) _Pragma("unroll") for (int k = 0; k < 2; ++k) dst[m][k] = *(const PG8_LAS bf16x8*)(lds + PG8_SA(b, h) + aoff + m * 2048 + k * 1024); } while (0)
#define PG8_LDB(dst, b, h) do { _Pragma("unroll") for (int n = 0; n < 2; ++n) _Pragma("unroll") for (int k = 0; k < 2; ++k) dst[n][k] = *(const PG8_LAS bf16x8*)(lds + PG8_SB(b, h) + boff + n * 2048 + k * 1024); } while (0)
#define PG8_MMA(ai, bj, At, Bt) do { __builtin_amdgcn_s_setprio(1); _Pragma("unroll") for (int m = 0; m < 4; ++m) _Pragma("unroll") for (int n = 0; n < 2; ++n) _Pragma("unroll") for (int k = 0; k < 2; ++k) \
        acc[ai][bj][m][n] = __builtin_amdgcn_mfma_f32_16x16x32_bf16(Bt[n][k], At[m][k], acc[ai][bj][m][n], 0, 0, 0); __builtin_amdgcn_s_setprio(0); } while (0)
#define PG8_WAIT_V(n) asm volatile("s_waitcnt vmcnt(" #n ")" ::: "memory")
#define PG8_WAIT_L(n) asm volatile("s_waitcnt lgkmcnt(" #n ")" ::: "memory")
#define PG8_BAR __builtin_amdgcn_s_barrier()
#define PG8_SCHED __builtin_amdgcn_sched_barrier(0)
    Unit cur, nxt; int ui = 0;
    if (!S.next(0, cur)) return;
    f32x4 acc[2][2][4][2];
#pragma unroll
    for (int a = 0; a < 2; ++a)
#pragma unroll
        for (int b = 0; b < 2; ++b)
#pragma unroll
            for (int m = 0; m < 4; ++m)
#pragma unroll
                for (int n = 0; n < 2; ++n) acc[a][b][m][n] = (f32x4){0.f, 0.f, 0.f, 0.f};
    bf16x8 At[4][2], B0[2][2], B1[2][2];
    const char* cA = (const char*)g.A + (size_t)cur.pm * tstep; const char* cB = (const char*)g.Bt + (size_t)cur.pn * tstep;
    S.a_ready(cur);
    if constexpr (SP2) {
        PG8_STAGE(PG8_SB(0, 0), cB, voffB); PG8_STAGE(PG8_SB(0, 1), cB + hstep, voffB); PG8_STAGE(PG8_SA(0, 0), cA, voffA); PG8_STAGE(PG8_SA(0, 1), cA + hstep, voffA);
        if (wr == 1) PG8_BAR;
        PG8_WAIT_V(2); PG8_BAR;
        PG8_STAGE(PG8_SB(1, 0), cB + kstep, voffB); PG8_STAGE(PG8_SA(1, 0), cA + kstep, voffA); PG8_STAGE(PG8_SB(1, 1), cB + hstep + kstep, voffB);
        PG8_WAIT_V(6); PG8_BAR;
    } else {
        PG8_STAGE(PG8_SB(0, 0), cB, voffB); PG8_STAGE(PG8_SA(0, 0), cA, voffA); PG8_STAGE(PG8_SB(0, 1), cB + hstep, voffB); PG8_STAGE(PG8_SA(0, 1), cA + hstep, voffA);
        if (wr == 1) PG8_BAR;
        PG8_WAIT_V(4); PG8_BAR;
        PG8_STAGE(PG8_SB(1, 0), cB + kstep, voffB); PG8_STAGE(PG8_SA(1, 0), cA + kstep, voffA); PG8_STAGE(PG8_SB(1, 1), cB + hstep + kstep, voffB);
        PG8_WAIT_V(6); PG8_BAR;
    }
    for (;;) {
        const bool has_next = S.next(ui + 1, nxt);
        const char* nA = has_next ? (const char*)g.A + (size_t)nxt.pm * tstep : cA; const char* nB = has_next ? (const char*)g.Bt + (size_t)nxt.pn * tstep : cB;
        for (int t = 0; t < nt; t += 2) {
            const bool last = (t == nt - 2);
            const char* a1 = cA + (size_t)(t + 1) * kstep;
            const char* a2 = last ? nA : cA + (size_t)(t + 2) * kstep; const char* b2 = last ? nB : cB + (size_t)(t + 2) * kstep;
            const char* a3 = a2 + kstep; const char* b3 = b2 + kstep;
            if (last && has_next) S.a_ready(nxt);
            if constexpr (SP2) {
            PG8_LDB(B0, 0, 0); PG8_LDB(B1, 0, 1); PG8_SCHED; PG8_LDA(At, 0, 0); PG8_STAGE(PG8_SA(1, 1), a1 + hstep, voffA);
            PG8_WAIT_V(8); PG8_WAIT_L(0); PG8_BAR; PG8_MMA(0, 0, At, B0); PG8_MMA(0, 1, At, B1); PG8_BAR; PG8_SCHED;
            PG8_LDA(At, 0, 1); PG8_STAGE(PG8_SB(0, 0), b2, voffB); PG8_STAGE(PG8_SB(0, 1), b2 + hstep, voffB); PG8_STAGE(PG8_SA(0, 0), a2, voffA);
            PG8_WAIT_V(8); PG8_WAIT_L(0); PG8_BAR; PG8_MMA(1, 0, At, B0); PG8_MMA(1, 1, At, B1); PG8_BAR; PG8_SCHED;
            PG8_LDB(B0, 1, 0); PG8_LDB(B1, 1, 1); PG8_SCHED; PG8_LDA(At, 1, 0); PG8_STAGE(PG8_SA(0, 1), a2 + hstep, voffA);
            PG8_WAIT_V(8); PG8_WAIT_L(0); PG8_BAR; PG8_MMA(0, 0, At, B0); PG8_MMA(0, 1, At, B1); PG8_BAR; PG8_SCHED;
            PG8_LDA(At, 1, 1); PG8_STAGE(PG8_SB(1, 0), b3, voffB); PG8_STAGE(PG8_SB(1, 1), b3 + hstep, voffB); PG8_STAGE(PG8_SA(1, 0), a3, voffA);
            PG8_WAIT_V(8); PG8_WAIT_L(0); PG8_BAR; PG8_MMA(1, 0, At, B0); PG8_MMA(1, 1, At, B1); PG8_BAR; PG8_SCHED;
            } else {
            PG8_LDB(B0, 0, 0); PG8_SCHED; PG8_LDA(At, 0, 0); PG8_STAGE(PG8_SA(1, 1), a1 + hstep, voffA);
            PG8_WAIT_L(8); PG8_BAR; PG8_WAIT_L(0); PG8_MMA(0, 0, At, B0); PG8_BAR; PG8_SCHED;
            PG8_LDB(B1, 0, 1); PG8_STAGE(PG8_SB(0, 0), b2, voffB);
            PG8_BAR; PG8_WAIT_L(0); PG8_MMA(0, 1, At, B1); PG8_BAR;
            PG8_LDA(At, 0, 1); PG8_STAGE(PG8_SA(0, 0), a2, voffA);
            PG8_BAR; PG8_WAIT_L(0); PG8_MMA(1, 0, At, B0); PG8_BAR; PG8_SCHED;
            PG8_STAGE(PG8_SB(0, 1), b2 + hstep, voffB);
            PG8_WAIT_V(6); PG8_BAR; PG8_MMA(1, 1, At, B1); PG8_BAR;
            PG8_LDB(B0, 1, 0); PG8_SCHED; PG8_LDA(At, 1, 0); PG8_STAGE(PG8_SA(0, 1), a2 + hstep, voffA);
            PG8_WAIT_L(8); PG8_BAR; PG8_WAIT_L(0); PG8_MMA(0, 0, At, B0); PG8_BAR; PG8_SCHED;
            PG8_LDB(B1, 1, 1); PG8_STAGE(PG8_SB(1, 0), b3, voffB);
            PG8_BAR; PG8_WAIT_L(0); PG8_MMA(0, 1, At, B1); PG8_BAR;
            PG8_LDA(At, 1, 1); PG8_STAGE(PG8_SA(1, 0), a3, voffA);
            PG8_BAR; PG8_WAIT_L(0); PG8_MMA(1, 0, At, B0); PG8_BAR; PG8_SCHED;
            PG8_STAGE(PG8_SB(1, 1), b3 + hstep, voffB);
            PG8_WAIT_V(6); PG8_BAR; PG8_MMA(1, 1, At, B1); PG8_BAR;
            }
        }
        if constexpr (ALIGN_EPI) { if (wr == 0) PG8_BAR; }
        E(acc, cur, wr, wc, fr, fq); S.done(cur);
        if (!has_next) break;
#pragma unroll
        for (int a = 0; a < 2; ++a)
#pragma unroll
            for (int b = 0; b < 2; ++b)
#pragma unroll
                for (int m = 0; m < 4; ++m)
#pragma unroll
                    for (int n = 0; n < 2; ++n) acc[a][b][m][n] = (f32x4){0.f, 0.f, 0.f, 0.f};
        cur = nxt; cA = nA; cB = nB; ++ui;
        if constexpr (ALIGN_EPI) { if (wr == 1) PG8_BAR; }
    }
    PG8_WAIT_V(0);
    if constexpr (!ALIGN_EPI) { if (wr == 0) PG8_BAR; }
    PG8_BAR;
#undef PG8_SA
#undef PG8_SB
#undef PG8_STAGE
#undef PG8_LDA
#undef PG8_LDB
#undef PG8_MMA
#undef PG8_WAIT_V
#undef PG8_WAIT_L
#undef PG8_BAR
#undef PG8_SCHED
}
}
constexpr int D = 1024, NB = 4, SEQ = 8192, DB = 8, DSEQ = 64, NMB = NB + DB;
constexpr int GH = 8, GDK = 128, GDV = 128;
constexpr int SH = 32, SP = 64, SN = 128, SG = 8;
constexpr int DFF = 2816, CONV_CH = 7168, IN_COLS = 12336;
constexpr int NPROJ = 12288;
constexpr int NIN = 12544;
constexpr int NUP = 2 * DFF;
constexpr float EPS = 1e-6f;
#ifndef SLAB_T
#define SLAB_T 1024
#endif
constexpr int NSLAB = SEQ / SLAB_T, RP = NB * SLAB_T, RS = DB * DSEQ, RMAX = RP + RS;
constexpr size_t O_YP = 0, O_YS = O_YP + (size_t)NB * SEQ * D, O_CMP = O_YS + (size_t)DB * DSEQ * D, O_GP = O_CMP + (size_t)NB * 3 * CONV_CH,
                 O_SP = O_GP + (size_t)NB * GH * GDK * GDV, O_CFP = O_SP + (size_t)NB * SH * SN * SP, O_CMS = O_CFP + (size_t)NB * 2 * NUP,
                 O_GS = O_CMS + (size_t)DB * 3 * CONV_CH, O_SS = O_GS + (size_t)DB * GH * GDK * GDV, O_CFS = O_SS + (size_t)DB * SH * SN * SP,
                 O_END = O_CFS + (size_t)DB * 2 * NUP;
constexpr size_t MiB = 1u << 20;
constexpr size_t WS_CTL = 0, CTL_ZERO_BYTES = 1 * MiB;
constexpr size_t WS_MODV = 1 * MiB;
constexpr size_t WS_G1 = WS_MODV + 512 * 1024;
constexpr size_t WS_G2 = WS_G1 + 64 * 1024;
constexpr size_t WS_SHW = WS_G2 + 64 * 1024;
constexpr size_t WS_CARRY_MIX = 2 * MiB;
constexpr size_t WS_CARRY_FFN = 3 * MiB;
constexpr size_t WS_WIN = 4 * MiB;
constexpr size_t WS_WG = WS_WIN + (size_t)NIN * D * 2;
constexpr size_t WS_WS = WS_WG + (size_t)D * D * 2;
constexpr size_t WS_WOUT = WS_WS + (size_t)D * 2048 * 2;
constexpr size_t WS_WUP = WS_WOUT + (size_t)D * D * 2;
constexpr size_t WS_WDN = WS_WUP + (size_t)NUP * D * 2;
constexpr size_t WS_SLAB = 56 * MiB;
static_assert(WS_WDN + (size_t)D * DFF * 2 <= WS_SLAB, "weights fit");
constexpr size_t SZ_HB = (size_t)RMAX * D * 2, SZ_PROJ = (size_t)RMAX * NPROJ * 2, SZ_SM = (size_t)RMAX * 64 * 4, SZ_OG = (size_t)RMAX * D * 2, SZ_YS = (size_t)RMAX * 2048 * 2,
                 SZ_T1 = (size_t)RMAX * D * 4, SZ_MIX = (size_t)RMAX * D * 2, SZ_X1 = (size_t)RMAX * D * 4, SZ_X1G = (size_t)RMAX * D * 2, SZ_SS = (size_t)RMAX * 16 * 4,
                 SZ_U = (size_t)RMAX * NUP * 2, SZ_ACT = (size_t)RMAX * DFF * 2;
constexpr size_t WS_HB = WS_SLAB, WS_PROJ = WS_HB + SZ_HB, WS_SM = WS_PROJ + SZ_PROJ, WS_OG = WS_SM + SZ_SM, WS_YS = WS_OG + SZ_OG, WS_T1 = WS_YS + SZ_YS, WS_MIX = WS_T1 + SZ_T1,
                 WS_X1 = WS_MIX + SZ_MIX, WS_X1G = WS_X1 + SZ_X1, WS_SS1 = WS_X1G + SZ_X1G, WS_SS2 = WS_SS1 + SZ_SS, WS_U = WS_SS2 + SZ_SS, WS_ACT = WS_U + SZ_U, WS_END = WS_ACT + SZ_ACT;
static_assert(WS_END <= 480 * MiB, "workspace map fits");
constexpr int LDS_BYTES = 147456, LDSCTL_OFF = LDS_BYTES - 512, MISC_OFF = LDSCTL_OFF + 320, RING_BYTES = LDSCTL_OFF;
constexpr int NWAVES = 8, NTHR = 512;

#define GAS __attribute__((address_space(1)))
#define LAS __attribute__((address_space(3)))
typedef unsigned short bf16;
typedef unsigned v4u __attribute__((ext_vector_type(4)));
typedef unsigned v2u __attribute__((ext_vector_type(2)));
typedef float f32x4 __attribute__((ext_vector_type(4)));
typedef GAS unsigned gu32;
#define RLX_AGENT __ATOMIC_RELAXED, __HIP_MEMORY_SCOPE_AGENT
#define LDS_WAIT() asm volatile("s_waitcnt lgkmcnt(0)" ::: "memory")
#define VM_WAIT() asm volatile("s_waitcnt vmcnt(0)" ::: "memory")
__device__ __forceinline__ unsigned f2bf(float f) { unsigned u = __builtin_bit_cast(unsigned, f); return (u + 0x7fffu + ((u >> 16) & 1u)) >> 16; }
__device__ __forceinline__ unsigned pk2(float lo, float hi) { return f2bf(lo) | (f2bf(hi) << 16); }
__device__ __forceinline__ float bf2f(unsigned short h) { return __builtin_bit_cast(float, (unsigned)h << 16); }
__device__ __forceinline__ float bflo(unsigned w) { return __builtin_bit_cast(float, w << 16); }
__device__ __forceinline__ float bfhi(unsigned w) { return __builtin_bit_cast(float, w & 0xffff0000u); }
__device__ __forceinline__ float sigmoidf_(float x) { return 1.f / (1.f + __expf(-x)); }
__device__ __forceinline__ float siluf_(float x) { return x / (1.f + __expf(-x)); }
__device__ __forceinline__ float softplusf_(float x) { const float e = __expf(-fabsf(x)), u = 1.f + e, d = u - 1.f; const float l = (d == 0.f) ? e : __logf(u) * (e / d); return fmaxf(x, 0.f) + l; }
__device__ __forceinline__ float wave_sum(float v) {
#pragma unroll
    for (int o = 1; o < 64; o <<= 1) v += __shfl_xor(v, o);
    return v;
}

struct Args { const float* in[30]; float* out; unsigned char* ws; int ph_lo, ph_hi; };

struct Frame {
    LAS unsigned char* lds;
    volatile LAS unsigned* MISC;
    gu32* ctl;
    int tid, lane, wave, G, bid;
    const Args& A;
    float* out; unsigned char* ws;
    __device__ __forceinline__ Frame(const Args& a) : A(a) {}
};
__device__ __forceinline__ int row_mb(int r) { return r < RP ? (r / SLAB_T) : NB + ((r - RP) / DSEQ); }
__device__ __forceinline__ size_t row_goff(int s, int r) {
    if (r < RP) { const int b = r / SLAB_T, tl = r % SLAB_T; return ((size_t)b * SEQ + (size_t)s * SLAB_T + tl) * D; }
    return (size_t)(r - RP) * D;
}
__device__ __forceinline__ int slab_rows(int s) { return s == 0 ? RMAX : RP; }
struct MapWin { __device__ __forceinline__ int operator()(int n) const { return n < 10240 ? n : (n < 12288 ? n + 48 : (n < 12336 ? n - 2048 : -1)); } };
struct MapId  { __device__ __forceinline__ int operator()(int n) const { return n; } };
struct MapUp  { __device__ __forceinline__ int operator()(int n) const { const int j = n >> 8, c = n & 255; return c < 128 ? 128 * j + c : DFF + 128 * j + (c - 128); } };
template <class Map>
__device__ __forceinline__ void p0_transpose_item(const float* W, int ldw, int K, bf16* WT, Map map, LAS float* scr, int item, int nblk, int lane) {
    const int kb = item / nblk, nb = item % nblk, k0 = 64 * kb, n0 = 32 * nb;
    const int sc = map(n0 + (lane & 31));
#pragma unroll 8
    for (int i = 0; i < 32; ++i) { const int kk = 2 * i + (lane >> 5); scr[kk * 33 + (lane & 31)] = sc >= 0 ? W[(size_t)(k0 + kk) * ldw + sc] : 0.f; }
    LDS_WAIT(); asm volatile("" ::: "memory");
    const int c = lane & 7;
#pragma unroll
    for (int j = 0; j < 4; ++j) { const int n = (lane >> 3) + 8 * j; const LAS float* s = scr + (8 * c) * 33 + n;
        v4u o; o.x = pk2(s[0 * 33], s[1 * 33]); o.y = pk2(s[2 * 33], s[3 * 33]); o.z = pk2(s[4 * 33], s[5 * 33]); o.w = pk2(s[6 * 33], s[7 * 33]);
        *(GAS v4u*)(WT + (size_t)(n0 + n) * K + k0 + 8 * c) = o; }
    LDS_WAIT(); asm volatile("" ::: "memory");
}
__device__ __forceinline__ void p0_mod_item(Frame& F, int item) {
    LAS float* sc = (LAS float*)F.lds; LAS float* red = (LAS float*)(F.lds + 49152);
    const float* cp = F.A.in[6]; const float* cs = F.A.in[7]; const float* w_ada = F.A.in[8]; const float* b_ada = F.A.in[9];
    for (int idx = F.tid; idx < NMB * D; idx += NTHR) { const int b = idx / D, k = idx % D; const float c = b < NB ? cp[b * D + k] : cs[(b - NB) * D + k]; sc[idx] = siluf_(c); }
    __syncthreads();
    float acc[NMB];
#pragma unroll
    for (int b = 0; b < NMB; ++b) acc[b] = 0.f;
    const int col = item * 64 + F.lane, kb = F.wave * 128;
    for (int k = 0; k < 128; ++k) { const float wv = w_ada[(size_t)(kb + k) * 6144 + col];
#pragma unroll
        for (int b = 0; b < NMB; ++b) acc[b] += sc[b * D + kb + k] * wv; }
#pragma unroll
    for (int b = 0; b < NMB; ++b) red[(F.wave * NMB + b) * 64 + F.lane] = acc[b];
    __syncthreads();
    float* modv = (float*)(F.ws + WS_MODV);
    for (int idx = F.tid; idx < NMB * 64; idx += NTHR) { const int b = idx / 64, l = idx % 64; float s = b_ada[item * 64 + l];
#pragma unroll
        for (int w = 0; w < 8; ++w) s += red[(w * NMB + b) * 64 + l];
        modv[b * 6144 + item * 64 + l] = s; }
    __syncthreads();
}
__device__ __forceinline__ void phase_prologue0(Frame& F) {
    for (int it = F.bid; it < 96; it += F.G) p0_mod_item(F, it);
    LAS float* scr = (LAS float*)(F.lds + F.wave * 16384);
    const int gw = F.bid * NWAVES + F.wave, NGW = F.G * NWAVES;
    constexpr int I_IN = (D / 64) * (NIN / 32), I_G = (D / 64) * (D / 32), I_S = (2048 / 64) * (D / 32), I_O = I_G, I_UP = (D / 64) * (NUP / 32), I_DN = (DFF / 64) * (D / 32);
    constexpr int NITEMS = I_IN + I_G + I_S + I_O + I_UP + I_DN;
    for (int it = gw; it < NITEMS; it += NGW) {
        int r = it;
        if (r < I_IN) { p0_transpose_item(F.A.in[11], IN_COLS, D, (bf16*)(F.ws + WS_WIN), MapWin(), scr, r, NIN / 32, F.lane); continue; } r -= I_IN;
        if (r < I_G) { p0_transpose_item(F.A.in[21], D, D, (bf16*)(F.ws + WS_WG), MapId(), scr, r, D / 32, F.lane); continue; } r -= I_G;
        if (r < I_S) { p0_transpose_item(F.A.in[22], D, 2048, (bf16*)(F.ws + WS_WS), MapId(), scr, r, D / 32, F.lane); continue; } r -= I_S;
        if (r < I_O) { p0_transpose_item(F.A.in[23], D, D, (bf16*)(F.ws + WS_WOUT), MapId(), scr, r, D / 32, F.lane); continue; } r -= I_O;
        if (r < I_UP) { p0_transpose_item(F.A.in[25], NUP, D, (bf16*)(F.ws + WS_WUP), MapUp(), scr, r, NUP / 32, F.lane); continue; } r -= I_UP;
        p0_transpose_item(F.A.in[28], D, DFF, (bf16*)(F.ws + WS_WDN), MapId(), scr, r, D / 32, F.lane);
    }
}
__device__ __forceinline__ void phase_prologue1(Frame& F) {
    const float* modv = (const float*)(F.ws + WS_MODV);
    float* g1 = (float*)(F.ws + WS_G1); float* g2 = (float*)(F.ws + WS_G2); float* shw = (float*)(F.ws + WS_SHW);
    for (int idx = F.bid * NTHR + F.tid; idx < NMB * D; idx += F.G * NTHR) { const int b = idx / D, k = idx % D;
        g1[idx] = F.A.in[10][k] * (1.f + modv[b * 6144 + 1024 + k]); g2[idx] = F.A.in[24][k] * (1.f + modv[b * 6144 + 4096 + k]); }
    LAS float* sh = (LAS float*)F.lds;
    for (int idx = F.tid; idx < NMB * D; idx += NTHR) sh[idx] = modv[(idx / D) * 6144 + 3072 + (idx % D)];
    __syncthreads();
    const bf16* wup = (const bf16*)(F.ws + WS_WUP);
    const int gw = F.bid * NWAVES + F.wave, NGW = F.G * NWAVES;
    for (int n = gw; n < NUP; n += NGW) {
        const GAS v4u* wr = (const GAS v4u*)(wup + (size_t)n * D + F.lane * 16);
        const v4u w0 = wr[0], w1 = wr[1];
        float wf[16] = {bflo(w0.x), bfhi(w0.x), bflo(w0.y), bfhi(w0.y), bflo(w0.z), bfhi(w0.z), bflo(w0.w), bfhi(w0.w), bflo(w1.x), bfhi(w1.x), bflo(w1.y), bfhi(w1.y), bflo(w1.z), bfhi(w1.z), bflo(w1.w), bfhi(w1.w)};
        float res = 0.f;
#pragma unroll 1
        for (int b = 0; b < NMB; ++b) { float a = 0.f;
#pragma unroll
            for (int i = 0; i < 16; ++i) a += wf[i] * sh[b * D + F.lane * 16 + i];
            a = wave_sum(a); if (F.lane == b) res = a; }
        if (F.lane < NMB) shw[F.lane * NUP + n] = res;
    }
    __syncthreads();
}
__device__ __forceinline__ void phase_norm1(Frame& F, int s) {
    const float* modv = (const float*)(F.ws + WS_MODV); const float* g1 = (const float*)(F.ws + WS_G1); bf16* hb = (bf16*)(F.ws + WS_HB);
    const int gw = F.bid * NWAVES + F.wave, NGW = F.G * NWAVES, R = slab_rows(s);
    for (int r = gw; r < R; r += NGW) {
        const float* xrow = (r < RP ? F.A.in[0] : F.A.in[1]) + row_goff(s, r); const int mb = row_mb(r);
        const GAS f32x4* xr = (const GAS f32x4*)xrow + F.lane;
        f32x4 v[4]; float ss = 0.f;
#pragma unroll
        for (int j = 0; j < 4; ++j) { v[j] = xr[64 * j]; ss += (v[j].x * v[j].x + v[j].y * v[j].y) + (v[j].z * v[j].z + v[j].w * v[j].w); }
        const float rs = rsqrtf(wave_sum(ss) * (1.f / D) + EPS);
        GAS v2u* o8 = (GAS v2u*)(hb + (size_t)r * D) + F.lane;
#pragma unroll
        for (int j = 0; j < 4; ++j) { const int k = 4 * F.lane + 256 * j; const f32x4 g = *(const GAS f32x4*)(g1 + mb * D + k); const f32x4 sh = *(const GAS f32x4*)(modv + mb * 6144 + k);
            v2u o; o.x = pk2(v[j].x * rs * g.x + sh.x, v[j].y * rs * g.y + sh.y); o.y = pk2(v[j].z * rs * g.z + sh.z, v[j].w * rs * g.w + sh.w); o8[64 * j] = o; }
    }
}
__device__ __forceinline__ void phase_final(Frame& F, int s) {
    const float* ss2 = (const float*)(F.ws + WS_SS2); const float* wf = F.A.in[29];
    const int gw = F.bid * NWAVES + F.wave, NGW = F.G * NWAVES, R = slab_rows(s);
    for (int r = gw; r < R; r += NGW) {
        float* yrow = F.out + (r < RP ? O_YP : O_YS) + row_goff(s, r);
        float t = F.lane < 16 ? ss2[(size_t)r * 16 + F.lane] : 0.f; t = wave_sum(t);
        const float rs = rsqrtf(t * (1.f / D) + EPS);
        GAS f32x4* yr = (GAS f32x4*)yrow + F.lane;
#pragma unroll
        for (int j = 0; j < 4; ++j) { f32x4 v = yr[64 * j]; const f32x4 w = *(const GAS f32x4*)(wf + 4 * F.lane + 256 * j); v.x *= rs * w.x; v.y *= rs * w.y; v.z *= rs * w.z; v.w *= rs * w.w; yr[64 * j] = v; }
    }
}
__device__ __forceinline__ void u_hist_row(Frame& F, int s, int r, int back, int c8, int j, int cc, float (&ua)[8], float (&uv)[8]) {
    const bf16* U = (const bf16*)(F.ws + WS_U);
    int tl, b; bool samp = r >= RP;
    if (!samp) { b = r / SLAB_T; tl = r % SLAB_T; } else { b = (r - RP) / DSEQ; tl = (r - RP) % DSEQ; }
    if (tl - back >= 0) {
        const bf16* p = U + (size_t)(r - back) * NUP + 256 * j + cc;
        const v4u a = *(const GAS v4u*)p, v = *(const GAS v4u*)(p + 128);
        ua[0] = bflo(a.x); ua[1] = bfhi(a.x); ua[2] = bflo(a.y); ua[3] = bfhi(a.y); ua[4] = bflo(a.z); ua[5] = bfhi(a.z); ua[6] = bflo(a.w); ua[7] = bfhi(a.w);
        uv[0] = bflo(v.x); uv[1] = bfhi(v.x); uv[2] = bflo(v.y); uv[3] = bfhi(v.y); uv[4] = bflo(v.z); uv[5] = bfhi(v.z); uv[6] = bflo(v.w); uv[7] = bfhi(v.w);
        return;
    }
    const int hi = 2 + (tl - back);
    if (samp) { const float* st = F.A.in[5] + ((size_t)b * 2 + hi) * NUP;
#pragma unroll
        for (int i = 0; i < 8; ++i) { ua[i] = st[c8 + i]; uv[i] = st[DFF + c8 + i]; } return; }
    if (s == 0) {
#pragma unroll
        for (int i = 0; i < 8; ++i) { ua[i] = 0.f; uv[i] = 0.f; } return; }
    const float* cf = (const float*)(F.ws + WS_CARRY_FFN) + (((size_t)(s & 1) * NB + b) * 2 + hi) * NUP + 256 * j + cc;
#pragma unroll
    for (int i = 0; i < 8; ++i) { ua[i] = cf[i]; uv[i] = cf[128 + i]; }
}
__device__ __forceinline__ void phase_convact(Frame& F, int s) {
    const bf16* U = (const bf16*)(F.ws + WS_U); bf16* ACT = (bf16*)(F.ws + WS_ACT);
    const float* wc = F.A.in[26]; const float* bc = F.A.in[27];
    const int R = slab_rows(s); const long total = (long)R * (DFF / 8);
    for (long idx = (long)F.bid * NTHR + F.tid; idx < total; idx += (long)F.G * NTHR) {
        const int r = (int)(idx / (DFF / 8)), c8 = (int)(idx % (DFF / 8)) * 8, j = c8 >> 7, cc = c8 & 127;
        float a0[8], v0[8], a1[8], v1[8], a2[8], v2[8];
        u_hist_row(F, s, r, 0, c8, j, cc, a2, v2); u_hist_row(F, s, r, 1, c8, j, cc, a1, v1); u_hist_row(F, s, r, 2, c8, j, cc, a0, v0);
        float o[8];
#pragma unroll
        for (int i = 0; i < 8; ++i) { const int ca = c8 + i, cv = DFF + c8 + i;
            const float xa = bc[ca] + wc[ca] * a0[i] + wc[NUP + ca] * a1[i] + wc[2 * NUP + ca] * a2[i];
            const float xv = bc[cv] + wc[cv] * v0[i] + wc[NUP + cv] * v1[i] + wc[2 * NUP + cv] * v2[i];
            o[i] = siluf_(xa) * xv; }
        v4u w; w.x = pk2(o[0], o[1]); w.y = pk2(o[2], o[3]); w.z = pk2(o[4], o[5]); w.w = pk2(o[6], o[7]);
        *(GAS v4u*)(ACT + (size_t)r * DFF + c8) = w;
    }
    float* cfn = (float*)(F.ws + WS_CARRY_FFN) + (size_t)((s + 1) & 1) * NB * 2 * NUP;
    for (int idx = F.bid * NTHR + F.tid; idx < NB * 2 * NUP; idx += F.G * NTHR) {
        const int b = idx / (2 * NUP), i = (idx / NUP) % 2, c = idx % NUP; const int r = b * SLAB_T + SLAB_T - 2 + i;
        const float v = bf2f(U[(size_t)r * NUP + c]); cfn[idx] = v;
        if (s == NSLAB - 1) { const int j = c >> 8, cc = c & 255; const int oc = cc < 128 ? 128 * j + cc : DFF + 128 * j + (cc - 128); F.out[O_CFP + ((size_t)b * 2 + i) * NUP + oc] = v; }
    }
    if (s == 0) for (int idx = F.bid * NTHR + F.tid; idx < DB * 2 * NUP; idx += F.G * NTHR) {
        const int b = idx / (2 * NUP), i = (idx / NUP) % 2, c = idx % NUP; const int r = RP + b * DSEQ + DSEQ - 2 + i;
        const int j = c >> 8, cc = c & 255; const int oc = cc < 128 ? 128 * j + cc : DFF + 128 * j + (cc - 128);
        F.out[O_CFS + ((size_t)b * 2 + i) * NUP + oc] = bf2f(U[(size_t)r * NUP + c]);
    }
}
__device__ __forceinline__ void phase_mix_carry(Frame& F, int s) {
    const bf16* P = (const bf16*)(F.ws + WS_PROJ);
    float* cmn = (float*)(F.ws + WS_CARRY_MIX) + (size_t)((s + 1) & 1) * NB * 3 * CONV_CH;
    for (int idx = F.bid * NTHR + F.tid; idx < NB * 3 * CONV_CH; idx += F.G * NTHR) {
        const int b = idx / (3 * CONV_CH), i = (idx / CONV_CH) % 3, c = idx % CONV_CH; const int r = b * SLAB_T + SLAB_T - 3 + i;
        const float v = bf2f(P[(size_t)r * NPROJ + c]); cmn[idx] = v;
        if (s == NSLAB - 1) F.out[O_CMP + idx] = v;
    }
    if (s == 0) for (int idx = F.bid * NTHR + F.tid; idx < DB * 3 * CONV_CH; idx += F.G * NTHR) {
        const int b = idx / (3 * CONV_CH), i = (idx / CONV_CH) % 3, c = idx % CONV_CH; const int r = RP + b * DSEQ + DSEQ - 3 + i;
        F.out[O_CMS + idx] = bf2f(P[(size_t)r * NPROJ + c]);
    }
}
namespace epi {
using pg8::f32x4; using pg8::Unit; using pg8::BM; using pg8::HALF; using pg8::cvt_pk_bf16; using pg8::u32x4; using pg8::u32x2;
struct EpiProj {
    static constexpr bool PERM = true;
    bf16* P; float* SM;
    __device__ __forceinline__ void operator()(const f32x4 (&acc)[2][2][4][2], const Unit& u, int wr, int wc, int fr, int fq) const {
        const int row0 = u.pm * BM + wr * 64 + fr;
        if (u.pn == 48) {
            if (wc < 2) {
#pragma unroll
                for (int ai = 0; ai < 2; ++ai)
#pragma unroll
                    for (int m = 0; m < 4; ++m) { float* rp = SM + (size_t)(row0 + ai * HALF + m * 16) * 64 + wc * 32 + 8 * fq;
                        *(f32x4*)rp = acc[ai][0][m][0]; *(f32x4*)(rp + 4) = acc[ai][0][m][1]; }
            }
            return;
        }
        const bool sg = u.pn >= 40;
        const int col0 = u.pn * BM + wc * 32 + 8 * fq;
#pragma unroll
        for (int ai = 0; ai < 2; ++ai)
#pragma unroll
            for (int m = 0; m < 4; ++m) { bf16* rowp = P + (size_t)(row0 + ai * HALF + m * 16) * NPROJ + col0;
#pragma unroll
                for (int bj = 0; bj < 2; ++bj) { f32x4 v0 = acc[ai][bj][m][0], v1 = acc[ai][bj][m][1];
                    if (sg) {
#pragma unroll
                        for (int i = 0; i < 4; ++i) { v0[i] = sigmoidf_(v0[i]); v1[i] = sigmoidf_(v1[i]); } }
                    u32x4 w; w.x = cvt_pk_bf16(v0[0], v0[1]); w.y = cvt_pk_bf16(v0[2], v0[3]); w.z = cvt_pk_bf16(v1[0], v1[1]); w.w = cvt_pk_bf16(v1[2], v1[3]);
                    *(u32x4*)(rowp + bj * HALF) = w; } }
    }
};
struct EpiGate1 {
    static constexpr bool PERM = false;
    const bf16* P; float* T1;
    __device__ __forceinline__ void operator()(const f32x4 (&acc)[2][2][4][2], const Unit& u, int wr, int wc, int fr, int fq) const {
        const int row0 = u.pm * BM + wr * 64 + fr, col0 = u.pn * BM + wc * 32 + 4 * fq;
#pragma unroll
        for (int ai = 0; ai < 2; ++ai)
#pragma unroll
            for (int m = 0; m < 4; ++m) { const size_t r = (size_t)(row0 + ai * HALF + m * 16);
#pragma unroll
                for (int bj = 0; bj < 2; ++bj)
#pragma unroll
                    for (int n = 0; n < 2; ++n) { const int c = col0 + bj * HALF + n * 16; const u32x2 g = *(const u32x2*)(P + r * NPROJ + 10240 + c); const f32x4 a = acc[ai][bj][m][n];
                        f32x4 o; o.x = a.x * bflo(g.x); o.y = a.y * bfhi(g.x); o.z = a.z * bflo(g.y); o.w = a.w * bfhi(g.y); *(f32x4*)(T1 + r * D + c) = o; } }
    }
};
struct EpiGate2 {
    static constexpr bool PERM = false;
    const bf16* P; const float* T1; bf16* MIX;
    __device__ __forceinline__ void operator()(const f32x4 (&acc)[2][2][4][2], const Unit& u, int wr, int wc, int fr, int fq) const {
        const int row0 = u.pm * BM + wr * 64 + fr, col0 = u.pn * BM + wc * 32 + 4 * fq;
#pragma unroll
        for (int ai = 0; ai < 2; ++ai)
#pragma unroll
            for (int m = 0; m < 4; ++m) { const size_t r = (size_t)(row0 + ai * HALF + m * 16);
#pragma unroll
                for (int bj = 0; bj < 2; ++bj)
#pragma unroll
                    for (int n = 0; n < 2; ++n) { const int c = col0 + bj * HALF + n * 16; const u32x2 g = *(const u32x2*)(P + r * NPROJ + 11264 + c); const f32x4 a = acc[ai][bj][m][n];
                        const f32x4 t = *(const f32x4*)(T1 + r * D + c);
                        u32x2 o; o.x = cvt_pk_bf16(t.x + a.x * bflo(g.x), t.y + a.y * bfhi(g.x)); o.y = cvt_pk_bf16(t.z + a.z * bflo(g.y), t.w + a.w * bfhi(g.y)); *(u32x2*)(MIX + r * D + c) = o; } }
    }
};
struct EpiOut {
    static constexpr bool PERM = false;
    const float* xp; const float* xs; const float* modv; const float* g2; float* X1; bf16* X1G; float* SS; int slab;
    __device__ __forceinline__ void operator()(const f32x4 (&acc)[2][2][4][2], const Unit& u, int wr, int wc, int fr, int fq) const {
        const int col0 = u.pn * BM + wc * 32 + 4 * fq;
#pragma unroll
        for (int ai = 0; ai < 2; ++ai) {
            const int rb = u.pm * BM + ai * HALF + wr * 64; const int mb = row_mb(rb);
#pragma unroll
            for (int m = 0; m < 4; ++m) { const int r = rb + m * 16 + fr; const float* xrow = (r < RP ? xp : xs) + row_goff(slab, r); float sq = 0.f;
#pragma unroll
                for (int bj = 0; bj < 2; ++bj)
#pragma unroll
                    for (int n = 0; n < 2; ++n) { const int c = col0 + bj * HALF + n * 16; const f32x4 a = acc[ai][bj][m][n];
                        const f32x4 xv = *(const f32x4*)(xrow + c), gt = *(const f32x4*)(modv + mb * 6144 + 2048 + c), gg = *(const f32x4*)(g2 + mb * D + c);
                        f32x4 o = xv + gt * a; *(f32x4*)(X1 + (size_t)r * D + c) = o; sq += (o.x * o.x + o.y * o.y) + (o.z * o.z + o.w * o.w);
                        u32x2 w; w.x = cvt_pk_bf16(o.x * gg.x, o.y * gg.y); w.y = cvt_pk_bf16(o.z * gg.z, o.w * gg.w); *(u32x2*)(X1G + (size_t)r * D + c) = w; }
                sq += __shfl_xor(sq, 16); sq += __shfl_xor(sq, 32);
                if (fq == 0) SS[(size_t)r * 16 + u.pn * 4 + wc] = sq; }
        }
    }
};
struct EpiUp {
    static constexpr bool PERM = true;
    const float* SS; const float* shw; bf16* U;
    __device__ __forceinline__ void operator()(const f32x4 (&acc)[2][2][4][2], const Unit& u, int wr, int wc, int fr, int fq) const {
        const int col0 = u.pn * BM + wc * 32 + 8 * fq;
#pragma unroll
        for (int ai = 0; ai < 2; ++ai) {
            const int rb = u.pm * BM + ai * HALF + wr * 64; const int mb = row_mb(rb);
            f32x4 sv[2][2];
#pragma unroll
            for (int bj = 0; bj < 2; ++bj)
#pragma unroll
                for (int n = 0; n < 2; ++n) sv[bj][n] = *(const f32x4*)(shw + mb * NUP + col0 + bj * HALF + 4 * n);
#pragma unroll
            for (int m = 0; m < 4; ++m) { const int r = rb + m * 16 + fr; const f32x4* sp = (const f32x4*)(SS + (size_t)r * 16);
                const f32x4 s0 = sp[0], s1 = sp[1], s2 = sp[2], s3 = sp[3];
                const float tot = ((s0.x + s0.y) + (s0.z + s0.w)) + ((s1.x + s1.y) + (s1.z + s1.w)) + ((s2.x + s2.y) + (s2.z + s2.w)) + ((s3.x + s3.y) + (s3.z + s3.w));
                const float rs = rsqrtf(tot * (1.f / D) + EPS);
#pragma unroll
                for (int bj = 0; bj < 2; ++bj) { const f32x4 v0 = acc[ai][bj][m][0] * rs + sv[bj][0], v1 = acc[ai][bj][m][1] * rs + sv[bj][1];
                    u32x4 w; w.x = cvt_pk_bf16(v0[0], v0[1]); w.y = cvt_pk_bf16(v0[2], v0[3]); w.z = cvt_pk_bf16(v1[0], v1[1]); w.w = cvt_pk_bf16(v1[2], v1[3]);
                    *(u32x4*)(U + (size_t)r * NUP + col0 + bj * HALF) = w; } }
        }
    }
};
struct EpiDown {
    static constexpr bool PERM = false;
    const float* X1; const float* modv; float* yp; float* ys; float* SS; int slab;
    __device__ __forceinline__ void operator()(const f32x4 (&acc)[2][2][4][2], const Unit& u, int wr, int wc, int fr, int fq) const {
        const int col0 = u.pn * BM + wc * 32 + 4 * fq;
#pragma unroll
        for (int ai = 0; ai < 2; ++ai) {
            const int rb = u.pm * BM + ai * HALF + wr * 64; const int mb = row_mb(rb);
#pragma unroll
            for (int m = 0; m < 4; ++m) { const int r = rb + m * 16 + fr; float* yrow = (r < RP ? yp : ys) + row_goff(slab, r); float sq = 0.f;
#pragma unroll
                for (int bj = 0; bj < 2; ++bj)
#pragma unroll
                    for (int n = 0; n < 2; ++n) { const int c = col0 + bj * HALF + n * 16; const f32x4 a = acc[ai][bj][m][n];
                        const f32x4 xv = *(const f32x4*)(X1 + (size_t)r * D + c), gt = *(const f32x4*)(modv + mb * 6144 + 5120 + c);
                        f32x4 o = xv + gt * a; *(f32x4*)(yrow + c) = o; sq += (o.x * o.x + o.y * o.y) + (o.z * o.z + o.w * o.w); }
                sq += __shfl_xor(sq, 16); sq += __shfl_xor(sq, 32);
                if (fq == 0) SS[(size_t)r * 16 + u.pn * 4 + wc] = sq; }
        }
    }
};
}
typedef short bf16x8 __attribute__((ext_vector_type(8)));
#define MFMA16(a, b, c) __builtin_amdgcn_mfma_f32_16x16x32_bf16((a), (b), (c), 0, 0, 0)
__device__ __forceinline__ bf16x8 ldfrag(const LAS bf16* base, int ld, int row0, int k0, int lane) {
    return *(const LAS bf16x8*)(base + (row0 + (lane & 15)) * ld + k0 + 8 * (lane >> 4));
}
__device__ __forceinline__ bf16x8 ldfrag_perm(const LAS bf16* base, int ld, int row0, int k0, int lane) {
    const LAS v2u* p = (const LAS v2u*)(base + (row0 + (lane & 15)) * ld + k0 + 4 * (lane >> 4));
    const v2u a = p[0], b = p[4];
    v4u w; w.x = a.x; w.y = a.y; w.z = b.x; w.w = b.y; return __builtin_bit_cast(bf16x8, w);
}
__device__ __forceinline__ bf16x8 acc2frag(f32x4 t0, f32x4 t1) {
    v4u w; w.x = pg8::cvt_pk_bf16(t0.x, t0.y); w.y = pg8::cvt_pk_bf16(t0.z, t0.w); w.z = pg8::cvt_pk_bf16(t1.x, t1.y); w.w = pg8::cvt_pk_bf16(t1.z, t1.w); return __builtin_bit_cast(bf16x8, w);
}
__device__ __forceinline__ float wave_incl_scan(float v, int lane) {
#pragma unroll
    for (int o = 1; o < 64; o <<= 1) { const float t = __shfl_up(v, o); if (lane >= o) v += t; }
    return v;
}
__device__ __forceinline__ float row16_sum(float v) { v += __shfl_xor(v, 1); v += __shfl_xor(v, 2); v += __shfl_xor(v, 4); v += __shfl_xor(v, 8); return v; }

constexpr int SL_CS = 0, SL_BS = 17408, SL_BT = 34816, SL_XT = 53248, SL_CB = 90112, SL_DT = 99328, SL_GAM = 100352, SL_PS = 101376, SL_ZS = 103424;
__device__ __forceinline__ void ssd_fast_job(Frame& F, int s, bool samp, int bb, int g) {
    const bf16* P = (const bf16*)(F.ws + WS_PROJ); const float* SM = (const float*)(F.ws + WS_SM); bf16* YS = (bf16*)(F.ws + WS_YS);
    LAS bf16* CS = (LAS bf16*)(F.lds + SL_CS); LAS bf16* BS = (LAS bf16*)(F.lds + SL_BS); LAS bf16* BT = (LAS bf16*)(F.lds + SL_BT); LAS bf16* XT = (LAS bf16*)(F.lds + SL_XT);
    LAS bf16* CBS = (LAS bf16*)(F.lds + SL_CB); LAS float* DTV = (LAS float*)(F.lds + SL_DT); LAS float* GAM = (LAS float*)(F.lds + SL_GAM); LAS float* PS = (LAS float*)(F.lds + SL_PS); LAS bf16* ZS = (LAS bf16*)(F.lds + SL_ZS) + F.wave * 2048;
    const int tid = F.tid, w = F.wave;
    int lane = F.lane; asm volatile("" : "+v"(lane)); int quad = lane >> 4, l15 = lane & 15;
    const int hl = w >> 1, ph = w & 1, head = 4 * g + hl;
    const int nchunk = samp ? 1 : SLAB_T / 64, row0 = samp ? RP + bb * DSEQ : bb * SLAB_T;
    f32x4 hacc[8][2];
    {
        const float* st = samp ? F.A.in[4] : F.out + O_SP;
        const size_t sb = (size_t)(bb * SH + head) * SN * SP;
#pragma unroll
        for (int mt = 0; mt < 8; ++mt)
#pragma unroll
            for (int nt = 0; nt < 2; ++nt)
#pragma unroll
                for (int r = 0; r < 4; ++r) { const int n = 16 * mt + 4 * quad + r, p = 32 * ph + 16 * nt + l15; hacc[mt][nt][r] = (samp || s > 0) ? st[sb + (size_t)n * SP + p] : 0.f; }
    }
    const int cidx = tid < 256 ? 3072 + g * 256 + tid : (tid < 384 ? 5120 + g * 128 + (tid - 256) : 6144 + g * 128 + (tid - 384));
    const float* wcv = F.A.in[12]; const float w0 = wcv[cidx], w1 = wcv[CONV_CH + cidx], w2 = wcv[2 * CONV_CH + cidx], w3 = wcv[3 * CONV_CH + cidx], bias = F.A.in[13][cidx];
    float h0 = 0.f, h1 = 0.f, h2 = 0.f;
    if (samp) { const float* st = F.A.in[2] + (size_t)bb * 3 * CONV_CH + cidx; h0 = st[0]; h1 = st[CONV_CH]; h2 = st[2 * CONV_CH]; }
    else if (s > 0) { const float* st = (const float*)(F.ws + WS_CARRY_MIX) + ((size_t)(s & 1) * NB + bb) * 3 * CONV_CH + cidx; h0 = st[0]; h1 = st[CONV_CH]; h2 = st[2 * CONV_CH]; }
    const float aneg = -__expf(F.A.in[17][head]), Dh = F.A.in[19][head];
    for (int c = 0; c < nchunk; ++c) {
        const int r0 = row0 + 64 * c;
        asm volatile("" : "+v"(lane)); quad = lane >> 4; l15 = lane & 15;
        v4u zr[4];
        { const GAS v4u* zp = (const GAS v4u*)(P + (size_t)(r0 + lane) * NPROJ + 8192 + head * 64 + 32 * ph);
#pragma unroll
          for (int i = 0; i < 4; ++i) zr[i] = zp[i]; }
        if (tid < 256) { const int hh = 4 * g + (tid >> 6); const float dt = softplusf_(SM[(size_t)(r0 + lane) * 64 + 16 + hh] + F.A.in[18][hh]);
            const float ga = wave_incl_scan(dt * (-__expf(F.A.in[17][hh])), lane); DTV[(tid >> 6) * 64 + lane] = dt; GAM[(tid >> 6) * 64 + lane] = ga; }
        __syncthreads();
        {
            unsigned colp2[32];
            const bf16* pc = P + (size_t)r0 * NPROJ + cidx;
            const LAS float* dtp = DTV + (tid < 256 ? (tid >> 6) * 64 : 0);
#pragma unroll
            for (int tb = 0; tb < 4; ++tb) { float raw[16];
#pragma unroll
                for (int t = 0; t < 16; ++t) raw[t] = bf2f(pc[(size_t)(16 * tb + t) * NPROJ]);
#pragma unroll
                for (int t = 0; t < 16; t += 2) { float va = bias + w0 * h0 + w1 * h1 + w2 * h2 + w3 * raw[t]; float vb = bias + w0 * h1 + w1 * h2 + w2 * raw[t] + w3 * raw[t + 1]; h0 = h2; h1 = raw[t]; h2 = raw[t + 1];
                    va = siluf_(va); vb = siluf_(vb); if (tid < 256) { va *= dtp[16 * tb + t]; vb *= dtp[16 * tb + t + 1]; }
                    colp2[8 * tb + (t >> 1)] = pk2(va, vb); }
                asm volatile("" ::: "memory"); }
            if (tid < 384) {
                LAS bf16* rowp = tid < 256 ? XT + tid * 72 : BT + (tid - 256) * 72;
#pragma unroll
                for (int i = 0; i < 8; ++i) { v4u o; o.x = colp2[4 * i]; o.y = colp2[4 * i + 1]; o.z = colp2[4 * i + 2]; o.w = colp2[4 * i + 3]; *(LAS v4u*)(rowp + 8 * i) = o; }
            }
            if (tid >= 256) {
                LAS bf16* colp = tid < 384 ? BS + (tid - 256) : CS + (tid - 384);
#pragma unroll
                for (int t = 0; t < 32; ++t) { colp[(2 * t) * 136] = (bf16)(colp2[t] & 0xffffu); colp[(2 * t + 1) * 136] = (bf16)(colp2[t] >> 16); }
            }
        }
#pragma unroll
        for (int i = 0; i < 4; ++i) *(LAS v4u*)(ZS + lane * 32 + 8 * i) = zr[i];
        __syncthreads();
        {
            const int mt = w >> 1;
#pragma unroll
            for (int q = 0; q < 2; ++q) { const int nt = 2 * (w & 1) + q; f32x4 acc = {0.f, 0.f, 0.f, 0.f};
#pragma unroll
                for (int ks = 0; ks < 4; ++ks) acc = MFMA16(ldfrag(CS, 136, 16 * mt, 32 * ks, lane), ldfrag(BS, 136, 16 * nt, 32 * ks, lane), acc);
#pragma unroll
                for (int r = 0; r < 4; ++r) CBS[(16 * mt + 4 * quad + r) * 72 + 16 * nt + l15] = (bf16)f2bf(acc[r]); }
        }
        __syncthreads();
        const LAS float* gm = GAM + hl * 64; const LAS float* dv = DTV + hl * 64;
        const float last = gm[63];
        f32x4 y[4][2];
        {
#pragma unroll
            for (int mt = 0; mt < 4; ++mt)
#pragma unroll
                for (int nt = 0; nt < 2; ++nt) y[mt][nt] = (f32x4){0.f, 0.f, 0.f, 0.f};
#pragma unroll
            for (int ks = 0; ks < 4; ++ks) { const bf16x8 hb0 = acc2frag(hacc[2 * ks][0], hacc[2 * ks + 1][0]), hb1 = acc2frag(hacc[2 * ks][1], hacc[2 * ks + 1][1]);
#pragma unroll
                for (int mt = 0; mt < 4; ++mt) { const bf16x8 a = ldfrag_perm(CS, 136, 16 * mt, 32 * ks, lane); y[mt][0] = MFMA16(a, hb0, y[mt][0]); y[mt][1] = MFMA16(a, hb1, y[mt][1]); }
                __builtin_amdgcn_sched_barrier(0); }
#pragma unroll
            for (int mt = 0; mt < 4; ++mt)
#pragma unroll
                for (int r = 0; r < 4; ++r) { const float eg = __expf(gm[16 * mt + 4 * quad + r]); y[mt][0][r] *= eg; y[mt][1][r] *= eg; }
        }
        {
            const int prow = hl * 64 + 32 * ph;
#pragma unroll
            for (int mt = 0; mt < 4; ++mt) { const int i = 16 * mt + l15; const float gi = gm[i], ddt = Dh / dv[i];
#pragma unroll
                for (int ks = 0; ks < 2; ++ks) { if (32 * ks > 16 * mt + 15) continue;
                    const bf16x8 a0 = ldfrag(CBS, 72, 16 * mt, 32 * ks, lane); const v4u aw = __builtin_bit_cast(v4u, a0);
                    const f32x4 g0 = *(const LAS f32x4*)(gm + 32 * ks + 8 * quad), g1 = *(const LAS f32x4*)(gm + 32 * ks + 8 * quad + 4);
                    float cv[8] = {bflo(aw.x), bfhi(aw.x), bflo(aw.y), bfhi(aw.y), bflo(aw.z), bfhi(aw.z), bflo(aw.w), bfhi(aw.w)};
                    const float gj[8] = {g0.x, g0.y, g0.z, g0.w, g1.x, g1.y, g1.z, g1.w};
#pragma unroll
                    for (int jj = 0; jj < 8; ++jj) { const int j = 32 * ks + 8 * quad + jj; float v = i >= j ? cv[jj] * __expf(gi - gj[jj]) : 0.f; if (i == j) v += ddt; cv[jj] = v; }
                    v4u bw; bw.x = pk2(cv[0], cv[1]); bw.y = pk2(cv[2], cv[3]); bw.z = pk2(cv[4], cv[5]); bw.w = pk2(cv[6], cv[7]); const bf16x8 a1 = __builtin_bit_cast(bf16x8, bw);
#pragma unroll
                    for (int nt = 0; nt < 2; ++nt) y[mt][nt] = MFMA16(a1, ldfrag(XT, 72, prow + 16 * nt, 32 * ks, lane), y[mt][nt]); }
                __builtin_amdgcn_sched_barrier(0); }
#pragma unroll
            for (int mt = 0; mt < 4; ++mt)
#pragma unroll
                for (int r = 0; r < 4; ++r) { const int i = 16 * mt + 4 * quad + r; float sq = 0.f;
#pragma unroll
                    for (int nt = 0; nt < 2; ++nt) { const float z = bf2f(ZS[i * 32 + 16 * nt + l15]); const float yz = y[mt][nt][r] * siluf_(z); y[mt][nt][r] = yz; sq += yz * yz; }
                    sq = row16_sum(sq); if (l15 == 0) PS[i * 8 + w] = sq; __builtin_amdgcn_sched_barrier(0); }
            const float el = __expf(last);
#pragma unroll
            for (int mt = 0; mt < 8; ++mt)
#pragma unroll
                for (int nt = 0; nt < 2; ++nt) hacc[mt][nt] = hacc[mt][nt] * el;
#pragma unroll
            for (int ks = 0; ks < 2; ++ks) { const f32x4 g0 = *(const LAS f32x4*)(gm + 32 * ks + 8 * quad), g1 = *(const LAS f32x4*)(gm + 32 * ks + 8 * quad + 4);
                const float ed[8] = {__expf(last - g0.x), __expf(last - g0.y), __expf(last - g0.z), __expf(last - g0.w), __expf(last - g1.x), __expf(last - g1.y), __expf(last - g1.z), __expf(last - g1.w)};
                bf16x8 xw[2];
#pragma unroll
                for (int nt = 0; nt < 2; ++nt) { const v4u xv = __builtin_bit_cast(v4u, ldfrag(XT, 72, prow + 16 * nt, 32 * ks, lane));
                    v4u o; o.x = pk2(bflo(xv.x) * ed[0], bfhi(xv.x) * ed[1]); o.y = pk2(bflo(xv.y) * ed[2], bfhi(xv.y) * ed[3]); o.z = pk2(bflo(xv.z) * ed[4], bfhi(xv.z) * ed[5]); o.w = pk2(bflo(xv.w) * ed[6], bfhi(xv.w) * ed[7]);
                    xw[nt] = __builtin_bit_cast(bf16x8, o); }
#pragma unroll
                for (int mt = 0; mt < 8; ++mt) { const bf16x8 a = ldfrag(BT, 72, 16 * mt, 32 * ks, lane); hacc[mt][0] = MFMA16(a, xw[0], hacc[mt][0]); hacc[mt][1] = MFMA16(a, xw[1], hacc[mt][1]); }
                __builtin_amdgcn_sched_barrier(0); }
        }
        __syncthreads();
#pragma unroll
        for (int mt = 0; mt < 4; ++mt)
#pragma unroll
            for (int r = 0; r < 4; ++r) { const int i = 16 * mt + 4 * quad + r; const f32x4 p0 = *(const LAS f32x4*)(PS + i * 8), p1 = *(const LAS f32x4*)(PS + i * 8 + 4);
                const float rs = rsqrtf((((p0.x + p0.y) + (p0.z + p0.w)) + ((p1.x + p1.y) + (p1.z + p1.w))) * (1.f / 256.f) + EPS);
#pragma unroll
                for (int nt = 0; nt < 2; ++nt) { const int ch = head * 64 + 32 * ph + 16 * nt + l15; YS[(size_t)(r0 + i) * 2048 + ch] = (bf16)f2bf(y[mt][nt][r] * rs * F.A.in[20][ch]); } }
    }
    {
        float* so = F.out + (samp ? O_SS : O_SP) + (size_t)(bb * SH + head) * SN * SP;
#pragma unroll
        for (int mt = 0; mt < 8; ++mt)
#pragma unroll
            for (int nt = 0; nt < 2; ++nt)
#pragma unroll
                for (int r = 0; r < 4; ++r) so[(size_t)(16 * mt + 4 * quad + r) * SP + 32 * ph + 16 * nt + l15] = hacc[mt][nt][r];
    }
    __syncthreads();
}
constexpr int NCH = SLAB_T / 64;
constexpr int GI_WKN = 0, GI_QG = 17408, GI_KT = 34816, GI_QKM = 53248, GI_IMG = 62464, GI_WV = GI_IMG, GI_SC = GI_IMG + 32768, GI_STRIDE = GI_SC + 256;
constexpr int GDN_ITEMS_MAX = NCH * NB * GH + DB * GH;
constexpr size_t WS_GDN = WS_END;
constexpr size_t WS_END2 = WS_GDN + (size_t)GDN_ITEMS_MAX * GI_STRIDE;
static_assert(WS_END2 <= 500 * MiB, "workspace map fits");
constexpr int GP_QS = 0, GP_KS = 17408, GP_LS = 34816, GP_SC = 51200, GP_HALF = 52224;

__device__ __forceinline__ void gdn_pre_pair(Frame& F, int s, int pair) {
    const bf16* P = (const bf16*)(F.ws + WS_PROJ); const float* SM = (const float*)(F.ws + WS_SM);
    const int tid = F.tid, hb = tid >> 8, ht = tid & 255, wl = (tid >> 6) & 3;
    int lane = F.lane; asm volatile("" : "+v"(lane)); const int quad = lane >> 4, l15 = lane & 15;
    const int it = 2 * pair + hb;
    int bsel, h, r0, c; bool samp;
    if (it < NCH * NB * GH) { samp = false; const int bh = it / NCH; c = it % NCH; bsel = bh >> 3; h = bh & 7; r0 = bsel * SLAB_T + 64 * c; }
    else { samp = true; const int q = it - NCH * NB * GH; bsel = q >> 3; h = q & 7; c = 0; r0 = RP + bsel * DSEQ; }
    unsigned char* img = F.ws + WS_GDN + (size_t)it * GI_STRIDE;
    LAS unsigned char* hbase = F.lds + hb * GP_HALF;
    LAS bf16* QS = (LAS bf16*)(hbase + GP_QS); LAS bf16* KS = (LAS bf16*)(hbase + GP_KS); LAS float* LS = (LAS float*)(hbase + GP_LS);
    LAS float* NQ = (LAS float*)(hbase + GP_SC); LAS float* NK = NQ + 64; LAS float* GAMS = NK + 64; LAS float* BTS = GAMS + 64;
    if (ht < 64) { const size_t r = (size_t)(r0 + lane); const float beta = sigmoidf_(SM[r * 64 + h]); const float g = -__expf(F.A.in[14][h]) * softplusf_(SM[r * 64 + 8 + h] + F.A.in[15][h]);
        GAMS[lane] = wave_incl_scan(g, lane); BTS[lane] = beta; }
    float y[64];
    {
        const float* wcv = F.A.in[12]; const float* bcv = F.A.in[13];
#pragma unroll
        for (int pass = 0; pass < 2; ++pass) {
            if (pass == 0 && ht >= 128) continue;
            const int cidx = ht < 128 ? (pass == 0 ? h * 128 + ht : 1024 + h * 128 + ht) : 2048 + h * 128 + (ht - 128);
            const float w0 = wcv[cidx], w1 = wcv[CONV_CH + cidx], w2 = wcv[2 * CONV_CH + cidx], w3 = wcv[3 * CONV_CH + cidx], bias = bcv[cidx];
            float h0 = 0.f, h1 = 0.f, h2 = 0.f;
            if (c > 0) { const bf16* pp = P + (size_t)(r0 - 3) * NPROJ + cidx; h0 = bf2f(pp[0]); h1 = bf2f(pp[NPROJ]); h2 = bf2f(pp[2 * NPROJ]); }
            else if (samp) { const float* st = F.A.in[2] + (size_t)bsel * 3 * CONV_CH + cidx; h0 = st[0]; h1 = st[CONV_CH]; h2 = st[2 * CONV_CH]; }
            else if (s > 0) { const float* st = (const float*)(F.ws + WS_CARRY_MIX) + ((size_t)(s & 1) * NB + bsel) * 3 * CONV_CH + cidx; h0 = st[0]; h1 = st[CONV_CH]; h2 = st[2 * CONV_CH]; }
            const bf16* pc = P + (size_t)r0 * NPROJ + cidx;
            LAS bf16* dst = (pass == 0 ? QS : KS) + ht;
#pragma unroll
            for (int tb = 0; tb < 4; ++tb) { float raw[16];
#pragma unroll
                for (int t = 0; t < 16; ++t) raw[t] = bf2f(pc[(size_t)(16 * tb + t) * NPROJ]);
#pragma unroll
                for (int t = 0; t < 16; ++t) { float val = bias + w0 * h0 + w1 * h1 + w2 * h2 + w3 * raw[t]; h0 = h1; h1 = h2; h2 = raw[t]; val = siluf_(val);
                    if (ht < 128) dst[(16 * tb + t) * 136] = (bf16)f2bf(val);
                    if (pass == 1) y[16 * tb + t] = val; }
                asm volatile("" ::: "memory"); }
        }
    }
    __syncthreads();
    f32x4 kk[4], qk[4];
    {
        bf16x8 ak[4], aq[4];
#pragma unroll
        for (int ks = 0; ks < 4; ++ks) { ak[ks] = ldfrag(KS, 136, 16 * wl, 32 * ks, lane); aq[ks] = ldfrag(QS, 136, 16 * wl, 32 * ks, lane); }
        f32x4 qq = {0.f, 0.f, 0.f, 0.f};
#pragma unroll
        for (int ks = 0; ks < 4; ++ks) qq = MFMA16(aq[ks], aq[ks], qq);
#pragma unroll
        for (int nt = 0; nt < 4; ++nt) {
            if (nt <= wl) { f32x4 a0 = {0.f, 0.f, 0.f, 0.f}, a1 = {0.f, 0.f, 0.f, 0.f};
#pragma unroll
                for (int ks = 0; ks < 4; ++ks) { const bf16x8 bk = ldfrag(KS, 136, 16 * nt, 32 * ks, lane); a0 = MFMA16(ak[ks], bk, a0); a1 = MFMA16(aq[ks], bk, a1); }
                kk[nt] = a0; qk[nt] = a1; } else { kk[nt] = qq; qk[nt] = qq; } }
        float dk = 0.f, dq = 0.f;
#pragma unroll
        for (int nt = 0; nt < 4; ++nt) if (nt == wl) {
#pragma unroll
            for (int r = 0; r < 4; ++r) if (4 * quad + r == l15) { dk = kk[nt][r]; dq = qq[r]; } }
        if ((l15 >> 2) == quad) { NK[16 * wl + l15] = rsqrtf(dk + EPS); NQ[16 * wl + l15] = rsqrtf(dq + EPS) * 0.08838834764831845f; }
    }
    __syncthreads();
    {
        bf16* QKM = (bf16*)(img + GI_QKM);
#pragma unroll
        for (int nt = 0; nt < 4; ++nt) { const int j = 16 * nt + l15; const float nkj = NK[j], gj = GAMS[j];
#pragma unroll
            for (int r = 0; r < 4; ++r) { const int i = 16 * wl + 4 * quad + r; const float e = __expf(GAMS[i] - gj);
                LS[i * 64 + j] = i > j ? kk[nt][r] * NK[i] * nkj * e * BTS[i] : 0.f;
                QKM[i * 72 + j] = (bf16)f2bf(i >= j ? qk[nt][r] * NQ[i] * nkj * e : 0.f); } }
    }
    const float last = GAMS[63];
    if (ht < 128) {
        bf16* KT = (bf16*)(img + GI_KT) + ht * 72;
#pragma unroll
        for (int i8 = 0; i8 < 8; ++i8) { float t[8];
#pragma unroll
            for (int e = 0; e < 8; ++e) { const int j = 8 * i8 + e; const float kh = y[j] * NK[j]; t[e] = kh * __expf(last - GAMS[j]); y[j] = kh * BTS[j] * __expf(GAMS[j]); }
            v4u o; o.x = pk2(t[0], t[1]); o.y = pk2(t[2], t[3]); o.z = pk2(t[4], t[5]); o.w = pk2(t[6], t[7]); *(GAS v4u*)(KT + 8 * i8) = o; }
    } else {
#pragma unroll
        for (int j = 0; j < 64; ++j) y[j] *= BTS[j];
    }
    __syncthreads();
#pragma unroll
    for (int i = 1; i < 64; ++i) { float acc = y[i];
#pragma unroll
        for (int j4 = 0; j4 < (i + 3) / 4; ++j4) { const f32x4 l = *(const LAS f32x4*)(LS + i * 64 + 4 * j4);
            acc -= l.x * y[4 * j4]; if (4 * j4 + 1 < i) acc -= l.y * y[4 * j4 + 1]; if (4 * j4 + 2 < i) acc -= l.z * y[4 * j4 + 2]; if (4 * j4 + 3 < i) acc -= l.w * y[4 * j4 + 3]; }
        y[i] = acc; }
    if (ht < 128) { bf16* WKN = (bf16*)(img + GI_WKN) + ht;
#pragma unroll
        for (int i = 0; i < 64; ++i) WKN[i * 136] = (bf16)f2bf(-y[i]); }
    else { float* WV = (float*)(img + GI_WV) + (ht - 128);
#pragma unroll
        for (int i = 0; i < 64; ++i) WV[i * 128] = y[i]; }
    {
        bf16* QG = (bf16*)(img + GI_QG);
#pragma unroll
        for (int q = 0; q < 4; ++q) { const int idx = ht + 256 * q, i = idx >> 4, d8 = (idx & 15) * 8; const v4u x = *(const LAS v4u*)(QS + i * 136 + d8); const float sc = NQ[i] * __expf(GAMS[i]);
            v4u o; o.x = pk2(bflo(x.x) * sc, bfhi(x.x) * sc); o.y = pk2(bflo(x.y) * sc, bfhi(x.y) * sc); o.z = pk2(bflo(x.z) * sc, bfhi(x.z) * sc); o.w = pk2(bflo(x.w) * sc, bfhi(x.w) * sc);
            *(GAS v4u*)(QG + i * 136 + d8) = o; }
        if (ht == 0) *(float*)(img + GI_SC) = __expf(last);
    }
    __syncthreads();
}
__device__ __forceinline__ void phase_gdn_pre(Frame& F, int s) {
    const int npairs = (s == 0 ? GDN_ITEMS_MAX : NCH * NB * GH) / 2;
    for (int p = F.bid; p < npairs; p += F.G) gdn_pre_pair(F, s, p);
}

constexpr int GS_BUF = 0, GS_PSQ = 2 * GI_IMG, GS_ZS = GS_PSQ + 4096;
static_assert(GS_ZS + 8 * 2048 <= RING_BYTES, "GDN sequential LDS map fits");
__device__ __forceinline__ void gdn_seq_job(Frame& F, int s, bool samp, int bb, int h) {
    const bf16* P = (const bf16*)(F.ws + WS_PROJ); bf16* OG = (bf16*)(F.ws + WS_OG);
    const int w = F.wave;
    int lane = F.lane; asm volatile("" : "+v"(lane)); int quad = lane >> 4, l15 = lane & 15;
    const int nchunk = samp ? 1 : NCH, row0 = samp ? RP + bb * DSEQ : bb * SLAB_T;
    const int item0 = samp ? NCH * NB * GH + bb * GH + h : (bb * GH + h) * NCH;
    const unsigned char* img0 = F.ws + WS_GDN + (size_t)item0 * GI_STRIDE;
    LAS float* PSQ = (LAS float*)(F.lds + GS_PSQ); LAS bf16* ZS = (LAS bf16*)(F.lds + GS_ZS) + w * 1024;
    f32x4 Sacc[8];
    {
        const float* st = samp ? F.A.in[3] : F.out + O_GP; const size_t sb = (size_t)(bb * GH + h) * GDK * GDV;
#pragma unroll
        for (int mt = 0; mt < 8; ++mt)
#pragma unroll
            for (int r = 0; r < 4; ++r) Sacc[mt][r] = (samp || s > 0) ? st[sb + (size_t)(16 * mt + 4 * quad + r) * GDV + 16 * w + l15] : 0.f;
    }
    const float gn = F.A.in[16][16 * w + l15];
#define GDN_STAGE(imgp, bufi) do { for (int pc_ = w; pc_ < GI_IMG / 1024; pc_ += 8) \
        __builtin_amdgcn_global_load_lds((const unsigned*)((imgp) + pc_ * 1024 + lane * 16), (LAS unsigned*)(F.lds + GS_BUF + (bufi) * GI_IMG + pc_ * 1024), 16, 0, 0); } while (0)
    GDN_STAGE(img0, 0);
    f32x4 wv[4];
    { const float* WV = (const float*)(img0 + GI_WV);
#pragma unroll
      for (int mt = 0; mt < 4; ++mt)
#pragma unroll
          for (int r = 0; r < 4; ++r) wv[mt][r] = WV[(16 * mt + 4 * quad + r) * 128 + 16 * w + l15]; }
    v4u zr0, zr1;
    { const GAS v4u* zp = (const GAS v4u*)(P + (size_t)(row0 + lane) * NPROJ + 7168 + h * 128 + 16 * w); zr0 = zp[0]; zr1 = zp[1]; }
    f32x4 Oprev[4];
#pragma unroll
    for (int mt = 0; mt < 4; ++mt) Oprev[mt] = wv[mt];
#define GDN_FINISH(cc) do { const LAS float* ps = PSQ + ((cc) & 1) * 512; const int rb = row0 + 64 * (cc); \
        _Pragma("unroll") for (int mt = 0; mt < 4; ++mt) _Pragma("unroll") for (int r = 0; r < 4; ++r) { const int i = 16 * mt + 4 * quad + r; \
            const f32x4 p0 = *(const LAS f32x4*)(ps + i * 8), p1 = *(const LAS f32x4*)(ps + i * 8 + 4); \
            const float rs = rsqrtf((((p0.x + p0.y) + (p0.z + p0.w)) + ((p1.x + p1.y) + (p1.z + p1.w))) * (1.f / GDV) + EPS); const float z = bf2f(ZS[i * 16 + l15]); \
            OG[(size_t)(rb + i) * D + h * 128 + 16 * w + l15] = (bf16)f2bf(Oprev[mt][r] * rs * gn * siluf_(z)); } } while (0)
    for (int c = 0; c < nchunk; ++c) {
        asm volatile("" : "+v"(lane)); quad = lane >> 4; l15 = lane & 15;
        asm volatile("s_waitcnt vmcnt(0)" ::: "memory");
        __syncthreads();
        const unsigned char* img = img0 + (size_t)c * GI_STRIDE;
        f32x4 wvn[4];
        const float el = *(const float*)(img + GI_SC);
        if (c + 1 < nchunk) { GDN_STAGE(img + GI_STRIDE, (c + 1) & 1);
            const float* WV = (const float*)(img + GI_STRIDE + GI_WV);
#pragma unroll
            for (int mt = 0; mt < 4; ++mt)
#pragma unroll
                for (int r = 0; r < 4; ++r) wvn[mt][r] = WV[(16 * mt + 4 * quad + r) * 128 + 16 * w + l15]; }
        else {
#pragma unroll
            for (int mt = 0; mt < 4; ++mt) wvn[mt] = wv[mt]; }
        if (c > 0) GDN_FINISH(c - 1);
        *(LAS v4u*)(ZS + lane * 16) = zr0; *(LAS v4u*)(ZS + lane * 16 + 8) = zr1;
        if (c + 1 < nchunk) { const GAS v4u* zp = (const GAS v4u*)(P + (size_t)(row0 + 64 * (c + 1) + lane) * NPROJ + 7168 + h * 128 + 16 * w); zr0 = zp[0]; zr1 = zp[1]; }
        const LAS unsigned char* buf = F.lds + GS_BUF + (c & 1) * GI_IMG;
        const LAS bf16* WKN = (const LAS bf16*)(buf + GI_WKN); const LAS bf16* QG = (const LAS bf16*)(buf + GI_QG); const LAS bf16* KT = (const LAS bf16*)(buf + GI_KT); const LAS bf16* QKM = (const LAS bf16*)(buf + GI_QKM);
        f32x4 U[4], O[4];
#pragma unroll
        for (int mt = 0; mt < 4; ++mt) { U[mt] = wv[mt]; O[mt] = (f32x4){0.f, 0.f, 0.f, 0.f}; }
#pragma unroll
        for (int ks = 0; ks < 4; ++ks) { const bf16x8 Sb = acc2frag(Sacc[2 * ks], Sacc[2 * ks + 1]);
#pragma unroll
            for (int mt = 0; mt < 4; ++mt) { U[mt] = MFMA16(ldfrag_perm(WKN, 136, 16 * mt, 32 * ks, lane), Sb, U[mt]); O[mt] = MFMA16(ldfrag_perm(QG, 136, 16 * mt, 32 * ks, lane), Sb, O[mt]); } }
        bf16x8 Ub[2];
#pragma unroll
        for (int ks = 0; ks < 2; ++ks) Ub[ks] = acc2frag(U[2 * ks], U[2 * ks + 1]);
#pragma unroll
        for (int ks = 0; ks < 2; ++ks)
#pragma unroll
            for (int mt = 0; mt < 4; ++mt) O[mt] = MFMA16(ldfrag_perm(QKM, 72, 16 * mt, 32 * ks, lane), Ub[ks], O[mt]);
#pragma unroll
        for (int mt = 0; mt < 8; ++mt) { Sacc[mt] = Sacc[mt] * el;
#pragma unroll
            for (int ks = 0; ks < 2; ++ks) Sacc[mt] = MFMA16(ldfrag_perm(KT, 72, 16 * mt, 32 * ks, lane), Ub[ks], Sacc[mt]); }
        { LAS float* ps = PSQ + (c & 1) * 512;
#pragma unroll
          for (int mt = 0; mt < 4; ++mt)
#pragma unroll
              for (int r = 0; r < 4; ++r) { const float sq = row16_sum(O[mt][r] * O[mt][r]); if (l15 == 0) ps[(16 * mt + 4 * quad + r) * 8 + w] = sq; Oprev[mt][r] = O[mt][r]; } }
#pragma unroll
        for (int mt = 0; mt < 4; ++mt) wv[mt] = wvn[mt];
    }
    __syncthreads();
    GDN_FINISH(nchunk - 1);
#undef GDN_FINISH
#undef GDN_STAGE
    {
        float* so = F.out + (samp ? O_GS : O_GP) + (size_t)(bb * GH + h) * GDK * GDV;
#pragma unroll
        for (int mt = 0; mt < 8; ++mt)
#pragma unroll
            for (int r = 0; r < 4; ++r) so[(size_t)(16 * mt + 4 * quad + r) * GDV + 16 * w + l15] = Sacc[mt][r];
    }
    __syncthreads();
}
__device__ __forceinline__ void gdn_naive_job(Frame& F, int s, bool samp, int bb, int h) {
    const bf16* P = (const bf16*)(F.ws + WS_PROJ); const float* SM = (const float*)(F.ws + WS_SM); bf16* OG = (bf16*)(F.ws + WS_OG);
    LAS float* qs = (LAS float*)F.lds; LAS float* ks = qs + 128; LAS float* vs = ks + 128; LAS float* part = vs + 128;
    LAS float* red = part + 8; LAS float* red2 = red + 512; LAS float* part2 = red2 + 512;
    const int tid = F.tid, v = tid & 127, kq = tid >> 7, ntok = samp ? DSEQ : SLAB_T, row0 = samp ? RP + bb * DSEQ : bb * SLAB_T;
    float S[32];
    const size_t sbase = ((size_t)(bb * GH + h) * GDK + kq * 32) * GDV + v;
    if (samp) { const float* st = F.A.in[3] + sbase;
#pragma unroll
        for (int i = 0; i < 32; ++i) S[i] = st[(size_t)i * GDV]; }
    else if (s == 0) {
#pragma unroll
        for (int i = 0; i < 32; ++i) S[i] = 0.f; }
    else { const float* st = F.out + O_GP + sbase;
#pragma unroll
        for (int i = 0; i < 32; ++i) S[i] = st[(size_t)i * GDV]; }
    const int role = tid >> 7, ch = tid & 127, cidx = role * 1024 + h * 128 + ch;
    float h0 = 0.f, h1 = 0.f, h2 = 0.f, w0 = 0.f, w1 = 0.f, w2 = 0.f, w3 = 0.f, bias = 0.f;
    if (tid < 384) {
        const float* wcv = F.A.in[12]; w0 = wcv[cidx]; w1 = wcv[CONV_CH + cidx]; w2 = wcv[2 * CONV_CH + cidx]; w3 = wcv[3 * CONV_CH + cidx]; bias = F.A.in[13][cidx];
        if (samp) { const float* st = F.A.in[2] + (size_t)bb * 3 * CONV_CH + cidx; h0 = st[0]; h1 = st[CONV_CH]; h2 = st[2 * CONV_CH]; }
        else if (s > 0) { const float* st = (const float*)(F.ws + WS_CARRY_MIX) + ((size_t)(s & 1) * NB + bb) * 3 * CONV_CH + cidx; h0 = st[0]; h1 = st[CONV_CH]; h2 = st[2 * CONV_CH]; }
    }
    const float Aexp = __expf(F.A.in[14][h]), dtb = F.A.in[15][h], gnorm = F.A.in[16][v];
    for (int t = 0; t < ntok; ++t) {
        const size_t r = (size_t)(row0 + t);
        if (tid < 384) {
            const float raw = bf2f(P[r * NPROJ + cidx]);
            float val = bias + w0 * h0 + w1 * h1 + w2 * h2 + w3 * raw; h0 = h1; h1 = h2; h2 = raw; val = siluf_(val);
            qs[role * 128 + ch] = val;
            if (role < 2) { const float sq = wave_sum(val * val); if (F.lane == 0) part[F.wave] = sq; }
        }
        __syncthreads();
        const float qsc = rsqrtf(part[0] + part[1] + EPS) * 0.08838834764831845f, ksc = rsqrtf(part[2] + part[3] + EPS);
        const float beta = sigmoidf_(SM[r * 64 + h]); const float g = -Aexp * softplusf_(SM[r * 64 + 8 + h] + dtb); const float a = __expf(g);
        float kn[32]; float p = 0.f;
#pragma unroll
        for (int i = 0; i < 32; ++i) { kn[i] = ks[kq * 32 + i] * ksc; p += kn[i] * S[i]; }
        red[kq * 128 + v] = p;
        __syncthreads();
        const float kS = (red[v] + red[128 + v]) + (red[256 + v] + red[384 + v]);
        const float d = beta * (vs[v] - a * kS);
        float po = 0.f;
#pragma unroll
        for (int i = 0; i < 32; ++i) { S[i] = a * S[i] + kn[i] * d; po += qs[kq * 32 + i] * qsc * S[i]; }
        red2[kq * 128 + v] = po;
        __syncthreads();
        float o = 0.f;
        if (tid < 128) { o = (red2[v] + red2[128 + v]) + (red2[256 + v] + red2[384 + v]); const float sq = wave_sum(o * o); if (F.lane == 0) part2[F.wave] = sq; }
        __syncthreads();
        if (tid < 128) { const float rs = rsqrtf((part2[0] + part2[1]) * (1.f / GDV) + EPS); const float z = bf2f(P[r * NPROJ + 7168 + h * 128 + v]);
            OG[r * D + h * 128 + v] = (bf16)f2bf(o * rs * gnorm * siluf_(z)); }
    }
    float* so = F.out + (samp ? O_GS : O_GP) + sbase;
#pragma unroll
    for (int i = 0; i < 32; ++i) so[(size_t)i * GDV] = S[i];
    __syncthreads();
}
__device__ __forceinline__ void ssd_naive_job(Frame& F, int s, bool samp, int bb, int g) {
    const bf16* P = (const bf16*)(F.ws + WS_PROJ); const float* SM = (const float*)(F.ws + WS_SM); bf16* YS = (bf16*)(F.ws + WS_YS);
    LAS float* xs = (LAS float*)F.lds; LAS float* Bs = xs + 256; LAS float* Cs = Bs + 128; LAS float* red = Cs + 128; LAS float* part = red + 512;
    const int tid = F.tid, hl = tid >> 7, p = tid & 63, nh = (tid >> 6) & 1, head = 4 * g + hl, ntok = samp ? DSEQ : SLAB_T, row0 = samp ? RP + bb * DSEQ : bb * SLAB_T;
    float hr[64];
    const size_t sbase = ((size_t)(bb * SH + head) * SN + nh * 64) * SP + p;
    if (samp) { const float* st = F.A.in[4] + sbase;
#pragma unroll
        for (int i = 0; i < 64; ++i) hr[i] = st[(size_t)i * SP]; }
    else if (s == 0) {
#pragma unroll
        for (int i = 0; i < 64; ++i) hr[i] = 0.f; }
    else { const float* st = F.out + O_SP + sbase;
#pragma unroll
        for (int i = 0; i < 64; ++i) hr[i] = st[(size_t)i * SP]; }
    const int cidx = tid < 256 ? 3072 + g * 256 + tid : (tid < 384 ? 5120 + g * 128 + (tid - 256) : 6144 + g * 128 + (tid - 384));
    const float* wcv = F.A.in[12]; const float w0 = wcv[cidx], w1 = wcv[CONV_CH + cidx], w2 = wcv[2 * CONV_CH + cidx], w3 = wcv[3 * CONV_CH + cidx], bias = F.A.in[13][cidx];
    float h0 = 0.f, h1 = 0.f, h2 = 0.f;
    if (samp) { const float* st = F.A.in[2] + (size_t)bb * 3 * CONV_CH + cidx; h0 = st[0]; h1 = st[CONV_CH]; h2 = st[2 * CONV_CH]; }
    else if (s > 0) { const float* st = (const float*)(F.ws + WS_CARRY_MIX) + ((size_t)(s & 1) * NB + bb) * 3 * CONV_CH + cidx; h0 = st[0]; h1 = st[CONV_CH]; h2 = st[2 * CONV_CH]; }
    const float aneg = -__expf(F.A.in[17][head]), dtb = F.A.in[18][head], Dh = F.A.in[19][head], nw = F.A.in[20][head * 64 + p];
    for (int t = 0; t < ntok; ++t) {
        const size_t r = (size_t)(row0 + t);
        { const float raw = bf2f(P[r * NPROJ + cidx]); float val = bias + w0 * h0 + w1 * h1 + w2 * h2 + w3 * raw; h0 = h1; h1 = h2; h2 = raw; xs[tid] = siluf_(val); }
        __syncthreads();
        const float dt = softplusf_(SM[r * 64 + 16 + head] + dtb), dA = __expf(dt * aneg), x = xs[hl * 64 + p], dx = dt * x;
        float py = 0.f;
#pragma unroll
        for (int i = 0; i < 64; ++i) { hr[i] = dA * hr[i] + dx * Bs[nh * 64 + i]; py += Cs[nh * 64 + i] * hr[i]; }
        red[tid] = py;
        __syncthreads();
        float yz = 0.f;
        if (nh == 0) { const float y = red[tid] + red[tid + 64] + Dh * x; const float z = bf2f(P[r * NPROJ + 8192 + head * 64 + p]); yz = y * siluf_(z);
            const float sq = wave_sum(yz * yz); if (F.lane == 0) part[F.wave] = sq; }
        __syncthreads();
        if (nh == 0) { const float rs = rsqrtf(((part[0] + part[2]) + (part[4] + part[6])) * (1.f / 256.f) + EPS); YS[r * 2048 + head * 64 + p] = (bf16)f2bf(yz * rs * nw); }
    }
    float* so = F.out + (samp ? O_SS : O_SP) + sbase;
#pragma unroll
    for (int i = 0; i < 64; ++i) so[(size_t)i * SP] = hr[i];
    __syncthreads();
}
__device__ __forceinline__ void phase_scan(Frame& F, int s) {
    const int njobs = s == 0 ? 192 : 64;
    for (int j = F.bid; j < njobs; j += F.G) {
        if (j < 32) {
#ifdef GDN_NAIVE
            gdn_naive_job(F, s, false, j >> 3, j & 7);
#else
            gdn_seq_job(F, s, false, j >> 3, j & 7);
#endif
        } else if (j < 64) {
#ifndef EXP_NO_SSD
            ssd_fast_job(F, s, false, (j - 32) >> 3, (j - 32) & 7);
#endif
        }
        else if (j < 128) {
#ifdef GDN_NAIVE
            gdn_naive_job(F, s, true, (j - 64) >> 3, (j - 64) & 7);
#else
            gdn_seq_job(F, s, true, (j - 64) >> 3, (j - 64) & 7);
#endif
        } else {
#ifndef EXP_NO_SSD
            ssd_fast_job(F, s, true, (j - 128) >> 3, (j - 128) & 7);
#endif
        }
    }
}
#define XB_TMO      128
#define XB_XCNT(j)  (256  + 64 * (j))
#define XB_XSUB(j)  (1280 + 64 * (j))
#define XB_XGEN(j)  (2304 + 64 * (j))
#define XB_TOP      3328
#define XB_TOPGEN   3392
#define XCD_BAR_WORDS 3456
#define XB_SPIN_CAP (1u << 18)
__device__ __forceinline__ unsigned xb_ld(unsigned* p)              { return __hip_atomic_load(p, __ATOMIC_RELAXED, __HIP_MEMORY_SCOPE_AGENT); }
__device__ __forceinline__ unsigned xb_add(unsigned* p, unsigned v) { return __hip_atomic_fetch_add(p, v, __ATOMIC_RELAXED, __HIP_MEMORY_SCOPE_AGENT); }
__device__ __forceinline__ unsigned xb_xcc_id() { return (unsigned)__builtin_amdgcn_s_getreg((3 << 11) | 20) & 0xFu; }
#define XB_SPIN(cond, bar) do { unsigned _sp = 0; while (cond) { __builtin_amdgcn_s_sleep(1); \
    if ((++_sp & 255u) == 0u) { if (xb_ld(&(bar)[XB_TMO])) break; if (_sp > XB_SPIN_CAP) { atomicAdd(&(bar)[XB_TMO], 1u); break; } } } } while (0)
struct XcdBarrier { unsigned* bar; unsigned x; volatile LAS unsigned* st; };
__device__ __forceinline__ XcdBarrier xcd_barrier_post(unsigned* bar, volatile LAS unsigned* st) {
    XcdBarrier b; b.bar = bar; b.x = xb_xcc_id(); b.st = st;
    if (threadIdx.x == 0) (void)xb_add(&bar[XB_XCNT(b.x)], 1u);
    return b;
}
__device__ __forceinline__ void xcd_barrier_complete(unsigned* bar, unsigned x, unsigned& nloc, unsigned& nx) {
    const unsigned G = gridDim.x * gridDim.y * gridDim.z;
    unsigned sum, cnt, mine, sp = 0u;
    for (;;) {
        sum = 0u; cnt = 0u; mine = 0u;
#pragma unroll
        for (unsigned j = 0; j < 16; ++j) { const unsigned c = xb_ld(&bar[XB_XCNT(j)]); sum += c; cnt += (c > 0u) ? 1u : 0u; mine = (j == x) ? c : mine; }
        if (sum == G) break;
        __builtin_amdgcn_s_sleep(1);
        if ((++sp & 255u) == 0u) { if (xb_ld(&bar[XB_TMO])) break; if (sp > XB_SPIN_CAP) { atomicAdd(&bar[XB_TMO], 1u); break; } }
    }
    nloc = mine > 0u ? mine : 1u; nx = cnt > 0u ? cnt : 1u;
}
__device__ __forceinline__ void xcd_barrier(const XcdBarrier& b) {
    asm volatile("s_waitcnt vmcnt(0)" ::: "memory");
    __syncthreads();
    if (threadIdx.x == 0) {
        unsigned* bar = b.bar;
        __builtin_amdgcn_s_waitcnt(0);
        unsigned nloc = b.st[0], nx = b.st[1];
        if (nloc == 0u) { xcd_barrier_complete(bar, b.x, nloc, nx); b.st[0] = nloc; b.st[1] = nx; }
        const unsigned old = xb_add(&bar[XB_XSUB(b.x)], 1u);
        const unsigned gen = old / nloc;
        if (old + 1u == (gen + 1u) * nloc) {
            __builtin_amdgcn_fence(__ATOMIC_RELEASE, "agent");
            asm volatile("s_waitcnt vmcnt(0)" ::: "memory");
            const unsigned og = xb_add(&bar[XB_TOP], 1u);
            const unsigned tg = og / nx;
            if (og + 1u == (tg + 1u) * nx) xb_add(&bar[XB_TOPGEN], 1u);
            else XB_SPIN(xb_ld(&bar[XB_TOPGEN]) == tg, bar);
            __builtin_amdgcn_fence(__ATOMIC_ACQUIRE, "agent");
            xb_add(&bar[XB_XGEN(b.x)], 1u);
            asm volatile("s_waitcnt vmcnt(0)" ::: "memory");
        } else {
            XB_SPIN(xb_ld(&bar[XB_XGEN(b.x)]) == gen, bar);
            __builtin_amdgcn_fence(__ATOMIC_ACQUIRE, "agent");
            asm volatile("s_waitcnt vmcnt(0)" ::: "memory");
        }
    }
    __syncthreads();
}
constexpr int CW_BAR = 4096;
#ifndef PHASE_MASK
#define PHASE_MASK 0xFFF
#endif
#define PM(k) ((PHASE_MASK >> (k)) & 1)
constexpr int STEPS_PER_SLAB = 11, NSTEPS = 2 + STEPS_PER_SLAB * NSLAB;
#define GEMM_PHASE(EPI_T, AOFF, BOFF, N_, K_, ...) do { pg8::Gemm g{(const pg8::bf16_t*)(F.ws + (AOFF)), (const pg8::bf16_t*)(F.ws + (BOFF)), R, (N_), (K_)}; \
    pg8::StaticOrder S; S.init(R, (N_), F.G, F.bid); epi::EPI_T E{__VA_ARGS__}; pg8::gemm_phase<epi::EPI_T, pg8::StaticOrder, true, true>(F.lds, g, S, E, F.tid); } while (0)
__device__ __forceinline__ void run_step(Frame& F, int st) {
    if (st == 0) { if constexpr (PM(10)) phase_prologue0(F); return; }
    if (st == 1) { if constexpr (PM(11)) phase_prologue1(F); return; }
    const int s = (st - 2) / STEPS_PER_SLAB, k = (st - 2) % STEPS_PER_SLAB, R = slab_rows(s);
    unsigned char* ws = F.ws;
    switch (k) {
    case 0: if constexpr (PM(0)) phase_norm1(F, s); break;
    case 1: if constexpr (PM(1)) GEMM_PHASE(EpiProj, WS_HB, WS_WIN, NIN, D, (bf16*)(ws + WS_PROJ), (float*)(ws + WS_SM)); break;
    case 2: if constexpr (PM(2)) {
#if !defined(GDN_NAIVE) && !defined(EXP_NO_PRE)
        phase_gdn_pre(F, s);
#endif
        } break;
    case 3: if constexpr (PM(2)) {
#ifndef EXP_NO_SCAN
        phase_scan(F, s);
#endif
        phase_mix_carry(F, s); } break;
    case 4: if constexpr (PM(3)) GEMM_PHASE(EpiGate1, WS_OG, WS_WG, D, D, (const bf16*)(ws + WS_PROJ), (float*)(ws + WS_T1)); break;
    case 5: if constexpr (PM(4)) GEMM_PHASE(EpiGate2, WS_YS, WS_WS, D, 2048, (const bf16*)(ws + WS_PROJ), (const float*)(ws + WS_T1), (bf16*)(ws + WS_MIX)); break;
    case 6: if constexpr (PM(5)) GEMM_PHASE(EpiOut, WS_MIX, WS_WOUT, D, D, F.A.in[0], F.A.in[1], (const float*)(ws + WS_MODV), (const float*)(ws + WS_G2), (float*)(ws + WS_X1), (bf16*)(ws + WS_X1G), (float*)(ws + WS_SS1), s); break;
    case 7: if constexpr (PM(6)) GEMM_PHASE(EpiUp, WS_X1G, WS_WUP, NUP, D, (const float*)(ws + WS_SS1), (const float*)(ws + WS_SHW), (bf16*)(ws + WS_U)); break;
    case 8: if constexpr (PM(7)) phase_convact(F, s); break;
    case 9: if constexpr (PM(8)) GEMM_PHASE(EpiDown, WS_ACT, WS_WDN, D, DFF, (const float*)(ws + WS_X1), (const float*)(ws + WS_MODV), F.out + O_YP, F.out + O_YS, (float*)(ws + WS_SS2), s); break;
    default: if constexpr (PM(9)) phase_final(F, s); break;
    }
}
__global__ void __launch_bounds__(NTHR, 2) mk_fwd(Args a) {
    extern __shared__ __attribute__((aligned(16))) unsigned char lds[];
    Frame F(a);
    F.lds = (LAS unsigned char*)lds; F.MISC = (volatile LAS unsigned*)(F.lds + MISC_OFF);
    F.tid = threadIdx.x; F.lane = F.tid & 63; F.wave = __builtin_amdgcn_readfirstlane(F.tid >> 6); F.G = gridDim.x; F.bid = blockIdx.x;
    F.out = a.out; F.ws = a.ws; F.ctl = (gu32*)(a.ws + WS_CTL);
    for (int u = F.tid; u < (LDS_BYTES - LDSCTL_OFF) / 4; u += NTHR) ((LAS unsigned*)(F.lds + LDSCTL_OFF))[u] = 0u;
    __syncthreads();
    XcdBarrier bar; bar.bar = (unsigned*)(F.ctl + CW_BAR); bar.x = 0; bar.st = nullptr;
    const bool multi = (a.ph_hi - a.ph_lo) > 1;
    if (multi) bar = xcd_barrier_post((unsigned*)(F.ctl + CW_BAR), F.MISC + 8);
    for (int st = a.ph_lo; st < a.ph_hi; ++st) {
        { int t_ = threadIdx.x, b_ = blockIdx.x; unsigned char* w_ = a.ws; float* o_ = a.out; asm volatile("" : "+v"(t_), "+s"(b_), "+s"(w_), "+s"(o_));
          F.tid = t_; F.lane = t_ & 63; F.wave = __builtin_amdgcn_readfirstlane(t_ >> 6); F.bid = b_; F.ws = w_; F.out = o_; }
        run_step(F, st);
        if (st + 1 < a.ph_hi) { if (st == a.ph_lo) cooperative_groups::this_grid().sync(); else xcd_barrier(bar); }
    }
}
#ifndef MK_SINGLE
#define MK_SINGLE 1
#endif
extern "C" void kernel_launch(void* const* d_in, const int* in_sizes, int n_in, void* d_out, int out_size, void* d_ws, size_t ws_size, hipStream_t stream) {
    static int grid = 0;
    if (grid == 0) {
        if (n_in != 30 || (size_t)out_size != O_END || ws_size < WS_END2) { fprintf(stderr, "kernel_launch: unexpected shapes: n_in %d out %d ws %zu (need %zu)\n", n_in, out_size, ws_size, (size_t)WS_END2); grid = -1; return; }
        int dev = 0, cus = 0;
        if (hipGetDevice(&dev) != hipSuccess || hipDeviceGetAttribute(&cus, hipDeviceAttributeMultiprocessorCount, dev) != hipSuccess) { grid = -1; return; }
        if (hipFuncSetAttribute((const void*)mk_fwd, hipFuncAttributeMaxDynamicSharedMemorySize, LDS_BYTES) != hipSuccess) { fprintf(stderr, "kernel_launch: hipFuncSetAttribute failed\n"); grid = -1; return; }
        int per_cu = 0;
        if (hipOccupancyMaxActiveBlocksPerMultiprocessor(&per_cu, (const void*)mk_fwd, NTHR, LDS_BYTES) != hipSuccess || per_cu < 1) fprintf(stderr, "kernel_launch: occupancy query says %d\n", per_cu);
        (void)hipGetLastError();
        grid = cus * (per_cu < 1 ? 1 : per_cu);
    }
    if (grid < 0) return;
    (void)hipMemsetAsync((char*)d_ws + WS_CTL, 0, CTL_ZERO_BYTES, stream);
    Args a{};
    for (int i = 0; i < 30; ++i) a.in[i] = (const float*)d_in[i];
    a.out = (float*)d_out; a.ws = (unsigned char*)d_ws;
#if MK_SINGLE
    a.ph_lo = 0; a.ph_hi = NSTEPS;
    void* kargs[] = {(void*)&a};
    hipError_t le = hipLaunchCooperativeKernel((const void*)mk_fwd, dim3(grid), dim3(NTHR), kargs, LDS_BYTES, stream);
    if (le != hipSuccess) fprintf(stderr, "kernel_launch: cooperative launch failed: %s (grid %d)\n", hipGetErrorString(le), grid);
#else
    for (int st = 0; st < NSTEPS; ++st) { a.ph_lo = st; a.ph_hi = st + 1; hipLaunchKernelGGL(mk_fwd, dim3(grid), dim3(NTHR), LDS_BYTES, stream, a); }
#endif
}
```

```cpp
#include <hip/hip_runtime.h>
#include <hip/hip_cooperative_groups.h>
#include <cstdio>
#include <cstdint>

namespace pg8 {
#define PG8_LAS __attribute__((address_space(3)))
typedef unsigned short bf16_t;
typedef short bf16x8 __attribute__((ext_vector_type(8)));
typedef float f32x4 __attribute__((ext_vector_type(4)));
typedef unsigned u32x4 __attribute__((ext_vector_type(4)));
typedef unsigned u32x2 __attribute__((ext_vector_type(2)));
constexpr int BM = 256, BK = 64, HALF = 128, HTB = HALF * BK * 2, STAGE_BYTES = 8 * HTB, NXCD = 8, WGM = 8;

__host__ __device__ __forceinline__ int lds_byte(int r, int c) { const int st = (r >> 4) * 2 + (c >> 5), rr = r & 15, cc = c & 31, ob = rr * 64 + cc * 2; return st * 1024 + (ob ^ (((ob >> 9) & 1) << 5)); }
__host__ __device__ __forceinline__ void stage_rc(int b, int& R, int& C) { const int st = b / 1024, sb = b % 1024, swz = sb ^ (((sb >> 9) & 1) << 5); R = (st >> 1) * 16 + swz / 64; C = (st & 1) * 32 + (swz % 64) / 2; }
__host__ __device__ __forceinline__ int perm32(int rho) { const int n = rho >> 4, i = rho & 15; return 8 * (i >> 2) + 4 * n + (i & 3); }

struct Unit { int pm, pn; };
struct Gemm { const bf16_t* A; const bf16_t* Bt; int M, N, K; };

struct StaticOrder {
    int nM, nN, nwg, G, c;
    __host__ __device__ void init(int M, int N, int G_, int c_) { nM = M / BM; nN = N / BM; nwg = nM * nN; G = G_; c = c_; }
    __host__ __device__ bool next(int i, Unit& u) const {
        const long L = (long)i * G + c; if (L >= nwg) return false;
        int wgid = (int)L; { const int q = nwg / NXCD, r = nwg % NXCD, xcd = wgid % NXCD, off = wgid / NXCD; wgid = (xcd < r ? xcd * (q + 1) : r * (q + 1) + (xcd - r) * q) + off; }
        const int nig = WGM * nN, gid = wgid / nig, fm = gid * WGM, gsz = (nM - fm) < WGM ? (nM - fm) : WGM;
        u.pm = fm + ((wgid % nig) % gsz); u.pn = (wgid % nig) / gsz; return true;
    }
    __device__ __forceinline__ void a_ready(const Unit&) const {}
    __device__ __forceinline__ void done(const Unit&) const {}
};

__device__ __forceinline__ unsigned cvt_pk_bf16(float lo, float hi) { unsigned r; asm volatile("v_cvt_pk_bf16_f32 %0, %1, %2" : "=v"(r) : "v"(lo), "v"(hi)); return r; }

template <class Epi, class Sched, bool ALIGN_EPI = false, bool SP2 = false>
__device__ __forceinline__ void gemm_phase(PG8_LAS unsigned char* lds, const Gemm g, const Sched& S, const Epi& E, const int tid) {
    const int wid = __builtin_amdgcn_readfirstlane(tid >> 6), lane = tid & 63, wr = wid >> 2, wc = wid & 3, fr = lane & 15, fq = lane >> 4;
    const int K = g.K, nt = K / BK;
    unsigned voffA[2], voffB[2];
#pragma unroll
    for (int i = 0; i < 2; ++i) { int R, C; stage_rc(tid * 16 + i * 8192, R, C); const int Rb = Epi::PERM ? ((R & ~31) + perm32(R & 31)) : R;
        voffA[i] = (unsigned)(R * K + C) * 2u; voffB[i] = (unsigned)(Rb * K + C) * 2u; }
    const size_t kstep = (size_t)(BK * 2);
    const size_t hstep = (size_t)HALF * K * 2;
    const size_t tstep = 2 * hstep;
    const unsigned ldsw = (unsigned)wid * 1024u;
    const int aoff = lds_byte(wr * 64 + fr, fq * 8), boff = lds_byte(wc * 32 + fr, fq * 8);
#define PG8_SA(b, h) (((b) * 2 + (h)) * HTB)
#define PG8_SB(b, h) ((4 + (b) * 2 + (h)) * HTB)
#define PG8_STAGE(bufoff, gbase, voff) do { _Pragma("unroll") for (int _i = 0; _i < 2; ++_i) \
        __builtin_amdgcn_global_load_lds((const unsigned*)((const char*)(gbase) + (voff)[_i]), (PG8_LAS unsigned*)(lds + (bufoff) + ldsw + _i * 8192), 16, 0, 0); } while (0)
#define PG8_LDA(dst, b, h) do { _Pragma("unroll") for (int m = 0; m < 4; ++m) _Pragma("unroll") for (int k = 0; k < 2; ++k) dst[m][k] = *(const PG8_LAS bf16x8*)(lds + PG8_SA(b, h) + aoff + m * 2048 + k * 1024); } while (0)
#define PG8_LDB(dst, b, h) do { _Pragma("unroll") for (int n = 0; n < 2; ++n) _Pragma("unroll") for (int k = 0; k < 2; ++k) dst[n][k] = *(const PG8_LAS bf16x8*)(lds + PG8_SB(b, h) + boff + n * 2048 + k * 1024); } while (0)
#define PG8_MMA(ai, bj, At, Bt) do { __builtin_amdgcn_s_setprio(1); _Pragma("unroll") for (int m = 0; m < 4; ++m) _Pragma("unroll") for (int n = 0; n < 2; ++n) _Pragma("unroll") for (int k = 0; k < 2; ++k) \
        acc[ai][bj][m][n] = __builtin_amdgcn_mfma_f32_16x16x32_bf16(Bt[n][k], At[m][k], acc[ai][bj][m][n], 0, 0, 0); __builtin_amdgcn_s_setprio(0); } while (0)
#define PG8_WAIT_V(n) asm volatile("s_waitcnt vmcnt(" #n ")" ::: "memory")
#define PG8_WAIT_L(n) asm volatile("s_waitcnt lgkmcnt(" #n ")" ::: "memory")
#define PG8_BAR __builtin_amdgcn_s_barrier()
#define PG8_SCHED __builtin_amdgcn_sched_barrier(0)
    Unit cur, nxt; int ui = 0;
    if (!S.next(0, cur)) return;
    f32x4 acc[2][2][4][2];
#pragma unroll
    for (int a = 0; a < 2; ++a)
#pragma unroll
        for (int b = 0; b < 2; ++b)
#pragma unroll
            for (int m = 0; m < 4; ++m)
#pragma unroll
                for (int n = 0; n < 2; ++n) acc[a][b][m][n] = (f32x4){0.f, 0.f, 0.f, 0.f};
    bf16x8 At[4][2], B0[2][2], B1[2][2];
    const char* cA = (const char*)g.A + (size_t)cur.pm * tstep; const char* cB = (const char*)g.Bt + (size_t)cur.pn * tstep;
    S.a_ready(cur);
    if constexpr (SP2) {
        PG8_STAGE(PG8_SB(0, 0), cB, voffB); PG8_STAGE(PG8_SB(0, 1), cB + hstep, voffB); PG8_STAGE(PG8_SA(0, 0), cA, voffA); PG8_STAGE(PG8_SA(0, 1), cA + hstep, voffA);
        if (wr == 1) PG8_BAR;
        PG8_WAIT_V(2); PG8_BAR;
        PG8_STAGE(PG8_SB(1, 0), cB + kstep, voffB); PG8_STAGE(PG8_SA(1, 0), cA + kstep, voffA); PG8_STAGE(PG8_SB(1, 1), cB + hstep + kstep, voffB);
        PG8_WAIT_V(6); PG8_BAR;
    } else {
        PG8_STAGE(PG8_SB(0, 0), cB, voffB); PG8_STAGE(PG8_SA(0, 0), cA, voffA); PG8_STAGE(PG8_SB(0, 1), cB + hstep, voffB); PG8_STAGE(PG8_SA(0, 1), cA + hstep, voffA);
        if (wr == 1) PG8_BAR;
        PG8_WAIT_V(4); PG8_BAR;
        PG8_STAGE(PG8_SB(1, 0), cB + kstep, voffB); PG8_STAGE(PG8_SA(1, 0), cA + kstep, voffA); PG8_STAGE(PG8_SB(1, 1), cB + hstep + kstep, voffB);
        PG8_WAIT_V(6); PG8_BAR;
    }
    for (;;) {
        const bool has_next = S.next(ui + 1, nxt);
        const char* nA = has_next ? (const char*)g.A + (size_t)nxt.pm * tstep : cA; const char* nB = has_next ? (const char*)g.Bt + (size_t)nxt.pn * tstep : cB;
        for (int t = 0; t < nt; t += 2) {
            const bool last = (t == nt - 2);
            const char* a1 = cA + (size_t)(t + 1) * kstep;
            const char* a2 = last ? nA : cA + (size_t)(t + 2) * kstep; const char* b2 = last ? nB : cB + (size_t)(t + 2) * kstep;
            const char* a3 = a2 + kstep; const char* b3 = b2 + kstep;
            if (last && has_next) S.a_ready(nxt);
            if constexpr (SP2) {
            PG8_LDB(B0, 0, 0); PG8_LDB(B1, 0, 1); PG8_SCHED; PG8_LDA(At, 0, 0); PG8_STAGE(PG8_SA(1, 1), a1 + hstep, voffA);
            PG8_WAIT_V(8); PG8_WAIT_L(0); PG8_BAR; PG8_MMA(0, 0, At, B0); PG8_MMA(0, 1, At, B1); PG8_BAR; PG8_SCHED;
            PG8_LDA(At, 0, 1); PG8_STAGE(PG8_SB(0, 0), b2, voffB); PG8_STAGE(PG8_SB(0, 1), b2 + hstep, voffB); PG8_STAGE(PG8_SA(0, 0), a2, voffA);
            PG8_WAIT_V(8); PG8_WAIT_L(0); PG8_BAR; PG8_MMA(1, 0, At, B0); PG8_MMA(1, 1, At, B1); PG8_BAR; PG8_SCHED;
            PG8_LDB(B0, 1, 0); PG8_LDB(B1, 1, 1); PG8_SCHED; PG8_LDA(At, 1, 0); PG8_STAGE(PG8_SA(0, 1), a2 + hstep, voffA);
            PG8_WAIT_V(8); PG8_WAIT_L(0); PG8_BAR; PG8_MMA(0, 0, At, B0); PG8_MMA(0, 1, At, B1); PG8_BAR; PG8_SCHED;
            PG8_LDA(At, 1, 1); PG8_STAGE(PG8_SB(1, 0), b3, voffB); PG8_STAGE(PG8_SB(1, 1), b3 + hstep, voffB); PG8_STAGE(PG8_SA(1, 0), a3, voffA);
            PG8_WAIT_V(8); PG8_WAIT_L(0); PG8_BAR; PG8_MMA(1, 0, At, B0); PG8_MMA(1, 1, At, B1); PG8_BAR; PG8_SCHED;
            } else {
            PG8_LDB(B0, 0, 0); PG8_SCHED; PG8_LDA(At, 0, 0); PG8_STAGE(PG8_SA(1, 1), a1 + hstep, voffA);
            PG8_WAIT_L(8); PG8_BAR; PG8_WAIT_L(0); PG8_MMA(0, 0, At, B0); PG8_BAR; PG8_SCHED;
            PG8_LDB(B1, 0, 1); PG8_STAGE(PG8_SB(0, 0), b2, voffB);
            PG8_BAR; PG8_WAIT_L(0); PG8_MMA(0, 1, At, B1); PG8_BAR;
            PG8_LDA(At, 0, 1); PG8_STAGE(PG8_SA(0, 0), a2, voffA);
            PG8_BAR; PG8_WAIT_L(0); PG8_MMA(1, 0, At, B0); PG8_BAR; PG8_SCHED;
            PG8_STAGE(PG8_SB(0, 1), b2 + hstep, voffB);
            PG8_WAIT_V(6); PG8_BAR; PG8_MMA(1, 1, At, B1); PG8_BAR;
            PG8_LDB(B0, 1, 0); PG8_SCHED; PG8_LDA(At, 1, 0); PG8_STAGE(PG8_SA(0, 1), a2 + hstep, voffA);
            PG8_WAIT_L(8); PG8_BAR; PG8_WAIT_L(0); PG8_MMA(0, 0, At, B0); PG8_BAR; PG8_SCHED;
            PG8_LDB(B1, 1, 1); PG8_STAGE(PG8_SB(1, 0), b3, voffB);
            PG8_BAR; PG8_WAIT_L(0); PG8_MMA(0, 1, At, B1); PG8_BAR;
            PG8_LDA(At, 1, 1); PG8_STAGE(PG8_SA(1, 0), a3, voffA);
            PG8_BAR; PG8_WAIT_L(0); PG8_MMA(1, 0, At, B0); PG8_BAR; PG8_SCHED;
            PG8_STAGE(PG8_SB(1, 1), b3 + hstep, voffB);
            PG8_WAIT_V(6); PG8_BAR; PG8_MMA(1, 1, At, B1); PG8_BAR;
            }
        }
        if constexpr (ALIGN_EPI) { if (wr == 0) PG8_BAR; }
        E(acc, cur, wr, wc, fr, fq); S.done(cur);
        if (!has_next) break;
#pragma unroll
        for (int a = 0; a < 2; ++a)
#pragma unroll
            for (int b = 0; b < 2; ++b)
#pragma unroll
                for (int m = 0; m < 4; ++m)
#pragma unroll
                    for (int n = 0; n < 2; ++n) acc[a][b][m][n] = (f32x4){0.f, 0.f, 0.f, 0.f};
        cur = nxt; cA = nA; cB = nB; ++ui;
        if constexpr (ALIGN_EPI) { if (wr == 1) PG8_BAR; }
    }
    PG8_WAIT_V(0);
    if constexpr (!ALIGN_EPI) { if (wr == 0) PG8_BAR; }
    PG8_BAR;
#undef PG8_SA
#undef PG8_SB
#undef PG8_STAGE
#undef PG8_LDA
#undef PG8_LDB
#undef PG8_MMA
#undef PG8_WAIT_V
#undef PG8_WAIT_L
#undef PG8_BAR
#undef PG8_SCHED
}
}
constexpr int D = 1024, NB = 4, SEQ = 8192, DB = 8, DSEQ = 64, NMB = NB + DB;
constexpr int GH = 8, GDK = 128, GDV = 128;
constexpr int SH = 32, SP = 64, SN = 128, SG = 8;
constexpr int DFF = 2816, CONV_CH = 7168, IN_COLS = 12336;
constexpr int NPROJ = 12288;
constexpr int NIN = 12544;
constexpr int NUP = 2 * DFF;
constexpr float EPS = 1e-6f;
#ifndef SLAB_T
#define SLAB_T 1024
#endif
constexpr int NSLAB = SEQ / SLAB_T, RP = NB * SLAB_T, RS = DB * DSEQ, RMAX = RP + RS;
constexpr size_t O_YP = 0, O_YS = O_YP + (size_t)NB * SEQ * D, O_CMP = O_YS + (size_t)DB * DSEQ * D, O_GP = O_CMP + (size_t)NB * 3 * CONV_CH,
                 O_SP = O_GP + (size_t)NB * GH * GDK * GDV, O_CFP = O_SP + (size_t)NB * SH * SN * SP, O_CMS = O_CFP + (size_t)NB * 2 * NUP,
                 O_GS = O_CMS + (size_t)DB * 3 * CONV_CH, O_SS = O_GS + (size_t)DB * GH * GDK * GDV, O_CFS = O_SS + (size_t)DB * SH * SN * SP,
                 O_END = O_CFS + (size_t)DB * 2 * NUP;
constexpr size_t MiB = 1u << 20;
constexpr size_t WS_CTL = 0, CTL_ZERO_BYTES = 1 * MiB;
constexpr size_t WS_MODV = 1 * MiB;
constexpr size_t WS_G1 = WS_MODV + 512 * 1024;
constexpr size_t WS_G2 = WS_G1 + 64 * 1024;
constexpr size_t WS_SHW = WS_G2 + 64 * 1024;
constexpr size_t WS_CARRY_MIX = 2 * MiB;
constexpr size_t WS_CARRY_FFN = 3 * MiB;
constexpr size_t WS_WIN = 4 * MiB;
constexpr size_t WS_WG = WS_WIN + (size_t)NIN * D * 2;
constexpr size_t WS_WS = WS_WG + (size_t)D * D * 2;
constexpr size_t WS_WOUT = WS_WS + (size_t)D * 2048 * 2;
constexpr size_t WS_WUP = WS_WOUT + (size_t)D * D * 2;
constexpr size_t WS_WDN = WS_WUP + (size_t)NUP * D * 2;
constexpr size_t WS_SLAB = 56 * MiB;
static_assert(WS_WDN + (size_t)D * DFF * 2 <= WS_SLAB, "weights fit");
constexpr size_t SZ_HB = (size_t)RMAX * D * 2, SZ_PROJ = (size_t)RMAX * NPROJ * 2, SZ_SM = (size_t)RMAX * 64 * 4, SZ_OG = (size_t)RMAX * D * 2, SZ_YS = (size_t)RMAX * 2048 * 2,
                 SZ_T1 = (size_t)RMAX * D * 4, SZ_MIX = (size_t)RMAX * D * 2, SZ_X1 = (size_t)RMAX * D * 4, SZ_X1G = (size_t)RMAX * D * 2, SZ_SS = (size_t)RMAX * 16 * 4,
                 SZ_U = (size_t)RMAX * NUP * 2, SZ_ACT = (size_t)RMAX * DFF * 2;
constexpr size_t WS_HB = WS_SLAB, WS_PROJ = WS_HB + SZ_HB, WS_SM = WS_PROJ + SZ_PROJ, WS_OG = WS_SM + SZ_SM, WS_YS = WS_OG + SZ_OG, WS_T1 = WS_YS + SZ_YS, WS_MIX = WS_T1 + SZ_T1,
                 WS_X1 = WS_MIX + SZ_MIX, WS_X1G = WS_X1 + SZ_X1, WS_SS1 = WS_X1G + SZ_X1G, WS_SS2 = WS_SS1 + SZ_SS, WS_U = WS_SS2 + SZ_SS, WS_ACT = WS_U + SZ_U, WS_END = WS_ACT + SZ_ACT;
static_assert(WS_END <= 480 * MiB, "workspace map fits");
constexpr int LDS_BYTES = 147456, LDSCTL_OFF = LDS_BYTES - 512, MISC_OFF = LDSCTL_OFF + 320, RING_BYTES = LDSCTL_OFF;
constexpr int NWAVES = 8, NTHR = 512;

#define GAS __attribute__((address_space(1)))
#define LAS __attribute__((address_space(3)))
typedef unsigned short bf16;
typedef unsigned v4u __attribute__((ext_vector_type(4)));
typedef unsigned v2u __attribute__((ext_vector_type(2)));
typedef float f32x4 __attribute__((ext_vector_type(4)));
typedef GAS unsigned gu32;
#define RLX_AGENT __ATOMIC_RELAXED, __HIP_MEMORY_SCOPE_AGENT
#define LDS_WAIT() asm volatile("s_waitcnt lgkmcnt(0)" ::: "memory")
#define VM_WAIT() asm volatile("s_waitcnt vmcnt(0)" ::: "memory")
__device__ __forceinline__ unsigned f2bf(float f) { unsigned u = __builtin_bit_cast(unsigned, f); return (u + 0x7fffu + ((u >> 16) & 1u)) >> 16; }
__device__ __forceinline__ unsigned pk2(float lo, float hi) { return f2bf(lo) | (f2bf(hi) << 16); }
__device__ __forceinline__ float bf2f(unsigned short h) { return __builtin_bit_cast(float, (unsigned)h << 16); }
__device__ __forceinline__ float bflo(unsigned w) { return __builtin_bit_cast(float, w << 16); }
__device__ __forceinline__ float bfhi(unsigned w) { return __builtin_bit_cast(float, w & 0xffff0000u); }
__device__ __forceinline__ float sigmoidf_(float x) { return 1.f / (1.f + __expf(-x)); }
__device__ __forceinline__ float siluf_(float x) { return x / (1.f + __expf(-x)); }
__device__ __forceinline__ float softplusf_(float x) { const float e = __expf(-fabsf(x)), u = 1.f + e, d = u - 1.f; const float l = (d == 0.f) ? e : __logf(u) * (e / d); return fmaxf(x, 0.f) + l; }
__device__ __forceinline__ float wave_sum(float v) {
#pragma unroll
    for (int o = 1; o < 64; o <<= 1) v += __shfl_xor(v, o);
    return v;
}

struct Args { const float* in[30]; float* out; unsigned char* ws; int ph_lo, ph_hi; };

struct Frame {
    LAS unsigned char* lds;
    volatile LAS unsigned* MISC;
    gu32* ctl;
    int tid, lane, wave, G, bid;
    const Args& A;
    float* out; unsigned char* ws;
    __device__ __forceinline__ Frame(const Args& a) : A(a) {}
};
__device__ __forceinline__ int row_mb(int r) { return r < RP ? (r / SLAB_T) : NB + ((r - RP) / DSEQ); }
__device__ __forceinline__ size_t row_goff(int s, int r) {
    if (r < RP) { const int b = r / SLAB_T, tl = r % SLAB_T; return ((size_t)b * SEQ + (size_t)s * SLAB_T + tl) * D; }
    return (size_t)(r - RP) * D;
}
__device__ __forceinline__ int slab_rows(int s) { return s == 0 ? RMAX : RP; }
struct MapWin { __device__ __forceinline__ int operator()(int n) const { return n < 10240 ? n : (n < 12288 ? n + 48 : (n < 12336 ? n - 2048 : -1)); } };
struct MapId  { __device__ __forceinline__ int operator()(int n) const { return n; } };
struct MapUp  { __device__ __forceinline__ int operator()(int n) const { const int j = n >> 8, c = n & 255; return c < 128 ? 128 * j + c : DFF + 128 * j + (c - 128); } };
template <class Map>
__device__ __forceinline__ void p0_transpose_item(const float* W, int ldw, int K, bf16* WT, Map map, LAS float* scr, int item, int nblk, int lane) {
    const int kb = item / nblk, nb = item % nblk, k0 = 64 * kb, n0 = 32 * nb;
    const int sc = map(n0 + (lane & 31));
#pragma unroll 8
    for (int i = 0; i < 32; ++i) { const int kk = 2 * i + (lane >> 5); scr[kk * 33 + (lane & 31)] = sc >= 0 ? W[(size_t)(k0 + kk) * ldw + sc] : 0.f; }
    LDS_WAIT(); asm volatile("" ::: "memory");
    const int c = lane & 7;
#pragma unroll
    for (int j = 0; j < 4; ++j) { const int n = (lane >> 3) + 8 * j; const LAS float* s = scr + (8 * c) * 33 + n;
        v4u o; o.x = pk2(s[0 * 33], s[1 * 33]); o.y = pk2(s[2 * 33], s[3 * 33]); o.z = pk2(s[4 * 33], s[5 * 33]); o.w = pk2(s[6 * 33], s[7 * 33]);
        *(GAS v4u*)(WT + (size_t)(n0 + n) * K + k0 + 8 * c) = o; }
    LDS_WAIT(); asm volatile("" ::: "memory");
}
__device__ __forceinline__ void p0_mod_item(Frame& F, int item) {
    LAS float* sc = (LAS float*)F.lds; LAS float* red = (LAS float*)(F.lds + 49152);
    const float* cp = F.A.in[6]; const float* cs = F.A.in[7]; const float* w_ada = F.A.in[8]; const float* b_ada = F.A.in[9];
    for (int idx = F.tid; idx < NMB * D; idx += NTHR) { const int b = idx / D, k = idx % D; const float c = b < NB ? cp[b * D + k] : cs[(b - NB) * D + k]; sc[idx] = siluf_(c); }
    __syncthreads();
    float acc[NMB];
#pragma unroll
    for (int b = 0; b < NMB; ++b) acc[b] = 0.f;
    const int col = item * 64 + F.lane, kb = F.wave * 128;
    for (int k = 0; k < 128; ++k) { const float wv = w_ada[(size_t)(kb + k) * 6144 + col];
#pragma unroll
        for (int b = 0; b < NMB; ++b) acc[b] += sc[b * D + kb + k] * wv; }
#pragma unroll
    for (int b = 0; b < NMB; ++b) red[(F.wave * NMB + b) * 64 + F.lane] = acc[b];
    __syncthreads();
    float* modv = (float*)(F.ws + WS_MODV);
    for (int idx = F.tid; idx < NMB * 64; idx += NTHR) { const int b = idx / 64, l = idx % 64; float s = b_ada[item * 64 + l];
#pragma unroll
        for (int w = 0; w < 8; ++w) s += red[(w * NMB + b) * 64 + l];
        modv[b * 6144 + item * 64 + l] = s; }
    __syncthreads();
}
__device__ __forceinline__ void phase_prologue0(Frame& F) {
    for (int it = F.bid; it < 96; it += F.G) p0_mod_item(F, it);
    LAS float* scr = (LAS float*)(F.lds + F.wave * 16384);
    const int gw = F.bid * NWAVES + F.wave, NGW = F.G * NWAVES;
    constexpr int I_IN = (D / 64) * (NIN / 32), I_G = (D / 64) * (D / 32), I_S = (2048 / 64) * (D / 32), I_O = I_G, I_UP = (D / 64) * (NUP / 32), I_DN = (DFF / 64) * (D / 32);
    constexpr int NITEMS = I_IN + I_G + I_S + I_O + I_UP + I_DN;
    for (int it = gw; it < NITEMS; it += NGW) {
        int r = it;
        if (r < I_IN) { p0_transpose_item(F.A.in[11], IN_COLS, D, (bf16*)(F.ws + WS_WIN), MapWin(), scr, r, NIN / 32, F.lane); continue; } r -= I_IN;
        if (r < I_G) { p0_transpose_item(F.A.in[21], D, D, (bf16*)(F.ws + WS_WG), MapId(), scr, r, D / 32, F.lane); continue; } r -= I_G;
        if (r < I_S) { p0_transpose_item(F.A.in[22], D, 2048, (bf16*)(F.ws + WS_WS), MapId(), scr, r, D / 32, F.lane); continue; } r -= I_S;
        if (r < I_O) { p0_transpose_item(F.A.in[23], D, D, (bf16*)(F.ws + WS_WOUT), MapId(), scr, r, D / 32, F.lane); continue; } r -= I_O;
        if (r < I_UP) { p0_transpose_item(F.A.in[25], NUP, D, (bf16*)(F.ws + WS_WUP), MapUp(), scr, r, NUP / 32, F.lane); continue; } r -= I_UP;
        p0_transpose_item(F.A.in[28], D, DFF, (bf16*)(F.ws + WS_WDN), MapId(), scr, r, D / 32, F.lane);
    }
}
__device__ __forceinline__ void phase_prologue1(Frame& F) {
    const float* modv = (const float*)(F.ws + WS_MODV);
    float* g1 = (float*)(F.ws + WS_G1); float* g2 = (float*)(F.ws + WS_G2); float* shw = (float*)(F.ws + WS_SHW);
    for (int idx = F.bid * NTHR + F.tid; idx < NMB * D; idx += F.G * NTHR) { const int b = idx / D, k = idx % D;
        g1[idx] = F.A.in[10][k] * (1.f + modv[b * 6144 + 1024 + k]); g2[idx] = F.A.in[24][k] * (1.f + modv[b * 6144 + 4096 + k]); }
    LAS float* sh = (LAS float*)F.lds;
    for (int idx = F.tid; idx < NMB * D; idx += NTHR) sh[idx] = modv[(idx / D) * 6144 + 3072 + (idx % D)];
    __syncthreads();
    const bf16* wup = (const bf16*)(F.ws + WS_WUP);
    const int gw = F.bid * NWAVES + F.wave, NGW = F.G * NWAVES;
    for (int n = gw; n < NUP; n += NGW) {
        const GAS v4u* wr = (const GAS v4u*)(wup + (size_t)n * D + F.lane * 16);
        const v4u w0 = wr[0], w1 = wr[1];
        float wf[16] = {bflo(w0.x), bfhi(w0.x), bflo(w0.y), bfhi(w0.y), bflo(w0.z), bfhi(w0.z), bflo(w0.w), bfhi(w0.w), bflo(w1.x), bfhi(w1.x), bflo(w1.y), bfhi(w1.y), bflo(w1.z), bfhi(w1.z), bflo(w1.w), bfhi(w1.w)};
        float res = 0.f;
#pragma unroll 1
        for (int b = 0; b < NMB; ++b) { float a = 0.f;
#pragma unroll
            for (int i = 0; i < 16; ++i) a += wf[i] * sh[b * D + F.lane * 16 + i];
            a = wave_sum(a); if (F.lane == b) res = a; }
        if (F.lane < NMB) shw[F.lane * NUP + n] = res;
    }
    __syncthreads();
}
__device__ __forceinline__ void phase_norm1(Frame& F, int s) {
    const float* modv = (const float*)(F.ws + WS_MODV); const float* g1 = (const float*)(F.ws + WS_G1); bf16* hb = (bf16*)(F.ws + WS_HB);
    const int gw = F.bid * NWAVES + F.wave, NGW = F.G * NWAVES, R = slab_rows(s);
    for (int r = gw; r < R; r += NGW) {
        const float* xrow = (r < RP ? F.A.in[0] : F.A.in[1]) + row_goff(s, r); const int mb = row_mb(r);
        const GAS f32x4* xr = (const GAS f32x4*)xrow + F.lane;
        f32x4 v[4]; float ss = 0.f;
#pragma unroll
        for (int j = 0; j < 4; ++j) { v[j] = xr[64 * j]; ss += (v[j].x * v[j].x + v[j].y * v[j].y) + (v[j].z * v[j].z + v[j].w * v[j].w); }
        const float rs = rsqrtf(wave_sum(ss) * (1.f / D) + EPS);
        GAS v2u* o8 = (GAS v2u*)(hb + (size_t)r * D) + F.lane;
#pragma unroll
        for (int j = 0; j < 4; ++j) { const int k = 4 * F.lane + 256 * j; const f32x4 g = *(const GAS f32x4*)(g1 + mb * D + k); const f32x4 sh = *(const GAS f32x4*)(modv + mb * 6144 + k);
            v2u o; o.x = pk2(v[j].x * rs * g.x + sh.x, v[j].y * rs * g.y + sh.y); o.y = pk2(v[j].z * rs * g.z + sh.z, v[j].w * rs * g.w + sh.w); o8[64 * j] = o; }
    }
}
__device__ __forceinline__ void phase_final(Frame& F, int s) {
    const float* ss2 = (const float*)(F.ws + WS_SS2); const float* wf = F.A.in[29];
    const int gw = F.bid * NWAVES + F.wave, NGW = F.G * NWAVES, R = slab_rows(s);
    for (int r = gw; r < R; r += NGW) {
        float* yrow = F.out + (r < RP ? O_YP : O_YS) + row_goff(s, r);
        float t = F.lane < 16 ? ss2[(size_t)r * 16 + F.lane] : 0.f; t = wave_sum(t);
        const float rs = rsqrtf(t * (1.f / D) + EPS);
        GAS f32x4* yr = (GAS f32x4*)yrow + F.lane;
#pragma unroll
        for (int j = 0; j < 4; ++j) { f32x4 v = yr[64 * j]; const f32x4 w = *(const GAS f32x4*)(wf + 4 * F.lane + 256 * j); v.x *= rs * w.x; v.y *= rs * w.y; v.z *= rs * w.z; v.w *= rs * w.w; yr[64 * j] = v; }
    }
}
__device__ __forceinline__ void u_hist_row(Frame& F, int s, int r, int back, int c8, int j, int cc, float (&ua)[8], float (&uv)[8]) {
    const bf16* U = (const bf16*)(F.ws + WS_U);
    int tl, b; bool samp = r >= RP;
    if (!samp) { b = r / SLAB_T; tl = r % SLAB_T; } else { b = (r - RP) / DSEQ; tl = (r - RP) % DSEQ; }
    if (tl - back >= 0) {
        const bf16* p = U + (size_t)(r - back) * NUP + 256 * j + cc;
        const v4u a = *(const GAS v4u*)p, v = *(const GAS v4u*)(p + 128);
        ua[0] = bflo(a.x); ua[1] = bfhi(a.x); ua[2] = bflo(a.y); ua[3] = bfhi(a.y); ua[4] = bflo(a.z); ua[5] = bfhi(a.z); ua[6] = bflo(a.w); ua[7] = bfhi(a.w);
        uv[0] = bflo(v.x); uv[1] = bfhi(v.x); uv[2] = bflo(v.y); uv[3] = bfhi(v.y); uv[4] = bflo(v.z); uv[5] = bfhi(v.z); uv[6] = bflo(v.w); uv[7] = bfhi(v.w);
        return;
    }
    const int hi = 2 + (tl - back);
    if (samp) { const float* st = F.A.in[5] + ((size_t)b * 2 + hi) * NUP;
#pragma unroll
        for (int i = 0; i < 8; ++i) { ua[i] = st[c8 + i]; uv[i] = st[DFF + c8 + i]; } return; }
    if (s == 0) {
#pragma unroll
        for (int i = 0; i < 8; ++i) { ua[i] = 0.f; uv[i] = 0.f; } return; }
    const float* cf = (const float*)(F.ws + WS_CARRY_FFN) + (((size_t)(s & 1) * NB + b) * 2 + hi) * NUP + 256 * j + cc;
#pragma unroll
    for (int i = 0; i < 8; ++i) { ua[i] = cf[i]; uv[i] = cf[128 + i]; }
}
__device__ __forceinline__ void phase_convact(Frame& F, int s) {
    const bf16* U = (const bf16*)(F.ws + WS_U); bf16* ACT = (bf16*)(F.ws + WS_ACT);
    const float* wc = F.A.in[26]; const float* bc = F.A.in[27];
    const int R = slab_rows(s); const long total = (long)R * (DFF / 8);
    for (long idx = (long)F.bid * NTHR + F.tid; idx < total; idx += (long)F.G * NTHR) {
        const int r = (int)(idx / (DFF / 8)), c8 = (int)(idx % (DFF / 8)) * 8, j = c8 >> 7, cc = c8 & 127;
        float a0[8], v0[8], a1[8], v1[8], a2[8], v2[8];
        u_hist_row(F, s, r, 0, c8, j, cc, a2, v2); u_hist_row(F, s, r, 1, c8, j, cc, a1, v1); u_hist_row(F, s, r, 2, c8, j, cc, a0, v0);
        float o[8];
#pragma unroll
        for (int i = 0; i < 8; ++i) { const int ca = c8 + i, cv = DFF + c8 + i;
            const float xa = bc[ca] + wc[ca] * a0[i] + wc[NUP + ca] * a1[i] + wc[2 * NUP + ca] * a2[i];
            const float xv = bc[cv] + wc[cv] * v0[i] + wc[NUP + cv] * v1[i] + wc[2 * NUP + cv] * v2[i];
            o[i] = siluf_(xa) * xv; }
        v4u w; w.x = pk2(o[0], o[1]); w.y = pk2(o[2], o[3]); w.z = pk2(o[4], o[5]); w.w = pk2(o[6], o[7]);
        *(GAS v4u*)(ACT + (size_t)r * DFF + c8) = w;
    }
    float* cfn = (float*)(F.ws + WS_CARRY_FFN) + (size_t)((s + 1) & 1) * NB * 2 * NUP;
    for (int idx = F.bid * NTHR + F.tid; idx < NB * 2 * NUP; idx += F.G * NTHR) {
        const int b = idx / (2 * NUP), i = (idx / NUP) % 2, c = idx % NUP; const int r = b * SLAB_T + SLAB_T - 2 + i;
        const float v = bf2f(U[(size_t)r * NUP + c]); cfn[idx] = v;
        if (s == NSLAB - 1) { const int j = c >> 8, cc = c & 255; const int oc = cc < 128 ? 128 * j + cc : DFF + 128 * j + (cc - 128); F.out[O_CFP + ((size_t)b * 2 + i) * NUP + oc] = v; }
    }
    if (s == 0) for (int idx = F.bid * NTHR + F.tid; idx < DB * 2 * NUP; idx += F.G * NTHR) {
        const int b = idx / (2 * NUP), i = (idx / NUP) % 2, c = idx % NUP; const int r = RP + b * DSEQ + DSEQ - 2 + i;
        const int j = c >> 8, cc = c & 255; const int oc = cc < 128 ? 128 * j + cc : DFF + 128 * j + (cc - 128);
        F.out[O_CFS + ((size_t)b * 2 + i) * NUP + oc] = bf2f(U[(size_t)r * NUP + c]);
    }
}
__device__ __forceinline__ void phase_mix_carry(Frame& F, int s) {
    const bf16* P = (const bf16*)(F.ws + WS_PROJ);
    float* cmn = (float*)(F.ws + WS_CARRY_MIX) + (size_t)((s + 1) & 1) * NB * 3 * CONV_CH;
    for (int idx = F.bid * NTHR + F.tid; idx < NB * 3 * CONV_CH; idx += F.G * NTHR) {
        const int b = idx / (3 * CONV_CH), i = (idx / CONV_CH) % 3, c = idx % CONV_CH; const int r = b * SLAB_T + SLAB_T - 3 + i;
        const float v = bf2f(P[(size_t)r * NPROJ + c]); cmn[idx] = v;
        if (s == NSLAB - 1) F.out[O_CMP + idx] = v;
    }
    if (s == 0) for (int idx = F.bid * NTHR + F.tid; idx < DB * 3 * CONV_CH; idx += F.G * NTHR) {
        const int b = idx / (3 * CONV_CH), i = (idx / CONV_CH) % 3, c = idx % CONV_CH; const int r = RP + b * DSEQ + DSEQ - 3 + i;
        F.out[O_CMS + idx] = bf2f(P[(size_t)r * NPROJ + c]);
    }
}
namespace epi {
using pg8::f32x4; using pg8::Unit; using pg8::BM; using pg8::HALF; using pg8::cvt_pk_bf16; using pg8::u32x4; using pg8::u32x2;
struct EpiProj {
    static constexpr bool PERM = true;
    bf16* P; float* SM;
    __device__ __forceinline__ void operator()(const f32x4 (&acc)[2][2][4][2], const Unit& u, int wr, int wc, int fr, int fq) const {
        const int row0 = u.pm * BM + wr * 64 + fr;
        if (u.pn == 48) {
            if (wc < 2) {
#pragma unroll
                for (int ai = 0; ai < 2; ++ai)
#pragma unroll
                    for (int m = 0; m < 4; ++m) { float* rp = SM + (size_t)(row0 + ai * HALF + m * 16) * 64 + wc * 32 + 8 * fq;
                        *(f32x4*)rp = acc[ai][0][m][0]; *(f32x4*)(rp + 4) = acc[ai][0][m][1]; }
            }
            return;
        }
        const bool sg = u.pn >= 40;
        const int col0 = u.pn * BM + wc * 32 + 8 * fq;
#pragma unroll
        for (int ai = 0; ai < 2; ++ai)
#pragma unroll
            for (int m = 0; m < 4; ++m) { bf16* rowp = P + (size_t)(row0 + ai * HALF + m * 16) * NPROJ + col0;
#pragma unroll
                for (int bj = 0; bj < 2; ++bj) { f32x4 v0 = acc[ai][bj][m][0], v1 = acc[ai][bj][m][1];
                    if (sg) {
#pragma unroll
                        for (int i = 0; i < 4; ++i) { v0[i] = sigmoidf_(v0[i]); v1[i] = sigmoidf_(v1[i]); } }
                    u32x4 w; w.x = cvt_pk_bf16(v0[0], v0[1]); w.y = cvt_pk_bf16(v0[2], v0[3]); w.z = cvt_pk_bf16(v1[0], v1[1]); w.w = cvt_pk_bf16(v1[2], v1[3]);
                    *(u32x4*)(rowp + bj * HALF) = w; } }
    }
};
struct EpiGate1 {
    static constexpr bool PERM = false;
    const bf16* P; float* T1;
    __device__ __forceinline__ void operator()(const f32x4 (&acc)[2][2][4][2], const Unit& u, int wr, int wc, int fr, int fq) const {
        const int row0 = u.pm * BM + wr * 64 + fr, col0 = u.pn * BM + wc * 32 + 4 * fq;
#pragma unroll
        for (int ai = 0; ai < 2; ++ai)
#pragma unroll
            for (int m = 0; m < 4; ++m) { const size_t r = (size_t)(row0 + ai * HALF + m * 16);
#pragma unroll
                for (int bj = 0; bj < 2; ++bj)
#pragma unroll
                    for (int n = 0; n < 2; ++n) { const int c = col0 + bj * HALF + n * 16; const u32x2 g = *(const u32x2*)(P + r * NPROJ + 10240 + c); const f32x4 a = acc[ai][bj][m][n];
                        f32x4 o; o.x = a.x * bflo(g.x); o.y = a.y * bfhi(g.x); o.z = a.z * bflo(g.y); o.w = a.w * bfhi(g.y); *(f32x4*)(T1 + r * D + c) = o; } }
    }
};
struct EpiGate2 {
    static constexpr bool PERM = false;
    const bf16* P; const float* T1; bf16* MIX;
    __device__ __forceinline__ void operator()(const f32x4 (&acc)[2][2][4][2], const Unit& u, int wr, int wc, int fr, int fq) const {
        const int row0 = u.pm * BM + wr * 64 + fr, col0 = u.pn * BM + wc * 32 + 4 * fq;
#pragma unroll
        for (int ai = 0; ai < 2; ++ai)
#pragma unroll
            for (int m = 0; m < 4; ++m) { const size_t r = (size_t)(row0 + ai * HALF + m * 16);
#pragma unroll
                for (int bj = 0; bj < 2; ++bj)
#pragma unroll
                    for (int n = 0; n < 2; ++n) { const int c = col0 + bj * HALF + n * 16; const u32x2 g = *(const u32x2*)(P + r * NPROJ + 11264 + c); const f32x4 a = acc[ai][bj][m][n];
                        const f32x4 t = *(const f32x4*)(T1 + r * D + c);
                        u32x2 o; o.x = cvt_pk_bf16(t.x + a.x * bflo(g.x), t.y + a.y * bfhi(g.x)); o.y = cvt_pk_bf16(t.z + a.z * bflo(g.y), t.w + a.w * bfhi(g.y)); *(u32x2*)(MIX + r * D + c) = o; } }
    }
};
struct EpiOut {
    static constexpr bool PERM = false;
    const float* xp; const float* xs; const float* modv; const float* g2; float* X1; bf16* X1G; float* SS; int slab;
    __device__ __forceinline__ void operator()(const f32x4 (&acc)[2][2][4][2], const Unit& u, int wr, int wc, int fr, int fq) const {
        const int col0 = u.pn * BM + wc * 32 + 4 * fq;
#pragma unroll
        for (int ai = 0; ai < 2; ++ai) {
            const int rb = u.pm * BM + ai * HALF + wr * 64; const int mb = row_mb(rb);
#pragma unroll
            for (int m = 0; m < 4; ++m) { const int r = rb + m * 16 + fr; const float* xrow = (r < RP ? xp : xs) + row_goff(slab, r); float sq = 0.f;
#pragma unroll
                for (int bj = 0; bj < 2; ++bj)
#pragma unroll
                    for (int n = 0; n < 2; ++n) { const int c = col0 + bj * HALF + n * 16; const f32x4 a = acc[ai][bj][m][n];
                        const f32x4 xv = *(const f32x4*)(xrow + c), gt = *(const f32x4*)(modv + mb * 6144 + 2048 + c), gg = *(const f32x4*)(g2 + mb * D + c);
                        f32x4 o = xv + gt * a; *(f32x4*)(X1 + (size_t)r * D + c) = o; sq += (o.x * o.x + o.y * o.y) + (o.z * o.z + o.w * o.w);
                        u32x2 w; w.x = cvt_pk_bf16(o.x * gg.x, o.y * gg.y); w.y = cvt_pk_bf16(o.z * gg.z, o.w * gg.w); *(u32x2*)(X1G + (size_t)r * D + c) = w; }
                sq += __shfl_xor(sq, 16); sq += __shfl_xor(sq, 32);
                if (fq == 0) SS[(size_t)r * 16 + u.pn * 4 + wc] = sq; }
        }
    }
};
struct EpiUp {
    static constexpr bool PERM = true;
    const float* SS; const float* shw; bf16* U;
    __device__ __forceinline__ void operator()(const f32x4 (&acc)[2][2][4][2], const Unit& u, int wr, int wc, int fr, int fq) const {
        const int col0 = u.pn * BM + wc * 32 + 8 * fq;
#pragma unroll
        for (int ai = 0; ai < 2; ++ai) {
            const int rb = u.pm * BM + ai * HALF + wr * 64; const int mb = row_mb(rb);
            f32x4 sv[2][2];
#pragma unroll
            for (int bj = 0; bj < 2; ++bj)
#pragma unroll
                for (int n = 0; n < 2; ++n) sv[bj][n] = *(const f32x4*)(shw + mb * NUP + col0 + bj * HALF + 4 * n);
#pragma unroll
            for (int m = 0; m < 4; ++m) { const int r = rb + m * 16 + fr; const f32x4* sp = (const f32x4*)(SS + (size_t)r * 16);
                const f32x4 s0 = sp[0], s1 = sp[1], s2 = sp[2], s3 = sp[3];
                const float tot = ((s0.x + s0.y) + (s0.z + s0.w)) + ((s1.x + s1.y) + (s1.z + s1.w)) + ((s2.x + s2.y) + (s2.z + s2.w)) + ((s3.x + s3.y) + (s3.z + s3.w));
                const float rs = rsqrtf(tot * (1.f / D) + EPS);
#pragma unroll
                for (int bj = 0; bj < 2; ++bj) { const f32x4 v0 = acc[ai][bj][m][0] * rs + sv[bj][0], v1 = acc[ai][bj][m][1] * rs + sv[bj][1];
                    u32x4 w; w.x = cvt_pk_bf16(v0[0], v0[1]); w.y = cvt_pk_bf16(v0[2], v0[3]); w.z = cvt_pk_bf16(v1[0], v1[1]); w.w = cvt_pk_bf16(v1[2], v1[3]);
                    *(u32x4*)(U + (size_t)r * NUP + col0 + bj * HALF) = w; } }
        }
    }
};
struct EpiDown {
    static constexpr bool PERM = false;
    const float* X1; const float* modv; float* yp; float* ys; float* SS; int slab;
    __device__ __forceinline__ void operator()(const f32x4 (&acc)[2][2][4][2], const Unit& u, int wr, int wc, int fr, int fq) const {
        const int col0 = u.pn * BM + wc * 32 + 4 * fq;
#pragma unroll
        for (int ai = 0; ai < 2; ++ai) {
            const int rb = u.pm * BM + ai * HALF + wr * 64; const int mb = row_mb(rb);
#pragma unroll
            for (int m = 0; m < 4; ++m) { const int r = rb + m * 16 + fr; float* yrow = (r < RP ? yp : ys) + row_goff(slab, r); float sq = 0.f;
#pragma unroll
                for (int bj = 0; bj < 2; ++bj)
#pragma unroll
                    for (int n = 0; n < 2; ++n) { const int c = col0 + bj * HALF + n * 16; const f32x4 a = acc[ai][bj][m][n];
                        const f32x4 xv = *(const f32x4*)(X1 + (size_t)r * D + c), gt = *(const f32x4*)(modv + mb * 6144 + 5120 + c);
                        f32x4 o = xv + gt * a; *(f32x4*)(yrow + c) = o; sq += (o.x * o.x + o.y * o.y) + (o.z * o.z + o.w * o.w); }
                sq += __shfl_xor(sq, 16); sq += __shfl_xor(sq, 32);
                if (fq == 0) SS[(size_t)r * 16 + u.pn * 4 + wc] = sq; }
        }
    }
};
}
typedef short bf16x8 __attribute__((ext_vector_type(8)));
#define MFMA16(a, b, c) __builtin_amdgcn_mfma_f32_16x16x32_bf16((a), (b), (c), 0, 0, 0)
__device__ __forceinline__ bf16x8 ldfrag(const LAS bf16* base, int ld, int row0, int k0, int lane) {
    return *(const LAS bf16x8*)(base + (row0 + (lane & 15)) * ld + k0 + 8 * (lane >> 4));
}
__device__ __forceinline__ bf16x8 ldfrag_perm(const LAS bf16* base, int ld, int row0, int k0, int lane) {
    const LAS v2u* p = (const LAS v2u*)(base + (row0 + (lane & 15)) * ld + k0 + 4 * (lane >> 4));
    const v2u a = p[0], b = p[4];
    v4u w; w.x = a.x; w.y = a.y; w.z = b.x; w.w = b.y; return __builtin_bit_cast(bf16x8, w);
}
__device__ __forceinline__ bf16x8 acc2frag(f32x4 t0, f32x4 t1) {
    v4u w; w.x = pg8::cvt_pk_bf16(t0.x, t0.y); w.y = pg8::cvt_pk_bf16(t0.z, t0.w); w.z = pg8::cvt_pk_bf16(t1.x, t1.y); w.w = pg8::cvt_pk_bf16(t1.z, t1.w); return __builtin_bit_cast(bf16x8, w);
}
__device__ __forceinline__ float wave_incl_scan(float v, int lane) {
#pragma unroll
    for (int o = 1; o < 64; o <<= 1) { const float t = __shfl_up(v, o); if (lane >= o) v += t; }
    return v;
}
__device__ __forceinline__ float row16_sum(float v) { v += __shfl_xor(v, 1); v += __shfl_xor(v, 2); v += __shfl_xor(v, 4); v += __shfl_xor(v, 8); return v; }

constexpr int SL_CS = 0, SL_BS = 17408, SL_BT = 34816, SL_XT = 53248, SL_CB = 90112, SL_DT = 99328, SL_GAM = 100352, SL_PS = 101376, SL_ZS = 103424;
__device__ __forceinline__ void ssd_fast_job(Frame& F, int s, bool samp, int bb, int g, bool dry = false) {
    const bf16* P = (const bf16*)(F.ws + WS_PROJ); const float* SM = (const float*)(F.ws + WS_SM); bf16* YS = (bf16*)(F.ws + WS_YS);
    LAS bf16* CS = (LAS bf16*)(F.lds + SL_CS); LAS bf16* BS = (LAS bf16*)(F.lds + SL_BS); LAS bf16* BT = (LAS bf16*)(F.lds + SL_BT); LAS bf16* XT = (LAS bf16*)(F.lds + SL_XT);
    LAS bf16* CBS = (LAS bf16*)(F.lds + SL_CB); LAS float* DTV = (LAS float*)(F.lds + SL_DT); LAS float* GAM = (LAS float*)(F.lds + SL_GAM); LAS float* PS = (LAS float*)(F.lds + SL_PS); LAS bf16* ZS = (LAS bf16*)(F.lds + SL_ZS) + F.wave * 2048;
    const int tid = F.tid, w = F.wave;
    int lane = F.lane; asm volatile("" : "+v"(lane)); int quad = lane >> 4, l15 = lane & 15;
    const int hl = w >> 1, ph = w & 1, head = 4 * g + hl;
    const int nchunk = samp ? 1 : SLAB_T / 64, row0 = samp ? RP + bb * DSEQ : bb * SLAB_T;
    f32x4 hacc[8][2];
    {
        const float* st = samp ? F.A.in[4] : F.out + O_SP;
        const size_t sb = (size_t)(bb * SH + head) * SN * SP;
#pragma unroll
        for (int mt = 0; mt < 8; ++mt)
#pragma unroll
            for (int nt = 0; nt < 2; ++nt)
#pragma unroll
                for (int r = 0; r < 4; ++r) { const int n = 16 * mt + 4 * quad + r, p = 32 * ph + 16 * nt + l15; hacc[mt][nt][r] = (samp || s > 0) ? st[sb + (size_t)n * SP + p] : 0.f; }
    }
    const int cidx = tid < 256 ? 3072 + g * 256 + tid : (tid < 384 ? 5120 + g * 128 + (tid - 256) : 6144 + g * 128 + (tid - 384));
    const float* wcv = F.A.in[12]; const float w0 = wcv[cidx], w1 = wcv[CONV_CH + cidx], w2 = wcv[2 * CONV_CH + cidx], w3 = wcv[3 * CONV_CH + cidx], bias = F.A.in[13][cidx];
    float h0 = 0.f, h1 = 0.f, h2 = 0.f;
    if (samp) { const float* st = F.A.in[2] + (size_t)bb * 3 * CONV_CH + cidx; h0 = st[0]; h1 = st[CONV_CH]; h2 = st[2 * CONV_CH]; }
    else if (s > 0) { const float* st = (const float*)(F.ws + WS_CARRY_MIX) + ((size_t)(s & 1) * NB + bb) * 3 * CONV_CH + cidx; h0 = st[0]; h1 = st[CONV_CH]; h2 = st[2 * CONV_CH]; }
    const float aneg = -__expf(F.A.in[17][head]), Dh = F.A.in[19][head];
    for (int c = 0; c < nchunk; ++c) {
        const int r0 = row0 + 64 * c;
        asm volatile("" : "+v"(lane)); quad = lane >> 4; l15 = lane & 15;
        v4u zr[4];
        { const GAS v4u* zp = (const GAS v4u*)(P + (size_t)(r0 + lane) * NPROJ + 8192 + head * 64 + 32 * ph);
#pragma unroll
          for (int i = 0; i < 4; ++i) zr[i] = zp[i]; }
        if (tid < 256) { const int hh = 4 * g + (tid >> 6); const float dt = softplusf_(SM[(size_t)(r0 + lane) * 64 + 16 + hh] + F.A.in[18][hh]);
            const float ga = wave_incl_scan(dt * (-__expf(F.A.in[17][hh])), lane); DTV[(tid >> 6) * 64 + lane] = dt; GAM[(tid >> 6) * 64 + lane] = ga; }
        __syncthreads();
        {
            unsigned colp2[32];
            const bf16* pc = P + (size_t)r0 * NPROJ + cidx;
            const LAS float* dtp = DTV + (tid < 256 ? (tid >> 6) * 64 : 0);
#pragma unroll
            for (int tb = 0; tb < 4; ++tb) { float raw[16];
#pragma unroll
                for (int t = 0; t < 16; ++t) raw[t] = bf2f(pc[(size_t)(16 * tb + t) * NPROJ]);
#pragma unroll
                for (int t = 0; t < 16; t += 2) { float va = bias + w0 * h0 + w1 * h1 + w2 * h2 + w3 * raw[t]; float vb = bias + w0 * h1 + w1 * h2 + w2 * raw[t] + w3 * raw[t + 1]; h0 = h2; h1 = raw[t]; h2 = raw[t + 1];
                    va = siluf_(va); vb = siluf_(vb); if (tid < 256) { va *= dtp[16 * tb + t]; vb *= dtp[16 * tb + t + 1]; }
                    colp2[8 * tb + (t >> 1)] = pk2(va, vb); }
                asm volatile("" ::: "memory"); }
            if (tid < 384) {
                LAS bf16* rowp = tid < 256 ? XT + tid * 72 : BT + (tid - 256) * 72;
#pragma unroll
                for (int i = 0; i < 8; ++i) { v4u o; o.x = colp2[4 * i]; o.y = colp2[4 * i + 1]; o.z = colp2[4 * i + 2]; o.w = colp2[4 * i + 3]; *(LAS v4u*)(rowp + 8 * i) = o; }
            }
            if (tid >= 256) {
                LAS bf16* colp = tid < 384 ? BS + (tid - 256) : CS + (tid - 384);
#pragma unroll
                for (int t = 0; t < 32; ++t) { colp[(2 * t) * 136] = (bf16)(colp2[t] & 0xffffu); colp[(2 * t + 1) * 136] = (bf16)(colp2[t] >> 16); }
            }
        }
#pragma unroll
        for (int i = 0; i < 4; ++i) *(LAS v4u*)(ZS + lane * 32 + 8 * i) = zr[i];
        __syncthreads();
        {
            const int mt = w >> 1;
#pragma unroll
            for (int q = 0; q < 2; ++q) { const int nt = 2 * (w & 1) + q; f32x4 acc = {0.f, 0.f, 0.f, 0.f};
#pragma unroll
                for (int ks = 0; ks < 4; ++ks) acc = MFMA16(ldfrag(CS, 136, 16 * mt, 32 * ks, lane), ldfrag(BS, 136, 16 * nt, 32 * ks, lane), acc);
#pragma unroll
                for (int r = 0; r < 4; ++r) CBS[(16 * mt + 4 * quad + r) * 72 + 16 * nt + l15] = (bf16)f2bf(acc[r]); }
        }
        __syncthreads();
        const LAS float* gm = GAM + hl * 64; const LAS float* dv = DTV + hl * 64;
        const float last = gm[63];
        f32x4 y[4][2];
        {
#pragma unroll
            for (int mt = 0; mt < 4; ++mt)
#pragma unroll
                for (int nt = 0; nt < 2; ++nt) y[mt][nt] = (f32x4){0.f, 0.f, 0.f, 0.f};
#pragma unroll
            for (int ks = 0; ks < 4; ++ks) { const bf16x8 hb0 = acc2frag(hacc[2 * ks][0], hacc[2 * ks + 1][0]), hb1 = acc2frag(hacc[2 * ks][1], hacc[2 * ks + 1][1]);
#pragma unroll
                for (int mt = 0; mt < 4; ++mt) { const bf16x8 a = ldfrag_perm(CS, 136, 16 * mt, 32 * ks, lane); y[mt][0] = MFMA16(a, hb0, y[mt][0]); y[mt][1] = MFMA16(a, hb1, y[mt][1]); }
                __builtin_amdgcn_sched_barrier(0); }
#pragma unroll
            for (int mt = 0; mt < 4; ++mt)
#pragma unroll
                for (int r = 0; r < 4; ++r) { const float eg = __expf(gm[16 * mt + 4 * quad + r]); y[mt][0][r] *= eg; y[mt][1][r] *= eg; }
        }
        {
            const int prow = hl * 64 + 32 * ph;
#pragma unroll
            for (int mt = 0; mt < 4; ++mt) { const int i = 16 * mt + l15; const float gi = gm[i], ddt = Dh / dv[i];
#pragma unroll
                for (int ks = 0; ks < 2; ++ks) { if (32 * ks > 16 * mt + 15) continue;
                    const bf16x8 a0 = ldfrag(CBS, 72, 16 * mt, 32 * ks, lane); const v4u aw = __builtin_bit_cast(v4u, a0);
                    const f32x4 g0 = *(const LAS f32x4*)(gm + 32 * ks + 8 * quad), g1 = *(const LAS f32x4*)(gm + 32 * ks + 8 * quad + 4);
                    float cv[8] = {bflo(aw.x), bfhi(aw.x), bflo(aw.y), bfhi(aw.y), bflo(aw.z), bfhi(aw.z), bflo(aw.w), bfhi(aw.w)};
                    const float gj[8] = {g0.x, g0.y, g0.z, g0.w, g1.x, g1.y, g1.z, g1.w};
#pragma unroll
                    for (int jj = 0; jj < 8; ++jj) { const int j = 32 * ks + 8 * quad + jj; float v = i >= j ? cv[jj] * __expf(gi - gj[jj]) : 0.f; if (i == j) v += ddt; cv[jj] = v; }
                    v4u bw; bw.x = pk2(cv[0], cv[1]); bw.y = pk2(cv[2], cv[3]); bw.z = pk2(cv[4], cv[5]); bw.w = pk2(cv[6], cv[7]); const bf16x8 a1 = __builtin_bit_cast(bf16x8, bw);
#pragma unroll
                    for (int nt = 0; nt < 2; ++nt) y[mt][nt] = MFMA16(a1, ldfrag(XT, 72, prow + 16 * nt, 32 * ks, lane), y[mt][nt]); }
                __builtin_amdgcn_sched_barrier(0); }
#pragma unroll
            for (int mt = 0; mt < 4; ++mt)
#pragma unroll
                for (int r = 0; r < 4; ++r) { const int i = 16 * mt + 4 * quad + r; float sq = 0.f;
#pragma unroll
                    for (int nt = 0; nt < 2; ++nt) { const float z = bf2f(ZS[i * 32 + 16 * nt + l15]); const float yz = y[mt][nt][r] * siluf_(z); y[mt][nt][r] = yz; sq += yz * yz; }
                    sq = row16_sum(sq); if (l15 == 0) PS[i * 8 + w] = sq; __builtin_amdgcn_sched_barrier(0); }
            const float el = __expf(last);
#pragma unroll
            for (int mt = 0; mt < 8; ++mt)
#pragma unroll
                for (int nt = 0; nt < 2; ++nt) hacc[mt][nt] = hacc[mt][nt] * el;
#pragma unroll
            for (int ks = 0; ks < 2; ++ks) { const f32x4 g0 = *(const LAS f32x4*)(gm + 32 * ks + 8 * quad), g1 = *(const LAS f32x4*)(gm + 32 * ks + 8 * quad + 4);
                const float ed[8] = {__expf(last - g0.x), __expf(last - g0.y), __expf(last - g0.z), __expf(last - g0.w), __expf(last - g1.x), __expf(last - g1.y), __expf(last - g1.z), __expf(last - g1.w)};
                bf16x8 xw[2];
#pragma unroll
                for (int nt = 0; nt < 2; ++nt) { const v4u xv = __builtin_bit_cast(v4u, ldfrag(XT, 72, prow + 16 * nt, 32 * ks, lane));
                    v4u o; o.x = pk2(bflo(xv.x) * ed[0], bfhi(xv.x) * ed[1]); o.y = pk2(bflo(xv.y) * ed[2], bfhi(xv.y) * ed[3]); o.z = pk2(bflo(xv.z) * ed[4], bfhi(xv.z) * ed[5]); o.w = pk2(bflo(xv.w) * ed[6], bfhi(xv.w) * ed[7]);
                    xw[nt] = __builtin_bit_cast(bf16x8, o); }
#pragma unroll
                for (int mt = 0; mt < 8; ++mt) { const bf16x8 a = ldfrag(BT, 72, 16 * mt, 32 * ks, lane); hacc[mt][0] = MFMA16(a, xw[0], hacc[mt][0]); hacc[mt][1] = MFMA16(a, xw[1], hacc[mt][1]); }
                __builtin_amdgcn_sched_barrier(0); }
        }
        __syncthreads();
#pragma unroll
        for (int mt = 0; mt < 4; ++mt)
#pragma unroll
            for (int r = 0; r < 4; ++r) { const int i = 16 * mt + 4 * quad + r; const f32x4 p0 = *(const LAS f32x4*)(PS + i * 8), p1 = *(const LAS f32x4*)(PS + i * 8 + 4);
                const float rs = rsqrtf((((p0.x + p0.y) + (p0.z + p0.w)) + ((p1.x + p1.y) + (p1.z + p1.w))) * (1.f / 256.f) + EPS);
#pragma unroll
                for (int nt = 0; nt < 2; ++nt) { const int ch = head * 64 + 32 * ph + 16 * nt + l15; YS[(size_t)(r0 + i) * 2048 + ch] = (bf16)f2bf(y[mt][nt][r] * rs * F.A.in[20][ch]); } }
    }
    {
        float* so = (dry ? (float*)(F.ws + WS_T1) : F.out) + (samp ? O_SS : O_SP) - (dry ? O_GP : 0) + (size_t)(bb * SH + head) * SN * SP;
#pragma unroll
        for (int mt = 0; mt < 8; ++mt)
#pragma unroll
            for (int nt = 0; nt < 2; ++nt)
#pragma unroll
                for (int r = 0; r < 4; ++r) so[(size_t)(16 * mt + 4 * quad + r) * SP + 32 * ph + 16 * nt + l15] = hacc[mt][nt][r];
    }
    __syncthreads();
}
constexpr int NCH = SLAB_T / 64;
constexpr int GI_WKN = 0, GI_QG = 17408, GI_KT = 34816, GI_QKM = 53248, GI_IMG = 62464, GI_WV = GI_IMG, GI_SC = GI_IMG + 32768, GI_STRIDE = GI_SC + 256;
constexpr int GDN_ITEMS_MAX = NCH * NB * GH + DB * GH;
constexpr size_t WS_GDN = WS_END;
constexpr size_t WS_END2 = WS_GDN + (size_t)GDN_ITEMS_MAX * GI_STRIDE;
static_assert(WS_END2 <= 500 * MiB, "workspace map fits");
constexpr int GP_QS = 0, GP_KS = 17408, GP_LS = 34816, GP_SC = 51200, GP_HALF = 52224;

__device__ __forceinline__ void gdn_pre_pair(Frame& F, int s, int pair) {
    const bf16* P = (const bf16*)(F.ws + WS_PROJ); const float* SM = (const float*)(F.ws + WS_SM);
    const int tid = F.tid, hb = tid >> 8, ht = tid & 255, wl = (tid >> 6) & 3;
    int lane = F.lane; asm volatile("" : "+v"(lane)); const int quad = lane >> 4, l15 = lane & 15;
    const int it = 2 * pair + hb;
    int bsel, h, r0, c; bool samp;
    if (it < NCH * NB * GH) { samp = false; const int bh = it / NCH; c = it % NCH; bsel = bh >> 3; h = bh & 7; r0 = bsel * SLAB_T + 64 * c; }
    else { samp = true; const int q = it - NCH * NB * GH; bsel = q >> 3; h = q & 7; c = 0; r0 = RP + bsel * DSEQ; }
    unsigned char* img = F.ws + WS_GDN + (size_t)it * GI_STRIDE;
    LAS unsigned char* hbase = F.lds + hb * GP_HALF;
    LAS bf16* QS = (LAS bf16*)(hbase + GP_QS); LAS bf16* KS = (LAS bf16*)(hbase + GP_KS); LAS float* LS = (LAS float*)(hbase + GP_LS);
    LAS float* NQ = (LAS float*)(hbase + GP_SC); LAS float* NK = NQ + 64; LAS float* GAMS = NK + 64; LAS float* BTS = GAMS + 64;
    if (ht < 64) { const size_t r = (size_t)(r0 + lane); const float beta = sigmoidf_(SM[r * 64 + h]); const float g = -__expf(F.A.in[14][h]) * softplusf_(SM[r * 64 + 8 + h] + F.A.in[15][h]);
        GAMS[lane] = wave_incl_scan(g, lane); BTS[lane] = beta; }
    float y[64];
    {
        const float* wcv = F.A.in[12]; const float* bcv = F.A.in[13];
#pragma unroll
        for (int pass = 0; pass < 2; ++pass) {
            if (pass == 0 && ht >= 128) continue;
            const int cidx = ht < 128 ? (pass == 0 ? h * 128 + ht : 1024 + h * 128 + ht) : 2048 + h * 128 + (ht - 128);
            const float w0 = wcv[cidx], w1 = wcv[CONV_CH + cidx], w2 = wcv[2 * CONV_CH + cidx], w3 = wcv[3 * CONV_CH + cidx], bias = bcv[cidx];
            float h0 = 0.f, h1 = 0.f, h2 = 0.f;
            if (c > 0) { const bf16* pp = P + (size_t)(r0 - 3) * NPROJ + cidx; h0 = bf2f(pp[0]); h1 = bf2f(pp[NPROJ]); h2 = bf2f(pp[2 * NPROJ]); }
            else if (samp) { const float* st = F.A.in[2] + (size_t)bsel * 3 * CONV_CH + cidx; h0 = st[0]; h1 = st[CONV_CH]; h2 = st[2 * CONV_CH]; }
            else if (s > 0) { const float* st = (const float*)(F.ws + WS_CARRY_MIX) + ((size_t)(s & 1) * NB + bsel) * 3 * CONV_CH + cidx; h0 = st[0]; h1 = st[CONV_CH]; h2 = st[2 * CONV_CH]; }
            const bf16* pc = P + (size_t)r0 * NPROJ + cidx;
            LAS bf16* dst = (pass == 0 ? QS : KS) + ht;
#pragma unroll
            for (int tb = 0; tb < 4; ++tb) { float raw[16];
#pragma unroll
                for (int t = 0; t < 16; ++t) raw[t] = bf2f(pc[(size_t)(16 * tb + t) * NPROJ]);
#pragma unroll
                for (int t = 0; t < 16; ++t) { float val = bias + w0 * h0 + w1 * h1 + w2 * h2 + w3 * raw[t]; h0 = h1; h1 = h2; h2 = raw[t]; val = siluf_(val);
                    if (ht < 128) dst[(16 * tb + t) * 136] = (bf16)f2bf(val);
                    if (pass == 1) y[16 * tb + t] = val; }
                asm volatile("" ::: "memory"); }
        }
    }
    __syncthreads();
    f32x4 kk[4], qk[4];
    {
        bf16x8 ak[4], aq[4];
#pragma unroll
        for (int ks = 0; ks < 4; ++ks) { ak[ks] = ldfrag(KS, 136, 16 * wl, 32 * ks, lane); aq[ks] = ldfrag(QS, 136, 16 * wl, 32 * ks, lane); }
        f32x4 qq = {0.f, 0.f, 0.f, 0.f};
#pragma unroll
        for (int ks = 0; ks < 4; ++ks) qq = MFMA16(aq[ks], aq[ks], qq);
#pragma unroll
        for (int nt = 0; nt < 4; ++nt) {
            if (nt <= wl) { f32x4 a0 = {0.f, 0.f, 0.f, 0.f}, a1 = {0.f, 0.f, 0.f, 0.f};
#pragma unroll
                for (int ks = 0; ks < 4; ++ks) { const bf16x8 bk = ldfrag(KS, 136, 16 * nt, 32 * ks, lane); a0 = MFMA16(ak[ks], bk, a0); a1 = MFMA16(aq[ks], bk, a1); }
                kk[nt] = a0; qk[nt] = a1; } else { kk[nt] = qq; qk[nt] = qq; } }
        float dk = 0.f, dq = 0.f;
#pragma unroll
        for (int nt = 0; nt < 4; ++nt) if (nt == wl) {
#pragma unroll
            for (int r = 0; r < 4; ++r) if (4 * quad + r == l15) { dk = kk[nt][r]; dq = qq[r]; } }
        if ((l15 >> 2) == quad) { NK[16 * wl + l15] = rsqrtf(dk + EPS); NQ[16 * wl + l15] = rsqrtf(dq + EPS) * 0.08838834764831845f; }
    }
    __syncthreads();
    {
        bf16* QKM = (bf16*)(img + GI_QKM);
#pragma unroll
        for (int nt = 0; nt < 4; ++nt) { const int j = 16 * nt + l15; const float nkj = NK[j], gj = GAMS[j];
#pragma unroll
            for (int r = 0; r < 4; ++r) { const int i = 16 * wl + 4 * quad + r; const float e = __expf(GAMS[i] - gj);
                LS[i * 64 + j] = i > j ? kk[nt][r] * NK[i] * nkj * e * BTS[i] : 0.f;
                QKM[i * 72 + j] = (bf16)f2bf(i >= j ? qk[nt][r] * NQ[i] * nkj * e : 0.f); } }
    }
    const float last = GAMS[63];
    if (ht < 128) {
        bf16* KT = (bf16*)(img + GI_KT) + ht * 72;
#pragma unroll
        for (int i8 = 0; i8 < 8; ++i8) { float t[8];
#pragma unroll
            for (int e = 0; e < 8; ++e) { const int j = 8 * i8 + e; const float kh = y[j] * NK[j]; t[e] = kh * __expf(last - GAMS[j]); y[j] = kh * BTS[j] * __expf(GAMS[j]); }
            v4u o; o.x = pk2(t[0], t[1]); o.y = pk2(t[2], t[3]); o.z = pk2(t[4], t[5]); o.w = pk2(t[6], t[7]); *(GAS v4u*)(KT + 8 * i8) = o; }
    } else {
#pragma unroll
        for (int j = 0; j < 64; ++j) y[j] *= BTS[j];
    }
    __syncthreads();
#pragma unroll
    for (int i = 1; i < 64; ++i) { float acc = y[i];
#pragma unroll
        for (int j4 = 0; j4 < (i + 3) / 4; ++j4) { const f32x4 l = *(const LAS f32x4*)(LS + i * 64 + 4 * j4);
            acc -= l.x * y[4 * j4]; if (4 * j4 + 1 < i) acc -= l.y * y[4 * j4 + 1]; if (4 * j4 + 2 < i) acc -= l.z * y[4 * j4 + 2]; if (4 * j4 + 3 < i) acc -= l.w * y[4 * j4 + 3]; }
        y[i] = acc; }
    if (ht < 128) { bf16* WKN = (bf16*)(img + GI_WKN) + ht;
#pragma unroll
        for (int i = 0; i < 64; ++i) WKN[i * 136] = (bf16)f2bf(-y[i]); }
    else { float* WV = (float*)(img + GI_WV) + (ht - 128);
#pragma unroll
        for (int i = 0; i < 64; ++i) WV[i * 128] = y[i]; }
    {
        bf16* QG = (bf16*)(img + GI_QG);
#pragma unroll
        for (int q = 0; q < 4; ++q) { const int idx = ht + 256 * q, i = idx >> 4, d8 = (idx & 15) * 8; const v4u x = *(const LAS v4u*)(QS + i * 136 + d8); const float sc = NQ[i] * __expf(GAMS[i]);
            v4u o; o.x = pk2(bflo(x.x) * sc, bfhi(x.x) * sc); o.y = pk2(bflo(x.y) * sc, bfhi(x.y) * sc); o.z = pk2(bflo(x.z) * sc, bfhi(x.z) * sc); o.w = pk2(bflo(x.w) * sc, bfhi(x.w) * sc);
            *(GAS v4u*)(QG + i * 136 + d8) = o; }
        if (ht == 0) *(float*)(img + GI_SC) = __expf(last);
    }
    __syncthreads();
}
__device__ __forceinline__ void phase_gdn_pre(Frame& F, int s) {
    const int npairs = (s == 0 ? GDN_ITEMS_MAX : NCH * NB * GH) / 2;
    for (int p = F.bid; p < npairs; p += F.G) gdn_pre_pair(F, s, p);
}

constexpr int GS_BUF = 0, GS_PSQ = 2 * GI_IMG, GS_ZS = GS_PSQ + 4096;
static_assert(GS_ZS + 8 * 2048 <= RING_BYTES, "GDN sequential LDS map fits");
__device__ __forceinline__ void gdn_seq_job(Frame& F, int s, bool samp, int bb, int h, bool dry = false) {
    const bf16* P = (const bf16*)(F.ws + WS_PROJ); bf16* OG = (bf16*)(F.ws + WS_OG);
    const int w = F.wave;
    int lane = F.lane; asm volatile("" : "+v"(lane)); int quad = lane >> 4, l15 = lane & 15;
    const int nchunk = samp ? 1 : NCH, row0 = samp ? RP + bb * DSEQ : bb * SLAB_T;
    const int item0 = samp ? NCH * NB * GH + bb * GH + h : (bb * GH + h) * NCH;
    const unsigned char* img0 = F.ws + WS_GDN + (size_t)item0 * GI_STRIDE;
    LAS float* PSQ = (LAS float*)(F.lds + GS_PSQ); LAS bf16* ZS = (LAS bf16*)(F.lds + GS_ZS) + w * 1024;
    f32x4 Sacc[8];
    {
        const float* st = samp ? F.A.in[3] : F.out + O_GP; const size_t sb = (size_t)(bb * GH + h) * GDK * GDV;
#pragma unroll
        for (int mt = 0; mt < 8; ++mt)
#pragma unroll
            for (int r = 0; r < 4; ++r) Sacc[mt][r] = (samp || s > 0) ? st[sb + (size_t)(16 * mt + 4 * quad + r) * GDV + 16 * w + l15] : 0.f;
    }
    const float gn = F.A.in[16][16 * w + l15];
#define GDN_STAGE(imgp, bufi) do { for (int pc_ = w; pc_ < GI_IMG / 1024; pc_ += 8) \
        __builtin_amdgcn_global_load_lds((const unsigned*)((imgp) + pc_ * 1024 + lane * 16), (LAS unsigned*)(F.lds + GS_BUF + (bufi) * GI_IMG + pc_ * 1024), 16, 0, 0); } while (0)
    GDN_STAGE(img0, 0);
    f32x4 wv[4];
    { const float* WV = (const float*)(img0 + GI_WV);
#pragma unroll
      for (int mt = 0; mt < 4; ++mt)
#pragma unroll
          for (int r = 0; r < 4; ++r) wv[mt][r] = WV[(16 * mt + 4 * quad + r) * 128 + 16 * w + l15]; }
    v4u zr0, zr1;
    { const GAS v4u* zp = (const GAS v4u*)(P + (size_t)(row0 + lane) * NPROJ + 7168 + h * 128 + 16 * w); zr0 = zp[0]; zr1 = zp[1]; }
    f32x4 Oprev[4];
#pragma unroll
    for (int mt = 0; mt < 4; ++mt) Oprev[mt] = wv[mt];
#define GDN_FINISH(cc) do { const LAS float* ps = PSQ + ((cc) & 1) * 512; const int rb = row0 + 64 * (cc); \
        _Pragma("unroll") for (int mt = 0; mt < 4; ++mt) _Pragma("unroll") for (int r = 0; r < 4; ++r) { const int i = 16 * mt + 4 * quad + r; \
            const f32x4 p0 = *(const LAS f32x4*)(ps + i * 8), p1 = *(const LAS f32x4*)(ps + i * 8 + 4); \
            const float rs = rsqrtf((((p0.x + p0.y) + (p0.z + p0.w)) + ((p1.x + p1.y) + (p1.z + p1.w))) * (1.f / GDV) + EPS); const float z = bf2f(ZS[i * 16 + l15]); \
            OG[(size_t)(rb + i) * D + h * 128 + 16 * w + l15] = (bf16)f2bf(Oprev[mt][r] * rs * gn * siluf_(z)); } } while (0)
    for (int c = 0; c < nchunk; ++c) {
        asm volatile("" : "+v"(lane)); quad = lane >> 4; l15 = lane & 15;
        asm volatile("s_waitcnt vmcnt(0)" ::: "memory");
        __syncthreads();
        const unsigned char* img = img0 + (size_t)c * GI_STRIDE;
        f32x4 wvn[4];
        const float el = *(const float*)(img + GI_SC);
        if (c + 1 < nchunk) { GDN_STAGE(img + GI_STRIDE, (c + 1) & 1);
            const float* WV = (const float*)(img + GI_STRIDE + GI_WV);
#pragma unroll
            for (int mt = 0; mt < 4; ++mt)
#pragma unroll
                for (int r = 0; r < 4; ++r) wvn[mt][r] = WV[(16 * mt + 4 * quad + r) * 128 + 16 * w + l15]; }
        else {
#pragma unroll
            for (int mt = 0; mt < 4; ++mt) wvn[mt] = wv[mt]; }
        if (c > 0) GDN_FINISH(c - 1);
        *(LAS v4u*)(ZS + lane * 16) = zr0; *(LAS v4u*)(ZS + lane * 16 + 8) = zr1;
        if (c + 1 < nchunk) { const GAS v4u* zp = (const GAS v4u*)(P + (size_t)(row0 + 64 * (c + 1) + lane) * NPROJ + 7168 + h * 128 + 16 * w); zr0 = zp[0]; zr1 = zp[1]; }
        const LAS unsigned char* buf = F.lds + GS_BUF + (c & 1) * GI_IMG;
        const LAS bf16* WKN = (const LAS bf16*)(buf + GI_WKN); const LAS bf16* QG = (const LAS bf16*)(buf + GI_QG); const LAS bf16* KT = (const LAS bf16*)(buf + GI_KT); const LAS bf16* QKM = (const LAS bf16*)(buf + GI_QKM);
        f32x4 U[4], O[4];
#pragma unroll
        for (int mt = 0; mt < 4; ++mt) { U[mt] = wv[mt]; O[mt] = (f32x4){0.f, 0.f, 0.f, 0.f}; }
#pragma unroll
        for (int ks = 0; ks < 4; ++ks) { const bf16x8 Sb = acc2frag(Sacc[2 * ks], Sacc[2 * ks + 1]);
#pragma unroll
            for (int mt = 0; mt < 4; ++mt) { U[mt] = MFMA16(ldfrag_perm(WKN, 136, 16 * mt, 32 * ks, lane), Sb, U[mt]); O[mt] = MFMA16(ldfrag_perm(QG, 136, 16 * mt, 32 * ks, lane), Sb, O[mt]); } }
        bf16x8 Ub[2];
#pragma unroll
        for (int ks = 0; ks < 2; ++ks) Ub[ks] = acc2frag(U[2 * ks], U[2 * ks + 1]);
#pragma unroll
        for (int ks = 0; ks < 2; ++ks)
#pragma unroll
            for (int mt = 0; mt < 4; ++mt) O[mt] = MFMA16(ldfrag_perm(QKM, 72, 16 * mt, 32 * ks, lane), Ub[ks], O[mt]);
#pragma unroll
        for (int mt = 0; mt < 8; ++mt) { Sacc[mt] = Sacc[mt] * el;
#pragma unroll
            for (int ks = 0; ks < 2; ++ks) Sacc[mt] = MFMA16(ldfrag_perm(KT, 72, 16 * mt, 32 * ks, lane), Ub[ks], Sacc[mt]); }
        { LAS float* ps = PSQ + (c & 1) * 512;
#pragma unroll
          for (int mt = 0; mt < 4; ++mt)
#pragma unroll
              for (int r = 0; r < 4; ++r) { const float sq = row16_sum(O[mt][r] * O[mt][r]); if (l15 == 0) ps[(16 * mt + 4 * quad + r) * 8 + w] = sq; Oprev[mt][r] = O[mt][r]; } }
#pragma unroll
        for (int mt = 0; mt < 4; ++mt) wv[mt] = wvn[mt];
    }
    __syncthreads();
    GDN_FINISH(nchunk - 1);
#undef GDN_FINISH
#undef GDN_STAGE
    {
        float* so = (dry ? (float*)(F.ws + WS_T1) : F.out) + (samp ? O_GS : O_GP) - (dry ? O_GP : 0) + (size_t)(bb * GH + h) * GDK * GDV;
#pragma unroll
        for (int mt = 0; mt < 8; ++mt)
#pragma unroll
            for (int r = 0; r < 4; ++r) so[(size_t)(16 * mt + 4 * quad + r) * GDV + 16 * w + l15] = Sacc[mt][r];
    }
    __syncthreads();
}
constexpr int SI_CS = 0, SI_BT = 17408, SI_CB = 35840, SI_DT = 45056, SI_GAM = 46080, SI_IMG = 47104, SI_XT = SI_IMG, SI_STRIDE = SI_IMG + 32768;
constexpr int SSD_ITEMS_MAX = NCH * NB * SG + DB * SG;
constexpr size_t WS_SSD = WS_END2;
constexpr size_t WS_END3 = WS_SSD + (size_t)SSD_ITEMS_MAX * SI_STRIDE;
static_assert(WS_END3 <= 500 * MiB, "workspace map fits");
constexpr int SP_CS = 0, SP_BS = 17408, SP_DT = 34816, SP_GAM = 35840;

__device__ __forceinline__ void ssd_pre_item(Frame& F, int s, int it) {
    const bf16* P = (const bf16*)(F.ws + WS_PROJ); const float* SM = (const float*)(F.ws + WS_SM);
    const int tid = F.tid, w = F.wave;
    int lane = F.lane; asm volatile("" : "+v"(lane)); const int quad = lane >> 4, l15 = lane & 15;
    int bsel, g, r0, c; bool samp;
    if (it < NCH * NB * SG) { samp = false; const int bg = it / NCH; c = it % NCH; bsel = bg >> 3; g = bg & 7; r0 = bsel * SLAB_T + 64 * c; }
    else { samp = true; const int q = it - NCH * NB * SG; bsel = q >> 3; g = q & 7; c = 0; r0 = RP + bsel * DSEQ; }
    unsigned char* img = F.ws + WS_SSD + (size_t)it * SI_STRIDE;
    LAS bf16* CS = (LAS bf16*)(F.lds + SP_CS); LAS bf16* BS = (LAS bf16*)(F.lds + SP_BS); LAS float* DTV = (LAS float*)(F.lds + SP_DT); LAS float* GAM = (LAS float*)(F.lds + SP_GAM);
    if (tid < 256) { const int hh = 4 * g + (tid >> 6); const float dt = softplusf_(SM[(size_t)(r0 + lane) * 64 + 16 + hh] + F.A.in[18][hh]);
        const float ga = wave_incl_scan(dt * (-__expf(F.A.in[17][hh])), lane); DTV[(tid >> 6) * 64 + lane] = dt; GAM[(tid >> 6) * 64 + lane] = ga;
        ((float*)(img + SI_DT))[(tid >> 6) * 64 + lane] = dt; ((float*)(img + SI_GAM))[(tid >> 6) * 64 + lane] = ga; }
    __syncthreads();
    {
        const int cidx = tid < 256 ? 3072 + g * 256 + tid : (tid < 384 ? 5120 + g * 128 + (tid - 256) : 6144 + g * 128 + (tid - 384));
        const float* wcv = F.A.in[12]; const float w0 = wcv[cidx], w1 = wcv[CONV_CH + cidx], w2 = wcv[2 * CONV_CH + cidx], w3 = wcv[3 * CONV_CH + cidx], bias = F.A.in[13][cidx];
        float h0 = 0.f, h1 = 0.f, h2 = 0.f;
        if (c > 0) { const bf16* pp = P + (size_t)(r0 - 3) * NPROJ + cidx; h0 = bf2f(pp[0]); h1 = bf2f(pp[NPROJ]); h2 = bf2f(pp[2 * NPROJ]); }
        else if (samp) { const float* st = F.A.in[2] + (size_t)bsel * 3 * CONV_CH + cidx; h0 = st[0]; h1 = st[CONV_CH]; h2 = st[2 * CONV_CH]; }
        else if (s > 0) { const float* st = (const float*)(F.ws + WS_CARRY_MIX) + ((size_t)(s & 1) * NB + bsel) * 3 * CONV_CH + cidx; h0 = st[0]; h1 = st[CONV_CH]; h2 = st[2 * CONV_CH]; }
        unsigned colp2[32];
        const bf16* pc = P + (size_t)r0 * NPROJ + cidx;
        const LAS float* dtp = DTV + (tid < 256 ? (tid >> 6) * 64 : 0);
#pragma unroll
        for (int tb = 0; tb < 2; ++tb) { float raw[32];
#pragma unroll
            for (int t = 0; t < 32; ++t) raw[t] = bf2f(pc[(size_t)(32 * tb + t) * NPROJ]);
#pragma unroll
            for (int t = 0; t < 32; t += 2) { float va = bias + w0 * h0 + w1 * h1 + w2 * h2 + w3 * raw[t]; float vb = bias + w0 * h1 + w1 * h2 + w2 * raw[t] + w3 * raw[t + 1]; h0 = h2; h1 = raw[t]; h2 = raw[t + 1];
                va = siluf_(va); vb = siluf_(vb); if (tid < 256) { va *= dtp[32 * tb + t]; vb *= dtp[32 * tb + t + 1]; }
                colp2[16 * tb + (t >> 1)] = pk2(va, vb); }
            asm volatile("" ::: "memory"); }
        if (tid < 384) {
            bf16* rowp = tid < 256 ? (bf16*)(img + SI_XT) + tid * 64 : (bf16*)(img + SI_BT) + (tid - 256) * 72;
#pragma unroll
            for (int i = 0; i < 8; ++i) { v4u o; o.x = colp2[4 * i]; o.y = colp2[4 * i + 1]; o.z = colp2[4 * i + 2]; o.w = colp2[4 * i + 3]; *(GAS v4u*)(rowp + 8 * i) = o; }
        }
        if (tid >= 256) {
            LAS bf16* colp = tid < 384 ? BS + (tid - 256) : CS + (tid - 384);
#pragma unroll
            for (int t = 0; t < 32; ++t) { colp[(2 * t) * 136] = (bf16)(colp2[t] & 0xffffu); colp[(2 * t + 1) * 136] = (bf16)(colp2[t] >> 16); }
        }
    }
    __syncthreads();
    {
        const int mt = w >> 1; bf16* CBG = (bf16*)(img + SI_CB);
#pragma unroll
        for (int q = 0; q < 2; ++q) { const int nt = 2 * (w & 1) + q; f32x4 acc = {0.f, 0.f, 0.f, 0.f};
#pragma unroll
            for (int ks = 0; ks < 4; ++ks) acc = MFMA16(ldfrag(CS, 136, 16 * mt, 32 * ks, lane), ldfrag(BS, 136, 16 * nt, 32 * ks, lane), acc);
#pragma unroll
            for (int r = 0; r < 4; ++r) CBG[(16 * mt + 4 * quad + r) * 72 + 16 * nt + l15] = (bf16)f2bf(acc[r]); }
    }
    for (int i = tid; i < 17408 / 16; i += NTHR) *(GAS v4u*)(img + SI_CS + 16 * i) = *(const LAS v4u*)(F.lds + SP_CS + 16 * i);
    __syncthreads();
}
__device__ __forceinline__ void phase_ssd_pre(Frame& F, int s) {
    const int nitems = s == 0 ? SSD_ITEMS_MAX : NCH * NB * SG;
    for (int it = F.bid; it < nitems; it += F.G) ssd_pre_item(F, s, it);
}

constexpr int SQ_BUF = 0, SQ_PS = 2 * SI_IMG, SQ_ZS = SQ_PS + 2048;
static_assert(SQ_ZS + 8 * 4096 <= RING_BYTES, "SSD sequential LDS map fits");
__device__ __forceinline__ void ssd_seq_job(Frame& F, int s, bool samp, int bb, int g, bool dry = false) {
    const bf16* P = (const bf16*)(F.ws + WS_PROJ); bf16* YS = (bf16*)(F.ws + WS_YS);
    const int w = F.wave;
    int lane = F.lane; asm volatile("" : "+v"(lane)); int quad = lane >> 4, l15 = lane & 15;
    const int hl = w >> 1, ph = w & 1, head = 4 * g + hl;
    const int nchunk = samp ? 1 : NCH, row0 = samp ? RP + bb * DSEQ : bb * SLAB_T;
    const int item0 = samp ? NCH * NB * SG + bb * SG + g : (bb * SG + g) * NCH;
    const unsigned char* img0 = F.ws + WS_SSD + (size_t)item0 * SI_STRIDE;
    LAS float* PS = (LAS float*)(F.lds + SQ_PS); LAS bf16* ZS = (LAS bf16*)(F.lds + SQ_ZS) + w * 2048;
    f32x4 hacc[8][2];
    {
        const float* st = samp ? F.A.in[4] : F.out + O_SP;
        const size_t sb = (size_t)(bb * SH + head) * SN * SP;
#pragma unroll
        for (int mt = 0; mt < 8; ++mt)
#pragma unroll
            for (int nt = 0; nt < 2; ++nt)
#pragma unroll
                for (int r = 0; r < 4; ++r) { const int n = 16 * mt + 4 * quad + r, p = 32 * ph + 16 * nt + l15; hacc[mt][nt][r] = (samp || s > 0) ? st[sb + (size_t)n * SP + p] : 0.f; }
    }
    const float Dh = F.A.in[19][head];
    const int prow = hl * 64 + 32 * ph;
#define SSD_STAGE(imgp, bufi) do { for (int pc_ = w; pc_ < SI_IMG / 1024; pc_ += 8) \
        __builtin_amdgcn_global_load_lds((const unsigned*)((imgp) + pc_ * 1024 + lane * 16), (LAS unsigned*)(F.lds + SQ_BUF + (bufi) * SI_IMG + pc_ * 1024), 16, 0, 0); } while (0)
#define SSD_LOADXT(dst, imgp) do { const bf16* xb_ = (const bf16*)((imgp) + SI_XT); _Pragma("unroll") for (int nt = 0; nt < 2; ++nt) _Pragma("unroll") for (int ks = 0; ks < 2; ++ks) \
        dst[nt][ks] = *(const GAS v4u*)(xb_ + (prow + 16 * nt + l15) * 64 + 32 * ks + 8 * quad); } while (0)
    SSD_STAGE(img0, 0);
    v4u xt[2][2];
    SSD_LOADXT(xt, img0);
    for (int c = 0; c < nchunk; ++c) {
        asm volatile("" : "+v"(lane)); quad = lane >> 4; l15 = lane & 15;
        asm volatile("s_waitcnt vmcnt(0)" ::: "memory");
        __syncthreads();
        const unsigned char* img = img0 + (size_t)c * SI_STRIDE;
        const int r0 = row0 + 64 * c;
        v4u xtn[2][2];
        if (c + 1 < nchunk) { SSD_STAGE(img + SI_STRIDE, (c + 1) & 1); SSD_LOADXT(xtn, img + SI_STRIDE); }
        else {
#pragma unroll
            for (int nt = 0; nt < 2; ++nt)
#pragma unroll
                for (int ks = 0; ks < 2; ++ks) xtn[nt][ks] = xt[nt][ks]; }
        v4u zr[4];
        { const GAS v4u* zp = (const GAS v4u*)(P + (size_t)(r0 + lane) * NPROJ + 8192 + head * 64 + 32 * ph);
#pragma unroll
          for (int i = 0; i < 4; ++i) zr[i] = zp[i]; }
        const LAS unsigned char* buf = F.lds + SQ_BUF + (c & 1) * SI_IMG;
        const LAS bf16* CS = (const LAS bf16*)(buf + SI_CS); const LAS bf16* BT = (const LAS bf16*)(buf + SI_BT); const LAS bf16* CBS = (const LAS bf16*)(buf + SI_CB);
        const LAS float* gm = (const LAS float*)(buf + SI_GAM) + hl * 64; const LAS float* dv = (const LAS float*)(buf + SI_DT) + hl * 64;
        const float last = gm[63];
        f32x4 y[4][2];
#pragma unroll
        for (int mt = 0; mt < 4; ++mt)
#pragma unroll
            for (int nt = 0; nt < 2; ++nt) y[mt][nt] = (f32x4){0.f, 0.f, 0.f, 0.f};
#pragma unroll
        for (int ks = 0; ks < 4; ++ks) { const bf16x8 hb0 = acc2frag(hacc[2 * ks][0], hacc[2 * ks + 1][0]), hb1 = acc2frag(hacc[2 * ks][1], hacc[2 * ks + 1][1]);
#pragma unroll
            for (int mt = 0; mt < 4; ++mt) { const bf16x8 a = ldfrag_perm(CS, 136, 16 * mt, 32 * ks, lane); y[mt][0] = MFMA16(a, hb0, y[mt][0]); y[mt][1] = MFMA16(a, hb1, y[mt][1]); }
            __builtin_amdgcn_sched_barrier(0); }
#pragma unroll
        for (int i = 0; i < 4; ++i) *(LAS v4u*)(ZS + lane * 32 + 8 * i) = zr[i];
#pragma unroll
        for (int mt = 0; mt < 4; ++mt)
#pragma unroll
            for (int r = 0; r < 4; ++r) { const float eg = __expf(gm[16 * mt + 4 * quad + r]); y[mt][0][r] *= eg; y[mt][1][r] *= eg; }
#pragma unroll
        for (int mt = 0; mt < 4; ++mt) { const int i = 16 * mt + l15; const float gi = gm[i], ddt = Dh / dv[i];
#pragma unroll
            for (int ks = 0; ks < 2; ++ks) { if (32 * ks > 16 * mt + 15) continue;
                const v4u aw = __builtin_bit_cast(v4u, ldfrag(CBS, 72, 16 * mt, 32 * ks, lane));
                const f32x4 g0 = *(const LAS f32x4*)(gm + 32 * ks + 8 * quad), g1 = *(const LAS f32x4*)(gm + 32 * ks + 8 * quad + 4);
                float cv[8] = {bflo(aw.x), bfhi(aw.x), bflo(aw.y), bfhi(aw.y), bflo(aw.z), bfhi(aw.z), bflo(aw.w), bfhi(aw.w)};
                const float gj[8] = {g0.x, g0.y, g0.z, g0.w, g1.x, g1.y, g1.z, g1.w};
#pragma unroll
                for (int jj = 0; jj < 8; ++jj) { const int j = 32 * ks + 8 * quad + jj; float v = i >= j ? cv[jj] * __expf(gi - gj[jj]) : 0.f; if (i == j) v += ddt; cv[jj] = v; }
                v4u bw; bw.x = pk2(cv[0], cv[1]); bw.y = pk2(cv[2], cv[3]); bw.z = pk2(cv[4], cv[5]); bw.w = pk2(cv[6], cv[7]); const bf16x8 a1 = __builtin_bit_cast(bf16x8, bw);
#pragma unroll
                for (int nt = 0; nt < 2; ++nt) y[mt][nt] = MFMA16(a1, __builtin_bit_cast(bf16x8, xt[nt][ks]), y[mt][nt]); }
            __builtin_amdgcn_sched_barrier(0); }
#pragma unroll
        for (int mt = 0; mt < 4; ++mt)
#pragma unroll
            for (int r = 0; r < 4; ++r) { const int i = 16 * mt + 4 * quad + r; float sq = 0.f;
#pragma unroll
                for (int nt = 0; nt < 2; ++nt) { const float z = bf2f(ZS[i * 32 + 16 * nt + l15]); const float yz = y[mt][nt][r] * siluf_(z); y[mt][nt][r] = yz; sq += yz * yz; }
                sq = row16_sum(sq); if (l15 == 0) PS[i * 8 + w] = sq; }
        {
            const float el = __expf(last);
#pragma unroll
            for (int mt = 0; mt < 8; ++mt)
#pragma unroll
                for (int nt = 0; nt < 2; ++nt) hacc[mt][nt] = hacc[mt][nt] * el;
#pragma unroll
            for (int ks = 0; ks < 2; ++ks) { const f32x4 g0 = *(const LAS f32x4*)(gm + 32 * ks + 8 * quad), g1 = *(const LAS f32x4*)(gm + 32 * ks + 8 * quad + 4);
                const float ed[8] = {__expf(last - g0.x), __expf(last - g0.y), __expf(last - g0.z), __expf(last - g0.w), __expf(last - g1.x), __expf(last - g1.y), __expf(last - g1.z), __expf(last - g1.w)};
                bf16x8 xw[2];
#pragma unroll
                for (int nt = 0; nt < 2; ++nt) { const v4u xv = xt[nt][ks];
                    v4u o; o.x = pk2(bflo(xv.x) * ed[0], bfhi(xv.x) * ed[1]); o.y = pk2(bflo(xv.y) * ed[2], bfhi(xv.y) * ed[3]); o.z = pk2(bflo(xv.z) * ed[4], bfhi(xv.z) * ed[5]); o.w = pk2(bflo(xv.w) * ed[6], bfhi(xv.w) * ed[7]);
                    xw[nt] = __builtin_bit_cast(bf16x8, o); }
#pragma unroll
                for (int mt = 0; mt < 8; ++mt) { const bf16x8 a = ldfrag(BT, 72, 16 * mt, 32 * ks, lane); hacc[mt][0] = MFMA16(a, xw[0], hacc[mt][0]); hacc[mt][1] = MFMA16(a, xw[1], hacc[mt][1]); }
                __builtin_amdgcn_sched_barrier(0); }
        }
        __syncthreads();
#pragma unroll
        for (int mt = 0; mt < 4; ++mt)
#pragma unroll
            for (int r = 0; r < 4; ++r) { const int i = 16 * mt + 4 * quad + r; const f32x4 p0 = *(const LAS f32x4*)(PS + i * 8), p1 = *(const LAS f32x4*)(PS + i * 8 + 4);
                const float rs = rsqrtf((((p0.x + p0.y) + (p0.z + p0.w)) + ((p1.x + p1.y) + (p1.z + p1.w))) * (1.f / 256.f) + EPS);
#pragma unroll
                for (int nt = 0; nt < 2; ++nt) { const int ch = head * 64 + 32 * ph + 16 * nt + l15; YS[(size_t)(r0 + i) * 2048 + ch] = (bf16)f2bf(y[mt][nt][r] * rs * F.A.in[20][ch]); } }
#pragma unroll
        for (int nt = 0; nt < 2; ++nt)
#pragma unroll
            for (int ks = 0; ks < 2; ++ks) xt[nt][ks] = xtn[nt][ks];
    }
#undef SSD_STAGE
#undef SSD_LOADXT
    {
        float* so = (dry ? (float*)(F.ws + WS_T1) : F.out) + (samp ? O_SS : O_SP) - (dry ? O_GP : 0) + (size_t)(bb * SH + head) * SN * SP;
#pragma unroll
        for (int mt = 0; mt < 8; ++mt)
#pragma unroll
            for (int nt = 0; nt < 2; ++nt)
#pragma unroll
                for (int r = 0; r < 4; ++r) so[(size_t)(16 * mt + 4 * quad + r) * SP + 32 * ph + 16 * nt + l15] = hacc[mt][nt][r];
    }
    __syncthreads();
}
__device__ __forceinline__ void gdn_naive_job(Frame& F, int s, bool samp, int bb, int h) {
    const bf16* P = (const bf16*)(F.ws + WS_PROJ); const float* SM = (const float*)(F.ws + WS_SM); bf16* OG = (bf16*)(F.ws + WS_OG);
    LAS float* qs = (LAS float*)F.lds; LAS float* ks = qs + 128; LAS float* vs = ks + 128; LAS float* part = vs + 128;
    LAS float* red = part + 8; LAS float* red2 = red + 512; LAS float* part2 = red2 + 512;
    const int tid = F.tid, v = tid & 127, kq = tid >> 7, ntok = samp ? DSEQ : SLAB_T, row0 = samp ? RP + bb * DSEQ : bb * SLAB_T;
    float S[32];
    const size_t sbase = ((size_t)(bb * GH + h) * GDK + kq * 32) * GDV + v;
    if (samp) { const float* st = F.A.in[3] + sbase;
#pragma unroll
        for (int i = 0; i < 32; ++i) S[i] = st[(size_t)i * GDV]; }
    else if (s == 0) {
#pragma unroll
        for (int i = 0; i < 32; ++i) S[i] = 0.f; }
    else { const float* st = F.out + O_GP + sbase;
#pragma unroll
        for (int i = 0; i < 32; ++i) S[i] = st[(size_t)i * GDV]; }
    const int role = tid >> 7, ch = tid & 127, cidx = role * 1024 + h * 128 + ch;
    float h0 = 0.f, h1 = 0.f, h2 = 0.f, w0 = 0.f, w1 = 0.f, w2 = 0.f, w3 = 0.f, bias = 0.f;
    if (tid < 384) {
        const float* wcv = F.A.in[12]; w0 = wcv[cidx]; w1 = wcv[CONV_CH + cidx]; w2 = wcv[2 * CONV_CH + cidx]; w3 = wcv[3 * CONV_CH + cidx]; bias = F.A.in[13][cidx];
        if (samp) { const float* st = F.A.in[2] + (size_t)bb * 3 * CONV_CH + cidx; h0 = st[0]; h1 = st[CONV_CH]; h2 = st[2 * CONV_CH]; }
        else if (s > 0) { const float* st = (const float*)(F.ws + WS_CARRY_MIX) + ((size_t)(s & 1) * NB + bb) * 3 * CONV_CH + cidx; h0 = st[0]; h1 = st[CONV_CH]; h2 = st[2 * CONV_CH]; }
    }
    const float Aexp = __expf(F.A.in[14][h]), dtb = F.A.in[15][h], gnorm = F.A.in[16][v];
    for (int t = 0; t < ntok; ++t) {
        const size_t r = (size_t)(row0 + t);
        if (tid < 384) {
            const float raw = bf2f(P[r * NPROJ + cidx]);
            float val = bias + w0 * h0 + w1 * h1 + w2 * h2 + w3 * raw; h0 = h1; h1 = h2; h2 = raw; val = siluf_(val);
            qs[role * 128 + ch] = val;
            if (role < 2) { const float sq = wave_sum(val * val); if (F.lane == 0) part[F.wave] = sq; }
        }
        __syncthreads();
        const float qsc = rsqrtf(part[0] + part[1] + EPS) * 0.08838834764831845f, ksc = rsqrtf(part[2] + part[3] + EPS);
        const float beta = sigmoidf_(SM[r * 64 + h]); const float g = -Aexp * softplusf_(SM[r * 64 + 8 + h] + dtb); const float a = __expf(g);
        float kn[32]; float p = 0.f;
#pragma unroll
        for (int i = 0; i < 32; ++i) { kn[i] = ks[kq * 32 + i] * ksc; p += kn[i] * S[i]; }
        red[kq * 128 + v] = p;
        __syncthreads();
        const float kS = (red[v] + red[128 + v]) + (red[256 + v] + red[384 + v]);
        const float d = beta * (vs[v] - a * kS);
        float po = 0.f;
#pragma unroll
        for (int i = 0; i < 32; ++i) { S[i] = a * S[i] + kn[i] * d; po += qs[kq * 32 + i] * qsc * S[i]; }
        red2[kq * 128 + v] = po;
        __syncthreads();
        float o = 0.f;
        if (tid < 128) { o = (red2[v] + red2[128 + v]) + (red2[256 + v] + red2[384 + v]); const float sq = wave_sum(o * o); if (F.lane == 0) part2[F.wave] = sq; }
        __syncthreads();
        if (tid < 128) { const float rs = rsqrtf((part2[0] + part2[1]) * (1.f / GDV) + EPS); const float z = bf2f(P[r * NPROJ + 7168 + h * 128 + v]);
            OG[r * D + h * 128 + v] = (bf16)f2bf(o * rs * gnorm * siluf_(z)); }
    }
    float* so = F.out + (samp ? O_GS : O_GP) + sbase;
#pragma unroll
    for (int i = 0; i < 32; ++i) so[(size_t)i * GDV] = S[i];
    __syncthreads();
}
__device__ __forceinline__ void ssd_naive_job(Frame& F, int s, bool samp, int bb, int g) {
    const bf16* P = (const bf16*)(F.ws + WS_PROJ); const float* SM = (const float*)(F.ws + WS_SM); bf16* YS = (bf16*)(F.ws + WS_YS);
    LAS float* xs = (LAS float*)F.lds; LAS float* Bs = xs + 256; LAS float* Cs = Bs + 128; LAS float* red = Cs + 128; LAS float* part = red + 512;
    const int tid = F.tid, hl = tid >> 7, p = tid & 63, nh = (tid >> 6) & 1, head = 4 * g + hl, ntok = samp ? DSEQ : SLAB_T, row0 = samp ? RP + bb * DSEQ : bb * SLAB_T;
    float hr[64];
    const size_t sbase = ((size_t)(bb * SH + head) * SN + nh * 64) * SP + p;
    if (samp) { const float* st = F.A.in[4] + sbase;
#pragma unroll
        for (int i = 0; i < 64; ++i) hr[i] = st[(size_t)i * SP]; }
    else if (s == 0) {
#pragma unroll
        for (int i = 0; i < 64; ++i) hr[i] = 0.f; }
    else { const float* st = F.out + O_SP + sbase;
#pragma unroll
        for (int i = 0; i < 64; ++i) hr[i] = st[(size_t)i * SP]; }
    const int cidx = tid < 256 ? 3072 + g * 256 + tid : (tid < 384 ? 5120 + g * 128 + (tid - 256) : 6144 + g * 128 + (tid - 384));
    const float* wcv = F.A.in[12]; const float w0 = wcv[cidx], w1 = wcv[CONV_CH + cidx], w2 = wcv[2 * CONV_CH + cidx], w3 = wcv[3 * CONV_CH + cidx], bias = F.A.in[13][cidx];
    float h0 = 0.f, h1 = 0.f, h2 = 0.f;
    if (samp) { const float* st = F.A.in[2] + (size_t)bb * 3 * CONV_CH + cidx; h0 = st[0]; h1 = st[CONV_CH]; h2 = st[2 * CONV_CH]; }
    else if (s > 0) { const float* st = (const float*)(F.ws + WS_CARRY_MIX) + ((size_t)(s & 1) * NB + bb) * 3 * CONV_CH + cidx; h0 = st[0]; h1 = st[CONV_CH]; h2 = st[2 * CONV_CH]; }
    const float aneg = -__expf(F.A.in[17][head]), dtb = F.A.in[18][head], Dh = F.A.in[19][head], nw = F.A.in[20][head * 64 + p];
    for (int t = 0; t < ntok; ++t) {
        const size_t r = (size_t)(row0 + t);
        { const float raw = bf2f(P[r * NPROJ + cidx]); float val = bias + w0 * h0 + w1 * h1 + w2 * h2 + w3 * raw; h0 = h1; h1 = h2; h2 = raw; xs[tid] = siluf_(val); }
        __syncthreads();
        const float dt = softplusf_(SM[r * 64 + 16 + head] + dtb), dA = __expf(dt * aneg), x = xs[hl * 64 + p], dx = dt * x;
        float py = 0.f;
#pragma unroll
        for (int i = 0; i < 64; ++i) { hr[i] = dA * hr[i] + dx * Bs[nh * 64 + i]; py += Cs[nh * 64 + i] * hr[i]; }
        red[tid] = py;
        __syncthreads();
        float yz = 0.f;
        if (nh == 0) { const float y = red[tid] + red[tid + 64] + Dh * x; const float z = bf2f(P[r * NPROJ + 8192 + head * 64 + p]); yz = y * siluf_(z);
            const float sq = wave_sum(yz * yz); if (F.lane == 0) part[F.wave] = sq; }
        __syncthreads();
        if (nh == 0) { const float rs = rsqrtf(((part[0] + part[2]) + (part[4] + part[6])) * (1.f / 256.f) + EPS); YS[r * 2048 + head * 64 + p] = (bf16)f2bf(yz * rs * nw); }
    }
    float* so = F.out + (samp ? O_SS : O_SP) + sbase;
#pragma unroll
    for (int i = 0; i < 64; ++i) so[(size_t)i * SP] = hr[i];
    __syncthreads();
}
#ifndef SCAN_REP_GDN
#define SCAN_REP_GDN 0
#endif
#ifndef SCAN_REP_SSD
#define SCAN_REP_SSD 0
#endif
__device__ __forceinline__ void phase_scan(Frame& F, int s) {
    const int njobs = s == 0 ? 192 : 64;
    for (int j = F.bid; j < njobs; j += F.G) {
        if (j < 32) {
#ifdef GDN_NAIVE
            gdn_naive_job(F, s, false, j >> 3, j & 7);
#else
#if SCAN_REP_GDN
            gdn_seq_job(F, s, false, j >> 3, j & 7, true);
#endif
            gdn_seq_job(F, s, false, j >> 3, j & 7);
#endif
        } else if (j < 64) {
#ifndef EXP_NO_SSD
#if SCAN_REP_SSD
            ssd_seq_job(F, s, false, (j - 32) >> 3, (j - 32) & 7, true);
#endif
            ssd_seq_job(F, s, false, (j - 32) >> 3, (j - 32) & 7);
#endif
        }
        else if (j < 128) {
#ifdef GDN_NAIVE
            gdn_naive_job(F, s, true, (j - 64) >> 3, (j - 64) & 7);
#else
            gdn_seq_job(F, s, true, (j - 64) >> 3, (j - 64) & 7);
#endif
        } else {
#ifndef EXP_NO_SSD
            ssd_seq_job(F, s, true, (j - 128) >> 3, (j - 128) & 7);
#endif
        }
    }
}
#define XB_TMO      128
#define XB_XCNT(j)  (256  + 64 * (j))
#define XB_XSUB(j)  (1280 + 64 * (j))
#define XB_XGEN(j)  (2304 + 64 * (j))
#define XB_TOP      3328
#define XB_TOPGEN   3392
#define XCD_BAR_WORDS 3456
#define XB_SPIN_CAP (1u << 18)
__device__ __forceinline__ unsigned xb_ld(unsigned* p)              { return __hip_atomic_load(p, __ATOMIC_RELAXED, __HIP_MEMORY_SCOPE_AGENT); }
__device__ __forceinline__ unsigned xb_add(unsigned* p, unsigned v) { return __hip_atomic_fetch_add(p, v, __ATOMIC_RELAXED, __HIP_MEMORY_SCOPE_AGENT); }
__device__ __forceinline__ unsigned xb_xcc_id() { return (unsigned)__builtin_amdgcn_s_getreg((3 << 11) | 20) & 0xFu; }
#define XB_SPIN(cond, bar) do { unsigned _sp = 0; while (cond) { __builtin_amdgcn_s_sleep(1); \
    if ((++_sp & 255u) == 0u) { if (xb_ld(&(bar)[XB_TMO])) break; if (_sp > XB_SPIN_CAP) { atomicAdd(&(bar)[XB_TMO], 1u); break; } } } } while (0)
struct XcdBarrier { unsigned* bar; unsigned x; volatile LAS unsigned* st; };
__device__ __forceinline__ XcdBarrier xcd_barrier_post(unsigned* bar, volatile LAS unsigned* st) {
    XcdBarrier b; b.bar = bar; b.x = xb_xcc_id(); b.st = st;
    if (threadIdx.x == 0) (void)xb_add(&bar[XB_XCNT(b.x)], 1u);
    return b;
}
__device__ __forceinline__ void xcd_barrier_complete(unsigned* bar, unsigned x, unsigned& nloc, unsigned& nx) {
    const unsigned G = gridDim.x * gridDim.y * gridDim.z;
    unsigned sum, cnt, mine, sp = 0u;
    for (;;) {
        sum = 0u; cnt = 0u; mine = 0u;
#pragma unroll
        for (unsigned j = 0; j < 16; ++j) { const unsigned c = xb_ld(&bar[XB_XCNT(j)]); sum += c; cnt += (c > 0u) ? 1u : 0u; mine = (j == x) ? c : mine; }
        if (sum == G) break;
        __builtin_amdgcn_s_sleep(1);
        if ((++sp & 255u) == 0u) { if (xb_ld(&bar[XB_TMO])) break; if (sp > XB_SPIN_CAP) { atomicAdd(&bar[XB_TMO], 1u); break; } }
    }
    nloc = mine > 0u ? mine : 1u; nx = cnt > 0u ? cnt : 1u;
}
__device__ __forceinline__ void xcd_barrier(const XcdBarrier& b) {
    asm volatile("s_waitcnt vmcnt(0)" ::: "memory");
    __syncthreads();
    if (threadIdx.x == 0) {
        unsigned* bar = b.bar;
        __builtin_amdgcn_s_waitcnt(0);
        unsigned nloc = b.st[0], nx = b.st[1];
        if (nloc == 0u) { xcd_barrier_complete(bar, b.x, nloc, nx); b.st[0] = nloc; b.st[1] = nx; }
        const unsigned old = xb_add(&bar[XB_XSUB(b.x)], 1u);
        const unsigned gen = old / nloc;
        if (old + 1u == (gen + 1u) * nloc) {
            __builtin_amdgcn_fence(__ATOMIC_RELEASE, "agent");
            asm volatile("s_waitcnt vmcnt(0)" ::: "memory");
            const unsigned og = xb_add(&bar[XB_TOP], 1u);
            const unsigned tg = og / nx;
            if (og + 1u == (tg + 1u) * nx) xb_add(&bar[XB_TOPGEN], 1u);
            else XB_SPIN(xb_ld(&bar[XB_TOPGEN]) == tg, bar);
            __builtin_amdgcn_fence(__ATOMIC_ACQUIRE, "agent");
            xb_add(&bar[XB_XGEN(b.x)], 1u);
            asm volatile("s_waitcnt vmcnt(0)" ::: "memory");
        } else {
            XB_SPIN(xb_ld(&bar[XB_XGEN(b.x)]) == gen, bar);
            __builtin_amdgcn_fence(__ATOMIC_ACQUIRE, "agent");
            asm volatile("s_waitcnt vmcnt(0)" ::: "memory");
        }
    }
    __syncthreads();
}
constexpr int CW_BAR = 4096;
#ifndef PHASE_MASK
#define PHASE_MASK 0xFFF
#endif
#define PM(k) ((PHASE_MASK >> (k)) & 1)
#ifndef GEMM_REPS
#define GEMM_REPS 1
#endif
#ifndef PRE_REPS
#define PRE_REPS 1
#endif
constexpr int STEPS_PER_SLAB = 11, NSTEPS = 2 + STEPS_PER_SLAB * NSLAB;
#define GEMM_PHASE(EPI_T, AOFF, BOFF, N_, K_, ...) do { pg8::Gemm g{(const pg8::bf16_t*)(F.ws + (AOFF)), (const pg8::bf16_t*)(F.ws + (BOFF)), R, (N_), (K_)}; \
    pg8::StaticOrder S; S.init(R, (N_), F.G, F.bid); epi::EPI_T E{__VA_ARGS__}; pg8::gemm_phase<epi::EPI_T, pg8::StaticOrder, true, true>(F.lds, g, S, E, F.tid); if (GEMM_REPS > 1) { __syncthreads(); pg8::gemm_phase<epi::EPI_T, pg8::StaticOrder, true, true>(F.lds, g, S, E, F.tid); } } while (0)
__device__ __forceinline__ void run_step(Frame& F, int st) {
    if (st == 0) { if constexpr (PM(10)) phase_prologue0(F); return; }
    if (st == 1) { if constexpr (PM(11)) phase_prologue1(F); return; }
    const int s = (st - 2) / STEPS_PER_SLAB, k = (st - 2) % STEPS_PER_SLAB, R = slab_rows(s);
    unsigned char* ws = F.ws;
    switch (k) {
    case 0: if constexpr (PM(0)) phase_norm1(F, s); break;
    case 1: if constexpr (PM(1)) GEMM_PHASE(EpiProj, WS_HB, WS_WIN, NIN, D, (bf16*)(ws + WS_PROJ), (float*)(ws + WS_SM)); break;
    case 2: if constexpr (PM(2)) {
#if !defined(GDN_NAIVE) && !defined(EXP_NO_PRE)
        for (int rep_ = 0; rep_ < PRE_REPS; ++rep_) phase_gdn_pre(F, s);
        phase_ssd_pre(F, s);
#endif
        } break;
    case 3: if constexpr (PM(2)) {
#ifndef EXP_NO_SCAN
        phase_scan(F, s);
#endif
        phase_mix_carry(F, s); } break;
    case 4: if constexpr (PM(3)) GEMM_PHASE(EpiGate1, WS_OG, WS_WG, D, D, (const bf16*)(ws + WS_PROJ), (float*)(ws + WS_T1)); break;
    case 5: if constexpr (PM(4)) GEMM_PHASE(EpiGate2, WS_YS, WS_WS, D, 2048, (const bf16*)(ws + WS_PROJ), (const float*)(ws + WS_T1), (bf16*)(ws + WS_MIX)); break;
    case 6: if constexpr (PM(5)) GEMM_PHASE(EpiOut, WS_MIX, WS_WOUT, D, D, F.A.in[0], F.A.in[1], (const float*)(ws + WS_MODV), (const float*)(ws + WS_G2), (float*)(ws + WS_X1), (bf16*)(ws + WS_X1G), (float*)(ws + WS_SS1), s); break;
    case 7: if constexpr (PM(6)) GEMM_PHASE(EpiUp, WS_X1G, WS_WUP, NUP, D, (const float*)(ws + WS_SS1), (const float*)(ws + WS_SHW), (bf16*)(ws + WS_U)); break;
    case 8: if constexpr (PM(7)) phase_convact(F, s); break;
    case 9: if constexpr (PM(8)) GEMM_PHASE(EpiDown, WS_ACT, WS_WDN, D, DFF, (const float*)(ws + WS_X1), (const float*)(ws + WS_MODV), F.out + O_YP, F.out + O_YS, (float*)(ws + WS_SS2), s); break;
    default: if constexpr (PM(9)) phase_final(F, s); break;
    }
}
__global__ void __launch_bounds__(NTHR, 2) mk_fwd(Args a) {
    extern __shared__ __attribute__((aligned(16))) unsigned char lds[];
    Frame F(a);
    F.lds = (LAS unsigned char*)lds; F.MISC = (volatile LAS unsigned*)(F.lds + MISC_OFF);
    F.tid = threadIdx.x; F.lane = F.tid & 63; F.wave = __builtin_amdgcn_readfirstlane(F.tid >> 6); F.G = gridDim.x; F.bid = blockIdx.x;
    F.out = a.out; F.ws = a.ws; F.ctl = (gu32*)(a.ws + WS_CTL);
    for (int u = F.tid; u < (LDS_BYTES - LDSCTL_OFF) / 4; u += NTHR) ((LAS unsigned*)(F.lds + LDSCTL_OFF))[u] = 0u;
    __syncthreads();
    XcdBarrier bar; bar.bar = (unsigned*)(F.ctl + CW_BAR); bar.x = 0; bar.st = nullptr;
    const bool multi = (a.ph_hi - a.ph_lo) > 1;
    if (multi) bar = xcd_barrier_post((unsigned*)(F.ctl + CW_BAR), F.MISC + 8);
    for (int st = a.ph_lo; st < a.ph_hi; ++st) {
        { int t_ = threadIdx.x, b_ = blockIdx.x; unsigned char* w_ = a.ws; float* o_ = a.out; asm volatile("" : "+v"(t_), "+s"(b_), "+s"(w_), "+s"(o_));
          F.tid = t_; F.lane = t_ & 63; F.wave = __builtin_amdgcn_readfirstlane(t_ >> 6); F.bid = b_; F.ws = w_; F.out = o_; }
        run_step(F, st);
        if (st + 1 < a.ph_hi) { if (st == a.ph_lo) cooperative_groups::this_grid().sync(); else xcd_barrier(bar); }
    }
}
#ifndef MK_SINGLE
#define MK_SINGLE 1
#endif
extern "C" void kernel_launch(void* const* d_in, const int* in_sizes, int n_in, void* d_out, int out_size, void* d_ws, size_t ws_size, hipStream_t stream) {
    static int grid = 0;
    if (grid == 0) {
        if (n_in != 30 || (size_t)out_size != O_END || ws_size < WS_END3) { fprintf(stderr, "kernel_launch: unexpected shapes: n_in %d out %d ws %zu (need %zu)\n", n_in, out_size, ws_size, (size_t)WS_END3); grid = -1; return; }
        int dev = 0, cus = 0;
        if (hipGetDevice(&dev) != hipSuccess || hipDeviceGetAttribute(&cus, hipDeviceAttributeMultiprocessorCount, dev) != hipSuccess) { grid = -1; return; }
        if (hipFuncSetAttribute((const void*)mk_fwd, hipFuncAttributeMaxDynamicSharedMemorySize, LDS_BYTES) != hipSuccess) { fprintf(stderr, "kernel_launch: hipFuncSetAttribute failed\n"); grid = -1; return; }
        int per_cu = 0;
        if (hipOccupancyMaxActiveBlocksPerMultiprocessor(&per_cu, (const void*)mk_fwd, NTHR, LDS_BYTES) != hipSuccess || per_cu < 1) fprintf(stderr, "kernel_launch: occupancy query says %d\n", per_cu);
        (void)hipGetLastError();
        grid = cus * (per_cu < 1 ? 1 : per_cu);
    }
    if (grid < 0) return;
    (void)hipMemsetAsync((char*)d_ws + WS_CTL, 0, CTL_ZERO_BYTES, stream);
    Args a{};
    for (int i = 0; i < 30; ++i) a.in[i] = (const float*)d_in[i];
    a.out = (float*)d_out; a.ws = (unsigned char*)d_ws;
#if MK_SINGLE
    a.ph_lo = 0; a.ph_hi = NSTEPS;
    void* kargs[] = {(void*)&a};
    hipError_t le = hipLaunchCooperativeKernel((const void*)mk_fwd, dim3(grid), dim3(NTHR), kargs, LDS_BYTES, stream);
    if (le != hipSuccess) fprintf(stderr, "kernel_launch: cooperative launch failed: %s (grid %d)\n", hipGetErrorString(le), grid);
#else
    for (int st = 0; st < NSTEPS; ++st) { a.ph_lo = st; a.ph_hi = st + 1; hipLaunchKernelGGL(mk_fwd, dim3(grid), dim3(NTHR), LDS_BYTES, stream, a); }
#endif
}
```

```cpp
#include <hip/hip_runtime.h>
#include <hip/hip_cooperative_groups.h>
#include <cstdio>
#include <cstdint>

namespace pg8 {
#define PG8_LAS __attribute__((address_space(3)))
typedef unsigned short bf16_t;
typedef short bf16x8 __attribute__((ext_vector_type(8)));
typedef float f32x4 __attribute__((ext_vector_type(4)));
typedef unsigned u32x4 __attribute__((ext_vector_type(4)));
typedef unsigned u32x2 __attribute__((ext_vector_type(2)));
constexpr int BM = 256, BK = 64, HALF = 128, HTB = HALF * BK * 2, STAGE_BYTES = 8 * HTB, NXCD = 8, WGM = 8;

__host__ __device__ __forceinline__ int lds_byte(int r, int c) { const int st = (r >> 4) * 2 + (c >> 5), rr = r & 15, cc = c & 31, ob = rr * 64 + cc * 2; return st * 1024 + (ob ^ (((ob >> 9) & 1) << 5)); }
__host__ __device__ __forceinline__ void stage_rc(int b, int& R, int& C) { const int st = b / 1024, sb = b % 1024, swz = sb ^ (((sb >> 9) & 1) << 5); R = (st >> 1) * 16 + swz / 64; C = (st & 1) * 32 + (swz % 64) / 2; }
__host__ __device__ __forceinline__ int perm32(int rho) { const int n = rho >> 4, i = rho & 15; return 8 * (i >> 2) + 4 * n + (i & 3); }

struct Unit { int pm, pn; };
struct Gemm { const bf16_t* A; const bf16_t* Bt; int M, N, K; };

struct StaticOrder {
    int nM, nN, nwg, G, c;
    __host__ __device__ void init(int M, int N, int G_, int c_) { nM = M / BM; nN = N / BM; nwg = nM * nN; G = G_; c = c_; }
    __host__ __device__ bool next(int i, Unit& u) const {
        const long L = (long)i * G + c; if (L >= nwg) return false;
        int wgid = (int)L; { const int q = nwg / NXCD, r = nwg % NXCD, xcd = wgid % NXCD, off = wgid / NXCD; wgid = (xcd < r ? xcd * (q + 1) : r * (q + 1) + (xcd - r) * q) + off; }
        const int nig = WGM * nN, gid = wgid / nig, fm = gid * WGM, gsz = (nM - fm) < WGM ? (nM - fm) : WGM;
        u.pm = fm + ((wgid % nig) % gsz); u.pn = (wgid % nig) / gsz; return true;
    }
    __device__ __forceinline__ void a_ready(const Unit&) const {}
    __device__ __forceinline__ void done(const Unit&) const {}
};

__device__ __forceinline__ unsigned cvt_pk_bf16(float lo, float hi) { unsigned r; asm volatile("v_cvt_pk_bf16_f32 %0, %1, %2" : "=v"(r) : "v"(lo), "v"(hi)); return r; }

template <class Epi, class Sched, bool ALIGN_EPI = false, bool SP2 = false>
__device__ __forceinline__ void gemm_phase(PG8_LAS unsigned char* lds, const Gemm g, const Sched& S, const Epi& E, const int tid) {
    const int wid = __builtin_amdgcn_readfirstlane(tid >> 6), lane = tid & 63, wr = wid >> 2, wc = wid & 3, fr = lane & 15, fq = lane >> 4;
    const int K = g.K, nt = K / BK;
    unsigned voffA[2], voffB[2];
#pragma unroll
    for (int i = 0; i < 2; ++i) { int R, C; stage_rc(tid * 16 + i * 8192, R, C); const int Rb = Epi::PERM ? ((R & ~31) + perm32(R & 31)) : R;
        voffA[i] = (unsigned)(R * K + C) * 2u; voffB[i] = (unsigned)(Rb * K + C) * 2u; }
    const size_t kstep = (size_t)(BK * 2);
    const size_t hstep = (size_t)HALF * K * 2;
    const size_t tstep = 2 * hstep;
    const unsigned ldsw = (unsigned)wid * 1024u;
    const int aoff = lds_byte(wr * 64 + fr, fq * 8), boff = lds_byte(wc * 32 + fr, fq * 8);
#define PG8_SA(b, h) (((b) * 2 + (h)) * HTB)
#define PG8_SB(b, h) ((4 + (b) * 2 + (h)) * HTB)
#define PG8_STAGE(bufoff, gbase, voff) do { _Pragma("unroll") for (int _i = 0; _i < 2; ++_i) \
        __builtin_amdgcn_global_load_lds((const unsigned*)((const char*)(gbase) + (voff)[_i]), (PG8_LAS unsigned*)(lds + (bufoff) + ldsw + _i * 8192), 16, 0, 0); } while (0)
#define PG8_LDA(dst, b, h) do { _Pragma("unroll") for (int m = 0; m < 4; ++m) _Pragma("unroll") for (int k = 0; k < 2; ++k) dst[m][k] = *(const PG8_LAS bf16x8*)(lds + PG8_SA(b, h) + aoff + m * 2048 + k * 1024); } while (0)
#define PG8_LDB(dst, b, h) do { _Pragma("unroll") for (int n = 0; n < 2; ++n) _Pragma("unroll") for (int k = 0; k < 2; ++k) dst[n][k] = *(const PG8_LAS bf16x8*)(lds + PG8_SB(b, h) + boff + n * 2048 + k * 1024); } while (0)
#define PG8_MMA(ai, bj, At, Bt) do { __builtin_amdgcn_s_setprio(1); _Pragma("unroll") for (int m = 0; m < 4; ++m) _Pragma("unroll") for (int n = 0; n < 2; ++n) _Pragma("unroll") for (int k = 0; k < 2; ++k) \
        acc[ai][bj][m][n] = __builtin_amdgcn_mfma_f32_16x16x32_bf16(Bt[n][k], At[m][k], acc[ai][bj][m][n], 0, 0, 0); __builtin_amdgcn_s_setprio(0); } while (0)
#define PG8_WAIT_V(n) asm volatile("s_waitcnt vmcnt(" #n ")" ::: "memory")
#define PG8_WAIT_L(n) asm volatile("s_waitcnt lgkmcnt(" #n ")" ::: "memory")
#define PG8_BAR __builtin_amdgcn_s_barrier()
#define PG8_SCHED __builtin_amdgcn_sched_barrier(0)
    Unit cur, nxt; int ui = 0;
    if (!S.next(0, cur)) return;
    f32x4 acc[2][2][4][2];
#pragma unroll
    for (int a = 0; a < 2; ++a)
#pragma unroll
        for (int b = 0; b < 2; ++b)
#pragma unroll
            for (int m = 0; m < 4; ++m)
#pragma unroll
                for (int n = 0; n < 2; ++n) acc[a][b][m][n] = (f32x4){0.f, 0.f, 0.f, 0.f};
    bf16x8 At[4][2], B0[2][2], B1[2][2];
    const char* cA = (const char*)g.A + (size_t)cur.pm * tstep; const char* cB = (const char*)g.Bt + (size_t)cur.pn * tstep;
    S.a_ready(cur);
    if constexpr (SP2) {
        PG8_STAGE(PG8_SB(0, 0), cB, voffB); PG8_STAGE(PG8_SB(0, 1), cB + hstep, voffB); PG8_STAGE(PG8_SA(0, 0), cA, voffA); PG8_STAGE(PG8_SA(0, 1), cA + hstep, voffA);
        if (wr == 1) PG8_BAR;
        PG8_WAIT_V(2); PG8_BAR;
        PG8_STAGE(PG8_SB(1, 0), cB + kstep, voffB); PG8_STAGE(PG8_SA(1, 0), cA + kstep, voffA); PG8_STAGE(PG8_SB(1, 1), cB + hstep + kstep, voffB);
        PG8_WAIT_V(6); PG8_BAR;
    } else {
        PG8_STAGE(PG8_SB(0, 0), cB, voffB); PG8_STAGE(PG8_SA(0, 0), cA, voffA); PG8_STAGE(PG8_SB(0, 1), cB + hstep, voffB); PG8_STAGE(PG8_SA(0, 1), cA + hstep, voffA);
        if (wr == 1) PG8_BAR;
        PG8_WAIT_V(4); PG8_BAR;
        PG8_STAGE(PG8_SB(1, 0), cB + kstep, voffB); PG8_STAGE(PG8_SA(1, 0), cA + kstep, voffA); PG8_STAGE(PG8_SB(1, 1), cB + hstep + kstep, voffB);
        PG8_WAIT_V(6); PG8_BAR;
    }
    for (;;) {
        const bool has_next = S.next(ui + 1, nxt);
        const char* nA = has_next ? (const char*)g.A + (size_t)nxt.pm * tstep : cA; const char* nB = has_next ? (const char*)g.Bt + (size_t)nxt.pn * tstep : cB;
        for (int t = 0; t < nt; t += 2) {
            const bool last = (t == nt - 2);
            const char* a1 = cA + (size_t)(t + 1) * kstep;
            const char* a2 = last ? nA : cA + (size_t)(t + 2) * kstep; const char* b2 = last ? nB : cB + (size_t)(t + 2) * kstep;
            const char* a3 = a2 + kstep; const char* b3 = b2 + kstep;
            if (last && has_next) S.a_ready(nxt);
            if constexpr (SP2) {
            PG8_LDB(B0, 0, 0); PG8_LDB(B1, 0, 1); PG8_SCHED; PG8_LDA(At, 0, 0); PG8_STAGE(PG8_SA(1, 1), a1 + hstep, voffA);
            PG8_WAIT_V(8); PG8_WAIT_L(0); PG8_BAR; PG8_MMA(0, 0, At, B0); PG8_MMA(0, 1, At, B1); PG8_BAR; PG8_SCHED;
            PG8_LDA(At, 0, 1); PG8_STAGE(PG8_SB(0, 0), b2, voffB); PG8_STAGE(PG8_SB(0, 1), b2 + hstep, voffB); PG8_STAGE(PG8_SA(0, 0), a2, voffA);
            PG8_WAIT_V(8); PG8_WAIT_L(0); PG8_BAR; PG8_MMA(1, 0, At, B0); PG8_MMA(1, 1, At, B1); PG8_BAR; PG8_SCHED;
            PG8_LDB(B0, 1, 0); PG8_LDB(B1, 1, 1); PG8_SCHED; PG8_LDA(At, 1, 0); PG8_STAGE(PG8_SA(0, 1), a2 + hstep, voffA);
            PG8_WAIT_V(8); PG8_WAIT_L(0); PG8_BAR; PG8_MMA(0, 0, At, B0); PG8_MMA(0, 1, At, B1); PG8_BAR; PG8_SCHED;
            PG8_LDA(At, 1, 1); PG8_STAGE(PG8_SB(1, 0), b3, voffB); PG8_STAGE(PG8_SB(1, 1), b3 + hstep, voffB); PG8_STAGE(PG8_SA(1, 0), a3, voffA);
            PG8_WAIT_V(8); PG8_WAIT_L(0); PG8_BAR; PG8_MMA(1, 0, At, B0); PG8_MMA(1, 1, At, B1); PG8_BAR; PG8_SCHED;
            } else {
            PG8_LDB(B0, 0, 0); PG8_SCHED; PG8_LDA(At, 0, 0); PG8_STAGE(PG8_SA(1, 1), a1 + hstep, voffA);
            PG8_WAIT_L(8); PG8_BAR; PG8_WAIT_L(0); PG8_MMA(0, 0, At, B0); PG8_BAR; PG8_SCHED;
            PG8_LDB(B1, 0, 1); PG8_STAGE(PG8_SB(0, 0), b2, voffB);
            PG8_BAR; PG8_WAIT_L(0); PG8_MMA(0, 1, At, B1); PG8_BAR;
            PG8_LDA(At, 0, 1); PG8_STAGE(PG8_SA(0, 0), a2, voffA);
            PG8_BAR; PG8_WAIT_L(0); PG8_MMA(1, 0, At, B0); PG8_BAR; PG8_SCHED;
            PG8_STAGE(PG8_SB(0, 1), b2 + hstep, voffB);
            PG8_WAIT_V(6); PG8_BAR; PG8_MMA(1, 1, At, B1); PG8_BAR;
            PG8_LDB(B0, 1, 0); PG8_SCHED; PG8_LDA(At, 1, 0); PG8_STAGE(PG8_SA(0, 1), a2 + hstep, voffA);
            PG8_WAIT_L(8); PG8_BAR; PG8_WAIT_L(0); PG8_MMA(0, 0, At, B0); PG8_BAR; PG8_SCHED;
            PG8_LDB(B1, 1, 1); PG8_STAGE(PG8_SB(1, 0), b3, voffB);
            PG8_BAR; PG8_WAIT_L(0); PG8_MMA(0, 1, At, B1); PG8_BAR;
            PG8_LDA(At, 1, 1); PG8_STAGE(PG8_SA(1, 0), a3, voffA);
            PG8_BAR; PG8_WAIT_L(0); PG8_MMA(1, 0, At, B0); PG8_BAR; PG8_SCHED;
            PG8_STAGE(PG8_SB(1, 1), b3 + hstep, voffB);
            PG8_WAIT_V(6); PG8_BAR; PG8_MMA(1, 1, At, B1); PG8_BAR;
            }
        }
        if constexpr (ALIGN_EPI) { if (wr == 0) PG8_BAR; }
        E(acc, cur, wr, wc, fr, fq); S.done(cur);
        if (!has_next) break;
#pragma unroll
        for (int a = 0; a < 2; ++a)
#pragma unroll
            for (int b = 0; b < 2; ++b)
#pragma unroll
                for (int m = 0; m < 4; ++m)
#pragma unroll
                    for (int n = 0; n < 2; ++n) acc[a][b][m][n] = (f32x4){0.f, 0.f, 0.f, 0.f};
        cur = nxt; cA = nA; cB = nB; ++ui;
        if constexpr (ALIGN_EPI) { if (wr == 1) PG8_BAR; }
    }
    PG8_WAIT_V(0);
    if constexpr (!ALIGN_EPI) { if (wr == 0) PG8_BAR; }
    PG8_BAR;
#undef PG8_SA
#undef PG8_SB
#undef PG8_STAGE
#undef PG8_LDA
#undef PG8_LDB
#undef PG8_MMA
#undef PG8_WAIT_V
#undef PG8_WAIT_L
#undef PG8_BAR
#undef PG8_SCHED
}
}
constexpr int D = 1024, NB = 4, SEQ = 8192, DB = 8, DSEQ = 64, NMB = NB + DB;
constexpr int GH = 8, GDK = 128, GDV = 128;
constexpr int SH = 32, SP = 64, SN = 128, SG = 8;
constexpr int DFF = 2816, CONV_CH = 7168, IN_COLS = 12336;
constexpr int NPROJ = 12288;
constexpr int NIN = 12544;
constexpr int NUP = 2 * DFF;
constexpr float EPS = 1e-6f;
#ifndef SLAB_T
#define SLAB_T 1024
#endif
constexpr int NSLAB = SEQ / SLAB_T, RP = NB * SLAB_T, RS = DB * DSEQ, RMAX = RP + RS;
constexpr size_t O_YP = 0, O_YS = O_YP + (size_t)NB * SEQ * D, O_CMP = O_YS + (size_t)DB * DSEQ * D, O_GP = O_CMP + (size_t)NB * 3 * CONV_CH,
                 O_SP = O_GP + (size_t)NB * GH * GDK * GDV, O_CFP = O_SP + (size_t)NB * SH * SN * SP, O_CMS = O_CFP + (size_t)NB * 2 * NUP,
                 O_GS = O_CMS + (size_t)DB * 3 * CONV_CH, O_SS = O_GS + (size_t)DB * GH * GDK * GDV, O_CFS = O_SS + (size_t)DB * SH * SN * SP,
                 O_END = O_CFS + (size_t)DB * 2 * NUP;
constexpr size_t MiB = 1u << 20;
constexpr size_t WS_CTL = 0, CTL_ZERO_BYTES = 1 * MiB;
constexpr size_t WS_MODV = 1 * MiB;
constexpr size_t WS_G1 = WS_MODV + 512 * 1024;
constexpr size_t WS_G2 = WS_G1 + 64 * 1024;
constexpr size_t WS_SHW = WS_G2 + 64 * 1024;
constexpr size_t WS_CARRY_MIX = 2 * MiB;
constexpr size_t WS_CARRY_FFN = 3 * MiB;
constexpr size_t WS_WIN = 4 * MiB;
constexpr size_t WS_WG = WS_WIN + (size_t)NIN * D * 2;
constexpr size_t WS_WS = WS_WG + (size_t)D * D * 2;
constexpr size_t WS_WOUT = WS_WS + (size_t)D * 2048 * 2;
constexpr size_t WS_WUP = WS_WOUT + (size_t)D * D * 2;
constexpr size_t WS_WDN = WS_WUP + (size_t)NUP * D * 2;
constexpr size_t WS_SLAB = 56 * MiB;
static_assert(WS_WDN + (size_t)D * DFF * 2 <= WS_SLAB, "weights fit");
constexpr size_t SZ_HB = (size_t)RMAX * D * 2, SZ_PROJ = (size_t)RMAX * NPROJ * 2, SZ_SM = (size_t)RMAX * 64 * 4, SZ_OG = (size_t)RMAX * D * 2, SZ_YS = (size_t)RMAX * 2048 * 2,
                 SZ_T1 = (size_t)RMAX * D * 4, SZ_MIX = (size_t)RMAX * D * 2, SZ_X1 = (size_t)RMAX * D * 4, SZ_X1G = (size_t)RMAX * D * 2, SZ_SS = (size_t)RMAX * 16 * 4,
                 SZ_U = (size_t)RMAX * NUP * 2, SZ_ACT = (size_t)RMAX * DFF * 2;
constexpr size_t WS_HB = WS_SLAB, WS_PROJ = WS_HB + SZ_HB, WS_SM = WS_PROJ + SZ_PROJ, WS_OG = WS_SM + SZ_SM, WS_YS = WS_OG + SZ_OG, WS_T1 = WS_YS + SZ_YS, WS_MIX = WS_T1 + SZ_T1,
                 WS_X1 = WS_MIX + SZ_MIX, WS_X1G = WS_X1 + SZ_X1, WS_SS1 = WS_X1G + SZ_X1G, WS_SS2 = WS_SS1 + SZ_SS, WS_U = WS_SS2 + SZ_SS, WS_ACT = WS_U + SZ_U, WS_END = WS_ACT + SZ_ACT;
static_assert(WS_END <= 480 * MiB, "workspace map fits");
constexpr int LDS_BYTES = 147456, LDSCTL_OFF = LDS_BYTES - 512, MISC_OFF = LDSCTL_OFF + 320, RING_BYTES = LDSCTL_OFF;
constexpr int NWAVES = 8, NTHR = 512;

#define GAS __attribute__((address_space(1)))
#define LAS __attribute__((address_space(3)))
typedef unsigned short bf16;
typedef unsigned v4u __attribute__((ext_vector_type(4)));
typedef unsigned v2u __attribute__((ext_vector_type(2)));
typedef float f32x4 __attribute__((ext_vector_type(4)));
typedef GAS unsigned gu32;
#define RLX_AGENT __ATOMIC_RELAXED, __HIP_MEMORY_SCOPE_AGENT
#define LDS_WAIT() asm volatile("s_waitcnt lgkmcnt(0)" ::: "memory")
#define VM_WAIT() asm volatile("s_waitcnt vmcnt(0)" ::: "memory")
__device__ __forceinline__ unsigned f2bf(float f) { unsigned u = __builtin_bit_cast(unsigned, f); return (u + 0x7fffu + ((u >> 16) & 1u)) >> 16; }
__device__ __forceinline__ unsigned pk2(float lo, float hi) { return f2bf(lo) | (f2bf(hi) << 16); }
__device__ __forceinline__ float bf2f(unsigned short h) { return __builtin_bit_cast(float, (unsigned)h << 16); }
__device__ __forceinline__ float bflo(unsigned w) { return __builtin_bit_cast(float, w << 16); }
__device__ __forceinline__ float bfhi(unsigned w) { return __builtin_bit_cast(float, w & 0xffff0000u); }
__device__ __forceinline__ float sigmoidf_(float x) { return 1.f / (1.f + __expf(-x)); }
__device__ __forceinline__ float siluf_(float x) { return x / (1.f + __expf(-x)); }
__device__ __forceinline__ float softplusf_(float x) { const float e = __expf(-fabsf(x)), u = 1.f + e, d = u - 1.f; const float l = (d == 0.f) ? e : __logf(u) * (e / d); return fmaxf(x, 0.f) + l; }
__device__ __forceinline__ float wave_sum(float v) {
#pragma unroll
    for (int o = 1; o < 64; o <<= 1) v += __shfl_xor(v, o);
    return v;
}

struct Args { const float* in[30]; float* out; unsigned char* ws; int ph_lo, ph_hi; };

struct Frame {
    LAS unsigned char* lds;
    volatile LAS unsigned* MISC;
    gu32* ctl;
    int tid, lane, wave, G, bid;
    const Args& A;
    float* out; unsigned char* ws;
    __device__ __forceinline__ Frame(const Args& a) : A(a) {}
};
__device__ __forceinline__ int row_mb(int r) { return r < RP ? (r / SLAB_T) : NB + ((r - RP) / DSEQ); }
__device__ __forceinline__ size_t row_goff(int s, int r) {
    if (r < RP) { const int b = r / SLAB_T, tl = r % SLAB_T; return ((size_t)b * SEQ + (size_t)s * SLAB_T + tl) * D; }
    return (size_t)(r - RP) * D;
}
__device__ __forceinline__ int slab_rows(int s) { return s == 0 ? RMAX : RP; }
struct MapWin { __device__ __forceinline__ int operator()(int n) const { return n < 10240 ? n : (n < 12288 ? n + 48 : (n < 12336 ? n - 2048 : -1)); } };
struct MapId  { __device__ __forceinline__ int operator()(int n) const { return n; } };
struct MapUp  { __device__ __forceinline__ int operator()(int n) const { const int j = n >> 8, c = n & 255; return c < 128 ? 128 * j + c : DFF + 128 * j + (c - 128); } };
template <class Map>
__device__ __forceinline__ void p0_transpose_item(const float* W, int ldw, int K, bf16* WT, Map map, LAS float* scr, int item, int nblk, int lane) {
    const int kb = item / nblk, nb = item % nblk, k0 = 64 * kb, n0 = 32 * nb;
    const int sc = map(n0 + (lane & 31));
#pragma unroll 8
    for (int i = 0; i < 32; ++i) { const int kk = 2 * i + (lane >> 5); scr[kk * 33 + (lane & 31)] = sc >= 0 ? W[(size_t)(k0 + kk) * ldw + sc] : 0.f; }
    LDS_WAIT(); asm volatile("" ::: "memory");
    const int c = lane & 7;
#pragma unroll
    for (int j = 0; j < 4; ++j) { const int n = (lane >> 3) + 8 * j; const LAS float* s = scr + (8 * c) * 33 + n;
        v4u o; o.x = pk2(s[0 * 33], s[1 * 33]); o.y = pk2(s[2 * 33], s[3 * 33]); o.z = pk2(s[4 * 33], s[5 * 33]); o.w = pk2(s[6 * 33], s[7 * 33]);
        *(GAS v4u*)(WT + (size_t)(n0 + n) * K + k0 + 8 * c) = o; }
    LDS_WAIT(); asm volatile("" ::: "memory");
}
__device__ __forceinline__ void p0_mod_item(Frame& F, int item) {
    LAS float* sc = (LAS float*)F.lds; LAS float* red = (LAS float*)(F.lds + 49152);
    const float* cp = F.A.in[6]; const float* cs = F.A.in[7]; const float* w_ada = F.A.in[8]; const float* b_ada = F.A.in[9];
    for (int idx = F.tid; idx < NMB * D; idx += NTHR) { const int b = idx / D, k = idx % D; const float c = b < NB ? cp[b * D + k] : cs[(b - NB) * D + k]; sc[idx] = siluf_(c); }
    __syncthreads();
    float acc[NMB];
#pragma unroll
    for (int b = 0; b < NMB; ++b) acc[b] = 0.f;
    const int col = item * 64 + F.lane, kb = F.wave * 128;
    for (int k = 0; k < 128; ++k) { const float wv = w_ada[(size_t)(kb + k) * 6144 + col];
#pragma unroll
        for (int b = 0; b < NMB; ++b) acc[b] += sc[b * D + kb + k] * wv; }
#pragma unroll
    for (int b = 0; b < NMB; ++b) red[(F.wave * NMB + b) * 64 + F.lane] = acc[b];
    __syncthreads();
    float* modv = (float*)(F.ws + WS_MODV);
    for (int idx = F.tid; idx < NMB * 64; idx += NTHR) { const int b = idx / 64, l = idx % 64; float s = b_ada[item * 64 + l];
#pragma unroll
        for (int w = 0; w < 8; ++w) s += red[(w * NMB + b) * 64 + l];
        modv[b * 6144 + item * 64 + l] = s; }
    __syncthreads();
}
__device__ __forceinline__ void phase_prologue0(Frame& F) {
    for (int it = F.bid; it < 96; it += F.G) p0_mod_item(F, it);
    LAS float* scr = (LAS float*)(F.lds + F.wave * 16384);
    const int gw = F.bid * NWAVES + F.wave, NGW = F.G * NWAVES;
    constexpr int I_IN = (D / 64) * (NIN / 32), I_G = (D / 64) * (D / 32), I_S = (2048 / 64) * (D / 32), I_O = I_G, I_UP = (D / 64) * (NUP / 32), I_DN = (DFF / 64) * (D / 32);
    constexpr int NITEMS = I_IN + I_G + I_S + I_O + I_UP + I_DN;
    for (int it = gw; it < NITEMS; it += NGW) {
        int r = it;
        if (r < I_IN) { p0_transpose_item(F.A.in[11], IN_COLS, D, (bf16*)(F.ws + WS_WIN), MapWin(), scr, r, NIN / 32, F.lane); continue; } r -= I_IN;
        if (r < I_G) { p0_transpose_item(F.A.in[21], D, D, (bf16*)(F.ws + WS_WG), MapId(), scr, r, D / 32, F.lane); continue; } r -= I_G;
        if (r < I_S) { p0_transpose_item(F.A.in[22], D, 2048, (bf16*)(F.ws + WS_WS), MapId(), scr, r, D / 32, F.lane); continue; } r -= I_S;
        if (r < I_O) { p0_transpose_item(F.A.in[23], D, D, (bf16*)(F.ws + WS_WOUT), MapId(), scr, r, D / 32, F.lane); continue; } r -= I_O;
        if (r < I_UP) { p0_transpose_item(F.A.in[25], NUP, D, (bf16*)(F.ws + WS_WUP), MapUp(), scr, r, NUP / 32, F.lane); continue; } r -= I_UP;
        p0_transpose_item(F.A.in[28], D, DFF, (bf16*)(F.ws + WS_WDN), MapId(), scr, r, D / 32, F.lane);
    }
}
__device__ __forceinline__ void phase_prologue1(Frame& F) {
    const float* modv = (const float*)(F.ws + WS_MODV);
    float* g1 = (float*)(F.ws + WS_G1); float* g2 = (float*)(F.ws + WS_G2); float* shw = (float*)(F.ws + WS_SHW);
    for (int idx = F.bid * NTHR + F.tid; idx < NMB * D; idx += F.G * NTHR) { const int b = idx / D, k = idx % D;
        g1[idx] = F.A.in[10][k] * (1.f + modv[b * 6144 + 1024 + k]); g2[idx] = F.A.in[24][k] * (1.f + modv[b * 6144 + 4096 + k]); }
    LAS float* sh = (LAS float*)F.lds;
    for (int idx = F.tid; idx < NMB * D; idx += NTHR) sh[idx] = modv[(idx / D) * 6144 + 3072 + (idx % D)];
    __syncthreads();
    const bf16* wup = (const bf16*)(F.ws + WS_WUP);
    const int gw = F.bid * NWAVES + F.wave, NGW = F.G * NWAVES;
    for (int n = gw; n < NUP; n += NGW) {
        const GAS v4u* wr = (const GAS v4u*)(wup + (size_t)n * D + F.lane * 16);
        const v4u w0 = wr[0], w1 = wr[1];
        float wf[16] = {bflo(w0.x), bfhi(w0.x), bflo(w0.y), bfhi(w0.y), bflo(w0.z), bfhi(w0.z), bflo(w0.w), bfhi(w0.w), bflo(w1.x), bfhi(w1.x), bflo(w1.y), bfhi(w1.y), bflo(w1.z), bfhi(w1.z), bflo(w1.w), bfhi(w1.w)};
        float res = 0.f;
#pragma unroll 1
        for (int b = 0; b < NMB; ++b) { float a = 0.f;
#pragma unroll
            for (int i = 0; i < 16; ++i) a += wf[i] * sh[b * D + F.lane * 16 + i];
            a = wave_sum(a); if (F.lane == b) res = a; }
        if (F.lane < NMB) shw[F.lane * NUP + n] = res;
    }
    __syncthreads();
}
__device__ __forceinline__ void phase_norm1(Frame& F, int s) {
    const float* modv = (const float*)(F.ws + WS_MODV); const float* g1 = (const float*)(F.ws + WS_G1); bf16* hb = (bf16*)(F.ws + WS_HB);
    const int gw = F.bid * NWAVES + F.wave, NGW = F.G * NWAVES, R = slab_rows(s);
    for (int r = gw; r < R; r += NGW) {
        const float* xrow = (r < RP ? F.A.in[0] : F.A.in[1]) + row_goff(s, r); const int mb = row_mb(r);
        const GAS f32x4* xr = (const GAS f32x4*)xrow + F.lane;
        f32x4 v[4]; float ss = 0.f;
#pragma unroll
        for (int j = 0; j < 4; ++j) { v[j] = xr[64 * j]; ss += (v[j].x * v[j].x + v[j].y * v[j].y) + (v[j].z * v[j].z + v[j].w * v[j].w); }
        const float rs = rsqrtf(wave_sum(ss) * (1.f / D) + EPS);
        GAS v2u* o8 = (GAS v2u*)(hb + (size_t)r * D) + F.lane;
#pragma unroll
        for (int j = 0; j < 4; ++j) { const int k = 4 * F.lane + 256 * j; const f32x4 g = *(const GAS f32x4*)(g1 + mb * D + k); const f32x4 sh = *(const GAS f32x4*)(modv + mb * 6144 + k);
            v2u o; o.x = pk2(v[j].x * rs * g.x + sh.x, v[j].y * rs * g.y + sh.y); o.y = pk2(v[j].z * rs * g.z + sh.z, v[j].w * rs * g.w + sh.w); o8[64 * j] = o; }
    }
}
__device__ __forceinline__ void phase_final(Frame& F, int s) {
    const float* ss2 = (const float*)(F.ws + WS_SS2); const float* wf = F.A.in[29];
    const int gw = F.bid * NWAVES + F.wave, NGW = F.G * NWAVES, R = slab_rows(s);
    for (int r = gw; r < R; r += NGW) {
        float* yrow = F.out + (r < RP ? O_YP : O_YS) + row_goff(s, r);
        float t = F.lane < 16 ? ss2[(size_t)r * 16 + F.lane] : 0.f; t = wave_sum(t);
        const float rs = rsqrtf(t * (1.f / D) + EPS);
        GAS f32x4* yr = (GAS f32x4*)yrow + F.lane;
#pragma unroll
        for (int j = 0; j < 4; ++j) { f32x4 v = yr[64 * j]; const f32x4 w = *(const GAS f32x4*)(wf + 4 * F.lane + 256 * j); v.x *= rs * w.x; v.y *= rs * w.y; v.z *= rs * w.z; v.w *= rs * w.w; yr[64 * j] = v; }
    }
}
__device__ __forceinline__ void u_hist_row(Frame& F, int s, int r, int back, int c8, int j, int cc, float (&ua)[8], float (&uv)[8]) {
    const bf16* U = (const bf16*)(F.ws + WS_U);
    int tl, b; bool samp = r >= RP;
    if (!samp) { b = r / SLAB_T; tl = r % SLAB_T; } else { b = (r - RP) / DSEQ; tl = (r - RP) % DSEQ; }
    if (tl - back >= 0) {
        const bf16* p = U + (size_t)(r - back) * NUP + 256 * j + cc;
        const v4u a = *(const GAS v4u*)p, v = *(const GAS v4u*)(p + 128);
        ua[0] = bflo(a.x); ua[1] = bfhi(a.x); ua[2] = bflo(a.y); ua[3] = bfhi(a.y); ua[4] = bflo(a.z); ua[5] = bfhi(a.z); ua[6] = bflo(a.w); ua[7] = bfhi(a.w);
        uv[0] = bflo(v.x); uv[1] = bfhi(v.x); uv[2] = bflo(v.y); uv[3] = bfhi(v.y); uv[4] = bflo(v.z); uv[5] = bfhi(v.z); uv[6] = bflo(v.w); uv[7] = bfhi(v.w);
        return;
    }
    const int hi = 2 + (tl - back);
    if (samp) { const float* st = F.A.in[5] + ((size_t)b * 2 + hi) * NUP;
#pragma unroll
        for (int i = 0; i < 8; ++i) { ua[i] = st[c8 + i]; uv[i] = st[DFF + c8 + i]; } return; }
    if (s == 0) {
#pragma unroll
        for (int i = 0; i < 8; ++i) { ua[i] = 0.f; uv[i] = 0.f; } return; }
    const float* cf = (const float*)(F.ws + WS_CARRY_FFN) + (((size_t)(s & 1) * NB + b) * 2 + hi) * NUP + 256 * j + cc;
#pragma unroll
    for (int i = 0; i < 8; ++i) { ua[i] = cf[i]; uv[i] = cf[128 + i]; }
}
__device__ __forceinline__ void phase_convact(Frame& F, int s) {
    const bf16* U = (const bf16*)(F.ws + WS_U); bf16* ACT = (bf16*)(F.ws + WS_ACT);
    const float* wc = F.A.in[26]; const float* bc = F.A.in[27];
    const int R = slab_rows(s); const long total = (long)R * (DFF / 8);
    for (long idx = (long)F.bid * NTHR + F.tid; idx < total; idx += (long)F.G * NTHR) {
        const int r = (int)(idx / (DFF / 8)), c8 = (int)(idx % (DFF / 8)) * 8, j = c8 >> 7, cc = c8 & 127;
        float a0[8], v0[8], a1[8], v1[8], a2[8], v2[8];
        u_hist_row(F, s, r, 0, c8, j, cc, a2, v2); u_hist_row(F, s, r, 1, c8, j, cc, a1, v1); u_hist_row(F, s, r, 2, c8, j, cc, a0, v0);
        float o[8];
#pragma unroll
        for (int i = 0; i < 8; ++i) { const int ca = c8 + i, cv = DFF + c8 + i;
            const float xa = bc[ca] + wc[ca] * a0[i] + wc[NUP + ca] * a1[i] + wc[2 * NUP + ca] * a2[i];
            const float xv = bc[cv] + wc[cv] * v0[i] + wc[NUP + cv] * v1[i] + wc[2 * NUP + cv] * v2[i];
            o[i] = siluf_(xa) * xv; }
        v4u w; w.x = pk2(o[0], o[1]); w.y = pk2(o[2], o[3]); w.z = pk2(o[4], o[5]); w.w = pk2(o[6], o[7]);
        *(GAS v4u*)(ACT + (size_t)r * DFF + c8) = w;
    }
    float* cfn = (float*)(F.ws + WS_CARRY_FFN) + (size_t)((s + 1) & 1) * NB * 2 * NUP;
    for (int idx = F.bid * NTHR + F.tid; idx < NB * 2 * NUP; idx += F.G * NTHR) {
        const int b = idx / (2 * NUP), i = (idx / NUP) % 2, c = idx % NUP; const int r = b * SLAB_T + SLAB_T - 2 + i;
        const float v = bf2f(U[(size_t)r * NUP + c]); cfn[idx] = v;
        if (s == NSLAB - 1) { const int j = c >> 8, cc = c & 255; const int oc = cc < 128 ? 128 * j + cc : DFF + 128 * j + (cc - 128); F.out[O_CFP + ((size_t)b * 2 + i) * NUP + oc] = v; }
    }
    if (s == 0) for (int idx = F.bid * NTHR + F.tid; idx < DB * 2 * NUP; idx += F.G * NTHR) {
        const int b = idx / (2 * NUP), i = (idx / NUP) % 2, c = idx % NUP; const int r = RP + b * DSEQ + DSEQ - 2 + i;
        const int j = c >> 8, cc = c & 255; const int oc = cc < 128 ? 128 * j + cc : DFF + 128 * j + (cc - 128);
        F.out[O_CFS + ((size_t)b * 2 + i) * NUP + oc] = bf2f(U[(size_t)r * NUP + c]);
    }
}
__device__ __forceinline__ void phase_mix_carry(Frame& F, int s) {
    const bf16* P = (const bf16*)(F.ws + WS_PROJ);
    float* cmn = (float*)(F.ws + WS_CARRY_MIX) + (size_t)((s + 1) & 1) * NB * 3 * CONV_CH;
    for (int idx = F.bid * NTHR + F.tid; idx < NB * 3 * CONV_CH; idx += F.G * NTHR) {
        const int b = idx / (3 * CONV_CH), i = (idx / CONV_CH) % 3, c = idx % CONV_CH; const int r = b * SLAB_T + SLAB_T - 3 + i;
        const float v = bf2f(P[(size_t)r * NPROJ + c]); cmn[idx] = v;
        if (s == NSLAB - 1) F.out[O_CMP + idx] = v;
    }
    if (s == 0) for (int idx = F.bid * NTHR + F.tid; idx < DB * 3 * CONV_CH; idx += F.G * NTHR) {
        const int b = idx / (3 * CONV_CH), i = (idx / CONV_CH) % 3, c = idx % CONV_CH; const int r = RP + b * DSEQ + DSEQ - 3 + i;
        F.out[O_CMS + idx] = bf2f(P[(size_t)r * NPROJ + c]);
    }
}
namespace epi {
using pg8::f32x4; using pg8::Unit; using pg8::BM; using pg8::HALF; using pg8::cvt_pk_bf16; using pg8::u32x4; using pg8::u32x2;
struct EpiProj {
    static constexpr bool PERM = true;
    bf16* P; float* SM;
    __device__ __forceinline__ void operator()(const f32x4 (&acc)[2][2][4][2], const Unit& u, int wr, int wc, int fr, int fq) const {
        const int row0 = u.pm * BM + wr * 64 + fr;
        if (u.pn == 48) {
            if (wc < 2) {
#pragma unroll
                for (int ai = 0; ai < 2; ++ai)
#pragma unroll
                    for (int m = 0; m < 4; ++m) { float* rp = SM + (size_t)(row0 + ai * HALF + m * 16) * 64 + wc * 32 + 8 * fq;
                        *(f32x4*)rp = acc[ai][0][m][0]; *(f32x4*)(rp + 4) = acc[ai][0][m][1]; }
            }
            return;
        }
        const bool sg = u.pn >= 40;
        const int col0 = u.pn * BM + wc * 32 + 8 * fq;
#pragma unroll
        for (int ai = 0; ai < 2; ++ai)
#pragma unroll
            for (int m = 0; m < 4; ++m) { bf16* rowp = P + (size_t)(row0 + ai * HALF + m * 16) * NPROJ + col0;
#pragma unroll
                for (int bj = 0; bj < 2; ++bj) { f32x4 v0 = acc[ai][bj][m][0], v1 = acc[ai][bj][m][1];
                    if (sg) {
#pragma unroll
                        for (int i = 0; i < 4; ++i) { v0[i] = sigmoidf_(v0[i]); v1[i] = sigmoidf_(v1[i]); } }
                    u32x4 w; w.x = cvt_pk_bf16(v0[0], v0[1]); w.y = cvt_pk_bf16(v0[2], v0[3]); w.z = cvt_pk_bf16(v1[0], v1[1]); w.w = cvt_pk_bf16(v1[2], v1[3]);
                    *(u32x4*)(rowp + bj * HALF) = w; } }
    }
};
struct EpiGate1 {
    static constexpr bool PERM = false;
    const bf16* P; float* T1;
    __device__ __forceinline__ void operator()(const f32x4 (&acc)[2][2][4][2], const Unit& u, int wr, int wc, int fr, int fq) const {
        const int row0 = u.pm * BM + wr * 64 + fr, col0 = u.pn * BM + wc * 32 + 4 * fq;
#pragma unroll
        for (int ai = 0; ai < 2; ++ai)
#pragma unroll
            for (int m = 0; m < 4; ++m) { const size_t r = (size_t)(row0 + ai * HALF + m * 16);
#pragma unroll
                for (int bj = 0; bj < 2; ++bj)
#pragma unroll
                    for (int n = 0; n < 2; ++n) { const int c = col0 + bj * HALF + n * 16; const u32x2 g = *(const u32x2*)(P + r * NPROJ + 10240 + c); const f32x4 a = acc[ai][bj][m][n];
                        f32x4 o; o.x = a.x * bflo(g.x); o.y = a.y * bfhi(g.x); o.z = a.z * bflo(g.y); o.w = a.w * bfhi(g.y); *(f32x4*)(T1 + r * D + c) = o; } }
    }
};
struct EpiGate2 {
    static constexpr bool PERM = false;
    const bf16* P; const float* T1; bf16* MIX;
    __device__ __forceinline__ void operator()(const f32x4 (&acc)[2][2][4][2], const Unit& u, int wr, int wc, int fr, int fq) const {
        const int row0 = u.pm * BM + wr * 64 + fr, col0 = u.pn * BM + wc * 32 + 4 * fq;
#pragma unroll
        for (int ai = 0; ai < 2; ++ai)
#pragma unroll
            for (int m = 0; m < 4; ++m) { const size_t r = (size_t)(row0 + ai * HALF + m * 16);
#pragma unroll
                for (int bj = 0; bj < 2; ++bj)
#pragma unroll
                    for (int n = 0; n < 2; ++n) { const int c = col0 + bj * HALF + n * 16; const u32x2 g = *(const u32x2*)(P + r * NPROJ + 11264 + c); const f32x4 a = acc[ai][bj][m][n];
                        const f32x4 t = *(const f32x4*)(T1 + r * D + c);
                        u32x2 o; o.x = cvt_pk_bf16(t.x + a.x * bflo(g.x), t.y + a.y * bfhi(g.x)); o.y = cvt_pk_bf16(t.z + a.z * bflo(g.y), t.w + a.w * bfhi(g.y)); *(u32x2*)(MIX + r * D + c) = o; } }
    }
};
struct EpiOut {
    static constexpr bool PERM = false;
    const float* xp; const float* xs; const float* modv; const float* g2; float* X1; bf16* X1G; float* SS; int slab;
    __device__ __forceinline__ void operator()(const f32x4 (&acc)[2][2][4][2], const Unit& u, int wr, int wc, int fr, int fq) const {
        const int col0 = u.pn * BM + wc * 32 + 4 * fq;
#pragma unroll
        for (int ai = 0; ai < 2; ++ai) {
            const int rb = u.pm * BM + ai * HALF + wr * 64; const int mb = row_mb(rb);
#pragma unroll
            for (int m = 0; m < 4; ++m) { const int r = rb + m * 16 + fr; const float* xrow = (r < RP ? xp : xs) + row_goff(slab, r); float sq = 0.f;
#pragma unroll
                for (int bj = 0; bj < 2; ++bj)
#pragma unroll
                    for (int n = 0; n < 2; ++n) { const int c = col0 + bj * HALF + n * 16; const f32x4 a = acc[ai][bj][m][n];
                        const f32x4 xv = *(const f32x4*)(xrow + c), gt = *(const f32x4*)(modv + mb * 6144 + 2048 + c), gg = *(const f32x4*)(g2 + mb * D + c);
                        f32x4 o = xv + gt * a; *(f32x4*)(X1 + (size_t)r * D + c) = o; sq += (o.x * o.x + o.y * o.y) + (o.z * o.z + o.w * o.w);
                        u32x2 w; w.x = cvt_pk_bf16(o.x * gg.x, o.y * gg.y); w.y = cvt_pk_bf16(o.z * gg.z, o.w * gg.w); *(u32x2*)(X1G + (size_t)r * D + c) = w; }
                sq += __shfl_xor(sq, 16); sq += __shfl_xor(sq, 32);
                if (fq == 0) SS[(size_t)r * 16 + u.pn * 4 + wc] = sq; }
        }
    }
};
struct EpiUp {
    static constexpr bool PERM = true;
    const float* SS; const float* shw; bf16* U;
    __device__ __forceinline__ void operator()(const f32x4 (&acc)[2][2][4][2], const Unit& u, int wr, int wc, int fr, int fq) const {
        const int col0 = u.pn * BM + wc * 32 + 8 * fq;
#pragma unroll
        for (int ai = 0; ai < 2; ++ai) {
            const int rb = u.pm * BM + ai * HALF + wr * 64; const int mb = row_mb(rb);
            f32x4 sv[2][2];
#pragma unroll
            for (int bj = 0; bj < 2; ++bj)
#pragma unroll
                for (int n = 0; n < 2; ++n) sv[bj][n] = *(const f32x4*)(shw + mb * NUP + col0 + bj * HALF + 4 * n);
#pragma unroll
            for (int m = 0; m < 4; ++m) { const int r = rb + m * 16 + fr; const f32x4* sp = (const f32x4*)(SS + (size_t)r * 16);
                const f32x4 s0 = sp[0], s1 = sp[1], s2 = sp[2], s3 = sp[3];
                const float tot = ((s0.x + s0.y) + (s0.z + s0.w)) + ((s1.x + s1.y) + (s1.z + s1.w)) + ((s2.x + s2.y) + (s2.z + s2.w)) + ((s3.x + s3.y) + (s3.z + s3.w));
                const float rs = rsqrtf(tot * (1.f / D) + EPS);
#pragma unroll
                for (int bj = 0; bj < 2; ++bj) { const f32x4 v0 = acc[ai][bj][m][0] * rs + sv[bj][0], v1 = acc[ai][bj][m][1] * rs + sv[bj][1];
                    u32x4 w; w.x = cvt_pk_bf16(v0[0], v0[1]); w.y = cvt_pk_bf16(v0[2], v0[3]); w.z = cvt_pk_bf16(v1[0], v1[1]); w.w = cvt_pk_bf16(v1[2], v1[3]);
                    *(u32x4*)(U + (size_t)r * NUP + col0 + bj * HALF) = w; } }
        }
    }
};
struct EpiDown {
    static constexpr bool PERM = false;
    const float* X1; const float* modv; float* yp; float* ys; float* SS; int slab;
    __device__ __forceinline__ void operator()(const f32x4 (&acc)[2][2][4][2], const Unit& u, int wr, int wc, int fr, int fq) const {
        const int col0 = u.pn * BM + wc * 32 + 4 * fq;
#pragma unroll
        for (int ai = 0; ai < 2; ++ai) {
            const int rb = u.pm * BM + ai * HALF + wr * 64; const int mb = row_mb(rb);
#pragma unroll
            for (int m = 0; m < 4; ++m) { const int r = rb + m * 16 + fr; float* yrow = (r < RP ? yp : ys) + row_goff(slab, r); float sq = 0.f;
#pragma unroll
                for (int bj = 0; bj < 2; ++bj)
#pragma unroll
                    for (int n = 0; n < 2; ++n) { const int c = col0 + bj * HALF + n * 16; const f32x4 a = acc[ai][bj][m][n];
                        const f32x4 xv = *(const f32x4*)(X1 + (size_t)r * D + c), gt = *(const f32x4*)(modv + mb * 6144 + 5120 + c);
                        f32x4 o = xv + gt * a; *(f32x4*)(yrow + c) = o; sq += (o.x * o.x + o.y * o.y) + (o.z * o.z + o.w * o.w); }
                sq += __shfl_xor(sq, 16); sq += __shfl_xor(sq, 32);
                if (fq == 0) SS[(size_t)r * 16 + u.pn * 4 + wc] = sq; }
        }
    }
};
}
typedef short bf16x8 __attribute__((ext_vector_type(8)));
#define MFMA16(a, b, c) __builtin_amdgcn_mfma_f32_16x16x32_bf16((a), (b), (c), 0, 0, 0)
__device__ __forceinline__ bf16x8 ldfrag(const LAS bf16* base, int ld, int row0, int k0, int lane) {
    return *(const LAS bf16x8*)(base + (row0 + (lane & 15)) * ld + k0 + 8 * (lane >> 4));
}
__device__ __forceinline__ bf16x8 ldfrag_perm(const LAS bf16* base, int ld, int row0, int k0, int lane) {
    const LAS v2u* p = (const LAS v2u*)(base + (row0 + (lane & 15)) * ld + k0 + 4 * (lane >> 4));
    const v2u a = p[0], b = p[4];
    v4u w; w.x = a.x; w.y = a.y; w.z = b.x; w.w = b.y; return __builtin_bit_cast(bf16x8, w);
}
__device__ __forceinline__ bf16x8 acc2frag(f32x4 t0, f32x4 t1) {
    v4u w; w.x = pg8::cvt_pk_bf16(t0.x, t0.y); w.y = pg8::cvt_pk_bf16(t0.z, t0.w); w.z = pg8::cvt_pk_bf16(t1.x, t1.y); w.w = pg8::cvt_pk_bf16(t1.z, t1.w); return __builtin_bit_cast(bf16x8, w);
}
__device__ __forceinline__ float wave_incl_scan(float v, int lane) {
#pragma unroll
    for (int o = 1; o < 64; o <<= 1) { const float t = __shfl_up(v, o); if (lane >= o) v += t; }
    return v;
}
__device__ __forceinline__ float row16_sum(float v) { v += __shfl_xor(v, 1); v += __shfl_xor(v, 2); v += __shfl_xor(v, 4); v += __shfl_xor(v, 8); return v; }

constexpr int SL_CS = 0, SL_BS = 17408, SL_BT = 34816, SL_XT = 53248, SL_CB = 90112, SL_DT = 99328, SL_GAM = 100352, SL_PS = 101376, SL_ZS = 103424;
__device__ __forceinline__ void ssd_fast_job(Frame& F, int s, bool samp, int bb, int g, bool dry = false) {
    const bf16* P = (const bf16*)(F.ws + WS_PROJ); const float* SM = (const float*)(F.ws + WS_SM); bf16* YS = (bf16*)(F.ws + WS_YS);
    LAS bf16* CS = (LAS bf16*)(F.lds + SL_CS); LAS bf16* BS = (LAS bf16*)(F.lds + SL_BS); LAS bf16* BT = (LAS bf16*)(F.lds + SL_BT); LAS bf16* XT = (LAS bf16*)(F.lds + SL_XT);
    LAS bf16* CBS = (LAS bf16*)(F.lds + SL_CB); LAS float* DTV = (LAS float*)(F.lds + SL_DT); LAS float* GAM = (LAS float*)(F.lds + SL_GAM); LAS float* PS = (LAS float*)(F.lds + SL_PS); LAS bf16* ZS = (LAS bf16*)(F.lds + SL_ZS) + F.wave * 2048;
    const int tid = F.tid, w = F.wave;
    int lane = F.lane; asm volatile("" : "+v"(lane)); int quad = lane >> 4, l15 = lane & 15;
    const int hl = w >> 1, ph = w & 1, head = 4 * g + hl;
    const int nchunk = samp ? 1 : SLAB_T / 64, row0 = samp ? RP + bb * DSEQ : bb * SLAB_T;
    f32x4 hacc[8][2];
    {
        const float* st = samp ? F.A.in[4] : F.out + O_SP;
        const size_t sb = (size_t)(bb * SH + head) * SN * SP;
#pragma unroll
        for (int mt = 0; mt < 8; ++mt)
#pragma unroll
            for (int nt = 0; nt < 2; ++nt)
#pragma unroll
                for (int r = 0; r < 4; ++r) { const int n = 16 * mt + 4 * quad + r, p = 32 * ph + 16 * nt + l15; hacc[mt][nt][r] = (samp || s > 0) ? st[sb + (size_t)n * SP + p] : 0.f; }
    }
    const int cidx = tid < 256 ? 3072 + g * 256 + tid : (tid < 384 ? 5120 + g * 128 + (tid - 256) : 6144 + g * 128 + (tid - 384));
    const float* wcv = F.A.in[12]; const float w0 = wcv[cidx], w1 = wcv[CONV_CH + cidx], w2 = wcv[2 * CONV_CH + cidx], w3 = wcv[3 * CONV_CH + cidx], bias = F.A.in[13][cidx];
    float h0 = 0.f, h1 = 0.f, h2 = 0.f;
    if (samp) { const float* st = F.A.in[2] + (size_t)bb * 3 * CONV_CH + cidx; h0 = st[0]; h1 = st[CONV_CH]; h2 = st[2 * CONV_CH]; }
    else if (s > 0) { const float* st = (const float*)(F.ws + WS_CARRY_MIX) + ((size_t)(s & 1) * NB + bb) * 3 * CONV_CH + cidx; h0 = st[0]; h1 = st[CONV_CH]; h2 = st[2 * CONV_CH]; }
    const float aneg = -__expf(F.A.in[17][head]), Dh = F.A.in[19][head];
    for (int c = 0; c < nchunk; ++c) {
        const int r0 = row0 + 64 * c;
        asm volatile("" : "+v"(lane)); quad = lane >> 4; l15 = lane & 15;
        v4u zr[4];
        { const GAS v4u* zp = (const GAS v4u*)(P + (size_t)(r0 + lane) * NPROJ + 8192 + head * 64 + 32 * ph);
#pragma unroll
          for (int i = 0; i < 4; ++i) zr[i] = zp[i]; }
        if (tid < 256) { const int hh = 4 * g + (tid >> 6); const float dt = softplusf_(SM[(size_t)(r0 + lane) * 64 + 16 + hh] + F.A.in[18][hh]);
            const float ga = wave_incl_scan(dt * (-__expf(F.A.in[17][hh])), lane); DTV[(tid >> 6) * 64 + lane] = dt; GAM[(tid >> 6) * 64 + lane] = ga; }
        __syncthreads();
        {
            unsigned colp2[32];
            const bf16* pc = P + (size_t)r0 * NPROJ + cidx;
            const LAS float* dtp = DTV + (tid < 256 ? (tid >> 6) * 64 : 0);
#pragma unroll
            for (int tb = 0; tb < 4; ++tb) { float raw[16];
#pragma unroll
                for (int t = 0; t < 16; ++t) raw[t] = bf2f(pc[(size_t)(16 * tb + t) * NPROJ]);
#pragma unroll
                for (int t = 0; t < 16; t += 2) { float va = bias + w0 * h0 + w1 * h1 + w2 * h2 + w3 * raw[t]; float vb = bias + w0 * h1 + w1 * h2 + w2 * raw[t] + w3 * raw[t + 1]; h0 = h2; h1 = raw[t]; h2 = raw[t + 1];
                    va = siluf_(va); vb = siluf_(vb); if (tid < 256) { va *= dtp[16 * tb + t]; vb *= dtp[16 * tb + t + 1]; }
                    colp2[8 * tb + (t >> 1)] = pk2(va, vb); }
                asm volatile("" ::: "memory"); }
            if (tid < 384) {
                LAS bf16* rowp = tid < 256 ? XT + tid * 72 : BT + (tid - 256) * 72;
#pragma unroll
                for (int i = 0; i < 8; ++i) { v4u o; o.x = colp2[4 * i]; o.y = colp2[4 * i + 1]; o.z = colp2[4 * i + 2]; o.w = colp2[4 * i + 3]; *(LAS v4u*)(rowp + 8 * i) = o; }
            }
            if (tid >= 256) {
                LAS bf16* colp = tid < 384 ? BS + (tid - 256) : CS + (tid - 384);
#pragma unroll
                for (int t = 0; t < 32; ++t) { colp[(2 * t) * 136] = (bf16)(colp2[t] & 0xffffu); colp[(2 * t + 1) * 136] = (bf16)(colp2[t] >> 16); }
            }
        }
#pragma unroll
        for (int i = 0; i < 4; ++i) *(LAS v4u*)(ZS + lane * 32 + 8 * i) = zr[i];
        __syncthreads();
        {
            const int mt = w >> 1;
#pragma unroll
            for (int q = 0; q < 2; ++q) { const int nt = 2 * (w & 1) + q; f32x4 acc = {0.f, 0.f, 0.f, 0.f};
#pragma unroll
                for (int ks = 0; ks < 4; ++ks) acc = MFMA16(ldfrag(CS, 136, 16 * mt, 32 * ks, lane), ldfrag(BS, 136, 16 * nt, 32 * ks, lane), acc);
#pragma unroll
                for (int r = 0; r < 4; ++r) CBS[(16 * mt + 4 * quad + r) * 72 + 16 * nt + l15] = (bf16)f2bf(acc[r]); }
        }
        __syncthreads();
        const LAS float* gm = GAM + hl * 64; const LAS float* dv = DTV + hl * 64;
        const float last = gm[63];
        f32x4 y[4][2];
        {
#pragma unroll
            for (int mt = 0; mt < 4; ++mt)
#pragma unroll
                for (int nt = 0; nt < 2; ++nt) y[mt][nt] = (f32x4){0.f, 0.f, 0.f, 0.f};
#pragma unroll
            for (int ks = 0; ks < 4; ++ks) { const bf16x8 hb0 = acc2frag(hacc[2 * ks][0], hacc[2 * ks + 1][0]), hb1 = acc2frag(hacc[2 * ks][1], hacc[2 * ks + 1][1]);
#pragma unroll
                for (int mt = 0; mt < 4; ++mt) { const bf16x8 a = ldfrag_perm(CS, 136, 16 * mt, 32 * ks, lane); y[mt][0] = MFMA16(a, hb0, y[mt][0]); y[mt][1] = MFMA16(a, hb1, y[mt][1]); }
                __builtin_amdgcn_sched_barrier(0); }
#pragma unroll
            for (int mt = 0; mt < 4; ++mt)
#pragma unroll
                for (int r = 0; r < 4; ++r) { const float eg = __expf(gm[16 * mt + 4 * quad + r]); y[mt][0][r] *= eg; y[mt][1][r] *= eg; }
        }
        {
            const int prow = hl * 64 + 32 * ph;
#pragma unroll
            for (int mt = 0; mt < 4; ++mt) { const int i = 16 * mt + l15; const float gi = gm[i], ddt = Dh / dv[i];
#pragma unroll
                for (int ks = 0; ks < 2; ++ks) { if (32 * ks > 16 * mt + 15) continue;
                    const bf16x8 a0 = ldfrag(CBS, 72, 16 * mt, 32 * ks, lane); const v4u aw = __builtin_bit_cast(v4u, a0);
                    const f32x4 g0 = *(const LAS f32x4*)(gm + 32 * ks + 8 * quad), g1 = *(const LAS f32x4*)(gm + 32 * ks + 8 * quad + 4);
                    float cv[8] = {bflo(aw.x), bfhi(aw.x), bflo(aw.y), bfhi(aw.y), bflo(aw.z), bfhi(aw.z), bflo(aw.w), bfhi(aw.w)};
                    const float gj[8] = {g0.x, g0.y, g0.z, g0.w, g1.x, g1.y, g1.z, g1.w};
#pragma unroll
                    for (int jj = 0; jj < 8; ++jj) { const int j = 32 * ks + 8 * quad + jj; float v = i >= j ? cv[jj] * __expf(gi - gj[jj]) : 0.f; if (i == j) v += ddt; cv[jj] = v; }
                    v4u bw; bw.x = pk2(cv[0], cv[1]); bw.y = pk2(cv[2], cv[3]); bw.z = pk2(cv[4], cv[5]); bw.w = pk2(cv[6], cv[7]); const bf16x8 a1 = __builtin_bit_cast(bf16x8, bw);
#pragma unroll
                    for (int nt = 0; nt < 2; ++nt) y[mt][nt] = MFMA16(a1, ldfrag(XT, 72, prow + 16 * nt, 32 * ks, lane), y[mt][nt]); }
                __builtin_amdgcn_sched_barrier(0); }
#pragma unroll
            for (int mt = 0; mt < 4; ++mt)
#pragma unroll
                for (int r = 0; r < 4; ++r) { const int i = 16 * mt + 4 * quad + r; float sq = 0.f;
#pragma unroll
                    for (int nt = 0; nt < 2; ++nt) { const float z = bf2f(ZS[i * 32 + 16 * nt + l15]); const float yz = y[mt][nt][r] * siluf_(z); y[mt][nt][r] = yz; sq += yz * yz; }
                    sq = row16_sum(sq); if (l15 == 0) PS[i * 8 + w] = sq; __builtin_amdgcn_sched_barrier(0); }
            const float el = __expf(last);
#pragma unroll
            for (int mt = 0; mt < 8; ++mt)
#pragma unroll
                for (int nt = 0; nt < 2; ++nt) hacc[mt][nt] = hacc[mt][nt] * el;
#pragma unroll
            for (int ks = 0; ks < 2; ++ks) { const f32x4 g0 = *(const LAS f32x4*)(gm + 32 * ks + 8 * quad), g1 = *(const LAS f32x4*)(gm + 32 * ks + 8 * quad + 4);
                const float ed[8] = {__expf(last - g0.x), __expf(last - g0.y), __expf(last - g0.z), __expf(last - g0.w), __expf(last - g1.x), __expf(last - g1.y), __expf(last - g1.z), __expf(last - g1.w)};
                bf16x8 xw[2];
#pragma unroll
                for (int nt = 0; nt < 2; ++nt) { const v4u xv = __builtin_bit_cast(v4u, ldfrag(XT, 72, prow + 16 * nt, 32 * ks, lane));
                    v4u o; o.x = pk2(bflo(xv.x) * ed[0], bfhi(xv.x) * ed[1]); o.y = pk2(bflo(xv.y) * ed[2], bfhi(xv.y) * ed[3]); o.z = pk2(bflo(xv.z) * ed[4], bfhi(xv.z) * ed[5]); o.w = pk2(bflo(xv.w) * ed[6], bfhi(xv.w) * ed[7]);
                    xw[nt] = __builtin_bit_cast(bf16x8, o); }
#pragma unroll
                for (int mt = 0; mt < 8; ++mt) { const bf16x8 a = ldfrag(BT, 72, 16 * mt, 32 * ks, lane); hacc[mt][0] = MFMA16(a, xw[0], hacc[mt][0]); hacc[mt][1] = MFMA16(a, xw[1], hacc[mt][1]); }
                __builtin_amdgcn_sched_barrier(0); }
        }
        __syncthreads();
#pragma unroll
        for (int mt = 0; mt < 4; ++mt)
#pragma unroll
            for (int r = 0; r < 4; ++r) { const int i = 16 * mt + 4 * quad + r; const f32x4 p0 = *(const LAS f32x4*)(PS + i * 8), p1 = *(const LAS f32x4*)(PS + i * 8 + 4);
                const float rs = rsqrtf((((p0.x + p0.y) + (p0.z + p0.w)) + ((p1.x + p1.y) + (p1.z + p1.w))) * (1.f / 256.f) + EPS);
#pragma unroll
                for (int nt = 0; nt < 2; ++nt) { const int ch = head * 64 + 32 * ph + 16 * nt + l15; YS[(size_t)(r0 + i) * 2048 + ch] = (bf16)f2bf(y[mt][nt][r] * rs * F.A.in[20][ch]); } }
    }
    {
        float* so = (dry ? (float*)(F.ws + WS_T1) : F.out) + (samp ? O_SS : O_SP) - (dry ? O_GP : 0) + (size_t)(bb * SH + head) * SN * SP;
#pragma unroll
        for (int mt = 0; mt < 8; ++mt)
#pragma unroll
            for (int nt = 0; nt < 2; ++nt)
#pragma unroll
                for (int r = 0; r < 4; ++r) so[(size_t)(16 * mt + 4 * quad + r) * SP + 32 * ph + 16 * nt + l15] = hacc[mt][nt][r];
    }
    __syncthreads();
}
constexpr int NCH = SLAB_T / 64;
constexpr int GI_WKN = 0, GI_QG = 17408, GI_KT = 34816, GI_QKM = 53248, GI_IMG = 62464, GI_WV = GI_IMG, GI_SC = GI_IMG + 32768, GI_STRIDE = GI_SC + 256;
constexpr int GDN_ITEMS_MAX = NCH * NB * GH + DB * GH;
constexpr size_t WS_GDN = WS_END;
constexpr size_t WS_END2 = WS_GDN + (size_t)GDN_ITEMS_MAX * GI_STRIDE;
static_assert(WS_END2 <= 500 * MiB, "workspace map fits");
constexpr int GP_QS = 0, GP_KS = 17408, GP_LS = 34816, GP_SC = 51200, GP_HALF = 52224;

__device__ __forceinline__ void gdn_pre_pair(Frame& F, int s, int pair) {
    const bf16* P = (const bf16*)(F.ws + WS_PROJ); const float* SM = (const float*)(F.ws + WS_SM);
    const int tid = F.tid, hb = tid >> 8, ht = tid & 255, wl = (tid >> 6) & 3;
    int lane = F.lane; asm volatile("" : "+v"(lane)); const int quad = lane >> 4, l15 = lane & 15;
    const int it = 2 * pair + hb;
    int bsel, h, r0, c; bool samp;
    if (it < NCH * NB * GH) { samp = false; const int bh = it / NCH; c = it % NCH; bsel = bh >> 3; h = bh & 7; r0 = bsel * SLAB_T + 64 * c; }
    else { samp = true; const int q = it - NCH * NB * GH; bsel = q >> 3; h = q & 7; c = 0; r0 = RP + bsel * DSEQ; }
    unsigned char* img = F.ws + WS_GDN + (size_t)it * GI_STRIDE;
    LAS unsigned char* hbase = F.lds + hb * GP_HALF;
    LAS bf16* QS = (LAS bf16*)(hbase + GP_QS); LAS bf16* KS = (LAS bf16*)(hbase + GP_KS); LAS float* LS = (LAS float*)(hbase + GP_LS);
    LAS float* NQ = (LAS float*)(hbase + GP_SC); LAS float* NK = NQ + 64; LAS float* GAMS = NK + 64; LAS float* BTS = GAMS + 64;
    if (ht < 64) { const size_t r = (size_t)(r0 + lane); const float beta = sigmoidf_(SM[r * 64 + h]); const float g = -__expf(F.A.in[14][h]) * softplusf_(SM[r * 64 + 8 + h] + F.A.in[15][h]);
        GAMS[lane] = wave_incl_scan(g, lane); BTS[lane] = beta; }
    float y[64];
    {
        const float* wcv = F.A.in[12]; const float* bcv = F.A.in[13];
#pragma unroll
        for (int pass = 0; pass < 2; ++pass) {
            if (pass == 0 && ht >= 128) continue;
            const int cidx = ht < 128 ? (pass == 0 ? h * 128 + ht : 1024 + h * 128 + ht) : 2048 + h * 128 + (ht - 128);
            const float w0 = wcv[cidx], w1 = wcv[CONV_CH + cidx], w2 = wcv[2 * CONV_CH + cidx], w3 = wcv[3 * CONV_CH + cidx], bias = bcv[cidx];
            float h0 = 0.f, h1 = 0.f, h2 = 0.f;
            if (c > 0) { const bf16* pp = P + (size_t)(r0 - 3) * NPROJ + cidx; h0 = bf2f(pp[0]); h1 = bf2f(pp[NPROJ]); h2 = bf2f(pp[2 * NPROJ]); }
            else if (samp) { const float* st = F.A.in[2] + (size_t)bsel * 3 * CONV_CH + cidx; h0 = st[0]; h1 = st[CONV_CH]; h2 = st[2 * CONV_CH]; }
            else if (s > 0) { const float* st = (const float*)(F.ws + WS_CARRY_MIX) + ((size_t)(s & 1) * NB + bsel) * 3 * CONV_CH + cidx; h0 = st[0]; h1 = st[CONV_CH]; h2 = st[2 * CONV_CH]; }
            const bf16* pc = P + (size_t)r0 * NPROJ + cidx;
            LAS bf16* dst = (pass == 0 ? QS : KS) + ht;
#pragma unroll
            for (int tb = 0; tb < 4; ++tb) { float raw[16];
#pragma unroll
                for (int t = 0; t < 16; ++t) raw[t] = bf2f(pc[(size_t)(16 * tb + t) * NPROJ]);
#pragma unroll
                for (int t = 0; t < 16; ++t) { float val = bias + w0 * h0 + w1 * h1 + w2 * h2 + w3 * raw[t]; h0 = h1; h1 = h2; h2 = raw[t]; val = siluf_(val);
                    if (ht < 128) dst[(16 * tb + t) * 136] = (bf16)f2bf(val);
                    if (pass == 1) y[16 * tb + t] = val; }
                asm volatile("" ::: "memory"); }
        }
    }
    __syncthreads();
    f32x4 kk[4], qk[4];
    {
        bf16x8 ak[4], aq[4];
#pragma unroll
        for (int ks = 0; ks < 4; ++ks) { ak[ks] = ldfrag(KS, 136, 16 * wl, 32 * ks, lane); aq[ks] = ldfrag(QS, 136, 16 * wl, 32 * ks, lane); }
        f32x4 qq = {0.f, 0.f, 0.f, 0.f};
#pragma unroll
        for (int ks = 0; ks < 4; ++ks) qq = MFMA16(aq[ks], aq[ks], qq);
#pragma unroll
        for (int nt = 0; nt < 4; ++nt) {
            if (nt <= wl) { f32x4 a0 = {0.f, 0.f, 0.f, 0.f}, a1 = {0.f, 0.f, 0.f, 0.f};
#pragma unroll
                for (int ks = 0; ks < 4; ++ks) { const bf16x8 bk = ldfrag(KS, 136, 16 * nt, 32 * ks, lane); a0 = MFMA16(ak[ks], bk, a0); a1 = MFMA16(aq[ks], bk, a1); }
                kk[nt] = a0; qk[nt] = a1; } else { kk[nt] = qq; qk[nt] = qq; } }
        float dk = 0.f, dq = 0.f;
#pragma unroll
        for (int nt = 0; nt < 4; ++nt) if (nt == wl) {
#pragma unroll
            for (int r = 0; r < 4; ++r) if (4 * quad + r == l15) { dk = kk[nt][r]; dq = qq[r]; } }
        if ((l15 >> 2) == quad) { NK[16 * wl + l15] = rsqrtf(dk + EPS); NQ[16 * wl + l15] = rsqrtf(dq + EPS) * 0.08838834764831845f; }
    }
    __syncthreads();
    {
        bf16* QKM = (bf16*)(img + GI_QKM);
#pragma unroll
        for (int nt = 0; nt < 4; ++nt) { const int j = 16 * nt + l15; const float nkj = NK[j], gj = GAMS[j];
#pragma unroll
            for (int r = 0; r < 4; ++r) { const int i = 16 * wl + 4 * quad + r; const float e = __expf(GAMS[i] - gj);
                LS[i * 64 + j] = i > j ? kk[nt][r] * NK[i] * nkj * e * BTS[i] : 0.f;
                QKM[i * 72 + j] = (bf16)f2bf(i >= j ? qk[nt][r] * NQ[i] * nkj * e : 0.f); } }
    }
    const float last = GAMS[63];
    if (ht < 128) {
        bf16* KT = (bf16*)(img + GI_KT) + ht * 72;
#pragma unroll
        for (int i8 = 0; i8 < 8; ++i8) { float t[8];
#pragma unroll
            for (int e = 0; e < 8; ++e) { const int j = 8 * i8 + e; const float kh = y[j] * NK[j]; t[e] = kh * __expf(last - GAMS[j]); y[j] = kh * BTS[j] * __expf(GAMS[j]); }
            v4u o; o.x = pk2(t[0], t[1]); o.y = pk2(t[2], t[3]); o.z = pk2(t[4], t[5]); o.w = pk2(t[6], t[7]); *(GAS v4u*)(KT + 8 * i8) = o; }
    } else {
#pragma unroll
        for (int j = 0; j < 64; ++j) y[j] *= BTS[j];
    }
    __syncthreads();
#pragma unroll
    for (int i = 1; i < 64; ++i) { float acc = y[i];
#pragma unroll
        for (int j4 = 0; j4 < (i + 3) / 4; ++j4) { const f32x4 l = *(const LAS f32x4*)(LS + i * 64 + 4 * j4);
            acc -= l.x * y[4 * j4]; if (4 * j4 + 1 < i) acc -= l.y * y[4 * j4 + 1]; if (4 * j4 + 2 < i) acc -= l.z * y[4 * j4 + 2]; if (4 * j4 + 3 < i) acc -= l.w * y[4 * j4 + 3]; }
        y[i] = acc; }
    if (ht < 128) { bf16* WKN = (bf16*)(img + GI_WKN) + ht;
#pragma unroll
        for (int i = 0; i < 64; ++i) WKN[i * 136] = (bf16)f2bf(-y[i]); }
    else { float* WV = (float*)(img + GI_WV) + (ht - 128);
#pragma unroll
        for (int i = 0; i < 64; ++i) WV[i * 128] = y[i]; }
    {
        bf16* QG = (bf16*)(img + GI_QG);
#pragma unroll
        for (int q = 0; q < 4; ++q) { const int idx = ht + 256 * q, i = idx >> 4, d8 = (idx & 15) * 8; const v4u x = *(const LAS v4u*)(QS + i * 136 + d8); const float sc = NQ[i] * __expf(GAMS[i]);
            v4u o; o.x = pk2(bflo(x.x) * sc, bfhi(x.x) * sc); o.y = pk2(bflo(x.y) * sc, bfhi(x.y) * sc); o.z = pk2(bflo(x.z) * sc, bfhi(x.z) * sc); o.w = pk2(bflo(x.w) * sc, bfhi(x.w) * sc);
            *(GAS v4u*)(QG + i * 136 + d8) = o; }
        if (ht == 0) *(float*)(img + GI_SC) = __expf(last);
    }
    __syncthreads();
}
__device__ __forceinline__ void phase_gdn_pre(Frame& F, int s) {
    const int npairs = (s == 0 ? GDN_ITEMS_MAX : NCH * NB * GH) / 2;
    for (int p = F.bid; p < npairs; p += F.G) gdn_pre_pair(F, s, p);
}

constexpr int GS_BUF = 0, GS_PSQ = 2 * GI_IMG, GS_ZS = GS_PSQ + 4096;
static_assert(GS_ZS + 8 * 2048 <= RING_BYTES, "GDN sequential LDS map fits");
__device__ __forceinline__ void gdn_seq_job(Frame& F, int s, bool samp, int bb, int h, bool dry = false) {
    const bf16* P = (const bf16*)(F.ws + WS_PROJ); bf16* OG = (bf16*)(F.ws + WS_OG);
    const int w = F.wave;
    int lane = F.lane; asm volatile("" : "+v"(lane)); int quad = lane >> 4, l15 = lane & 15;
    const int nchunk = samp ? 1 : NCH, row0 = samp ? RP + bb * DSEQ : bb * SLAB_T;
    const int item0 = samp ? NCH * NB * GH + bb * GH + h : (bb * GH + h) * NCH;
    const unsigned char* img0 = F.ws + WS_GDN + (size_t)item0 * GI_STRIDE;
    LAS float* PSQ = (LAS float*)(F.lds + GS_PSQ); LAS bf16* ZS = (LAS bf16*)(F.lds + GS_ZS) + w * 1024;
    f32x4 Sacc[8];
    {
        const float* st = samp ? F.A.in[3] : F.out + O_GP; const size_t sb = (size_t)(bb * GH + h) * GDK * GDV;
#pragma unroll
        for (int mt = 0; mt < 8; ++mt)
#pragma unroll
            for (int r = 0; r < 4; ++r) Sacc[mt][r] = (samp || s > 0) ? st[sb + (size_t)(16 * mt + 4 * quad + r) * GDV + 16 * w + l15] : 0.f;
    }
    const float gn = F.A.in[16][16 * w + l15];
#define GDN_STAGE(imgp, bufi) do { for (int pc_ = w; pc_ < GI_IMG / 1024; pc_ += 8) \
        __builtin_amdgcn_global_load_lds((const unsigned*)((imgp) + pc_ * 1024 + lane * 16), (LAS unsigned*)(F.lds + GS_BUF + (bufi) * GI_IMG + pc_ * 1024), 16, 0, 0); } while (0)
    GDN_STAGE(img0, 0);
    f32x4 wv[4];
    { const float* WV = (const float*)(img0 + GI_WV);
#pragma unroll
      for (int mt = 0; mt < 4; ++mt)
#pragma unroll
          for (int r = 0; r < 4; ++r) wv[mt][r] = WV[(16 * mt + 4 * quad + r) * 128 + 16 * w + l15]; }
    v4u zr0, zr1;
    { const GAS v4u* zp = (const GAS v4u*)(P + (size_t)(row0 + lane) * NPROJ + 7168 + h * 128 + 16 * w); zr0 = zp[0]; zr1 = zp[1]; }
    float el_next = *(const float*)(img0 + GI_SC);
    f32x4 Oprev[4];
#pragma unroll
    for (int mt = 0; mt < 4; ++mt) Oprev[mt] = wv[mt];
#define GDN_FINISH(cc) do { const LAS float* ps = PSQ + ((cc) & 1) * 512; const int rb = row0 + 64 * (cc); \
        _Pragma("unroll") for (int mt = 0; mt < 4; ++mt) _Pragma("unroll") for (int r = 0; r < 4; ++r) { const int i = 16 * mt + 4 * quad + r; \
            const f32x4 p0 = *(const LAS f32x4*)(ps + i * 8), p1 = *(const LAS f32x4*)(ps + i * 8 + 4); \
            const float rs = rsqrtf((((p0.x + p0.y) + (p0.z + p0.w)) + ((p1.x + p1.y) + (p1.z + p1.w))) * (1.f / GDV) + EPS); const float z = bf2f(ZS[i * 16 + l15]); \
            OG[(size_t)(rb + i) * D + h * 128 + 16 * w + l15] = (bf16)f2bf(Oprev[mt][r] * rs * gn * siluf_(z)); } } while (0)
    for (int c = 0; c < nchunk; ++c) {
        asm volatile("" : "+v"(lane)); quad = lane >> 4; l15 = lane & 15;
        asm volatile("s_waitcnt vmcnt(0)" ::: "memory");
        __syncthreads();
        const unsigned char* img = img0 + (size_t)c * GI_STRIDE;
        f32x4 wvn[4];
        const float el = el_next;
        if (c + 1 < nchunk) { GDN_STAGE(img + GI_STRIDE, (c + 1) & 1); el_next = *(const float*)(img + GI_STRIDE + GI_SC);
            const float* WV = (const float*)(img + GI_STRIDE + GI_WV);
#pragma unroll
            for (int mt = 0; mt < 4; ++mt)
#pragma unroll
                for (int r = 0; r < 4; ++r) wvn[mt][r] = WV[(16 * mt + 4 * quad + r) * 128 + 16 * w + l15]; }
        else {
#pragma unroll
            for (int mt = 0; mt < 4; ++mt) wvn[mt] = wv[mt]; }
        if (c > 0) GDN_FINISH(c - 1);
        *(LAS v4u*)(ZS + lane * 16) = zr0; *(LAS v4u*)(ZS + lane * 16 + 8) = zr1;
        if (c + 1 < nchunk) { const GAS v4u* zp = (const GAS v4u*)(P + (size_t)(row0 + 64 * (c + 1) + lane) * NPROJ + 7168 + h * 128 + 16 * w); zr0 = zp[0]; zr1 = zp[1]; }
        const LAS unsigned char* buf = F.lds + GS_BUF + (c & 1) * GI_IMG;
        const LAS bf16* WKN = (const LAS bf16*)(buf + GI_WKN); const LAS bf16* QG = (const LAS bf16*)(buf + GI_QG); const LAS bf16* KT = (const LAS bf16*)(buf + GI_KT); const LAS bf16* QKM = (const LAS bf16*)(buf + GI_QKM);
        f32x4 U[4], O[4];
#pragma unroll
        for (int mt = 0; mt < 4; ++mt) { U[mt] = wv[mt]; O[mt] = (f32x4){0.f, 0.f, 0.f, 0.f}; }
#pragma unroll
        for (int ks = 0; ks < 4; ++ks) { const bf16x8 Sb = acc2frag(Sacc[2 * ks], Sacc[2 * ks + 1]);
#pragma unroll
            for (int mt = 0; mt < 4; ++mt) { U[mt] = MFMA16(ldfrag_perm(WKN, 136, 16 * mt, 32 * ks, lane), Sb, U[mt]); O[mt] = MFMA16(ldfrag_perm(QG, 136, 16 * mt, 32 * ks, lane), Sb, O[mt]); } }
        bf16x8 Ub[2];
#pragma unroll
        for (int ks = 0; ks < 2; ++ks) Ub[ks] = acc2frag(U[2 * ks], U[2 * ks + 1]);
#pragma unroll
        for (int ks = 0; ks < 2; ++ks)
#pragma unroll
            for (int mt = 0; mt < 4; ++mt) O[mt] = MFMA16(ldfrag_perm(QKM, 72, 16 * mt, 32 * ks, lane), Ub[ks], O[mt]);
#pragma unroll
        for (int mt = 0; mt < 8; ++mt) { Sacc[mt] = Sacc[mt] * el;
#pragma unroll
            for (int ks = 0; ks < 2; ++ks) Sacc[mt] = MFMA16(ldfrag_perm(KT, 72, 16 * mt, 32 * ks, lane), Ub[ks], Sacc[mt]); }
        { LAS float* ps = PSQ + (c & 1) * 512;
#pragma unroll
          for (int mt = 0; mt < 4; ++mt)
#pragma unroll
              for (int r = 0; r < 4; ++r) { const float sq = row16_sum(O[mt][r] * O[mt][r]); if (l15 == 0) ps[(16 * mt + 4 * quad + r) * 8 + w] = sq; Oprev[mt][r] = O[mt][r]; } }
#pragma unroll
        for (int mt = 0; mt < 4; ++mt) wv[mt] = wvn[mt];
    }
    __syncthreads();
    GDN_FINISH(nchunk - 1);
#undef GDN_FINISH
#undef GDN_STAGE
    {
        float* so = (dry ? (float*)(F.ws + WS_T1) : F.out) + (samp ? O_GS : O_GP) - (dry ? O_GP : 0) + (size_t)(bb * GH + h) * GDK * GDV;
#pragma unroll
        for (int mt = 0; mt < 8; ++mt)
#pragma unroll
            for (int r = 0; r < 4; ++r) so[(size_t)(16 * mt + 4 * quad + r) * GDV + 16 * w + l15] = Sacc[mt][r];
    }
    __syncthreads();
}
constexpr int SI_CS = 0, SI_BT = 17408, SI_CB = 35840, SI_DT = 45056, SI_GAM = 46080, SI_IMG = 47104, SI_XT = SI_IMG, SI_STRIDE = SI_IMG + 32768;
constexpr int SSD_ITEMS_MAX = NCH * NB * SG + DB * SG;
constexpr size_t WS_SSD = WS_END2;
constexpr size_t WS_END3 = WS_SSD + (size_t)SSD_ITEMS_MAX * SI_STRIDE;
static_assert(WS_END3 <= 500 * MiB, "workspace map fits");
constexpr int SP_CS = 0, SP_BS = 17408, SP_DT = 34816, SP_GAM = 35840;

__device__ __forceinline__ void ssd_pre_item(Frame& F, int s, int it) {
    const bf16* P = (const bf16*)(F.ws + WS_PROJ); const float* SM = (const float*)(F.ws + WS_SM);
    const int tid = F.tid, w = F.wave;
    int lane = F.lane; asm volatile("" : "+v"(lane)); const int quad = lane >> 4, l15 = lane & 15;
    int bsel, g, r0, c; bool samp;
    if (it < NCH * NB * SG) { samp = false; const int bg = it / NCH; c = it % NCH; bsel = bg >> 3; g = bg & 7; r0 = bsel * SLAB_T + 64 * c; }
    else { samp = true; const int q = it - NCH * NB * SG; bsel = q >> 3; g = q & 7; c = 0; r0 = RP + bsel * DSEQ; }
    unsigned char* img = F.ws + WS_SSD + (size_t)it * SI_STRIDE;
    LAS bf16* CS = (LAS bf16*)(F.lds + SP_CS); LAS bf16* BS = (LAS bf16*)(F.lds + SP_BS); LAS float* DTV = (LAS float*)(F.lds + SP_DT); LAS float* GAM = (LAS float*)(F.lds + SP_GAM);
    if (tid < 256) { const int hh = 4 * g + (tid >> 6); const float dt = softplusf_(SM[(size_t)(r0 + lane) * 64 + 16 + hh] + F.A.in[18][hh]);
        const float ga = wave_incl_scan(dt * (-__expf(F.A.in[17][hh])), lane); DTV[(tid >> 6) * 64 + lane] = dt; GAM[(tid >> 6) * 64 + lane] = ga;
        ((float*)(img + SI_DT))[(tid >> 6) * 64 + lane] = dt; ((float*)(img + SI_GAM))[(tid >> 6) * 64 + lane] = ga; }
    __syncthreads();
    {
        const int cidx = tid < 256 ? 3072 + g * 256 + tid : (tid < 384 ? 5120 + g * 128 + (tid - 256) : 6144 + g * 128 + (tid - 384));
        const float* wcv = F.A.in[12]; const float w0 = wcv[cidx], w1 = wcv[CONV_CH + cidx], w2 = wcv[2 * CONV_CH + cidx], w3 = wcv[3 * CONV_CH + cidx], bias = F.A.in[13][cidx];
        float h0 = 0.f, h1 = 0.f, h2 = 0.f;
        if (c > 0) { const bf16* pp = P + (size_t)(r0 - 3) * NPROJ + cidx; h0 = bf2f(pp[0]); h1 = bf2f(pp[NPROJ]); h2 = bf2f(pp[2 * NPROJ]); }
        else if (samp) { const float* st = F.A.in[2] + (size_t)bsel * 3 * CONV_CH + cidx; h0 = st[0]; h1 = st[CONV_CH]; h2 = st[2 * CONV_CH]; }
        else if (s > 0) { const float* st = (const float*)(F.ws + WS_CARRY_MIX) + ((size_t)(s & 1) * NB + bsel) * 3 * CONV_CH + cidx; h0 = st[0]; h1 = st[CONV_CH]; h2 = st[2 * CONV_CH]; }
        unsigned colp2[32];
        const bf16* pc = P + (size_t)r0 * NPROJ + cidx;
        const LAS float* dtp = DTV + (tid < 256 ? (tid >> 6) * 64 : 0);
#pragma unroll
        for (int tb = 0; tb < 2; ++tb) { float raw[32];
#pragma unroll
            for (int t = 0; t < 32; ++t) raw[t] = bf2f(pc[(size_t)(32 * tb + t) * NPROJ]);
#pragma unroll
            for (int t = 0; t < 32; t += 2) { float va = bias + w0 * h0 + w1 * h1 + w2 * h2 + w3 * raw[t]; float vb = bias + w0 * h1 + w1 * h2 + w2 * raw[t] + w3 * raw[t + 1]; h0 = h2; h1 = raw[t]; h2 = raw[t + 1];
                va = siluf_(va); vb = siluf_(vb); if (tid < 256) { va *= dtp[32 * tb + t]; vb *= dtp[32 * tb + t + 1]; }
                colp2[16 * tb + (t >> 1)] = pk2(va, vb); }
            asm volatile("" ::: "memory"); }
        if (tid < 384) {
            bf16* rowp = tid < 256 ? (bf16*)(img + SI_XT) + tid * 64 : (bf16*)(img + SI_BT) + (tid - 256) * 72;
#pragma unroll
            for (int i = 0; i < 8; ++i) { v4u o; o.x = colp2[4 * i]; o.y = colp2[4 * i + 1]; o.z = colp2[4 * i + 2]; o.w = colp2[4 * i + 3]; *(GAS v4u*)(rowp + 8 * i) = o; }
        }
        if (tid >= 256) {
            LAS bf16* colp = tid < 384 ? BS + (tid - 256) : CS + (tid - 384);
#pragma unroll
            for (int t = 0; t < 32; ++t) { colp[(2 * t) * 136] = (bf16)(colp2[t] & 0xffffu); colp[(2 * t + 1) * 136] = (bf16)(colp2[t] >> 16); }
        }
    }
    __syncthreads();
    {
        const int mt = w >> 1; bf16* CBG = (bf16*)(img + SI_CB);
#pragma unroll
        for (int q = 0; q < 2; ++q) { const int nt = 2 * (w & 1) + q; f32x4 acc = {0.f, 0.f, 0.f, 0.f};
#pragma unroll
            for (int ks = 0; ks < 4; ++ks) acc = MFMA16(ldfrag(CS, 136, 16 * mt, 32 * ks, lane), ldfrag(BS, 136, 16 * nt, 32 * ks, lane), acc);
#pragma unroll
            for (int r = 0; r < 4; ++r) CBG[(16 * mt + 4 * quad + r) * 72 + 16 * nt + l15] = (bf16)f2bf(acc[r]); }
    }
    for (int i = tid; i < 17408 / 16; i += NTHR) *(GAS v4u*)(img + SI_CS + 16 * i) = *(const LAS v4u*)(F.lds + SP_CS + 16 * i);
    __syncthreads();
}
__device__ __forceinline__ void phase_ssd_pre(Frame& F, int s) {
    const int nitems = s == 0 ? SSD_ITEMS_MAX : NCH * NB * SG;
    for (int it = F.bid; it < nitems; it += F.G) ssd_pre_item(F, s, it);
}

constexpr int SQ_BUF = 0, SQ_PS = 2 * SI_IMG, SQ_ZS = SQ_PS + 2048;
static_assert(SQ_ZS + 8 * 4096 <= RING_BYTES, "SSD sequential LDS map fits");
__device__ __forceinline__ void ssd_seq_job(Frame& F, int s, bool samp, int bb, int g, bool dry = false) {
    const bf16* P = (const bf16*)(F.ws + WS_PROJ); bf16* YS = (bf16*)(F.ws + WS_YS);
    const int w = F.wave;
    int lane = F.lane; asm volatile("" : "+v"(lane)); int quad = lane >> 4, l15 = lane & 15;
    const int hl = w >> 1, ph = w & 1, head = 4 * g + hl;
    const int nchunk = samp ? 1 : NCH, row0 = samp ? RP + bb * DSEQ : bb * SLAB_T;
    const int item0 = samp ? NCH * NB * SG + bb * SG + g : (bb * SG + g) * NCH;
    const unsigned char* img0 = F.ws + WS_SSD + (size_t)item0 * SI_STRIDE;
    LAS float* PS = (LAS float*)(F.lds + SQ_PS); LAS bf16* ZS = (LAS bf16*)(F.lds + SQ_ZS) + w * 2048;
    f32x4 hacc[8][2];
    {
        const float* st = samp ? F.A.in[4] : F.out + O_SP;
        const size_t sb = (size_t)(bb * SH + head) * SN * SP;
#pragma unroll
        for (int mt = 0; mt < 8; ++mt)
#pragma unroll
            for (int nt = 0; nt < 2; ++nt)
#pragma unroll
                for (int r = 0; r < 4; ++r) { const int n = 16 * mt + 4 * quad + r, p = 32 * ph + 16 * nt + l15; hacc[mt][nt][r] = (samp || s > 0) ? st[sb + (size_t)n * SP + p] : 0.f; }
    }
    const float Dh = F.A.in[19][head];
    const int prow = hl * 64 + 32 * ph;
#define SSD_STAGE(imgp, bufi) do { for (int pc_ = w; pc_ < SI_IMG / 1024; pc_ += 8) \
        __builtin_amdgcn_global_load_lds((const unsigned*)((imgp) + pc_ * 1024 + lane * 16), (LAS unsigned*)(F.lds + SQ_BUF + (bufi) * SI_IMG + pc_ * 1024), 16, 0, 0); } while (0)
#define SSD_LOADXT(dst, imgp) do { const bf16* xb_ = (const bf16*)((imgp) + SI_XT); _Pragma("unroll") for (int nt = 0; nt < 2; ++nt) _Pragma("unroll") for (int ks = 0; ks < 2; ++ks) \
        dst[nt][ks] = *(const GAS v4u*)(xb_ + (prow + 16 * nt + l15) * 64 + 32 * ks + 8 * quad); } while (0)
    SSD_STAGE(img0, 0);
    v4u xt[2][2];
    SSD_LOADXT(xt, img0);
    v4u zr[4];
    { const GAS v4u* zp = (const GAS v4u*)(P + (size_t)(row0 + lane) * NPROJ + 8192 + head * 64 + 32 * ph);
#pragma unroll
      for (int i = 0; i < 4; ++i) zr[i] = zp[i]; }
    const float nw0 = F.A.in[20][head * 64 + 32 * ph + l15], nw1 = F.A.in[20][head * 64 + 32 * ph + 16 + l15];
    for (int c = 0; c < nchunk; ++c) {
        asm volatile("" : "+v"(lane)); quad = lane >> 4; l15 = lane & 15;
        asm volatile("s_waitcnt vmcnt(0)" ::: "memory");
        __syncthreads();
        const unsigned char* img = img0 + (size_t)c * SI_STRIDE;
        const int r0 = row0 + 64 * c;
        v4u xtn[2][2];
        if (c + 1 < nchunk) { SSD_STAGE(img + SI_STRIDE, (c + 1) & 1); SSD_LOADXT(xtn, img + SI_STRIDE); }
        else {
#pragma unroll
            for (int nt = 0; nt < 2; ++nt)
#pragma unroll
                for (int ks = 0; ks < 2; ++ks) xtn[nt][ks] = xt[nt][ks]; }
#pragma unroll
        for (int i = 0; i < 4; ++i) *(LAS v4u*)(ZS + lane * 32 + 8 * i) = zr[i];
        if (c + 1 < nchunk) { const GAS v4u* zp = (const GAS v4u*)(P + (size_t)(r0 + 64 + lane) * NPROJ + 8192 + head * 64 + 32 * ph);
#pragma unroll
          for (int i = 0; i < 4; ++i) zr[i] = zp[i]; }
        const LAS unsigned char* buf = F.lds + SQ_BUF + (c & 1) * SI_IMG;
        const LAS bf16* CS = (const LAS bf16*)(buf + SI_CS); const LAS bf16* BT = (const LAS bf16*)(buf + SI_BT); const LAS bf16* CBS = (const LAS bf16*)(buf + SI_CB);
        const LAS float* gm = (const LAS float*)(buf + SI_GAM) + hl * 64; const LAS float* dv = (const LAS float*)(buf + SI_DT) + hl * 64;
        const float last = gm[63];
        f32x4 y[4][2];
#pragma unroll
        for (int mt = 0; mt < 4; ++mt)
#pragma unroll
            for (int nt = 0; nt < 2; ++nt) y[mt][nt] = (f32x4){0.f, 0.f, 0.f, 0.f};
#pragma unroll
        for (int ks = 0; ks < 4; ++ks) { const bf16x8 hb0 = acc2frag(hacc[2 * ks][0], hacc[2 * ks + 1][0]), hb1 = acc2frag(hacc[2 * ks][1], hacc[2 * ks + 1][1]);
#pragma unroll
            for (int mt = 0; mt < 4; ++mt) { const bf16x8 a = ldfrag_perm(CS, 136, 16 * mt, 32 * ks, lane); y[mt][0] = MFMA16(a, hb0, y[mt][0]); y[mt][1] = MFMA16(a, hb1, y[mt][1]); }
            __builtin_amdgcn_sched_barrier(0); }
#pragma unroll
        for (int mt = 0; mt < 4; ++mt)
#pragma unroll
            for (int r = 0; r < 4; ++r) { const float eg = __expf(gm[16 * mt + 4 * quad + r]); y[mt][0][r] *= eg; y[mt][1][r] *= eg; }
#pragma unroll
        for (int mt = 0; mt < 4; ++mt) { const int i = 16 * mt + l15; const float gi = gm[i], ddt = Dh / dv[i];
#pragma unroll
            for (int ks = 0; ks < 2; ++ks) { if (32 * ks > 16 * mt + 15) continue;
                const v4u aw = __builtin_bit_cast(v4u, ldfrag(CBS, 72, 16 * mt, 32 * ks, lane));
                const f32x4 g0 = *(const LAS f32x4*)(gm + 32 * ks + 8 * quad), g1 = *(const LAS f32x4*)(gm + 32 * ks + 8 * quad + 4);
                float cv[8] = {bflo(aw.x), bfhi(aw.x), bflo(aw.y), bfhi(aw.y), bflo(aw.z), bfhi(aw.z), bflo(aw.w), bfhi(aw.w)};
                const float gj[8] = {g0.x, g0.y, g0.z, g0.w, g1.x, g1.y, g1.z, g1.w};
#pragma unroll
                for (int jj = 0; jj < 8; ++jj) { const int j = 32 * ks + 8 * quad + jj; float v = i >= j ? cv[jj] * __expf(gi - gj[jj]) : 0.f; if (i == j) v += ddt; cv[jj] = v; }
                v4u bw; bw.x = pk2(cv[0], cv[1]); bw.y = pk2(cv[2], cv[3]); bw.z = pk2(cv[4], cv[5]); bw.w = pk2(cv[6], cv[7]); const bf16x8 a1 = __builtin_bit_cast(bf16x8, bw);
#pragma unroll
                for (int nt = 0; nt < 2; ++nt) y[mt][nt] = MFMA16(a1, __builtin_bit_cast(bf16x8, xt[nt][ks]), y[mt][nt]); }
            __builtin_amdgcn_sched_barrier(0); }
#pragma unroll
        for (int mt = 0; mt < 4; ++mt)
#pragma unroll
            for (int r = 0; r < 4; ++r) { const int i = 16 * mt + 4 * quad + r; float sq = 0.f;
#pragma unroll
                for (int nt = 0; nt < 2; ++nt) { const float z = bf2f(ZS[i * 32 + 16 * nt + l15]); const float yz = y[mt][nt][r] * siluf_(z); y[mt][nt][r] = yz; sq += yz * yz; }
                sq = row16_sum(sq); if (l15 == 0) PS[i * 8 + w] = sq; }
        {
            const float el = __expf(last);
#pragma unroll
            for (int mt = 0; mt < 8; ++mt)
#pragma unroll
                for (int nt = 0; nt < 2; ++nt) hacc[mt][nt] = hacc[mt][nt] * el;
#pragma unroll
            for (int ks = 0; ks < 2; ++ks) { const f32x4 g0 = *(const LAS f32x4*)(gm + 32 * ks + 8 * quad), g1 = *(const LAS f32x4*)(gm + 32 * ks + 8 * quad + 4);
                const float ed[8] = {__expf(last - g0.x), __expf(last - g0.y), __expf(last - g0.z), __expf(last - g0.w), __expf(last - g1.x), __expf(last - g1.y), __expf(last - g1.z), __expf(last - g1.w)};
                bf16x8 xw[2];
#pragma unroll
                for (int nt = 0; nt < 2; ++nt) { const v4u xv = xt[nt][ks];
                    v4u o; o.x = pk2(bflo(xv.x) * ed[0], bfhi(xv.x) * ed[1]); o.y = pk2(bflo(xv.y) * ed[2], bfhi(xv.y) * ed[3]); o.z = pk2(bflo(xv.z) * ed[4], bfhi(xv.z) * ed[5]); o.w = pk2(bflo(xv.w) * ed[6], bfhi(xv.w) * ed[7]);
                    xw[nt] = __builtin_bit_cast(bf16x8, o); }
#pragma unroll
                for (int mt = 0; mt < 8; ++mt) { const bf16x8 a = ldfrag(BT, 72, 16 * mt, 32 * ks, lane); hacc[mt][0] = MFMA16(a, xw[0], hacc[mt][0]); hacc[mt][1] = MFMA16(a, xw[1], hacc[mt][1]); }
                __builtin_amdgcn_sched_barrier(0); }
        }
        __syncthreads();
#pragma unroll
        for (int mt = 0; mt < 4; ++mt)
#pragma unroll
            for (int r = 0; r < 4; ++r) { const int i = 16 * mt + 4 * quad + r; const f32x4 p0 = *(const LAS f32x4*)(PS + i * 8), p1 = *(const LAS f32x4*)(PS + i * 8 + 4);
                const float rs = rsqrtf((((p0.x + p0.y) + (p0.z + p0.w)) + ((p1.x + p1.y) + (p1.z + p1.w))) * (1.f / 256.f) + EPS);
#pragma unroll
                for (int nt = 0; nt < 2; ++nt) { const int ch = head * 64 + 32 * ph + 16 * nt + l15; YS[(size_t)(r0 + i) * 2048 + ch] = (bf16)f2bf(y[mt][nt][r] * rs * (nt ? nw1 : nw0)); } }
#pragma unroll
        for (int nt = 0; nt < 2; ++nt)
#pragma unroll
            for (int ks = 0; ks < 2; ++ks) xt[nt][ks] = xtn[nt][ks];
    }
#undef SSD_STAGE
#undef SSD_LOADXT
    {
        float* so = (dry ? (float*)(F.ws + WS_T1) : F.out) + (samp ? O_SS : O_SP) - (dry ? O_GP : 0) + (size_t)(bb * SH + head) * SN * SP;
#pragma unroll
        for (int mt = 0; mt < 8; ++mt)
#pragma unroll
            for (int nt = 0; nt < 2; ++nt)
#pragma unroll
                for (int r = 0; r < 4; ++r) so[(size_t)(16 * mt + 4 * quad + r) * SP + 32 * ph + 16 * nt + l15] = hacc[mt][nt][r];
    }
    __syncthreads();
}
__device__ __forceinline__ void gdn_naive_job(Frame& F, int s, bool samp, int bb, int h) {
    const bf16* P = (const bf16*)(F.ws + WS_PROJ); const float* SM = (const float*)(F.ws + WS_SM); bf16* OG = (bf16*)(F.ws + WS_OG);
    LAS float* qs = (LAS float*)F.lds; LAS float* ks = qs + 128; LAS float* vs = ks + 128; LAS float* part = vs + 128;
    LAS float* red = part + 8; LAS float* red2 = red + 512; LAS float* part2 = red2 + 512;
    const int tid = F.tid, v = tid & 127, kq = tid >> 7, ntok = samp ? DSEQ : SLAB_T, row0 = samp ? RP + bb * DSEQ : bb * SLAB_T;
    float S[32];
    const size_t sbase = ((size_t)(bb * GH + h) * GDK + kq * 32) * GDV + v;
    if (samp) { const float* st = F.A.in[3] + sbase;
#pragma unroll
        for (int i = 0; i < 32; ++i) S[i] = st[(size_t)i * GDV]; }
    else if (s == 0) {
#pragma unroll
        for (int i = 0; i < 32; ++i) S[i] = 0.f; }
    else { const float* st = F.out + O_GP + sbase;
#pragma unroll
        for (int i = 0; i < 32; ++i) S[i] = st[(size_t)i * GDV]; }
    const int role = tid >> 7, ch = tid & 127, cidx = role * 1024 + h * 128 + ch;
    float h0 = 0.f, h1 = 0.f, h2 = 0.f, w0 = 0.f, w1 = 0.f, w2 = 0.f, w3 = 0.f, bias = 0.f;
    if (tid < 384) {
        const float* wcv = F.A.in[12]; w0 = wcv[cidx]; w1 = wcv[CONV_CH + cidx]; w2 = wcv[2 * CONV_CH + cidx]; w3 = wcv[3 * CONV_CH + cidx]; bias = F.A.in[13][cidx];
        if (samp) { const float* st = F.A.in[2] + (size_t)bb * 3 * CONV_CH + cidx; h0 = st[0]; h1 = st[CONV_CH]; h2 = st[2 * CONV_CH]; }
        else if (s > 0) { const float* st = (const float*)(F.ws + WS_CARRY_MIX) + ((size_t)(s & 1) * NB + bb) * 3 * CONV_CH + cidx; h0 = st[0]; h1 = st[CONV_CH]; h2 = st[2 * CONV_CH]; }
    }
    const float Aexp = __expf(F.A.in[14][h]), dtb = F.A.in[15][h], gnorm = F.A.in[16][v];
    for (int t = 0; t < ntok; ++t) {
        const size_t r = (size_t)(row0 + t);
        if (tid < 384) {
            const float raw = bf2f(P[r * NPROJ + cidx]);
            float val = bias + w0 * h0 + w1 * h1 + w2 * h2 + w3 * raw; h0 = h1; h1 = h2; h2 = raw; val = siluf_(val);
            qs[role * 128 + ch] = val;
            if (role < 2) { const float sq = wave_sum(val * val); if (F.lane == 0) part[F.wave] = sq; }
        }
        __syncthreads();
        const float qsc = rsqrtf(part[0] + part[1] + EPS) * 0.08838834764831845f, ksc = rsqrtf(part[2] + part[3] + EPS);
        const float beta = sigmoidf_(SM[r * 64 + h]); const float g = -Aexp * softplusf_(SM[r * 64 + 8 + h] + dtb); const float a = __expf(g);
        float kn[32]; float p = 0.f;
#pragma unroll
        for (int i = 0; i < 32; ++i) { kn[i] = ks[kq * 32 + i] * ksc; p += kn[i] * S[i]; }
        red[kq * 128 + v] = p;
        __syncthreads();
        const float kS = (red[v] + red[128 + v]) + (red[256 + v] + red[384 + v]);
        const float d = beta * (vs[v] - a * kS);
        float po = 0.f;
#pragma unroll
        for (int i = 0; i < 32; ++i) { S[i] = a * S[i] + kn[i] * d; po += qs[kq * 32 + i] * qsc * S[i]; }
        red2[kq * 128 + v] = po;
        __syncthreads();
        float o = 0.f;
        if (tid < 128) { o = (red2[v] + red2[128 + v]) + (red2[256 + v] + red2[384 + v]); const float sq = wave_sum(o * o); if (F.lane == 0) part2[F.wave] = sq; }
        __syncthreads();
        if (tid < 128) { const float rs = rsqrtf((part2[0] + part2[1]) * (1.f / GDV) + EPS); const float z = bf2f(P[r * NPROJ + 7168 + h * 128 + v]);
            OG[r * D + h * 128 + v] = (bf16)f2bf(o * rs * gnorm * siluf_(z)); }
    }
    float* so = F.out + (samp ? O_GS : O_GP) + sbase;
#pragma unroll
    for (int i = 0; i < 32; ++i) so[(size_t)i * GDV] = S[i];
    __syncthreads();
}
__device__ __forceinline__ void ssd_naive_job(Frame& F, int s, bool samp, int bb, int g) {
    const bf16* P = (const bf16*)(F.ws + WS_PROJ); const float* SM = (const float*)(F.ws + WS_SM); bf16* YS = (bf16*)(F.ws + WS_YS);
    LAS float* xs = (LAS float*)F.lds; LAS float* Bs = xs + 256; LAS float* Cs = Bs + 128; LAS float* red = Cs + 128; LAS float* part = red + 512;
    const int tid = F.tid, hl = tid >> 7, p = tid & 63, nh = (tid >> 6) & 1, head = 4 * g + hl, ntok = samp ? DSEQ : SLAB_T, row0 = samp ? RP + bb * DSEQ : bb * SLAB_T;
    float hr[64];
    const size_t sbase = ((size_t)(bb * SH + head) * SN + nh * 64) * SP + p;
    if (samp) { const float* st = F.A.in[4] + sbase;
#pragma unroll
        for (int i = 0; i < 64; ++i) hr[i] = st[(size_t)i * SP]; }
    else if (s == 0) {
#pragma unroll
        for (int i = 0; i < 64; ++i) hr[i] = 0.f; }
    else { const float* st = F.out + O_SP + sbase;
#pragma unroll
        for (int i = 0; i < 64; ++i) hr[i] = st[(size_t)i * SP]; }
    const int cidx = tid < 256 ? 3072 + g * 256 + tid : (tid < 384 ? 5120 + g * 128 + (tid - 256) : 6144 + g * 128 + (tid - 384));
    const float* wcv = F.A.in[12]; const float w0 = wcv[cidx], w1 = wcv[CONV_CH + cidx], w2 = wcv[2 * CONV_CH + cidx], w3 = wcv[3 * CONV_CH + cidx], bias = F.A.in[13][cidx];
    float h0 = 0.f, h1 = 0.f, h2 = 0.f;
    if (samp) { const float* st = F.A.in[2] + (size_t)bb * 3 * CONV_CH + cidx; h0 = st[0]; h1 = st[CONV_CH]; h2 = st[2 * CONV_CH]; }
    else if (s > 0) { const float* st = (const float*)(F.ws + WS_CARRY_MIX) + ((size_t)(s & 1) * NB + bb) * 3 * CONV_CH + cidx; h0 = st[0]; h1 = st[CONV_CH]; h2 = st[2 * CONV_CH]; }
    const float aneg = -__expf(F.A.in[17][head]), dtb = F.A.in[18][head], Dh = F.A.in[19][head], nw = F.A.in[20][head * 64 + p];
    for (int t = 0; t < ntok; ++t) {
        const size_t r = (size_t)(row0 + t);
        { const float raw = bf2f(P[r * NPROJ + cidx]); float val = bias + w0 * h0 + w1 * h1 + w2 * h2 + w3 * raw; h0 = h1; h1 = h2; h2 = raw; xs[tid] = siluf_(val); }
        __syncthreads();
        const float dt = softplusf_(SM[r * 64 + 16 + head] + dtb), dA = __expf(dt * aneg), x = xs[hl * 64 + p], dx = dt * x;
        float py = 0.f;
#pragma unroll
        for (int i = 0; i < 64; ++i) { hr[i] = dA * hr[i] + dx * Bs[nh * 64 + i]; py += Cs[nh * 64 + i] * hr[i]; }
        red[tid] = py;
        __syncthreads();
        float yz = 0.f;
        if (nh == 0) { const float y = red[tid] + red[tid + 64] + Dh * x; const float z = bf2f(P[r * NPROJ + 8192 + head * 64 + p]); yz = y * siluf_(z);
            const float sq = wave_sum(yz * yz); if (F.lane == 0) part[F.wave] = sq; }
        __syncthreads();
        if (nh == 0) { const float rs = rsqrtf(((part[0] + part[2]) + (part[4] + part[6])) * (1.f / 256.f) + EPS); YS[r * 2048 + head * 64 + p] = (bf16)f2bf(yz * rs * nw); }
    }
    float* so = F.out + (samp ? O_SS : O_SP) + sbase;
#pragma unroll
    for (int i = 0; i < 64; ++i) so[(size_t)i * SP] = hr[i];
    __syncthreads();
}
#ifndef SCAN_REP_GDN
#define SCAN_REP_GDN 0
#endif
#ifndef SCAN_REP_SSD
#define SCAN_REP_SSD 0
#endif
__device__ __forceinline__ void phase_scan(Frame& F, int s) {
    const int njobs = s == 0 ? 192 : 64;
    for (int j = F.bid; j < njobs; j += F.G) {
        if (j < 32) {
#ifdef GDN_NAIVE
            gdn_naive_job(F, s, false, j >> 3, j & 7);
#else
#if SCAN_REP_GDN
            gdn_seq_job(F, s, false, j >> 3, j & 7, true);
#endif
            gdn_seq_job(F, s, false, j >> 3, j & 7);
#endif
        } else if (j < 64) {
#ifndef EXP_NO_SSD
#if SCAN_REP_SSD
            ssd_seq_job(F, s, false, (j - 32) >> 3, (j - 32) & 7, true);
#endif
            ssd_seq_job(F, s, false, (j - 32) >> 3, (j - 32) & 7);
#endif
        }
        else if (j < 128) {
#ifdef GDN_NAIVE
            gdn_naive_job(F, s, true, (j - 64) >> 3, (j - 64) & 7);
#else
            gdn_seq_job(F, s, true, (j - 64) >> 3, (j - 64) & 7);
#endif
        } else {
#ifndef EXP_NO_SSD
            ssd_seq_job(F, s, true, (j - 128) >> 3, (j - 128) & 7);
#endif
        }
    }
}
#define XB_TMO      128
#define XB_XCNT(j)  (256  + 64 * (j))
#define XB_XSUB(j)  (1280 + 64 * (j))
#define XB_XGEN(j)  (2304 + 64 * (j))
#define XB_TOP      3328
#define XB_TOPGEN   3392
#define XCD_BAR_WORDS 3456
#define XB_SPIN_CAP (1u << 18)
__device__ __forceinline__ unsigned xb_ld(unsigned* p)              { return __hip_atomic_load(p, __ATOMIC_RELAXED, __HIP_MEMORY_SCOPE_AGENT); }
__device__ __forceinline__ unsigned xb_add(unsigned* p, unsigned v) { return __hip_atomic_fetch_add(p, v, __ATOMIC_RELAXED, __HIP_MEMORY_SCOPE_AGENT); }
__device__ __forceinline__ unsigned xb_xcc_id() { return (unsigned)__builtin_amdgcn_s_getreg((3 << 11) | 20) & 0xFu; }
#define XB_SPIN(cond, bar) do { unsigned _sp = 0; while (cond) { __builtin_amdgcn_s_sleep(1); \
    if ((++_sp & 255u) == 0u) { if (xb_ld(&(bar)[XB_TMO])) break; if (_sp > XB_SPIN_CAP) { atomicAdd(&(bar)[XB_TMO], 1u); break; } } } } while (0)
struct XcdBarrier { unsigned* bar; unsigned x; volatile LAS unsigned* st; };
__device__ __forceinline__ XcdBarrier xcd_barrier_post(unsigned* bar, volatile LAS unsigned* st) {
    XcdBarrier b; b.bar = bar; b.x = xb_xcc_id(); b.st = st;
    if (threadIdx.x == 0) (void)xb_add(&bar[XB_XCNT(b.x)], 1u);
    return b;
}
__device__ __forceinline__ void xcd_barrier_complete(unsigned* bar, unsigned x, unsigned& nloc, unsigned& nx) {
    const unsigned G = gridDim.x * gridDim.y * gridDim.z;
    unsigned sum, cnt, mine, sp = 0u;
    for (;;) {
        sum = 0u; cnt = 0u; mine = 0u;
#pragma unroll
        for (unsigned j = 0; j < 16; ++j) { const unsigned c = xb_ld(&bar[XB_XCNT(j)]); sum += c; cnt += (c > 0u) ? 1u : 0u; mine = (j == x) ? c : mine; }
        if (sum == G) break;
        __builtin_amdgcn_s_sleep(1);
        if ((++sp & 255u) == 0u) { if (xb_ld(&bar[XB_TMO])) break; if (sp > XB_SPIN_CAP) { atomicAdd(&bar[XB_TMO], 1u); break; } }
    }
    nloc = mine > 0u ? mine : 1u; nx = cnt > 0u ? cnt : 1u;
}
__device__ __forceinline__ void xcd_barrier(const XcdBarrier& b) {
    asm volatile("s_waitcnt vmcnt(0)" ::: "memory");
    __syncthreads();
    if (threadIdx.x == 0) {
        unsigned* bar = b.bar;
        __builtin_amdgcn_s_waitcnt(0);
        unsigned nloc = b.st[0], nx = b.st[1];
        if (nloc == 0u) { xcd_barrier_complete(bar, b.x, nloc, nx); b.st[0] = nloc; b.st[1] = nx; }
        const unsigned old = xb_add(&bar[XB_XSUB(b.x)], 1u);
        const unsigned gen = old / nloc;
        if (old + 1u == (gen + 1u) * nloc) {
            __builtin_amdgcn_fence(__ATOMIC_RELEASE, "agent");
            asm volatile("s_waitcnt vmcnt(0)" ::: "memory");
            const unsigned og = xb_add(&bar[XB_TOP], 1u);
            const unsigned tg = og / nx;
            if (og + 1u == (tg + 1u) * nx) xb_add(&bar[XB_TOPGEN], 1u);
            else XB_SPIN(xb_ld(&bar[XB_TOPGEN]) == tg, bar);
            __builtin_amdgcn_fence(__ATOMIC_ACQUIRE, "agent");
            xb_add(&bar[XB_XGEN(b.x)], 1u);
            asm volatile("s_waitcnt vmcnt(0)" ::: "memory");
        } else {
            XB_SPIN(xb_ld(&bar[XB_XGEN(b.x)]) == gen, bar);
            __builtin_amdgcn_fence(__ATOMIC_ACQUIRE, "agent");
            asm volatile("s_waitcnt vmcnt(0)" ::: "memory");
        }
    }
    __syncthreads();
}
constexpr int CW_BAR = 4096;
#ifndef PHASE_MASK
#define PHASE_MASK 0xFFF
#endif
#define PM(k) ((PHASE_MASK >> (k)) & 1)
#ifndef GEMM_REPS
#define GEMM_REPS 1
#endif
#ifndef PRE_REPS
#define PRE_REPS 1
#endif
constexpr int STEPS_PER_SLAB = 11, NSTEPS = 2 + STEPS_PER_SLAB * NSLAB;
#define GEMM_PHASE(EPI_T, AOFF, BOFF, N_, K_, ...) do { pg8::Gemm g{(const pg8::bf16_t*)(F.ws + (AOFF)), (const pg8::bf16_t*)(F.ws + (BOFF)), R, (N_), (K_)}; \
    pg8::StaticOrder S; S.init(R, (N_), F.G, F.bid); epi::EPI_T E{__VA_ARGS__}; pg8::gemm_phase<epi::EPI_T, pg8::StaticOrder, true, true>(F.lds, g, S, E, F.tid); if (GEMM_REPS > 1) { __syncthreads(); pg8::gemm_phase<epi::EPI_T, pg8::StaticOrder, true, true>(F.lds, g, S, E, F.tid); } } while (0)
__device__ __forceinline__ void run_step(Frame& F, int st) {
    if (st == 0) { if constexpr (PM(10)) phase_prologue0(F); return; }
    if (st == 1) { if constexpr (PM(11)) phase_prologue1(F); return; }
    const int s = (st - 2) / STEPS_PER_SLAB, k = (st - 2) % STEPS_PER_SLAB, R = slab_rows(s);
    unsigned char* ws = F.ws;
    switch (k) {
    case 0: if constexpr (PM(0)) phase_norm1(F, s); break;
    case 1: if constexpr (PM(1)) GEMM_PHASE(EpiProj, WS_HB, WS_WIN, NIN, D, (bf16*)(ws + WS_PROJ), (float*)(ws + WS_SM)); break;
    case 2: if constexpr (PM(2)) {
#if !defined(GDN_NAIVE) && !defined(EXP_NO_PRE)
        for (int rep_ = 0; rep_ < PRE_REPS; ++rep_) phase_gdn_pre(F, s);
        phase_ssd_pre(F, s);
#endif
        } break;
    case 3: if constexpr (PM(2)) {
#ifndef EXP_NO_SCAN
        phase_scan(F, s);
#endif
        phase_mix_carry(F, s); } break;
    case 4: if constexpr (PM(3)) GEMM_PHASE(EpiGate1, WS_OG, WS_WG, D, D, (const bf16*)(ws + WS_PROJ), (float*)(ws + WS_T1)); break;
    case 5: if constexpr (PM(4)) GEMM_PHASE(EpiGate2, WS_YS, WS_WS, D, 2048, (const bf16*)(ws + WS_PROJ), (const float*)(ws + WS_T1), (bf16*)(ws + WS_MIX)); break;
    case 6: if constexpr (PM(5)) GEMM_PHASE(EpiOut, WS_MIX, WS_WOUT, D, D, F.A.in[0], F.A.in[1], (const float*)(ws + WS_MODV), (const float*)(ws + WS_G2), (float*)(ws + WS_X1), (bf16*)(ws + WS_X1G), (float*)(ws + WS_SS1), s); break;
    case 7: if constexpr (PM(6)) GEMM_PHASE(EpiUp, WS_X1G, WS_WUP, NUP, D, (const float*)(ws + WS_SS1), (const float*)(ws + WS_SHW), (bf16*)(ws + WS_U)); break;
    case 8: if constexpr (PM(7)) phase_convact(F, s); break;
    case 9: if constexpr (PM(8)) GEMM_PHASE(EpiDown, WS_ACT, WS_WDN, D, DFF, (const float*)(ws + WS_X1), (const float*)(ws + WS_MODV), F.out + O_YP, F.out + O_YS, (float*)(ws + WS_SS2), s); break;
    default: if constexpr (PM(9)) phase_final(F, s); break;
    }
}
__global__ void __launch_bounds__(NTHR, 2) mk_fwd(Args a) {
    extern __shared__ __attribute__((aligned(16))) unsigned char lds[];
    Frame F(a);
    F.lds = (LAS unsigned char*)lds; F.MISC = (volatile LAS unsigned*)(F.lds + MISC_OFF);
    F.tid = threadIdx.x; F.lane = F.tid & 63; F.wave = __builtin_amdgcn_readfirstlane(F.tid >> 6); F.G = gridDim.x; F.bid = blockIdx.x;
    F.out = a.out; F.ws = a.ws; F.ctl = (gu32*)(a.ws + WS_CTL);
    for (int u = F.tid; u < (LDS_BYTES - LDSCTL_OFF) / 4; u += NTHR) ((LAS unsigned*)(F.lds + LDSCTL_OFF))[u] = 0u;
    __syncthreads();
    XcdBarrier bar; bar.bar = (unsigned*)(F.ctl + CW_BAR); bar.x = 0; bar.st = nullptr;
    const bool multi = (a.ph_hi - a.ph_lo) > 1;
    if (multi) bar = xcd_barrier_post((unsigned*)(F.ctl + CW_BAR), F.MISC + 8);
    for (int st = a.ph_lo; st < a.ph_hi; ++st) {
        { int t_ = threadIdx.x, b_ = blockIdx.x; unsigned char* w_ = a.ws; float* o_ = a.out; asm volatile("" : "+v"(t_), "+s"(b_), "+s"(w_), "+s"(o_));
          F.tid = t_; F.lane = t_ & 63; F.wave = __builtin_amdgcn_readfirstlane(t_ >> 6); F.bid = b_; F.ws = w_; F.out = o_; }
        run_step(F, st);
        if (st + 1 < a.ph_hi) { if (st == a.ph_lo) cooperative_groups::this_grid().sync(); else xcd_barrier(bar); }
    }
}
#ifndef MK_SINGLE
#define MK_SINGLE 1
#endif
extern "C" void kernel_launch(void* const* d_in, const int* in_sizes, int n_in, void* d_out, int out_size, void* d_ws, size_t ws_size, hipStream_t stream) {
    static int grid = 0;
    if (grid == 0) {
        if (n_in != 30 || (size_t)out_size != O_END || ws_size < WS_END3) { fprintf(stderr, "kernel_launch: unexpected shapes: n_in %d out %d ws %zu (need %zu)\n", n_in, out_size, ws_size, (size_t)WS_END3); grid = -1; return; }
        int dev = 0, cus = 0;
        if (hipGetDevice(&dev) != hipSuccess || hipDeviceGetAttribute(&cus, hipDeviceAttributeMultiprocessorCount, dev) != hipSuccess) { grid = -1; return; }
        if (hipFuncSetAttribute((const void*)mk_fwd, hipFuncAttributeMaxDynamicSharedMemorySize, LDS_BYTES) != hipSuccess) { fprintf(stderr, "kernel_launch: hipFuncSetAttribute failed\n"); grid = -1; return; }
        int per_cu = 0;
        if (hipOccupancyMaxActiveBlocksPerMultiprocessor(&per_cu, (const void*)mk_fwd, NTHR, LDS_BYTES) != hipSuccess || per_cu < 1) fprintf(stderr, "kernel_launch: occupancy query says %d\n", per_cu);
        (void)hipGetLastError();
        grid = cus * (per_cu < 1 ? 1 : per_cu);
    }
    if (grid < 0) return;
    (void)hipMemsetAsync((char*)d_ws + WS_CTL, 0, CTL_ZERO_BYTES, stream);
    Args a{};
    for (int i = 0; i < 30; ++i) a.in[i] = (const float*)d_in[i];
    a.out = (float*)d_out; a.ws = (unsigned char*)d_ws;
#if MK_SINGLE
    a.ph_lo = 0; a.ph_hi = NSTEPS;
    void* kargs[] = {(void*)&a};
    hipError_t le = hipLaunchCooperativeKernel((const void*)mk_fwd, dim3(grid), dim3(NTHR), kargs, LDS_BYTES, stream);
    if (le != hipSuccess) fprintf(stderr, "kernel_launch: cooperative launch failed: %s (grid %d)\n", hipGetErrorString(le), grid);
#else
    for (int st = 0; st < NSTEPS; ++st) { a.ph_lo = st; a.ph_hi = st + 1; hipLaunchKernelGGL(mk_fwd, dim3(grid), dim3(NTHR), LDS_BYTES, stream, a); }
#endif
}
```

```cpp
#include <hip/hip_runtime.h>
#include <hip/hip_cooperative_groups.h>
#include <cstdio>
#include <cstdint>

namespace pg8 {
#define PG8_LAS __attribute__((address_space(3)))
typedef unsigned short bf16_t;
typedef short bf16x8 __attribute__((ext_vector_type(8)));
typedef float f32x4 __attribute__((ext_vector_type(4)));
typedef unsigned u32x4 __attribute__((ext_vector_type(4)));
typedef unsigned u32x2 __attribute__((ext_vector_type(2)));
constexpr int BM = 256, BK = 64, HALF = 128, HTB = HALF * BK * 2, STAGE_BYTES = 8 * HTB, NXCD = 8, WGM = 8;

__host__ __device__ __forceinline__ int lds_byte(int r, int c) { const int st = (r >> 4) * 2 + (c >> 5), rr = r & 15, cc = c & 31, ob = rr * 64 + cc * 2; return st * 1024 + (ob ^ (((ob >> 9) & 1) << 5)); }
__host__ __device__ __forceinline__ void stage_rc(int b, int& R, int& C) { const int st = b / 1024, sb = b % 1024, swz = sb ^ (((sb >> 9) & 1) << 5); R = (st >> 1) * 16 + swz / 64; C = (st & 1) * 32 + (swz % 64) / 2; }
__host__ __device__ __forceinline__ int perm32(int rho) { const int n = rho >> 4, i = rho & 15; return 8 * (i >> 2) + 4 * n + (i & 3); }

struct Unit { int pm, pn; };
struct Gemm { const bf16_t* A; const bf16_t* Bt; int M, N, K; };

struct StaticOrder {
    int nM, nN, nwg, G, c;
    __host__ __device__ void init(int M, int N, int G_, int c_) { nM = M / BM; nN = N / BM; nwg = nM * nN; G = G_; c = c_; }
    __host__ __device__ bool next(int i, Unit& u) const {
        const long L = (long)i * G + c; if (L >= nwg) return false;
        int wgid = (int)L; { const int q = nwg / NXCD, r = nwg % NXCD, xcd = wgid % NXCD, off = wgid / NXCD; wgid = (xcd < r ? xcd * (q + 1) : r * (q + 1) + (xcd - r) * q) + off; }
        const int nig = WGM * nN, gid = wgid / nig, fm = gid * WGM, gsz = (nM - fm) < WGM ? (nM - fm) : WGM;
        u.pm = fm + ((wgid % nig) % gsz); u.pn = (wgid % nig) / gsz; return true;
    }
    __device__ __forceinline__ void a_ready(const Unit&) const {}
    __device__ __forceinline__ void done(const Unit&) const {}
};

typedef float f32x2_t __attribute__((ext_vector_type(2))); typedef __bf16 bf16x2_t __attribute__((ext_vector_type(2)));
__device__ __forceinline__ unsigned cvt_pk_bf16(float lo, float hi) { f32x2_t v = {lo, hi}; bf16x2_t b = __builtin_convertvector(v, bf16x2_t); return __builtin_bit_cast(unsigned, b); }

template <class Epi, class Sched, bool ALIGN_EPI = false, bool SP2 = false>
__device__ __forceinline__ void gemm_phase(PG8_LAS unsigned char* lds, const Gemm g, const Sched& S, const Epi& E, const int tid) {
    const int wid = __builtin_amdgcn_readfirstlane(tid >> 6), lane = tid & 63, wr = wid >> 2, wc = wid & 3, fr = lane & 15, fq = lane >> 4;
    const int K = g.K, nt = K / BK;
    unsigned voffA[2], voffB[2];
#pragma unroll
    for (int i = 0; i < 2; ++i) { int R, C; stage_rc(tid * 16 + i * 8192, R, C); const int Rb = Epi::PERM ? ((R & ~31) + perm32(R & 31)) : R;
        voffA[i] = (unsigned)(R * K + C) * 2u; voffB[i] = (unsigned)(Rb * K + C) * 2u; }
    const size_t kstep = (size_t)(BK * 2);
    const size_t hstep = (size_t)HALF * K * 2;
    const size_t tstep = 2 * hstep;
    const unsigned ldsw = (unsigned)wid * 1024u;
    const int aoff = lds_byte(wr * 64 + fr, fq * 8), boff = lds_byte(wc * 32 + fr, fq * 8);
#define PG8_SA(b, h) (((b) * 2 + (h)) * HTB)
#define PG8_SB(b, h) ((4 + (b) * 2 + (h)) * HTB)
#define PG8_STAGE(bufoff, gbase, voff) do { _Pragma("unroll") for (int _i = 0; _i < 2; ++_i) \
        __builtin_amdgcn_global_load_lds((const unsigned*)((const char*)(gbase) + (voff)[_i]), (PG8_LAS unsigned*)(lds + (bufoff) + ldsw + _i * 8192), 16, 0, 0); } while (0)
#define PG8_LDA(dst, b, h) do { _Pragma("unroll") for (int m = 0; m < 4; ++m) _Pragma("unroll") for (int k = 0; k < 2; ++k) dst[m][k] = *(const PG8_LAS bf16x8*)(lds + PG8_SA(b, h) + aoff + m * 2048 + k * 1024); } while (0)
#define PG8_LDB(dst, b, h) do { _Pragma("unroll") for (int n = 0; n < 2; ++n) _Pragma("unroll") for (int k = 0; k < 2; ++k) dst[n][k] = *(const PG8_LAS bf16x8*)(lds + PG8_SB(b, h) + boff + n * 2048 + k * 1024); } while (0)
#define PG8_MMA(ai, bj, At, Bt) do { __builtin_amdgcn_s_setprio(1); _Pragma("unroll") for (int m = 0; m < 4; ++m) _Pragma("unroll") for (int n = 0; n < 2; ++n) _Pragma("unroll") for (int k = 0; k < 2; ++k) \
        acc[ai][bj][m][n] = __builtin_amdgcn_mfma_f32_16x16x32_bf16(Bt[n][k], At[m][k], acc[ai][bj][m][n], 0, 0, 0); __builtin_amdgcn_s_setprio(0); } while (0)
#define PG8_WAIT_V(n) asm volatile("s_waitcnt vmcnt(" #n ")" ::: "memory")
#define PG8_WAIT_L(n) asm volatile("s_waitcnt lgkmcnt(" #n ")" ::: "memory")
#define PG8_BAR __builtin_amdgcn_s_barrier()
#define PG8_SCHED __builtin_amdgcn_sched_barrier(0)
    Unit cur, nxt; int ui = 0;
    if (!S.next(0, cur)) return;
    f32x4 acc[2][2][4][2];
#pragma unroll
    for (int a = 0; a < 2; ++a)
#pragma unroll
        for (int b = 0; b < 2; ++b)
#pragma unroll
            for (int m = 0; m < 4; ++m)
#pragma unroll
                for (int n = 0; n < 2; ++n) acc[a][b][m][n] = (f32x4){0.f, 0.f, 0.f, 0.f};
    bf16x8 At[4][2], B0[2][2], B1[2][2];
    const char* cA = (const char*)g.A + (size_t)cur.pm * tstep; const char* cB = (const char*)g.Bt + (size_t)cur.pn * tstep;
    S.a_ready(cur);
    if constexpr (SP2) {
        PG8_STAGE(PG8_SB(0, 0), cB, voffB); PG8_STAGE(PG8_SB(0, 1), cB + hstep, voffB); PG8_STAGE(PG8_SA(0, 0), cA, voffA); PG8_STAGE(PG8_SA(0, 1), cA + hstep, voffA);
        if (wr == 1) PG8_BAR;
        PG8_WAIT_V(2); PG8_BAR;
        PG8_STAGE(PG8_SB(1, 0), cB + kstep, voffB); PG8_STAGE(PG8_SA(1, 0), cA + kstep, voffA); PG8_STAGE(PG8_SB(1, 1), cB + hstep + kstep, voffB);
        PG8_WAIT_V(6); PG8_BAR;
    } else {
        PG8_STAGE(PG8_SB(0, 0), cB, voffB); PG8_STAGE(PG8_SA(0, 0), cA, voffA); PG8_STAGE(PG8_SB(0, 1), cB + hstep, voffB); PG8_STAGE(PG8_SA(0, 1), cA + hstep, voffA);
        if (wr == 1) PG8_BAR;
        PG8_WAIT_V(4); PG8_BAR;
        PG8_STAGE(PG8_SB(1, 0), cB + kstep, voffB); PG8_STAGE(PG8_SA(1, 0), cA + kstep, voffA); PG8_STAGE(PG8_SB(1, 1), cB + hstep + kstep, voffB);
        PG8_WAIT_V(6); PG8_BAR;
    }
    for (;;) {
        const bool has_next = S.next(ui + 1, nxt);
        const char* nA = has_next ? (const char*)g.A + (size_t)nxt.pm * tstep : cA; const char* nB = has_next ? (const char*)g.Bt + (size_t)nxt.pn * tstep : cB;
        for (int t = 0; t < nt; t += 2) {
            const bool last = (t == nt - 2);
            const char* a1 = cA + (size_t)(t + 1) * kstep;
            const char* a2 = last ? nA : cA + (size_t)(t + 2) * kstep; const char* b2 = last ? nB : cB + (size_t)(t + 2) * kstep;
            const char* a3 = a2 + kstep; const char* b3 = b2 + kstep;
            if (last && has_next) S.a_ready(nxt);
            if constexpr (SP2) {
            PG8_LDB(B0, 0, 0); PG8_LDB(B1, 0, 1); PG8_SCHED; PG8_LDA(At, 0, 0); PG8_STAGE(PG8_SA(1, 1), a1 + hstep, voffA);
            PG8_WAIT_V(8); PG8_WAIT_L(0); PG8_BAR; PG8_MMA(0, 0, At, B0); PG8_MMA(0, 1, At, B1); PG8_BAR; PG8_SCHED;
            PG8_LDA(At, 0, 1); PG8_STAGE(PG8_SB(0, 0), b2, voffB); PG8_STAGE(PG8_SB(0, 1), b2 + hstep, voffB); PG8_STAGE(PG8_SA(0, 0), a2, voffA);
            PG8_WAIT_V(8); PG8_WAIT_L(0); PG8_BAR; PG8_MMA(1, 0, At, B0); PG8_MMA(1, 1, At, B1); PG8_BAR; PG8_SCHED;
            PG8_LDB(B0, 1, 0); PG8_LDB(B1, 1, 1); PG8_SCHED; PG8_LDA(At, 1, 0); PG8_STAGE(PG8_SA(0, 1), a2 + hstep, voffA);
            PG8_WAIT_V(8); PG8_WAIT_L(0); PG8_BAR; PG8_MMA(0, 0, At, B0); PG8_MMA(0, 1, At, B1); PG8_BAR; PG8_SCHED;
            PG8_LDA(At, 1, 1); PG8_STAGE(PG8_SB(1, 0), b3, voffB); PG8_STAGE(PG8_SB(1, 1), b3 + hstep, voffB); PG8_STAGE(PG8_SA(1, 0), a3, voffA);
            PG8_WAIT_V(8); PG8_WAIT_L(0); PG8_BAR; PG8_MMA(1, 0, At, B0); PG8_MMA(1, 1, At, B1); PG8_BAR; PG8_SCHED;
            } else {
            PG8_LDB(B0, 0, 0); PG8_SCHED; PG8_LDA(At, 0, 0); PG8_STAGE(PG8_SA(1, 1), a1 + hstep, voffA);
            PG8_WAIT_L(8); PG8_BAR; PG8_WAIT_L(0); PG8_MMA(0, 0, At, B0); PG8_BAR; PG8_SCHED;
            PG8_LDB(B1, 0, 1); PG8_STAGE(PG8_SB(0, 0), b2, voffB);
            PG8_BAR; PG8_WAIT_L(0); PG8_MMA(0, 1, At, B1); PG8_BAR;
            PG8_LDA(At, 0, 1); PG8_STAGE(PG8_SA(0, 0), a2, voffA);
            PG8_BAR; PG8_WAIT_L(0); PG8_MMA(1, 0, At, B0); PG8_BAR; PG8_SCHED;
            PG8_STAGE(PG8_SB(0, 1), b2 + hstep, voffB);
            PG8_WAIT_V(6); PG8_BAR; PG8_MMA(1, 1, At, B1); PG8_BAR;
            PG8_LDB(B0, 1, 0); PG8_SCHED; PG8_LDA(At, 1, 0); PG8_STAGE(PG8_SA(0, 1), a2 + hstep, voffA);
            PG8_WAIT_L(8); PG8_BAR; PG8_WAIT_L(0); PG8_MMA(0, 0, At, B0); PG8_BAR; PG8_SCHED;
            PG8_LDB(B1, 1, 1); PG8_STAGE(PG8_SB(1, 0), b3, voffB);
            PG8_BAR; PG8_WAIT_L(0); PG8_MMA(0, 1, At, B1); PG8_BAR;
            PG8_LDA(At, 1, 1); PG8_STAGE(PG8_SA(1, 0), a3, voffA);
            PG8_BAR; PG8_WAIT_L(0); PG8_MMA(1, 0, At, B0); PG8_BAR; PG8_SCHED;
            PG8_STAGE(PG8_SB(1, 1), b3 + hstep, voffB);
            PG8_WAIT_V(6); PG8_BAR; PG8_MMA(1, 1, At, B1); PG8_BAR;
            }
        }
        if constexpr (ALIGN_EPI) { if (wr == 0) PG8_BAR; }
        E(acc, cur, wr, wc, fr, fq); S.done(cur);
        if (!has_next) break;
#pragma unroll
        for (int a = 0; a < 2; ++a)
#pragma unroll
            for (int b = 0; b < 2; ++b)
#pragma unroll
                for (int m = 0; m < 4; ++m)
#pragma unroll
                    for (int n = 0; n < 2; ++n) acc[a][b][m][n] = (f32x4){0.f, 0.f, 0.f, 0.f};
        cur = nxt; cA = nA; cB = nB; ++ui;
        if constexpr (ALIGN_EPI) { if (wr == 1) PG8_BAR; }
    }
    PG8_WAIT_V(0);
    if constexpr (!ALIGN_EPI) { if (wr == 0) PG8_BAR; }
    PG8_BAR;
#undef PG8_SA
#undef PG8_SB
#undef PG8_STAGE
#undef PG8_LDA
#undef PG8_LDB
#undef PG8_MMA
#undef PG8_WAIT_V
#undef PG8_WAIT_L
#undef PG8_BAR
#undef PG8_SCHED
}
}
constexpr int D = 1024, NB = 4, SEQ = 8192, DB = 8, DSEQ = 64, NMB = NB + DB;
constexpr int GH = 8, GDK = 128, GDV = 128;
constexpr int SH = 32, SP = 64, SN = 128, SG = 8;
constexpr int DFF = 2816, CONV_CH = 7168, IN_COLS = 12336;
constexpr int NPROJ = 12288;
constexpr int NIN = 12544;
constexpr int NUP = 2 * DFF;
constexpr float EPS = 1e-6f;
#ifndef SLAB_T
#define SLAB_T 1024
#endif
constexpr int NSLAB = SEQ / SLAB_T, RP = NB * SLAB_T, RS = DB * DSEQ, RMAX = RP + RS;
constexpr size_t O_YP = 0, O_YS = O_YP + (size_t)NB * SEQ * D, O_CMP = O_YS + (size_t)DB * DSEQ * D, O_GP = O_CMP + (size_t)NB * 3 * CONV_CH,
                 O_SP = O_GP + (size_t)NB * GH * GDK * GDV, O_CFP = O_SP + (size_t)NB * SH * SN * SP, O_CMS = O_CFP + (size_t)NB * 2 * NUP,
                 O_GS = O_CMS + (size_t)DB * 3 * CONV_CH, O_SS = O_GS + (size_t)DB * GH * GDK * GDV, O_CFS = O_SS + (size_t)DB * SH * SN * SP,
                 O_END = O_CFS + (size_t)DB * 2 * NUP;
constexpr size_t MiB = 1u << 20;
constexpr size_t WS_CTL = 0, CTL_ZERO_BYTES = 1 * MiB;
constexpr size_t WS_MODV = 1 * MiB;
constexpr size_t WS_G1 = WS_MODV + 512 * 1024;
constexpr size_t WS_G2 = WS_G1 + 64 * 1024;
constexpr size_t WS_SHW = WS_G2 + 64 * 1024;
constexpr size_t WS_CARRY_MIX = 2 * MiB;
constexpr size_t WS_CARRY_FFN = 3 * MiB;
constexpr size_t WS_WIN = 4 * MiB;
constexpr size_t WS_WG = WS_WIN + (size_t)NIN * D * 2;
constexpr size_t WS_WS = WS_WG + (size_t)D * D * 2;
constexpr size_t WS_WOUT = WS_WS + (size_t)D * 2048 * 2;
constexpr size_t WS_WUP = WS_WOUT + (size_t)D * D * 2;
constexpr size_t WS_WDN = WS_WUP + (size_t)NUP * D * 2;
constexpr size_t WS_SLAB = 56 * MiB;
static_assert(WS_WDN + (size_t)D * DFF * 2 <= WS_SLAB, "weights fit");
constexpr size_t SZ_HB = (size_t)RMAX * D * 2, SZ_PROJ = (size_t)RMAX * NPROJ * 2, SZ_SM = (size_t)RMAX * 64 * 4, SZ_OG = (size_t)RMAX * D * 2, SZ_YS = (size_t)RMAX * 2048 * 2,
                 SZ_T1 = (size_t)RMAX * D * 4, SZ_MIX = (size_t)RMAX * D * 2, SZ_X1 = (size_t)RMAX * D * 4, SZ_X1G = (size_t)RMAX * D * 2, SZ_SS = (size_t)RMAX * 16 * 4,
                 SZ_U = (size_t)RMAX * NUP * 2, SZ_ACT = (size_t)RMAX * DFF * 2;
constexpr size_t WS_HB = WS_SLAB, WS_PROJ = WS_HB + SZ_HB, WS_SM = WS_PROJ + SZ_PROJ, WS_OG = WS_SM + SZ_SM, WS_YS = WS_OG + SZ_OG, WS_T1 = WS_YS + SZ_YS, WS_MIX = WS_T1 + SZ_T1,
                 WS_X1 = WS_MIX + SZ_MIX, WS_X1G = WS_X1 + SZ_X1, WS_SS1 = WS_X1G + SZ_X1G, WS_SS2 = WS_SS1 + SZ_SS, WS_U = WS_SS2 + SZ_SS, WS_ACT = WS_U + SZ_U, WS_END = WS_ACT + SZ_ACT;
static_assert(WS_END <= 480 * MiB, "workspace map fits");
constexpr int LDS_BYTES = 147456, LDSCTL_OFF = LDS_BYTES - 512, MISC_OFF = LDSCTL_OFF + 320, RING_BYTES = LDSCTL_OFF;
constexpr int NWAVES = 8, NTHR = 512;

#define GAS __attribute__((address_space(1)))
#define LAS __attribute__((address_space(3)))
typedef unsigned short bf16;
typedef unsigned v4u __attribute__((ext_vector_type(4)));
typedef unsigned v2u __attribute__((ext_vector_type(2)));
typedef float f32x4 __attribute__((ext_vector_type(4)));
typedef GAS unsigned gu32;
#define RLX_AGENT __ATOMIC_RELAXED, __HIP_MEMORY_SCOPE_AGENT
#define LDS_WAIT() asm volatile("s_waitcnt lgkmcnt(0)" ::: "memory")
#define VM_WAIT() asm volatile("s_waitcnt vmcnt(0)" ::: "memory")
__device__ __forceinline__ unsigned pk2(float lo, float hi) { return pg8::cvt_pk_bf16(lo, hi); }
__device__ __forceinline__ unsigned f2bf(float f) { return pk2(f, f) & 0xffffu; }
__device__ __forceinline__ float bf2f(unsigned short h) { return __builtin_bit_cast(float, (unsigned)h << 16); }
__device__ __forceinline__ float bflo(unsigned w) { return __builtin_bit_cast(float, w << 16); }
__device__ __forceinline__ float bfhi(unsigned w) { return __builtin_bit_cast(float, w & 0xffff0000u); }
__device__ __forceinline__ float sigmoidf_(float x) { return __builtin_amdgcn_rcpf(1.f + __expf(-x)); }
__device__ __forceinline__ float siluf_(float x) { return x * __builtin_amdgcn_rcpf(1.f + __expf(-x)); }
__device__ __forceinline__ float softplusf_(float x) { const float e = __expf(-fabsf(x)), u = 1.f + e, d = u - 1.f; const float l = (d == 0.f) ? e : __logf(u) * (e * __builtin_amdgcn_rcpf(d)); return fmaxf(x, 0.f) + l; }
__device__ __forceinline__ float wave_sum(float v) {
#pragma unroll
    for (int o = 1; o < 64; o <<= 1) v += __shfl_xor(v, o);
    return v;
}

struct Args { const float* in[30]; float* out; unsigned char* ws; int ph_lo, ph_hi; };

struct Frame {
    LAS unsigned char* lds;
    volatile LAS unsigned* MISC;
    gu32* ctl;
    int tid, lane, wave, G, bid;
    const Args& A;
    float* out; unsigned char* ws;
    __device__ __forceinline__ Frame(const Args& a) : A(a) {}
};
__device__ __forceinline__ int row_mb(int r) { return r < RP ? (r / SLAB_T) : NB + ((r - RP) / DSEQ); }
__device__ __forceinline__ size_t row_goff(int s, int r) {
    if (r < RP) { const int b = r / SLAB_T, tl = r % SLAB_T; return ((size_t)b * SEQ + (size_t)s * SLAB_T + tl) * D; }
    return (size_t)(r - RP) * D;
}
__device__ __forceinline__ int slab_rows(int s) { return s == 0 ? RMAX : RP; }
struct MapWin { __device__ __forceinline__ int operator()(int n) const { return n < 10240 ? n : (n < 12288 ? n + 48 : (n < 12336 ? n - 2048 : -1)); } };
struct MapId  { __device__ __forceinline__ int operator()(int n) const { return n; } };
struct MapUp  { __device__ __forceinline__ int operator()(int n) const { const int j = n >> 8, c = n & 255; return c < 128 ? 128 * j + c : DFF + 128 * j + (c - 128); } };
template <class Map>
__device__ __forceinline__ void p0_transpose_item(const float* W, int ldw, int K, bf16* WT, Map map, LAS float* scr, int item, int nblk, int lane) {
    const int kb = item / nblk, nb = item % nblk, k0 = 64 * kb, n0 = 32 * nb;
    const int sc = map(n0 + (lane & 31));
#pragma unroll 8
    for (int i = 0; i < 32; ++i) { const int kk = 2 * i + (lane >> 5); scr[kk * 33 + (lane & 31)] = sc >= 0 ? W[(size_t)(k0 + kk) * ldw + sc] : 0.f; }
    LDS_WAIT(); asm volatile("" ::: "memory");
    const int c = lane & 7;
#pragma unroll
    for (int j = 0; j < 4; ++j) { const int n = (lane >> 3) + 8 * j; const LAS float* s = scr + (8 * c) * 33 + n;
        v4u o; o.x = pk2(s[0 * 33], s[1 * 33]); o.y = pk2(s[2 * 33], s[3 * 33]); o.z = pk2(s[4 * 33], s[5 * 33]); o.w = pk2(s[6 * 33], s[7 * 33]);
        *(GAS v4u*)(WT + (size_t)(n0 + n) * K + k0 + 8 * c) = o; }
    LDS_WAIT(); asm volatile("" ::: "memory");
}
__device__ __forceinline__ void p0_mod_item(Frame& F, int item) {
    LAS float* sc = (LAS float*)F.lds; LAS float* red = (LAS float*)(F.lds + 49152);
    const float* cp = F.A.in[6]; const float* cs = F.A.in[7]; const float* w_ada = F.A.in[8]; const float* b_ada = F.A.in[9];
    for (int idx = F.tid; idx < NMB * D; idx += NTHR) { const int b = idx / D, k = idx % D; const float c = b < NB ? cp[b * D + k] : cs[(b - NB) * D + k]; sc[idx] = siluf_(c); }
    __syncthreads();
    float acc[NMB];
#pragma unroll
    for (int b = 0; b < NMB; ++b) acc[b] = 0.f;
    const int col = item * 64 + F.lane, kb = F.wave * 128;
    for (int k = 0; k < 128; ++k) { const float wv = w_ada[(size_t)(kb + k) * 6144 + col];
#pragma unroll
        for (int b = 0; b < NMB; ++b) acc[b] += sc[b * D + kb + k] * wv; }
#pragma unroll
    for (int b = 0; b < NMB; ++b) red[(F.wave * NMB + b) * 64 + F.lane] = acc[b];
    __syncthreads();
    float* modv = (float*)(F.ws + WS_MODV);
    for (int idx = F.tid; idx < NMB * 64; idx += NTHR) { const int b = idx / 64, l = idx % 64; float s = b_ada[item * 64 + l];
#pragma unroll
        for (int w = 0; w < 8; ++w) s += red[(w * NMB + b) * 64 + l];
        modv[b * 6144 + item * 64 + l] = s; }
    __syncthreads();
}
__device__ __forceinline__ void phase_prologue0(Frame& F) {
    for (int it = F.bid; it < 96; it += F.G) p0_mod_item(F, it);
    LAS float* scr = (LAS float*)(F.lds + F.wave * 16384);
    const int gw = F.bid * NWAVES + F.wave, NGW = F.G * NWAVES;
    constexpr int I_IN = (D / 64) * (NIN / 32), I_G = (D / 64) * (D / 32), I_S = (2048 / 64) * (D / 32), I_O = I_G, I_UP = (D / 64) * (NUP / 32), I_DN = (DFF / 64) * (D / 32);
    constexpr int NITEMS = I_IN + I_G + I_S + I_O + I_UP + I_DN;
    for (int it = gw; it < NITEMS; it += NGW) {
        int r = it;
        if (r < I_IN) { p0_transpose_item(F.A.in[11], IN_COLS, D, (bf16*)(F.ws + WS_WIN), MapWin(), scr, r, NIN / 32, F.lane); continue; } r -= I_IN;
        if (r < I_G) { p0_transpose_item(F.A.in[21], D, D, (bf16*)(F.ws + WS_WG), MapId(), scr, r, D / 32, F.lane); continue; } r -= I_G;
        if (r < I_S) { p0_transpose_item(F.A.in[22], D, 2048, (bf16*)(F.ws + WS_WS), MapId(), scr, r, D / 32, F.lane); continue; } r -= I_S;
        if (r < I_O) { p0_transpose_item(F.A.in[23], D, D, (bf16*)(F.ws + WS_WOUT), MapId(), scr, r, D / 32, F.lane); continue; } r -= I_O;
        if (r < I_UP) { p0_transpose_item(F.A.in[25], NUP, D, (bf16*)(F.ws + WS_WUP), MapUp(), scr, r, NUP / 32, F.lane); continue; } r -= I_UP;
        p0_transpose_item(F.A.in[28], D, DFF, (bf16*)(F.ws + WS_WDN), MapId(), scr, r, D / 32, F.lane);
    }
}
__device__ __forceinline__ void phase_prologue1(Frame& F) {
    const float* modv = (const float*)(F.ws + WS_MODV);
    float* g1 = (float*)(F.ws + WS_G1); float* g2 = (float*)(F.ws + WS_G2); float* shw = (float*)(F.ws + WS_SHW);
    for (int idx = F.bid * NTHR + F.tid; idx < NMB * D; idx += F.G * NTHR) { const int b = idx / D, k = idx % D;
        g1[idx] = F.A.in[10][k] * (1.f + modv[b * 6144 + 1024 + k]); g2[idx] = F.A.in[24][k] * (1.f + modv[b * 6144 + 4096 + k]); }
    LAS float* sh = (LAS float*)F.lds;
    for (int idx = F.tid; idx < NMB * D; idx += NTHR) sh[idx] = modv[(idx / D) * 6144 + 3072 + (idx % D)];
    __syncthreads();
    const bf16* wup = (const bf16*)(F.ws + WS_WUP);
    const int gw = F.bid * NWAVES + F.wave, NGW = F.G * NWAVES;
    for (int n = gw; n < NUP; n += NGW) {
        const GAS v4u* wr = (const GAS v4u*)(wup + (size_t)n * D + F.lane * 16);
        const v4u w0 = wr[0], w1 = wr[1];
        float wf[16] = {bflo(w0.x), bfhi(w0.x), bflo(w0.y), bfhi(w0.y), bflo(w0.z), bfhi(w0.z), bflo(w0.w), bfhi(w0.w), bflo(w1.x), bfhi(w1.x), bflo(w1.y), bfhi(w1.y), bflo(w1.z), bfhi(w1.z), bflo(w1.w), bfhi(w1.w)};
        float res = 0.f;
#pragma unroll 1
        for (int b = 0; b < NMB; ++b) { float a = 0.f;
#pragma unroll
            for (int i = 0; i < 16; ++i) a += wf[i] * sh[b * D + F.lane * 16 + i];
            a = wave_sum(a); if (F.lane == b) res = a; }
        if (F.lane < NMB) shw[F.lane * NUP + n] = res;
    }
    __syncthreads();
}
__device__ __forceinline__ void phase_norm1(Frame& F, int s) {
    const float* modv = (const float*)(F.ws + WS_MODV); const float* g1 = (const float*)(F.ws + WS_G1); bf16* hb = (bf16*)(F.ws + WS_HB);
    const int gw = F.bid * NWAVES + F.wave, NGW = F.G * NWAVES, R = slab_rows(s);
    for (int r = gw; r < R; r += NGW) {
        const float* xrow = (r < RP ? F.A.in[0] : F.A.in[1]) + row_goff(s, r); const int mb = row_mb(r);
        const GAS f32x4* xr = (const GAS f32x4*)xrow + F.lane;
        f32x4 v[4]; float ss = 0.f;
#pragma unroll
        for (int j = 0; j < 4; ++j) { v[j] = xr[64 * j]; ss += (v[j].x * v[j].x + v[j].y * v[j].y) + (v[j].z * v[j].z + v[j].w * v[j].w); }
        const float rs = rsqrtf(wave_sum(ss) * (1.f / D) + EPS);
        GAS v2u* o8 = (GAS v2u*)(hb + (size_t)r * D) + F.lane;
#pragma unroll
        for (int j = 0; j < 4; ++j) { const int k = 4 * F.lane + 256 * j; const f32x4 g = *(const GAS f32x4*)(g1 + mb * D + k); const f32x4 sh = *(const GAS f32x4*)(modv + mb * 6144 + k);
            v2u o; o.x = pk2(v[j].x * rs * g.x + sh.x, v[j].y * rs * g.y + sh.y); o.y = pk2(v[j].z * rs * g.z + sh.z, v[j].w * rs * g.w + sh.w); o8[64 * j] = o; }
    }
}
__device__ __forceinline__ void phase_final(Frame& F, int s) {
    const float* ss2 = (const float*)(F.ws + WS_SS2); const float* wf = F.A.in[29];
    const int gw = F.bid * NWAVES + F.wave, NGW = F.G * NWAVES, R = slab_rows(s);
    for (int r = gw; r < R; r += NGW) {
        float* yrow = F.out + (r < RP ? O_YP : O_YS) + row_goff(s, r);
        float t = F.lane < 16 ? ss2[(size_t)r * 16 + F.lane] : 0.f; t = wave_sum(t);
        const float rs = rsqrtf(t * (1.f / D) + EPS);
        GAS f32x4* yr = (GAS f32x4*)yrow + F.lane;
#pragma unroll
        for (int j = 0; j < 4; ++j) { f32x4 v = yr[64 * j]; const f32x4 w = *(const GAS f32x4*)(wf + 4 * F.lane + 256 * j); v.x *= rs * w.x; v.y *= rs * w.y; v.z *= rs * w.z; v.w *= rs * w.w; yr[64 * j] = v; }
    }
}
__device__ __forceinline__ void u_hist_row(Frame& F, int s, int r, int back, int c8, int j, int cc, float (&ua)[8], float (&uv)[8]) {
    const bf16* U = (const bf16*)(F.ws + WS_U);
    int tl, b; bool samp = r >= RP;
    if (!samp) { b = r / SLAB_T; tl = r % SLAB_T; } else { b = (r - RP) / DSEQ; tl = (r - RP) % DSEQ; }
    if (tl - back >= 0) {
        const bf16* p = U + (size_t)(r - back) * NUP + 256 * j + cc;
        const v4u a = *(const GAS v4u*)p, v = *(const GAS v4u*)(p + 128);
        ua[0] = bflo(a.x); ua[1] = bfhi(a.x); ua[2] = bflo(a.y); ua[3] = bfhi(a.y); ua[4] = bflo(a.z); ua[5] = bfhi(a.z); ua[6] = bflo(a.w); ua[7] = bfhi(a.w);
        uv[0] = bflo(v.x); uv[1] = bfhi(v.x); uv[2] = bflo(v.y); uv[3] = bfhi(v.y); uv[4] = bflo(v.z); uv[5] = bfhi(v.z); uv[6] = bflo(v.w); uv[7] = bfhi(v.w);
        return;
    }
    const int hi = 2 + (tl - back);
    if (samp) { const float* st = F.A.in[5] + ((size_t)b * 2 + hi) * NUP;
#pragma unroll
        for (int i = 0; i < 8; ++i) { ua[i] = st[c8 + i]; uv[i] = st[DFF + c8 + i]; } return; }
    if (s == 0) {
#pragma unroll
        for (int i = 0; i < 8; ++i) { ua[i] = 0.f; uv[i] = 0.f; } return; }
    const float* cf = (const float*)(F.ws + WS_CARRY_FFN) + (((size_t)(s & 1) * NB + b) * 2 + hi) * NUP + 256 * j + cc;
#pragma unroll
    for (int i = 0; i < 8; ++i) { ua[i] = cf[i]; uv[i] = cf[128 + i]; }
}
__device__ __forceinline__ void phase_convact(Frame& F, int s) {
    const bf16* U = (const bf16*)(F.ws + WS_U); bf16* ACT = (bf16*)(F.ws + WS_ACT);
    const float* wc = F.A.in[26]; const float* bc = F.A.in[27];
    const int R = slab_rows(s); const long total = (long)R * (DFF / 8);
    for (long idx = (long)F.bid * NTHR + F.tid; idx < total; idx += (long)F.G * NTHR) {
        const int r = (int)(idx / (DFF / 8)), c8 = (int)(idx % (DFF / 8)) * 8, j = c8 >> 7, cc = c8 & 127;
        float a0[8], v0[8], a1[8], v1[8], a2[8], v2[8];
        u_hist_row(F, s, r, 0, c8, j, cc, a2, v2); u_hist_row(F, s, r, 1, c8, j, cc, a1, v1); u_hist_row(F, s, r, 2, c8, j, cc, a0, v0);
        float o[8];
#pragma unroll
        for (int i = 0; i < 8; ++i) { const int ca = c8 + i, cv = DFF + c8 + i;
            const float xa = bc[ca] + wc[ca] * a0[i] + wc[NUP + ca] * a1[i] + wc[2 * NUP + ca] * a2[i];
            const float xv = bc[cv] + wc[cv] * v0[i] + wc[NUP + cv] * v1[i] + wc[2 * NUP + cv] * v2[i];
            o[i] = siluf_(xa) * xv; }
        v4u w; w.x = pk2(o[0], o[1]); w.y = pk2(o[2], o[3]); w.z = pk2(o[4], o[5]); w.w = pk2(o[6], o[7]);
        *(GAS v4u*)(ACT + (size_t)r * DFF + c8) = w;
    }
    float* cfn = (float*)(F.ws + WS_CARRY_FFN) + (size_t)((s + 1) & 1) * NB * 2 * NUP;
    for (int idx = F.bid * NTHR + F.tid; idx < NB * 2 * NUP; idx += F.G * NTHR) {
        const int b = idx / (2 * NUP), i = (idx / NUP) % 2, c = idx % NUP; const int r = b * SLAB_T + SLAB_T - 2 + i;
        const float v = bf2f(U[(size_t)r * NUP + c]); cfn[idx] = v;
        if (s == NSLAB - 1) { const int j = c >> 8, cc = c & 255; const int oc = cc < 128 ? 128 * j + cc : DFF + 128 * j + (cc - 128); F.out[O_CFP + ((size_t)b * 2 + i) * NUP + oc] = v; }
    }
    if (s == 0) for (int idx = F.bid * NTHR + F.tid; idx < DB * 2 * NUP; idx += F.G * NTHR) {
        const int b = idx / (2 * NUP), i = (idx / NUP) % 2, c = idx % NUP; const int r = RP + b * DSEQ + DSEQ - 2 + i;
        const int j = c >> 8, cc = c & 255; const int oc = cc < 128 ? 128 * j + cc : DFF + 128 * j + (cc - 128);
        F.out[O_CFS + ((size_t)b * 2 + i) * NUP + oc] = bf2f(U[(size_t)r * NUP + c]);
    }
}
__device__ __forceinline__ void phase_mix_carry(Frame& F, int s) {
    const bf16* P = (const bf16*)(F.ws + WS_PROJ);
    float* cmn = (float*)(F.ws + WS_CARRY_MIX) + (size_t)((s + 1) & 1) * NB * 3 * CONV_CH;
    for (int idx = F.bid * NTHR + F.tid; idx < NB * 3 * CONV_CH; idx += F.G * NTHR) {
        const int b = idx / (3 * CONV_CH), i = (idx / CONV_CH) % 3, c = idx % CONV_CH; const int r = b * SLAB_T + SLAB_T - 3 + i;
        const float v = bf2f(P[(size_t)r * NPROJ + c]); cmn[idx] = v;
        if (s == NSLAB - 1) F.out[O_CMP + idx] = v;
    }
    if (s == 0) for (int idx = F.bid * NTHR + F.tid; idx < DB * 3 * CONV_CH; idx += F.G * NTHR) {
        const int b = idx / (3 * CONV_CH), i = (idx / CONV_CH) % 3, c = idx % CONV_CH; const int r = RP + b * DSEQ + DSEQ - 3 + i;
        F.out[O_CMS + idx] = bf2f(P[(size_t)r * NPROJ + c]);
    }
}
namespace epi {
using pg8::f32x4; using pg8::Unit; using pg8::BM; using pg8::HALF; using pg8::cvt_pk_bf16; using pg8::u32x4; using pg8::u32x2;
struct EpiProj {
    static constexpr bool PERM = true;
    bf16* P; float* SM;
    __device__ __forceinline__ void operator()(const f32x4 (&acc)[2][2][4][2], const Unit& u, int wr, int wc, int fr, int fq) const {
        const int row0 = u.pm * BM + wr * 64 + fr;
        if (u.pn == 48) {
            if (wc < 2) {
#pragma unroll
                for (int ai = 0; ai < 2; ++ai)
#pragma unroll
                    for (int m = 0; m < 4; ++m) { float* rp = SM + (size_t)(row0 + ai * HALF + m * 16) * 64 + wc * 32 + 8 * fq;
                        *(f32x4*)rp = acc[ai][0][m][0]; *(f32x4*)(rp + 4) = acc[ai][0][m][1]; }
            }
            return;
        }
        const bool sg = u.pn >= 40;
        const int col0 = u.pn * BM + wc * 32 + 8 * fq;
#pragma unroll
        for (int ai = 0; ai < 2; ++ai)
#pragma unroll
            for (int m = 0; m < 4; ++m) { bf16* rowp = P + (size_t)(row0 + ai * HALF + m * 16) * NPROJ + col0;
#pragma unroll
                for (int bj = 0; bj < 2; ++bj) { f32x4 v0 = acc[ai][bj][m][0], v1 = acc[ai][bj][m][1];
                    if (sg) {
#pragma unroll
                        for (int i = 0; i < 4; ++i) { v0[i] = sigmoidf_(v0[i]); v1[i] = sigmoidf_(v1[i]); } }
                    u32x4 w; w.x = cvt_pk_bf16(v0[0], v0[1]); w.y = cvt_pk_bf16(v0[2], v0[3]); w.z = cvt_pk_bf16(v1[0], v1[1]); w.w = cvt_pk_bf16(v1[2], v1[3]);
                    *(u32x4*)(rowp + bj * HALF) = w; } }
    }
};
struct EpiGate1 {
    static constexpr bool PERM = false;
    const bf16* P; float* T1;
    __device__ __forceinline__ void operator()(const f32x4 (&acc)[2][2][4][2], const Unit& u, int wr, int wc, int fr, int fq) const {
        const int row0 = u.pm * BM + wr * 64 + fr, col0 = u.pn * BM + wc * 32 + 4 * fq;
#pragma unroll
        for (int ai = 0; ai < 2; ++ai)
#pragma unroll
            for (int m = 0; m < 4; ++m) { const size_t r = (size_t)(row0 + ai * HALF + m * 16);
#pragma unroll
                for (int bj = 0; bj < 2; ++bj)
#pragma unroll
                    for (int n = 0; n < 2; ++n) { const int c = col0 + bj * HALF + n * 16; const u32x2 g = *(const u32x2*)(P + r * NPROJ + 10240 + c); const f32x4 a = acc[ai][bj][m][n];
                        f32x4 o; o.x = a.x * bflo(g.x); o.y = a.y * bfhi(g.x); o.z = a.z * bflo(g.y); o.w = a.w * bfhi(g.y); *(f32x4*)(T1 + r * D + c) = o; } }
    }
};
struct EpiGate2 {
    static constexpr bool PERM = false;
    const bf16* P; const float* T1; bf16* MIX;
    __device__ __forceinline__ void operator()(const f32x4 (&acc)[2][2][4][2], const Unit& u, int wr, int wc, int fr, int fq) const {
        const int row0 = u.pm * BM + wr * 64 + fr, col0 = u.pn * BM + wc * 32 + 4 * fq;
#pragma unroll
        for (int ai = 0; ai < 2; ++ai)
#pragma unroll
            for (int m = 0; m < 4; ++m) { const size_t r = (size_t)(row0 + ai * HALF + m * 16);
#pragma unroll
                for (int bj = 0; bj < 2; ++bj)
#pragma unroll
                    for (int n = 0; n < 2; ++n) { const int c = col0 + bj * HALF + n * 16; const u32x2 g = *(const u32x2*)(P + r * NPROJ + 11264 + c); const f32x4 a = acc[ai][bj][m][n];
                        const f32x4 t = *(const f32x4*)(T1 + r * D + c);
                        u32x2 o; o.x = cvt_pk_bf16(t.x + a.x * bflo(g.x), t.y + a.y * bfhi(g.x)); o.y = cvt_pk_bf16(t.z + a.z * bflo(g.y), t.w + a.w * bfhi(g.y)); *(u32x2*)(MIX + r * D + c) = o; } }
    }
};
struct EpiOut {
    static constexpr bool PERM = false;
    const float* xp; const float* xs; const float* modv; const float* g2; float* X1; bf16* X1G; float* SS; int slab;
    __device__ __forceinline__ void operator()(const f32x4 (&acc)[2][2][4][2], const Unit& u, int wr, int wc, int fr, int fq) const {
        const int col0 = u.pn * BM + wc * 32 + 4 * fq;
#pragma unroll
        for (int ai = 0; ai < 2; ++ai) {
            const int rb = u.pm * BM + ai * HALF + wr * 64; const int mb = row_mb(rb);
#pragma unroll
            for (int m = 0; m < 4; ++m) { const int r = rb + m * 16 + fr; const float* xrow = (r < RP ? xp : xs) + row_goff(slab, r); float sq = 0.f;
#pragma unroll
                for (int bj = 0; bj < 2; ++bj)
#pragma unroll
                    for (int n = 0; n < 2; ++n) { const int c = col0 + bj * HALF + n * 16; const f32x4 a = acc[ai][bj][m][n];
                        const f32x4 xv = *(const f32x4*)(xrow + c), gt = *(const f32x4*)(modv + mb * 6144 + 2048 + c), gg = *(const f32x4*)(g2 + mb * D + c);
                        f32x4 o = xv + gt * a; *(f32x4*)(X1 + (size_t)r * D + c) = o; sq += (o.x * o.x + o.y * o.y) + (o.z * o.z + o.w * o.w);
                        u32x2 w; w.x = cvt_pk_bf16(o.x * gg.x, o.y * gg.y); w.y = cvt_pk_bf16(o.z * gg.z, o.w * gg.w); *(u32x2*)(X1G + (size_t)r * D + c) = w; }
                sq += __shfl_xor(sq, 16); sq += __shfl_xor(sq, 32);
                if (fq == 0) SS[(size_t)r * 16 + u.pn * 4 + wc] = sq; }
        }
    }
};
struct EpiUp {
    static constexpr bool PERM = true;
    const float* SS; const float* shw; bf16* U;
    __device__ __forceinline__ void operator()(const f32x4 (&acc)[2][2][4][2], const Unit& u, int wr, int wc, int fr, int fq) const {
        const int col0 = u.pn * BM + wc * 32 + 8 * fq;
#pragma unroll
        for (int ai = 0; ai < 2; ++ai) {
            const int rb = u.pm * BM + ai * HALF + wr * 64; const int mb = row_mb(rb);
            f32x4 sv[2][2];
#pragma unroll
            for (int bj = 0; bj < 2; ++bj)
#pragma unroll
                for (int n = 0; n < 2; ++n) sv[bj][n] = *(const f32x4*)(shw + mb * NUP + col0 + bj * HALF + 4 * n);
#pragma unroll
            for (int m = 0; m < 4; ++m) { const int r = rb + m * 16 + fr; const f32x4* sp = (const f32x4*)(SS + (size_t)r * 16);
                const f32x4 s0 = sp[0], s1 = sp[1], s2 = sp[2], s3 = sp[3];
                const float tot = ((s0.x + s0.y) + (s0.z + s0.w)) + ((s1.x + s1.y) + (s1.z + s1.w)) + ((s2.x + s2.y) + (s2.z + s2.w)) + ((s3.x + s3.y) + (s3.z + s3.w));
                const float rs = rsqrtf(tot * (1.f / D) + EPS);
#pragma unroll
                for (int bj = 0; bj < 2; ++bj) { const f32x4 v0 = acc[ai][bj][m][0] * rs + sv[bj][0], v1 = acc[ai][bj][m][1] * rs + sv[bj][1];
                    u32x4 w; w.x = cvt_pk_bf16(v0[0], v0[1]); w.y = cvt_pk_bf16(v0[2], v0[3]); w.z = cvt_pk_bf16(v1[0], v1[1]); w.w = cvt_pk_bf16(v1[2], v1[3]);
                    *(u32x4*)(U + (size_t)r * NUP + col0 + bj * HALF) = w; } }
        }
    }
};
struct EpiDown {
    static constexpr bool PERM = false;
    const float* X1; const float* modv; float* yp; float* ys; float* SS; int slab;
    __device__ __forceinline__ void operator()(const f32x4 (&acc)[2][2][4][2], const Unit& u, int wr, int wc, int fr, int fq) const {
        const int col0 = u.pn * BM + wc * 32 + 4 * fq;
#pragma unroll
        for (int ai = 0; ai < 2; ++ai) {
            const int rb = u.pm * BM + ai * HALF + wr * 64; const int mb = row_mb(rb);
#pragma unroll
            for (int m = 0; m < 4; ++m) { const int r = rb + m * 16 + fr; float* yrow = (r < RP ? yp : ys) + row_goff(slab, r); float sq = 0.f;
#pragma unroll
                for (int bj = 0; bj < 2; ++bj)
#pragma unroll
                    for (int n = 0; n < 2; ++n) { const int c = col0 + bj * HALF + n * 16; const f32x4 a = acc[ai][bj][m][n];
                        const f32x4 xv = *(const f32x4*)(X1 + (size_t)r * D + c), gt = *(const f32x4*)(modv + mb * 6144 + 5120 + c);
                        f32x4 o = xv + gt * a; *(f32x4*)(yrow + c) = o; sq += (o.x * o.x + o.y * o.y) + (o.z * o.z + o.w * o.w); }
                sq += __shfl_xor(sq, 16); sq += __shfl_xor(sq, 32);
                if (fq == 0) SS[(size_t)r * 16 + u.pn * 4 + wc] = sq; }
        }
    }
};
}
typedef short bf16x8 __attribute__((ext_vector_type(8)));
#define MFMA16(a, b, c) __builtin_amdgcn_mfma_f32_16x16x32_bf16((a), (b), (c), 0, 0, 0)
__device__ __forceinline__ bf16x8 ldfrag(const LAS bf16* base, int ld, int row0, int k0, int lane) {
    return *(const LAS bf16x8*)(base + (row0 + (lane & 15)) * ld + k0 + 8 * (lane >> 4));
}
__device__ __forceinline__ bf16x8 ldfrag_perm(const LAS bf16* base, int ld, int row0, int k0, int lane) {
    const LAS v2u* p = (const LAS v2u*)(base + (row0 + (lane & 15)) * ld + k0 + 4 * (lane >> 4));
    const v2u a = p[0], b = p[4];
    v4u w; w.x = a.x; w.y = a.y; w.z = b.x; w.w = b.y; return __builtin_bit_cast(bf16x8, w);
}
__device__ __forceinline__ bf16x8 acc2frag(f32x4 t0, f32x4 t1) {
    v4u w; w.x = pg8::cvt_pk_bf16(t0.x, t0.y); w.y = pg8::cvt_pk_bf16(t0.z, t0.w); w.z = pg8::cvt_pk_bf16(t1.x, t1.y); w.w = pg8::cvt_pk_bf16(t1.z, t1.w); return __builtin_bit_cast(bf16x8, w);
}
__device__ __forceinline__ float wave_incl_scan(float v, int lane) {
#pragma unroll
    for (int o = 1; o < 64; o <<= 1) { const float t = __shfl_up(v, o); if (lane >= o) v += t; }
    return v;
}
__device__ __forceinline__ float dpp_f(float v, int ctrl_sel) {
    const int x = __builtin_bit_cast(int, v); int r;
    switch (ctrl_sel) { case 0: r = __builtin_amdgcn_mov_dpp(x, 0xB1, 0xF, 0xF, true); break; case 1: r = __builtin_amdgcn_mov_dpp(x, 0x4E, 0xF, 0xF, true); break;
                        case 2: r = __builtin_amdgcn_mov_dpp(x, 0x141, 0xF, 0xF, true); break; default: r = __builtin_amdgcn_mov_dpp(x, 0x140, 0xF, 0xF, true); break; }
    return __builtin_bit_cast(float, r);
}
__device__ __forceinline__ float row16_sum(float v) { v += __shfl_xor(v, 1); v += __shfl_xor(v, 2); v += __shfl_xor(v, 4); v += __shfl_xor(v, 8); return v; }

constexpr int SL_CS = 0, SL_BS = 17408, SL_BT = 34816, SL_XT = 53248, SL_CB = 90112, SL_DT = 99328, SL_GAM = 100352, SL_PS = 101376, SL_ZS = 103424;
__device__ __forceinline__ void ssd_fast_job(Frame& F, int s, bool samp, int bb, int g, bool dry = false) {
    const bf16* P = (const bf16*)(F.ws + WS_PROJ); const float* SM = (const float*)(F.ws + WS_SM); bf16* YS = (bf16*)(F.ws + WS_YS);
    LAS bf16* CS = (LAS bf16*)(F.lds + SL_CS); LAS bf16* BS = (LAS bf16*)(F.lds + SL_BS); LAS bf16* BT = (LAS bf16*)(F.lds + SL_BT); LAS bf16* XT = (LAS bf16*)(F.lds + SL_XT);
    LAS bf16* CBS = (LAS bf16*)(F.lds + SL_CB); LAS float* DTV = (LAS float*)(F.lds + SL_DT); LAS float* GAM = (LAS float*)(F.lds + SL_GAM); LAS float* PS = (LAS float*)(F.lds + SL_PS); LAS bf16* ZS = (LAS bf16*)(F.lds + SL_ZS) + F.wave * 2048;
    const int tid = F.tid, w = F.wave;
    int lane = F.lane; asm volatile("" : "+v"(lane)); int quad = lane >> 4, l15 = lane & 15;
    const int hl = w >> 1, ph = w & 1, head = 4 * g + hl;
    const int nchunk = samp ? 1 : SLAB_T / 64, row0 = samp ? RP + bb * DSEQ : bb * SLAB_T;
    f32x4 hacc[8][2];
    {
        const float* st = samp ? F.A.in[4] : F.out + O_SP;
        const size_t sb = (size_t)(bb * SH + head) * SN * SP;
#pragma unroll
        for (int mt = 0; mt < 8; ++mt)
#pragma unroll
            for (int nt = 0; nt < 2; ++nt)
#pragma unroll
                for (int r = 0; r < 4; ++r) { const int n = 16 * mt + 4 * quad + r, p = 32 * ph + 16 * nt + l15; hacc[mt][nt][r] = (samp || s > 0) ? st[sb + (size_t)n * SP + p] : 0.f; }
    }
    const int cidx = tid < 256 ? 3072 + g * 256 + tid : (tid < 384 ? 5120 + g * 128 + (tid - 256) : 6144 + g * 128 + (tid - 384));
    const float* wcv = F.A.in[12]; const float w0 = wcv[cidx], w1 = wcv[CONV_CH + cidx], w2 = wcv[2 * CONV_CH + cidx], w3 = wcv[3 * CONV_CH + cidx], bias = F.A.in[13][cidx];
    float h0 = 0.f, h1 = 0.f, h2 = 0.f;
    if (samp) { const float* st = F.A.in[2] + (size_t)bb * 3 * CONV_CH + cidx; h0 = st[0]; h1 = st[CONV_CH]; h2 = st[2 * CONV_CH]; }
    else if (s > 0) { const float* st = (const float*)(F.ws + WS_CARRY_MIX) + ((size_t)(s & 1) * NB + bb) * 3 * CONV_CH + cidx; h0 = st[0]; h1 = st[CONV_CH]; h2 = st[2 * CONV_CH]; }
    const float aneg = -__expf(F.A.in[17][head]), Dh = F.A.in[19][head];
    for (int c = 0; c < nchunk; ++c) {
        const int r0 = row0 + 64 * c;
        asm volatile("" : "+v"(lane)); quad = lane >> 4; l15 = lane & 15;
        v4u zr[4];
        { const GAS v4u* zp = (const GAS v4u*)(P + (size_t)(r0 + lane) * NPROJ + 8192 + head * 64 + 32 * ph);
#pragma unroll
          for (int i = 0; i < 4; ++i) zr[i] = zp[i]; }
        if (tid < 256) { const int hh = 4 * g + (tid >> 6); const float dt = softplusf_(SM[(size_t)(r0 + lane) * 64 + 16 + hh] + F.A.in[18][hh]);
            const float ga = wave_incl_scan(dt * (-__expf(F.A.in[17][hh])), lane); DTV[(tid >> 6) * 64 + lane] = dt; GAM[(tid >> 6) * 64 + lane] = ga; }
        __syncthreads();
        {
            unsigned colp2[32];
            const bf16* pc = P + (size_t)r0 * NPROJ + cidx;
            const LAS float* dtp = DTV + (tid < 256 ? (tid >> 6) * 64 : 0);
#pragma unroll
            for (int tb = 0; tb < 4; ++tb) { float raw[16];
#pragma unroll
                for (int t = 0; t < 16; ++t) raw[t] = bf2f(pc[(size_t)(16 * tb + t) * NPROJ]);
#pragma unroll
                for (int t = 0; t < 16; t += 2) { float va = bias + w0 * h0 + w1 * h1 + w2 * h2 + w3 * raw[t]; float vb = bias + w0 * h1 + w1 * h2 + w2 * raw[t] + w3 * raw[t + 1]; h0 = h2; h1 = raw[t]; h2 = raw[t + 1];
                    va = siluf_(va); vb = siluf_(vb); if (tid < 256) { va *= dtp[16 * tb + t]; vb *= dtp[16 * tb + t + 1]; }
                    colp2[8 * tb + (t >> 1)] = pk2(va, vb); }
                asm volatile("" ::: "memory"); }
            if (tid < 384) {
                LAS bf16* rowp = tid < 256 ? XT + tid * 72 : BT + (tid - 256) * 72;
#pragma unroll
                for (int i = 0; i < 8; ++i) { v4u o; o.x = colp2[4 * i]; o.y = colp2[4 * i + 1]; o.z = colp2[4 * i + 2]; o.w = colp2[4 * i + 3]; *(LAS v4u*)(rowp + 8 * i) = o; }
            }
            if (tid >= 256) {
                LAS bf16* colp = tid < 384 ? BS + (tid - 256) : CS + (tid - 384);
#pragma unroll
                for (int t = 0; t < 32; ++t) { colp[(2 * t) * 136] = (bf16)(colp2[t] & 0xffffu); colp[(2 * t + 1) * 136] = (bf16)(colp2[t] >> 16); }
            }
        }
#pragma unroll
        for (int i = 0; i < 4; ++i) *(LAS v4u*)(ZS + lane * 32 + 8 * i) = zr[i];
        __syncthreads();
        {
            const int mt = w >> 1;
#pragma unroll
            for (int q = 0; q < 2; ++q) { const int nt = 2 * (w & 1) + q; f32x4 acc = {0.f, 0.f, 0.f, 0.f};
#pragma unroll
                for (int ks = 0; ks < 4; ++ks) acc = MFMA16(ldfrag(CS, 136, 16 * mt, 32 * ks, lane), ldfrag(BS, 136, 16 * nt, 32 * ks, lane), acc);
#pragma unroll
                for (int r = 0; r < 4; ++r) CBS[(16 * mt + 4 * quad + r) * 72 + 16 * nt + l15] = (bf16)f2bf(acc[r]); }
        }
        __syncthreads();
        const LAS float* gm = GAM + hl * 64; const LAS float* dv = DTV + hl * 64;
        const float last = gm[63];
        f32x4 y[4][2];
        {
#pragma unroll
            for (int mt = 0; mt < 4; ++mt)
#pragma unroll
                for (int nt = 0; nt < 2; ++nt) y[mt][nt] = (f32x4){0.f, 0.f, 0.f, 0.f};
#pragma unroll
            for (int ks = 0; ks < 4; ++ks) { const bf16x8 hb0 = acc2frag(hacc[2 * ks][0], hacc[2 * ks + 1][0]), hb1 = acc2frag(hacc[2 * ks][1], hacc[2 * ks + 1][1]);
#pragma unroll
                for (int mt = 0; mt < 4; ++mt) { const bf16x8 a = ldfrag_perm(CS, 136, 16 * mt, 32 * ks, lane); y[mt][0] = MFMA16(a, hb0, y[mt][0]); y[mt][1] = MFMA16(a, hb1, y[mt][1]); }
                __builtin_amdgcn_sched_barrier(0); }
#pragma unroll
            for (int mt = 0; mt < 4; ++mt)
#pragma unroll
                for (int r = 0; r < 4; ++r) { const float eg = __expf(gm[16 * mt + 4 * quad + r]); y[mt][0][r] *= eg; y[mt][1][r] *= eg; }
        }
        {
            const int prow = hl * 64 + 32 * ph;
#pragma unroll
            for (int mt = 0; mt < 4; ++mt) { const int i = 16 * mt + l15; const float gi = gm[i], ddt = Dh * __builtin_amdgcn_rcpf(dv[i]);
#pragma unroll
                for (int ks = 0; ks < 2; ++ks) { if (32 * ks > 16 * mt + 15) continue;
                    const bf16x8 a0 = ldfrag(CBS, 72, 16 * mt, 32 * ks, lane); const v4u aw = __builtin_bit_cast(v4u, a0);
                    const f32x4 g0 = *(const LAS f32x4*)(gm + 32 * ks + 8 * quad), g1 = *(const LAS f32x4*)(gm + 32 * ks + 8 * quad + 4);
                    float cv[8] = {bflo(aw.x), bfhi(aw.x), bflo(aw.y), bfhi(aw.y), bflo(aw.z), bfhi(aw.z), bflo(aw.w), bfhi(aw.w)};
                    const float gj[8] = {g0.x, g0.y, g0.z, g0.w, g1.x, g1.y, g1.z, g1.w};
#pragma unroll
                    for (int jj = 0; jj < 8; ++jj) { const int j = 32 * ks + 8 * quad + jj; float v = i >= j ? cv[jj] * __expf(gi - gj[jj]) : 0.f; if (i == j) v += ddt; cv[jj] = v; }
                    v4u bw; bw.x = pk2(cv[0], cv[1]); bw.y = pk2(cv[2], cv[3]); bw.z = pk2(cv[4], cv[5]); bw.w = pk2(cv[6], cv[7]); const bf16x8 a1 = __builtin_bit_cast(bf16x8, bw);
#pragma unroll
                    for (int nt = 0; nt < 2; ++nt) y[mt][nt] = MFMA16(a1, ldfrag(XT, 72, prow + 16 * nt, 32 * ks, lane), y[mt][nt]); }
                __builtin_amdgcn_sched_barrier(0); }
#pragma unroll
            for (int mt = 0; mt < 4; ++mt)
#pragma unroll
                for (int r = 0; r < 4; ++r) { const int i = 16 * mt + 4 * quad + r; float sq = 0.f;
#pragma unroll
                    for (int nt = 0; nt < 2; ++nt) { const float z = bf2f(ZS[i * 32 + 16 * nt + l15]); const float yz = y[mt][nt][r] * siluf_(z); y[mt][nt][r] = yz; sq += yz * yz; }
                    sq = row16_sum(sq); if (l15 == 0) PS[i * 8 + w] = sq; __builtin_amdgcn_sched_barrier(0); }
            const float el = __expf(last);
#pragma unroll
            for (int mt = 0; mt < 8; ++mt)
#pragma unroll
                for (int nt = 0; nt < 2; ++nt) hacc[mt][nt] = hacc[mt][nt] * el;
#pragma unroll
            for (int ks = 0; ks < 2; ++ks) { const f32x4 g0 = *(const LAS f32x4*)(gm + 32 * ks + 8 * quad), g1 = *(const LAS f32x4*)(gm + 32 * ks + 8 * quad + 4);
                const float ed[8] = {__expf(last - g0.x), __expf(last - g0.y), __expf(last - g0.z), __expf(last - g0.w), __expf(last - g1.x), __expf(last - g1.y), __expf(last - g1.z), __expf(last - g1.w)};
                bf16x8 xw[2];
#pragma unroll
                for (int nt = 0; nt < 2; ++nt) { const v4u xv = __builtin_bit_cast(v4u, ldfrag(XT, 72, prow + 16 * nt, 32 * ks, lane));
                    v4u o; o.x = pk2(bflo(xv.x) * ed[0], bfhi(xv.x) * ed[1]); o.y = pk2(bflo(xv.y) * ed[2], bfhi(xv.y) * ed[3]); o.z = pk2(bflo(xv.z) * ed[4], bfhi(xv.z) * ed[5]); o.w = pk2(bflo(xv.w) * ed[6], bfhi(xv.w) * ed[7]);
                    xw[nt] = __builtin_bit_cast(bf16x8, o); }
#pragma unroll
                for (int mt = 0; mt < 8; ++mt) { const bf16x8 a = ldfrag(BT, 72, 16 * mt, 32 * ks, lane); hacc[mt][0] = MFMA16(a, xw[0], hacc[mt][0]); hacc[mt][1] = MFMA16(a, xw[1], hacc[mt][1]); }
                __builtin_amdgcn_sched_barrier(0); }
        }
        __syncthreads();
#pragma unroll
        for (int mt = 0; mt < 4; ++mt)
#pragma unroll
            for (int r = 0; r < 4; ++r) { const int i = 16 * mt + 4 * quad + r; const f32x4 p0 = *(const LAS f32x4*)(PS + i * 8), p1 = *(const LAS f32x4*)(PS + i * 8 + 4);
                const float rs = rsqrtf((((p0.x + p0.y) + (p0.z + p0.w)) + ((p1.x + p1.y) + (p1.z + p1.w))) * (1.f / 256.f) + EPS);
#pragma unroll
                for (int nt = 0; nt < 2; ++nt) { const int ch = head * 64 + 32 * ph + 16 * nt + l15; YS[(size_t)(r0 + i) * 2048 + ch] = (bf16)f2bf(y[mt][nt][r] * rs * F.A.in[20][ch]); } }
    }
    {
        float* so = (dry ? (float*)(F.ws + WS_T1) : F.out) + (samp ? O_SS : O_SP) - (dry ? O_GP : 0) + (size_t)(bb * SH + head) * SN * SP;
#pragma unroll
        for (int mt = 0; mt < 8; ++mt)
#pragma unroll
            for (int nt = 0; nt < 2; ++nt)
#pragma unroll
                for (int r = 0; r < 4; ++r) so[(size_t)(16 * mt + 4 * quad + r) * SP + 32 * ph + 16 * nt + l15] = hacc[mt][nt][r];
    }
    __syncthreads();
}
constexpr int NCH = SLAB_T / 64;
constexpr int GI_WKN = 0, GI_QG = 17408, GI_KT = 34816, GI_QKM = 53248, GI_IMG = 62464, GI_WV = GI_IMG, GI_SC = GI_IMG + 32768, GI_STRIDE = GI_SC + 256;
constexpr int GDN_ITEMS_MAX = NCH * NB * GH + DB * GH;
constexpr size_t WS_GDN = WS_END;
constexpr size_t WS_END2 = WS_GDN + (size_t)GDN_ITEMS_MAX * GI_STRIDE;
static_assert(WS_END2 <= 500 * MiB, "workspace map fits");
constexpr int GP_QS = 0, GP_KS = 17408, GP_LS = 34816, GP_SC = 51200, GP_HALF = 52224;

__device__ __forceinline__ void gdn_pre_pair(Frame& F, int s, int pair) {
    const bf16* P = (const bf16*)(F.ws + WS_PROJ); const float* SM = (const float*)(F.ws + WS_SM);
    const int tid = F.tid, hb = tid >> 8, ht = tid & 255, wl = (tid >> 6) & 3;
    int lane = F.lane; asm volatile("" : "+v"(lane)); const int quad = lane >> 4, l15 = lane & 15;
    const int it = 2 * pair + hb;
    int bsel, h, r0, c; bool samp;
    if (it < NCH * NB * GH) { samp = false; const int bh = it / NCH; c = it % NCH; bsel = bh >> 3; h = bh & 7; r0 = bsel * SLAB_T + 64 * c; }
    else { samp = true; const int q = it - NCH * NB * GH; bsel = q >> 3; h = q & 7; c = 0; r0 = RP + bsel * DSEQ; }
    unsigned char* img = F.ws + WS_GDN + (size_t)it * GI_STRIDE;
    LAS unsigned char* hbase = F.lds + hb * GP_HALF;
    LAS bf16* QS = (LAS bf16*)(hbase + GP_QS); LAS bf16* KS = (LAS bf16*)(hbase + GP_KS); LAS float* LS = (LAS float*)(hbase + GP_LS);
    LAS float* NQ = (LAS float*)(hbase + GP_SC); LAS float* NK = NQ + 64; LAS float* GAMS = NK + 64; LAS float* BTS = GAMS + 64;
    if (ht < 64) { const size_t r = (size_t)(r0 + lane); const float beta = sigmoidf_(SM[r * 64 + h]); const float g = -__expf(F.A.in[14][h]) * softplusf_(SM[r * 64 + 8 + h] + F.A.in[15][h]);
        GAMS[lane] = wave_incl_scan(g, lane); BTS[lane] = beta; }
    float y[64];
    {
        const float* wcv = F.A.in[12]; const float* bcv = F.A.in[13];
#pragma unroll
        for (int pass = 0; pass < 2; ++pass) {
            if (pass == 0 && ht >= 128) continue;
            const int cidx = ht < 128 ? (pass == 0 ? h * 128 + ht : 1024 + h * 128 + ht) : 2048 + h * 128 + (ht - 128);
            const float w0 = wcv[cidx], w1 = wcv[CONV_CH + cidx], w2 = wcv[2 * CONV_CH + cidx], w3 = wcv[3 * CONV_CH + cidx], bias = bcv[cidx];
            float h0 = 0.f, h1 = 0.f, h2 = 0.f;
            if (c > 0) { const bf16* pp = P + (size_t)(r0 - 3) * NPROJ + cidx; h0 = bf2f(pp[0]); h1 = bf2f(pp[NPROJ]); h2 = bf2f(pp[2 * NPROJ]); }
            else if (samp) { const float* st = F.A.in[2] + (size_t)bsel * 3 * CONV_CH + cidx; h0 = st[0]; h1 = st[CONV_CH]; h2 = st[2 * CONV_CH]; }
            else if (s > 0) { const float* st = (const float*)(F.ws + WS_CARRY_MIX) + ((size_t)(s & 1) * NB + bsel) * 3 * CONV_CH + cidx; h0 = st[0]; h1 = st[CONV_CH]; h2 = st[2 * CONV_CH]; }
            const bf16* pc = P + (size_t)r0 * NPROJ + cidx;
            LAS bf16* dst = (pass == 0 ? QS : KS) + ht;
#pragma unroll
            for (int tb = 0; tb < 4; ++tb) { float raw[16];
#pragma unroll
                for (int t = 0; t < 16; ++t) raw[t] = bf2f(pc[(size_t)(16 * tb + t) * NPROJ]);
#pragma unroll
                for (int t = 0; t < 16; ++t) { float val = bias + w0 * h0 + w1 * h1 + w2 * h2 + w3 * raw[t]; h0 = h1; h1 = h2; h2 = raw[t]; val = siluf_(val);
                    if (ht < 128) dst[(16 * tb + t) * 136] = (bf16)f2bf(val);
                    if (pass == 1) y[16 * tb + t] = val; }
                asm volatile("" ::: "memory"); }
        }
    }
    __syncthreads();
    f32x4 kk[4], qk[4];
    {
        bf16x8 ak[4], aq[4];
#pragma unroll
        for (int ks = 0; ks < 4; ++ks) { ak[ks] = ldfrag(KS, 136, 16 * wl, 32 * ks, lane); aq[ks] = ldfrag(QS, 136, 16 * wl, 32 * ks, lane); }
        f32x4 qq = {0.f, 0.f, 0.f, 0.f};
#pragma unroll
        for (int ks = 0; ks < 4; ++ks) qq = MFMA16(aq[ks], aq[ks], qq);
#pragma unroll
        for (int nt = 0; nt < 4; ++nt) {
            if (nt <= wl) { f32x4 a0 = {0.f, 0.f, 0.f, 0.f}, a1 = {0.f, 0.f, 0.f, 0.f};
#pragma unroll
                for (int ks = 0; ks < 4; ++ks) { const bf16x8 bk = ldfrag(KS, 136, 16 * nt, 32 * ks, lane); a0 = MFMA16(ak[ks], bk, a0); a1 = MFMA16(aq[ks], bk, a1); }
                kk[nt] = a0; qk[nt] = a1; } else { kk[nt] = qq; qk[nt] = qq; } }
        float dk = 0.f, dq = 0.f;
#pragma unroll
        for (int nt = 0; nt < 4; ++nt) if (nt == wl) {
#pragma unroll
            for (int r = 0; r < 4; ++r) if (4 * quad + r == l15) { dk = kk[nt][r]; dq = qq[r]; } }
        if ((l15 >> 2) == quad) { NK[16 * wl + l15] = rsqrtf(dk + EPS); NQ[16 * wl + l15] = rsqrtf(dq + EPS) * 0.08838834764831845f; }
    }
    __syncthreads();
    {
        bf16* QKM = (bf16*)(img + GI_QKM);
#pragma unroll
        for (int nt = 0; nt < 4; ++nt) { const int j = 16 * nt + l15; const float nkj = NK[j], gj = GAMS[j];
#pragma unroll
            for (int r = 0; r < 4; ++r) { const int i = 16 * wl + 4 * quad + r; const float e = __expf(GAMS[i] - gj);
                LS[i * 64 + j] = i > j ? kk[nt][r] * NK[i] * nkj * e * BTS[i] : 0.f;
                QKM[i * 72 + j] = (bf16)f2bf(i >= j ? qk[nt][r] * NQ[i] * nkj * e : 0.f); } }
    }
    const float last = GAMS[63];
    if (ht < 128) {
        bf16* KT = (bf16*)(img + GI_KT) + ht * 72;
#pragma unroll
        for (int i8 = 0; i8 < 8; ++i8) { float t[8];
#pragma unroll
            for (int e = 0; e < 8; ++e) { const int j = 8 * i8 + e; const float kh = y[j] * NK[j]; t[e] = kh * __expf(last - GAMS[j]); y[j] = kh * BTS[j] * __expf(GAMS[j]); }
            v4u o; o.x = pk2(t[0], t[1]); o.y = pk2(t[2], t[3]); o.z = pk2(t[4], t[5]); o.w = pk2(t[6], t[7]); *(GAS v4u*)(KT + 8 * i8) = o; }
    } else {
#pragma unroll
        for (int j = 0; j < 64; ++j) y[j] *= BTS[j];
    }
    __syncthreads();
#pragma unroll
    for (int i = 1; i < 64; ++i) { float acc = y[i];
#pragma unroll
        for (int j4 = 0; j4 < (i + 3) / 4; ++j4) { const f32x4 l = *(const LAS f32x4*)(LS + i * 64 + 4 * j4);
            acc -= l.x * y[4 * j4]; if (4 * j4 + 1 < i) acc -= l.y * y[4 * j4 + 1]; if (4 * j4 + 2 < i) acc -= l.z * y[4 * j4 + 2]; if (4 * j4 + 3 < i) acc -= l.w * y[4 * j4 + 3]; }
        y[i] = acc; }
    if (ht < 128) { bf16* WKN = (bf16*)(img + GI_WKN) + ht;
#pragma unroll
        for (int i = 0; i < 64; ++i) WKN[i * 136] = (bf16)f2bf(-y[i]); }
    else { float* WV = (float*)(img + GI_WV) + (ht - 128);
#pragma unroll
        for (int i = 0; i < 64; ++i) WV[i * 128] = y[i]; }
    {
        bf16* QG = (bf16*)(img + GI_QG);
#pragma unroll
        for (int q = 0; q < 4; ++q) { const int idx = ht + 256 * q, i = idx >> 4, d8 = (idx & 15) * 8; const v4u x = *(const LAS v4u*)(QS + i * 136 + d8); const float sc = NQ[i] * __expf(GAMS[i]);
            v4u o; o.x = pk2(bflo(x.x) * sc, bfhi(x.x) * sc); o.y = pk2(bflo(x.y) * sc, bfhi(x.y) * sc); o.z = pk2(bflo(x.z) * sc, bfhi(x.z) * sc); o.w = pk2(bflo(x.w) * sc, bfhi(x.w) * sc);
            *(GAS v4u*)(QG + i * 136 + d8) = o; }
        if (ht == 0) *(float*)(img + GI_SC) = __expf(last);
    }
    __syncthreads();
}
__device__ __forceinline__ void phase_gdn_pre(Frame& F, int s) {
    const int npairs = (s == 0 ? GDN_ITEMS_MAX : NCH * NB * GH) / 2;
    for (int p = F.bid; p < npairs; p += F.G) gdn_pre_pair(F, s, p);
}

constexpr int GS_BUF = 0, GS_PSQ = 2 * GI_IMG, GS_ZS = GS_PSQ + 4096;
static_assert(GS_ZS + 8 * 2048 <= RING_BYTES, "GDN sequential LDS map fits");
__device__ __forceinline__ void gdn_seq_job(Frame& F, int s, bool samp, int bb, int h, bool dry = false) {
    const bf16* P = (const bf16*)(F.ws + WS_PROJ); bf16* OG = (bf16*)(F.ws + WS_OG);
    const int w = F.wave;
    int lane = F.lane; asm volatile("" : "+v"(lane)); int quad = lane >> 4, l15 = lane & 15;
    const int nchunk = samp ? 1 : NCH, row0 = samp ? RP + bb * DSEQ : bb * SLAB_T;
    const int item0 = samp ? NCH * NB * GH + bb * GH + h : (bb * GH + h) * NCH;
    const unsigned char* img0 = F.ws + WS_GDN + (size_t)item0 * GI_STRIDE;
    LAS float* PSQ = (LAS float*)(F.lds + GS_PSQ); LAS bf16* ZS = (LAS bf16*)(F.lds + GS_ZS) + w * 1024;
    f32x4 Sacc[8];
    {
        const float* st = samp ? F.A.in[3] : F.out + O_GP; const size_t sb = (size_t)(bb * GH + h) * GDK * GDV;
#pragma unroll
        for (int mt = 0; mt < 8; ++mt)
#pragma unroll
            for (int r = 0; r < 4; ++r) Sacc[mt][r] = (samp || s > 0) ? st[sb + (size_t)(16 * mt + 4 * quad + r) * GDV + 16 * w + l15] : 0.f;
    }
    const float gn = F.A.in[16][16 * w + l15];
#define GDN_STAGE(imgp, bufi) do { for (int pc_ = w; pc_ < GI_IMG / 1024; pc_ += 8) \
        __builtin_amdgcn_global_load_lds((const unsigned*)((imgp) + pc_ * 1024 + lane * 16), (LAS unsigned*)(F.lds + GS_BUF + (bufi) * GI_IMG + pc_ * 1024), 16, 0, 0); } while (0)
    GDN_STAGE(img0, 0);
    f32x4 wv[4];
    { const float* WV = (const float*)(img0 + GI_WV);
#pragma unroll
      for (int mt = 0; mt < 4; ++mt)
#pragma unroll
          for (int r = 0; r < 4; ++r) wv[mt][r] = WV[(16 * mt + 4 * quad + r) * 128 + 16 * w + l15]; }
    v4u zr0, zr1;
    { const GAS v4u* zp = (const GAS v4u*)(P + (size_t)(row0 + lane) * NPROJ + 7168 + h * 128 + 16 * w); zr0 = zp[0]; zr1 = zp[1]; }
    float el_next = *(const float*)(img0 + GI_SC);
    f32x4 Oprev[4];
#pragma unroll
    for (int mt = 0; mt < 4; ++mt) Oprev[mt] = wv[mt];
#define GDN_FINISH(cc) do { const LAS float* ps = PSQ + ((cc) & 1) * 512; const int rb = row0 + 64 * (cc); \
        _Pragma("unroll") for (int mt = 0; mt < 4; ++mt) _Pragma("unroll") for (int r = 0; r < 4; ++r) { const int i = 16 * mt + 4 * quad + r; \
            const f32x4 p0 = *(const LAS f32x4*)(ps + i * 8), p1 = *(const LAS f32x4*)(ps + i * 8 + 4); \
            const float rs = rsqrtf((((p0.x + p0.y) + (p0.z + p0.w)) + ((p1.x + p1.y) + (p1.z + p1.w))) * (1.f / GDV) + EPS); const float z = bf2f(ZS[i * 16 + l15]); \
            OG[(size_t)(rb + i) * D + h * 128 + 16 * w + l15] = (bf16)f2bf(Oprev[mt][r] * rs * gn * siluf_(z)); } } while (0)
    for (int c = 0; c < nchunk; ++c) {
        asm volatile("" : "+v"(lane)); quad = lane >> 4; l15 = lane & 15;
        asm volatile("s_waitcnt vmcnt(0)" ::: "memory");
        __syncthreads();
        const unsigned char* img = img0 + (size_t)c * GI_STRIDE;
        f32x4 wvn[4];
        const float el = el_next;
        if (c + 1 < nchunk) { GDN_STAGE(img + GI_STRIDE, (c + 1) & 1); el_next = *(const float*)(img + GI_STRIDE + GI_SC);
            const float* WV = (const float*)(img + GI_STRIDE + GI_WV);
#pragma unroll
            for (int mt = 0; mt < 4; ++mt)
#pragma unroll
                for (int r = 0; r < 4; ++r) wvn[mt][r] = WV[(16 * mt + 4 * quad + r) * 128 + 16 * w + l15]; }
        else {
#pragma unroll
            for (int mt = 0; mt < 4; ++mt) wvn[mt] = wv[mt]; }
        if (c > 0) GDN_FINISH(c - 1);
        *(LAS v4u*)(ZS + lane * 16) = zr0; *(LAS v4u*)(ZS + lane * 16 + 8) = zr1;
        if (c + 1 < nchunk) { const GAS v4u* zp = (const GAS v4u*)(P + (size_t)(row0 + 64 * (c + 1) + lane) * NPROJ + 7168 + h * 128 + 16 * w); zr0 = zp[0]; zr1 = zp[1]; }
        const LAS unsigned char* buf = F.lds + GS_BUF + (c & 1) * GI_IMG;
        const LAS bf16* WKN = (const LAS bf16*)(buf + GI_WKN); const LAS bf16* QG = (const LAS bf16*)(buf + GI_QG); const LAS bf16* KT = (const LAS bf16*)(buf + GI_KT); const LAS bf16* QKM = (const LAS bf16*)(buf + GI_QKM);
        f32x4 U[4], O[4];
#pragma unroll
        for (int mt = 0; mt < 4; ++mt) { U[mt] = wv[mt]; O[mt] = (f32x4){0.f, 0.f, 0.f, 0.f}; }
#pragma unroll
        for (int ks = 0; ks < 4; ++ks) { const bf16x8 Sb = acc2frag(Sacc[2 * ks], Sacc[2 * ks + 1]);
#pragma unroll
            for (int mt = 0; mt < 4; ++mt) { U[mt] = MFMA16(ldfrag_perm(WKN, 136, 16 * mt, 32 * ks, lane), Sb, U[mt]); O[mt] = MFMA16(ldfrag_perm(QG, 136, 16 * mt, 32 * ks, lane), Sb, O[mt]); } }
        bf16x8 Ub[2];
#pragma unroll
        for (int ks = 0; ks < 2; ++ks) Ub[ks] = acc2frag(U[2 * ks], U[2 * ks + 1]);
#pragma unroll
        for (int ks = 0; ks < 2; ++ks)
#pragma unroll
            for (int mt = 0; mt < 4; ++mt) O[mt] = MFMA16(ldfrag_perm(QKM, 72, 16 * mt, 32 * ks, lane), Ub[ks], O[mt]);
#pragma unroll
        for (int mt = 0; mt < 8; ++mt) { Sacc[mt] = Sacc[mt] * el;
#pragma unroll
            for (int ks = 0; ks < 2; ++ks) Sacc[mt] = MFMA16(ldfrag_perm(KT, 72, 16 * mt, 32 * ks, lane), Ub[ks], Sacc[mt]); }
        { LAS float* ps = PSQ + (c & 1) * 512;
#pragma unroll
          for (int mt = 0; mt < 4; ++mt)
#pragma unroll
              for (int r = 0; r < 4; ++r) { const float sq = row16_sum(O[mt][r] * O[mt][r]); if (l15 == 0) ps[(16 * mt + 4 * quad + r) * 8 + w] = sq; Oprev[mt][r] = O[mt][r]; } }
#pragma unroll
        for (int mt = 0; mt < 4; ++mt) wv[mt] = wvn[mt];
    }
    __syncthreads();
    GDN_FINISH(nchunk - 1);
#undef GDN_FINISH
#undef GDN_STAGE
    {
        float* so = (dry ? (float*)(F.ws + WS_T1) : F.out) + (samp ? O_GS : O_GP) - (dry ? O_GP : 0) + (size_t)(bb * GH + h) * GDK * GDV;
#pragma unroll
        for (int mt = 0; mt < 8; ++mt)
#pragma unroll
            for (int r = 0; r < 4; ++r) so[(size_t)(16 * mt + 4 * quad + r) * GDV + 16 * w + l15] = Sacc[mt][r];
    }
    __syncthreads();
}
constexpr int SI_CS = 0, SI_BT = 17408, SI_CB = 35840, SI_DT = 45056, SI_GAM = 46080, SI_IMG = 47104, SI_XT = SI_IMG, SI_STRIDE = SI_IMG + 32768;
constexpr int SSD_ITEMS_MAX = NCH * NB * SG + DB * SG;
constexpr size_t WS_SSD = WS_END2;
constexpr size_t WS_END3 = WS_SSD + (size_t)SSD_ITEMS_MAX * SI_STRIDE;
static_assert(WS_END3 <= 500 * MiB, "workspace map fits");
constexpr int SP_CS = 0, SP_BS = 17408, SP_DT = 34816, SP_GAM = 35840;

__device__ __forceinline__ void ssd_pre_item(Frame& F, int s, int it) {
    const bf16* P = (const bf16*)(F.ws + WS_PROJ); const float* SM = (const float*)(F.ws + WS_SM);
    const int tid = F.tid, w = F.wave;
    int lane = F.lane; asm volatile("" : "+v"(lane)); const int quad = lane >> 4, l15 = lane & 15;
    int bsel, g, r0, c; bool samp;
    if (it < NCH * NB * SG) { samp = false; const int bg = it / NCH; c = it % NCH; bsel = bg >> 3; g = bg & 7; r0 = bsel * SLAB_T + 64 * c; }
    else { samp = true; const int q = it - NCH * NB * SG; bsel = q >> 3; g = q & 7; c = 0; r0 = RP + bsel * DSEQ; }
    unsigned char* img = F.ws + WS_SSD + (size_t)it * SI_STRIDE;
    LAS bf16* CS = (LAS bf16*)(F.lds + SP_CS); LAS bf16* BS = (LAS bf16*)(F.lds + SP_BS); LAS float* DTV = (LAS float*)(F.lds + SP_DT); LAS float* GAM = (LAS float*)(F.lds + SP_GAM);
    if (tid < 256) { const int hh = 4 * g + (tid >> 6); const float dt = softplusf_(SM[(size_t)(r0 + lane) * 64 + 16 + hh] + F.A.in[18][hh]);
        const float ga = wave_incl_scan(dt * (-__expf(F.A.in[17][hh])), lane); DTV[(tid >> 6) * 64 + lane] = dt; GAM[(tid >> 6) * 64 + lane] = ga;
        ((float*)(img + SI_DT))[(tid >> 6) * 64 + lane] = dt; ((float*)(img + SI_GAM))[(tid >> 6) * 64 + lane] = ga; }
    __syncthreads();
    {
        const int cidx = tid < 256 ? 3072 + g * 256 + tid : (tid < 384 ? 5120 + g * 128 + (tid - 256) : 6144 + g * 128 + (tid - 384));
        const float* wcv = F.A.in[12]; const float w0 = wcv[cidx], w1 = wcv[CONV_CH + cidx], w2 = wcv[2 * CONV_CH + cidx], w3 = wcv[3 * CONV_CH + cidx], bias = F.A.in[13][cidx];
        float h0 = 0.f, h1 = 0.f, h2 = 0.f;
        if (c > 0) { const bf16* pp = P + (size_t)(r0 - 3) * NPROJ + cidx; h0 = bf2f(pp[0]); h1 = bf2f(pp[NPROJ]); h2 = bf2f(pp[2 * NPROJ]); }
        else if (samp) { const float* st = F.A.in[2] + (size_t)bsel * 3 * CONV_CH + cidx; h0 = st[0]; h1 = st[CONV_CH]; h2 = st[2 * CONV_CH]; }
        else if (s > 0) { const float* st = (const float*)(F.ws + WS_CARRY_MIX) + ((size_t)(s & 1) * NB + bsel) * 3 * CONV_CH + cidx; h0 = st[0]; h1 = st[CONV_CH]; h2 = st[2 * CONV_CH]; }
        unsigned colp2[32];
        const bf16* pc = P + (size_t)r0 * NPROJ + cidx;
        const LAS float* dtp = DTV + (tid < 256 ? (tid >> 6) * 64 : 0);
#pragma unroll
        for (int tb = 0; tb < 2; ++tb) { float raw[32];
#pragma unroll
            for (int t = 0; t < 32; ++t) raw[t] = bf2f(pc[(size_t)(32 * tb + t) * NPROJ]);
#pragma unroll
            for (int t = 0; t < 32; t += 2) { float va = bias + w0 * h0 + w1 * h1 + w2 * h2 + w3 * raw[t]; float vb = bias + w0 * h1 + w1 * h2 + w2 * raw[t] + w3 * raw[t + 1]; h0 = h2; h1 = raw[t]; h2 = raw[t + 1];
                va = siluf_(va); vb = siluf_(vb); if (tid < 256) { va *= dtp[32 * tb + t]; vb *= dtp[32 * tb + t + 1]; }
                colp2[16 * tb + (t >> 1)] = pk2(va, vb); }
            asm volatile("" ::: "memory"); }
        if (tid < 384) {
            bf16* rowp = tid < 256 ? (bf16*)(img + SI_XT) + tid * 64 : (bf16*)(img + SI_BT) + (tid - 256) * 72;
#pragma unroll
            for (int i = 0; i < 8; ++i) { v4u o; o.x = colp2[4 * i]; o.y = colp2[4 * i + 1]; o.z = colp2[4 * i + 2]; o.w = colp2[4 * i + 3]; *(GAS v4u*)(rowp + 8 * i) = o; }
        }
        if (tid >= 256) {
            LAS bf16* colp = tid < 384 ? BS + (tid - 256) : CS + (tid - 384);
#pragma unroll
            for (int t = 0; t < 32; ++t) { colp[(2 * t) * 136] = (bf16)(colp2[t] & 0xffffu); colp[(2 * t + 1) * 136] = (bf16)(colp2[t] >> 16); }
        }
    }
    __syncthreads();
    {
        const int mt = w >> 1; bf16* CBG = (bf16*)(img + SI_CB);
#pragma unroll
        for (int q = 0; q < 2; ++q) { const int nt = 2 * (w & 1) + q; f32x4 acc = {0.f, 0.f, 0.f, 0.f};
#pragma unroll
            for (int ks = 0; ks < 4; ++ks) acc = MFMA16(ldfrag(CS, 136, 16 * mt, 32 * ks, lane), ldfrag(BS, 136, 16 * nt, 32 * ks, lane), acc);
#pragma unroll
            for (int r = 0; r < 4; ++r) CBG[(16 * mt + 4 * quad + r) * 72 + 16 * nt + l15] = (bf16)f2bf(acc[r]); }
    }
    for (int i = tid; i < 17408 / 16; i += NTHR) *(GAS v4u*)(img + SI_CS + 16 * i) = *(const LAS v4u*)(F.lds + SP_CS + 16 * i);
    __syncthreads();
}
__device__ __forceinline__ void phase_ssd_pre(Frame& F, int s) {
    const int nitems = s == 0 ? SSD_ITEMS_MAX : NCH * NB * SG;
    for (int it = F.bid; it < nitems; it += F.G) ssd_pre_item(F, s, it);
}

constexpr int SQ_BUF = 0, SQ_PS = 2 * SI_IMG, SQ_ZS = SQ_PS + 2048;
static_assert(SQ_ZS + 8 * 4096 <= RING_BYTES, "SSD sequential LDS map fits");
__device__ __forceinline__ void ssd_seq_job(Frame& F, int s, bool samp, int bb, int g, bool dry = false) {
    const bf16* P = (const bf16*)(F.ws + WS_PROJ); bf16* YS = (bf16*)(F.ws + WS_YS);
    const int w = F.wave;
    int lane = F.lane; asm volatile("" : "+v"(lane)); int quad = lane >> 4, l15 = lane & 15;
    const int hl = w >> 1, ph = w & 1, head = 4 * g + hl;
    const int nchunk = samp ? 1 : NCH, row0 = samp ? RP + bb * DSEQ : bb * SLAB_T;
    const int item0 = samp ? NCH * NB * SG + bb * SG + g : (bb * SG + g) * NCH;
    const unsigned char* img0 = F.ws + WS_SSD + (size_t)item0 * SI_STRIDE;
    LAS float* PS = (LAS float*)(F.lds + SQ_PS); LAS bf16* ZS = (LAS bf16*)(F.lds + SQ_ZS) + w * 2048;
    f32x4 hacc[8][2];
    {
        const float* st = samp ? F.A.in[4] : F.out + O_SP;
        const size_t sb = (size_t)(bb * SH + head) * SN * SP;
#pragma unroll
        for (int mt = 0; mt < 8; ++mt)
#pragma unroll
            for (int nt = 0; nt < 2; ++nt)
#pragma unroll
                for (int r = 0; r < 4; ++r) { const int n = 16 * mt + 4 * quad + r, p = 32 * ph + 16 * nt + l15; hacc[mt][nt][r] = (samp || s > 0) ? st[sb + (size_t)n * SP + p] : 0.f; }
    }
    const float Dh = F.A.in[19][head];
    const int prow = hl * 64 + 32 * ph;
#define SSD_STAGE(imgp, bufi) do { for (int pc_ = w; pc_ < SI_IMG / 1024; pc_ += 8) \
        __builtin_amdgcn_global_load_lds((const unsigned*)((imgp) + pc_ * 1024 + lane * 16), (LAS unsigned*)(F.lds + SQ_BUF + (bufi) * SI_IMG + pc_ * 1024), 16, 0, 0); } while (0)
#define SSD_LOADXT(dst, imgp) do { const bf16* xb_ = (const bf16*)((imgp) + SI_XT); _Pragma("unroll") for (int nt = 0; nt < 2; ++nt) _Pragma("unroll") for (int ks = 0; ks < 2; ++ks) \
        dst[nt][ks] = *(const GAS v4u*)(xb_ + (prow + 16 * nt + l15) * 64 + 32 * ks + 8 * quad); } while (0)
    SSD_STAGE(img0, 0);
    v4u xt[2][2];
    SSD_LOADXT(xt, img0);
    v4u zr[4];
    { const GAS v4u* zp = (const GAS v4u*)(P + (size_t)(row0 + lane) * NPROJ + 8192 + head * 64 + 32 * ph);
#pragma unroll
      for (int i = 0; i < 4; ++i) zr[i] = zp[i]; }
    const float nw0 = F.A.in[20][head * 64 + 32 * ph + l15], nw1 = F.A.in[20][head * 64 + 32 * ph + 16 + l15];
    for (int c = 0; c < nchunk; ++c) {
        asm volatile("" : "+v"(lane)); quad = lane >> 4; l15 = lane & 15;
        asm volatile("s_waitcnt vmcnt(0)" ::: "memory");
        __syncthreads();
        const unsigned char* img = img0 + (size_t)c * SI_STRIDE;
        const int r0 = row0 + 64 * c;
        v4u xtn[2][2];
        if (c + 1 < nchunk) { SSD_STAGE(img + SI_STRIDE, (c + 1) & 1); SSD_LOADXT(xtn, img + SI_STRIDE); }
        else {
#pragma unroll
            for (int nt = 0; nt < 2; ++nt)
#pragma unroll
                for (int ks = 0; ks < 2; ++ks) xtn[nt][ks] = xt[nt][ks]; }
#pragma unroll
        for (int i = 0; i < 4; ++i) *(LAS v4u*)(ZS + lane * 32 + 8 * i) = zr[i];
        if (c + 1 < nchunk) { const GAS v4u* zp = (const GAS v4u*)(P + (size_t)(r0 + 64 + lane) * NPROJ + 8192 + head * 64 + 32 * ph);
#pragma unroll
          for (int i = 0; i < 4; ++i) zr[i] = zp[i]; }
        const LAS unsigned char* buf = F.lds + SQ_BUF + (c & 1) * SI_IMG;
        const LAS bf16* CS = (const LAS bf16*)(buf + SI_CS); const LAS bf16* BT = (const LAS bf16*)(buf + SI_BT); const LAS bf16* CBS = (const LAS bf16*)(buf + SI_CB);
        const LAS float* gm = (const LAS float*)(buf + SI_GAM) + hl * 64; const LAS float* dv = (const LAS float*)(buf + SI_DT) + hl * 64;
        const float last = gm[63];
        f32x4 y[4][2];
#pragma unroll
        for (int mt = 0; mt < 4; ++mt)
#pragma unroll
            for (int nt = 0; nt < 2; ++nt) y[mt][nt] = (f32x4){0.f, 0.f, 0.f, 0.f};
#pragma unroll
        for (int ks = 0; ks < 4; ++ks) { const bf16x8 hb0 = acc2frag(hacc[2 * ks][0], hacc[2 * ks + 1][0]), hb1 = acc2frag(hacc[2 * ks][1], hacc[2 * ks + 1][1]);
#pragma unroll
            for (int mt = 0; mt < 4; ++mt) { const bf16x8 a = ldfrag_perm(CS, 136, 16 * mt, 32 * ks, lane); y[mt][0] = MFMA16(a, hb0, y[mt][0]); y[mt][1] = MFMA16(a, hb1, y[mt][1]); }
            __builtin_amdgcn_sched_barrier(0); }
#pragma unroll
        for (int mt = 0; mt < 4; ++mt)
#pragma unroll
            for (int r = 0; r < 4; ++r) { const float eg = __expf(gm[16 * mt + 4 * quad + r]); y[mt][0][r] *= eg; y[mt][1][r] *= eg; }
#pragma unroll
        for (int mt = 0; mt < 4; ++mt) { const int i = 16 * mt + l15; const float gi = gm[i], ddt = Dh * __builtin_amdgcn_rcpf(dv[i]);
#pragma unroll
            for (int ks = 0; ks < 2; ++ks) { if (32 * ks > 16 * mt + 15) continue;
                const v4u aw = __builtin_bit_cast(v4u, ldfrag(CBS, 72, 16 * mt, 32 * ks, lane));
                const f32x4 g0 = *(const LAS f32x4*)(gm + 32 * ks + 8 * quad), g1 = *(const LAS f32x4*)(gm + 32 * ks + 8 * quad + 4);
                float cv[8] = {bflo(aw.x), bfhi(aw.x), bflo(aw.y), bfhi(aw.y), bflo(aw.z), bfhi(aw.z), bflo(aw.w), bfhi(aw.w)};
                const float gj[8] = {g0.x, g0.y, g0.z, g0.w, g1.x, g1.y, g1.z, g1.w};
#pragma unroll
                for (int jj = 0; jj < 8; ++jj) { const int j = 32 * ks + 8 * quad + jj; float v = i >= j ? cv[jj] * __expf(gi - gj[jj]) : 0.f; if (i == j) v += ddt; cv[jj] = v; }
                v4u bw; bw.x = pk2(cv[0], cv[1]); bw.y = pk2(cv[2], cv[3]); bw.z = pk2(cv[4], cv[5]); bw.w = pk2(cv[6], cv[7]); const bf16x8 a1 = __builtin_bit_cast(bf16x8, bw);
#pragma unroll
                for (int nt = 0; nt < 2; ++nt) y[mt][nt] = MFMA16(a1, __builtin_bit_cast(bf16x8, xt[nt][ks]), y[mt][nt]); }
            __builtin_amdgcn_sched_barrier(0); }
#pragma unroll
        for (int mt = 0; mt < 4; ++mt)
#pragma unroll
            for (int r = 0; r < 4; ++r) { const int i = 16 * mt + 4 * quad + r; float sq = 0.f;
#pragma unroll
                for (int nt = 0; nt < 2; ++nt) { const float z = bf2f(ZS[i * 32 + 16 * nt + l15]); const float yz = y[mt][nt][r] * siluf_(z); y[mt][nt][r] = yz; sq += yz * yz; }
                sq = row16_sum(sq); if (l15 == 0) PS[i * 8 + w] = sq; }
        {
            const float el = __expf(last);
#pragma unroll
            for (int mt = 0; mt < 8; ++mt)
#pragma unroll
                for (int nt = 0; nt < 2; ++nt) hacc[mt][nt] = hacc[mt][nt] * el;
#pragma unroll
            for (int ks = 0; ks < 2; ++ks) { const f32x4 g0 = *(const LAS f32x4*)(gm + 32 * ks + 8 * quad), g1 = *(const LAS f32x4*)(gm + 32 * ks + 8 * quad + 4);
                const float ed[8] = {__expf(last - g0.x), __expf(last - g0.y), __expf(last - g0.z), __expf(last - g0.w), __expf(last - g1.x), __expf(last - g1.y), __expf(last - g1.z), __expf(last - g1.w)};
                bf16x8 xw[2];
#pragma unroll
                for (int nt = 0; nt < 2; ++nt) { const v4u xv = xt[nt][ks];
                    v4u o; o.x = pk2(bflo(xv.x) * ed[0], bfhi(xv.x) * ed[1]); o.y = pk2(bflo(xv.y) * ed[2], bfhi(xv.y) * ed[3]); o.z = pk2(bflo(xv.z) * ed[4], bfhi(xv.z) * ed[5]); o.w = pk2(bflo(xv.w) * ed[6], bfhi(xv.w) * ed[7]);
                    xw[nt] = __builtin_bit_cast(bf16x8, o); }
#pragma unroll
                for (int mt = 0; mt < 8; ++mt) { const bf16x8 a = ldfrag(BT, 72, 16 * mt, 32 * ks, lane); hacc[mt][0] = MFMA16(a, xw[0], hacc[mt][0]); hacc[mt][1] = MFMA16(a, xw[1], hacc[mt][1]); }
                __builtin_amdgcn_sched_barrier(0); }
        }
        __syncthreads();
#pragma unroll
        for (int mt = 0; mt < 4; ++mt)
#pragma unroll
            for (int r = 0; r < 4; ++r) { const int i = 16 * mt + 4 * quad + r; const f32x4 p0 = *(const LAS f32x4*)(PS + i * 8), p1 = *(const LAS f32x4*)(PS + i * 8 + 4);
                const float rs = rsqrtf((((p0.x + p0.y) + (p0.z + p0.w)) + ((p1.x + p1.y) + (p1.z + p1.w))) * (1.f / 256.f) + EPS);
#pragma unroll
                for (int nt = 0; nt < 2; ++nt) { const int ch = head * 64 + 32 * ph + 16 * nt + l15; YS[(size_t)(r0 + i) * 2048 + ch] = (bf16)f2bf(y[mt][nt][r] * rs * (nt ? nw1 : nw0)); } }
#pragma unroll
        for (int nt = 0; nt < 2; ++nt)
#pragma unroll
            for (int ks = 0; ks < 2; ++ks) xt[nt][ks] = xtn[nt][ks];
    }
#undef SSD_STAGE
#undef SSD_LOADXT
    {
        float* so = (dry ? (float*)(F.ws + WS_T1) : F.out) + (samp ? O_SS : O_SP) - (dry ? O_GP : 0) + (size_t)(bb * SH + head) * SN * SP;
#pragma unroll
        for (int mt = 0; mt < 8; ++mt)
#pragma unroll
            for (int nt = 0; nt < 2; ++nt)
#pragma unroll
                for (int r = 0; r < 4; ++r) so[(size_t)(16 * mt + 4 * quad + r) * SP + 32 * ph + 16 * nt + l15] = hacc[mt][nt][r];
    }
    __syncthreads();
}
__device__ __forceinline__ void gdn_naive_job(Frame& F, int s, bool samp, int bb, int h) {
    const bf16* P = (const bf16*)(F.ws + WS_PROJ); const float* SM = (const float*)(F.ws + WS_SM); bf16* OG = (bf16*)(F.ws + WS_OG);
    LAS float* qs = (LAS float*)F.lds; LAS float* ks = qs + 128; LAS float* vs = ks + 128; LAS float* part = vs + 128;
    LAS float* red = part + 8; LAS float* red2 = red + 512; LAS float* part2 = red2 + 512;
    const int tid = F.tid, v = tid & 127, kq = tid >> 7, ntok = samp ? DSEQ : SLAB_T, row0 = samp ? RP + bb * DSEQ : bb * SLAB_T;
    float S[32];
    const size_t sbase = ((size_t)(bb * GH + h) * GDK + kq * 32) * GDV + v;
    if (samp) { const float* st = F.A.in[3] + sbase;
#pragma unroll
        for (int i = 0; i < 32; ++i) S[i] = st[(size_t)i * GDV]; }
    else if (s == 0) {
#pragma unroll
        for (int i = 0; i < 32; ++i) S[i] = 0.f; }
    else { const float* st = F.out + O_GP + sbase;
#pragma unroll
        for (int i = 0; i < 32; ++i) S[i] = st[(size_t)i * GDV]; }
    const int role = tid >> 7, ch = tid & 127, cidx = role * 1024 + h * 128 + ch;
    float h0 = 0.f, h1 = 0.f, h2 = 0.f, w0 = 0.f, w1 = 0.f, w2 = 0.f, w3 = 0.f, bias = 0.f;
    if (tid < 384) {
        const float* wcv = F.A.in[12]; w0 = wcv[cidx]; w1 = wcv[CONV_CH + cidx]; w2 = wcv[2 * CONV_CH + cidx]; w3 = wcv[3 * CONV_CH + cidx]; bias = F.A.in[13][cidx];
        if (samp) { const float* st = F.A.in[2] + (size_t)bb * 3 * CONV_CH + cidx; h0 = st[0]; h1 = st[CONV_CH]; h2 = st[2 * CONV_CH]; }
        else if (s > 0) { const float* st = (const float*)(F.ws + WS_CARRY_MIX) + ((size_t)(s & 1) * NB + bb) * 3 * CONV_CH + cidx; h0 = st[0]; h1 = st[CONV_CH]; h2 = st[2 * CONV_CH]; }
    }
    const float Aexp = __expf(F.A.in[14][h]), dtb = F.A.in[15][h], gnorm = F.A.in[16][v];
    for (int t = 0; t < ntok; ++t) {
        const size_t r = (size_t)(row0 + t);
        if (tid < 384) {
            const float raw = bf2f(P[r * NPROJ + cidx]);
            float val = bias + w0 * h0 + w1 * h1 + w2 * h2 + w3 * raw; h0 = h1; h1 = h2; h2 = raw; val = siluf_(val);
            qs[role * 128 + ch] = val;
            if (role < 2) { const float sq = wave_sum(val * val); if (F.lane == 0) part[F.wave] = sq; }
        }
        __syncthreads();
        const float qsc = rsqrtf(part[0] + part[1] + EPS) * 0.08838834764831845f, ksc = rsqrtf(part[2] + part[3] + EPS);
        const float beta = sigmoidf_(SM[r * 64 + h]); const float g = -Aexp * softplusf_(SM[r * 64 + 8 + h] + dtb); const float a = __expf(g);
        float kn[32]; float p = 0.f;
#pragma unroll
        for (int i = 0; i < 32; ++i) { kn[i] = ks[kq * 32 + i] * ksc; p += kn[i] * S[i]; }
        red[kq * 128 + v] = p;
        __syncthreads();
        const float kS = (red[v] + red[128 + v]) + (red[256 + v] + red[384 + v]);
        const float d = beta * (vs[v] - a * kS);
        float po = 0.f;
#pragma unroll
        for (int i = 0; i < 32; ++i) { S[i] = a * S[i] + kn[i] * d; po += qs[kq * 32 + i] * qsc * S[i]; }
        red2[kq * 128 + v] = po;
        __syncthreads();
        float o = 0.f;
        if (tid < 128) { o = (red2[v] + red2[128 + v]) + (red2[256 + v] + red2[384 + v]); const float sq = wave_sum(o * o); if (F.lane == 0) part2[F.wave] = sq; }
        __syncthreads();
        if (tid < 128) { const float rs = rsqrtf((part2[0] + part2[1]) * (1.f / GDV) + EPS); const float z = bf2f(P[r * NPROJ + 7168 + h * 128 + v]);
            OG[r * D + h * 128 + v] = (bf16)f2bf(o * rs * gnorm * siluf_(z)); }
    }
    float* so = F.out + (samp ? O_GS : O_GP) + sbase;
#pragma unroll
    for (int i = 0; i < 32; ++i) so[(size_t)i * GDV] = S[i];
    __syncthreads();
}
__device__ __forceinline__ void ssd_naive_job(Frame& F, int s, bool samp, int bb, int g) {
    const bf16* P = (const bf16*)(F.ws + WS_PROJ); const float* SM = (const float*)(F.ws + WS_SM); bf16* YS = (bf16*)(F.ws + WS_YS);
    LAS float* xs = (LAS float*)F.lds; LAS float* Bs = xs + 256; LAS float* Cs = Bs + 128; LAS float* red = Cs + 128; LAS float* part = red + 512;
    const int tid = F.tid, hl = tid >> 7, p = tid & 63, nh = (tid >> 6) & 1, head = 4 * g + hl, ntok = samp ? DSEQ : SLAB_T, row0 = samp ? RP + bb * DSEQ : bb * SLAB_T;
    float hr[64];
    const size_t sbase = ((size_t)(bb * SH + head) * SN + nh * 64) * SP + p;
    if (samp) { const float* st = F.A.in[4] + sbase;
#pragma unroll
        for (int i = 0; i < 64; ++i) hr[i] = st[(size_t)i * SP]; }
    else if (s == 0) {
#pragma unroll
        for (int i = 0; i < 64; ++i) hr[i] = 0.f; }
    else { const float* st = F.out + O_SP + sbase;
#pragma unroll
        for (int i = 0; i < 64; ++i) hr[i] = st[(size_t)i * SP]; }
    const int cidx = tid < 256 ? 3072 + g * 256 + tid : (tid < 384 ? 5120 + g * 128 + (tid - 256) : 6144 + g * 128 + (tid - 384));
    const float* wcv = F.A.in[12]; const float w0 = wcv[cidx], w1 = wcv[CONV_CH + cidx], w2 = wcv[2 * CONV_CH + cidx], w3 = wcv[3 * CONV_CH + cidx], bias = F.A.in[13][cidx];
    float h0 = 0.f, h1 = 0.f, h2 = 0.f;
    if (samp) { const float* st = F.A.in[2] + (size_t)bb * 3 * CONV_CH + cidx; h0 = st[0]; h1 = st[CONV_CH]; h2 = st[2 * CONV_CH]; }
    else if (s > 0) { const float* st = (const float*)(F.ws + WS_CARRY_MIX) + ((size_t)(s & 1) * NB + bb) * 3 * CONV_CH + cidx; h0 = st[0]; h1 = st[CONV_CH]; h2 = st[2 * CONV_CH]; }
    const float aneg = -__expf(F.A.in[17][head]), dtb = F.A.in[18][head], Dh = F.A.in[19][head], nw = F.A.in[20][head * 64 + p];
    for (int t = 0; t < ntok; ++t) {
        const size_t r = (size_t)(row0 + t);
        { const float raw = bf2f(P[r * NPROJ + cidx]); float val = bias + w0 * h0 + w1 * h1 + w2 * h2 + w3 * raw; h0 = h1; h1 = h2; h2 = raw; xs[tid] = siluf_(val); }
        __syncthreads();
        const float dt = softplusf_(SM[r * 64 + 16 + head] + dtb), dA = __expf(dt * aneg), x = xs[hl * 64 + p], dx = dt * x;
        float py = 0.f;
#pragma unroll
        for (int i = 0; i < 64; ++i) { hr[i] = dA * hr[i] + dx * Bs[nh * 64 + i]; py += Cs[nh * 64 + i] * hr[i]; }
        red[tid] = py;
        __syncthreads();
        float yz = 0.f;
        if (nh == 0) { const float y = red[tid] + red[tid + 64] + Dh * x; const float z = bf2f(P[r * NPROJ + 8192 + head * 64 + p]); yz = y * siluf_(z);
            const float sq = wave_sum(yz * yz); if (F.lane == 0) part[F.wave] = sq; }
        __syncthreads();
        if (nh == 0) { const float rs = rsqrtf(((part[0] + part[2]) + (part[4] + part[6])) * (1.f / 256.f) + EPS); YS[r * 2048 + head * 64 + p] = (bf16)f2bf(yz * rs * nw); }
    }
    float* so = F.out + (samp ? O_SS : O_SP) + sbase;
#pragma unroll
    for (int i = 0; i < 64; ++i) so[(size_t)i * SP] = hr[i];
    __syncthreads();
}
#ifndef SCAN_REP_GDN
#define SCAN_REP_GDN 0
#endif
#ifndef SCAN_REP_SSD
#define SCAN_REP_SSD 0
#endif
__device__ __forceinline__ void phase_scan(Frame& F, int s) {
    const int njobs = s == 0 ? 192 : 64;
    for (int j = F.bid; j < njobs; j += F.G) {
        if (j < 32) {
#ifdef GDN_NAIVE
            gdn_naive_job(F, s, false, j >> 3, j & 7);
#else
#if SCAN_REP_GDN
            gdn_seq_job(F, s, false, j >> 3, j & 7, true);
#endif
            gdn_seq_job(F, s, false, j >> 3, j & 7);
#endif
        } else if (j < 64) {
#ifndef EXP_NO_SSD
#if SCAN_REP_SSD
            ssd_seq_job(F, s, false, (j - 32) >> 3, (j - 32) & 7, true);
#endif
            ssd_seq_job(F, s, false, (j - 32) >> 3, (j - 32) & 7);
#endif
        }
        else if (j < 128) {
#ifdef GDN_NAIVE
            gdn_naive_job(F, s, true, (j - 64) >> 3, (j - 64) & 7);
#else
            gdn_seq_job(F, s, true, (j - 64) >> 3, (j - 64) & 7);
#endif
        } else {
#ifndef EXP_NO_SSD
            ssd_seq_job(F, s, true, (j - 128) >> 3, (j - 128) & 7);
#endif
        }
    }
}
#define XB_TMO      128
#define XB_XCNT(j)  (256  + 64 * (j))
#define XB_XSUB(j)  (1280 + 64 * (j))
#define XB_XGEN(j)  (2304 + 64 * (j))
#define XB_TOP      3328
#define XB_TOPGEN   3392
#define XCD_BAR_WORDS 3456
#define XB_SPIN_CAP (1u << 18)
__device__ __forceinline__ unsigned xb_ld(unsigned* p)              { return __hip_atomic_load(p, __ATOMIC_RELAXED, __HIP_MEMORY_SCOPE_AGENT); }
__device__ __forceinline__ unsigned xb_add(unsigned* p, unsigned v) { return __hip_atomic_fetch_add(p, v, __ATOMIC_RELAXED, __HIP_MEMORY_SCOPE_AGENT); }
__device__ __forceinline__ unsigned xb_xcc_id() { return (unsigned)__builtin_amdgcn_s_getreg((3 << 11) | 20) & 0xFu; }
#define XB_SPIN(cond, bar) do { unsigned _sp = 0; while (cond) { __builtin_amdgcn_s_sleep(1); \
    if ((++_sp & 255u) == 0u) { if (xb_ld(&(bar)[XB_TMO])) break; if (_sp > XB_SPIN_CAP) { atomicAdd(&(bar)[XB_TMO], 1u); break; } } } } while (0)
struct XcdBarrier { unsigned* bar; unsigned x; volatile LAS unsigned* st; };
__device__ __forceinline__ XcdBarrier xcd_barrier_post(unsigned* bar, volatile LAS unsigned* st) {
    XcdBarrier b; b.bar = bar; b.x = xb_xcc_id(); b.st = st;
    if (threadIdx.x == 0) (void)xb_add(&bar[XB_XCNT(b.x)], 1u);
    return b;
}
__device__ __forceinline__ void xcd_barrier_complete(unsigned* bar, unsigned x, unsigned& nloc, unsigned& nx) {
    const unsigned G = gridDim.x * gridDim.y * gridDim.z;
    unsigned sum, cnt, mine, sp = 0u;
    for (;;) {
        sum = 0u; cnt = 0u; mine = 0u;
#pragma unroll
        for (unsigned j = 0; j < 16; ++j) { const unsigned c = xb_ld(&bar[XB_XCNT(j)]); sum += c; cnt += (c > 0u) ? 1u : 0u; mine = (j == x) ? c : mine; }
        if (sum == G) break;
        __builtin_amdgcn_s_sleep(1);
        if ((++sp & 255u) == 0u) { if (xb_ld(&bar[XB_TMO])) break; if (sp > XB_SPIN_CAP) { atomicAdd(&bar[XB_TMO], 1u); break; } }
    }
    nloc = mine > 0u ? mine : 1u; nx = cnt > 0u ? cnt : 1u;
}
__device__ __forceinline__ void xcd_barrier(const XcdBarrier& b) {
    asm volatile("s_waitcnt vmcnt(0)" ::: "memory");
    __syncthreads();
    if (threadIdx.x == 0) {
        unsigned* bar = b.bar;
        __builtin_amdgcn_s_waitcnt(0);
        unsigned nloc = b.st[0], nx = b.st[1];
        if (nloc == 0u) { xcd_barrier_complete(bar, b.x, nloc, nx); b.st[0] = nloc; b.st[1] = nx; }
        const unsigned old = xb_add(&bar[XB_XSUB(b.x)], 1u);
        const unsigned gen = old / nloc;
        if (old + 1u == (gen + 1u) * nloc) {
            __builtin_amdgcn_fence(__ATOMIC_RELEASE, "agent");
            asm volatile("s_waitcnt vmcnt(0)" ::: "memory");
            const unsigned og = xb_add(&bar[XB_TOP], 1u);
            const unsigned tg = og / nx;
            if (og + 1u == (tg + 1u) * nx) xb_add(&bar[XB_TOPGEN], 1u);
            else XB_SPIN(xb_ld(&bar[XB_TOPGEN]) == tg, bar);
            __builtin_amdgcn_fence(__ATOMIC_ACQUIRE, "agent");
            xb_add(&bar[XB_XGEN(b.x)], 1u);
            asm volatile("s_waitcnt vmcnt(0)" ::: "memory");
        } else {
            XB_SPIN(xb_ld(&bar[XB_XGEN(b.x)]) == gen, bar);
            __builtin_amdgcn_fence(__ATOMIC_ACQUIRE, "agent");
            asm volatile("s_waitcnt vmcnt(0)" ::: "memory");
        }
    }
    __syncthreads();
}
constexpr int CW_BAR = 4096;
#ifndef PHASE_MASK
#define PHASE_MASK 0xFFF
#endif
#define PM(k) ((PHASE_MASK >> (k)) & 1)
#ifndef GEMM_REPS
#define GEMM_REPS 1
#endif
#ifndef PRE_REPS
#define PRE_REPS 1
#endif
constexpr int STEPS_PER_SLAB = 11, NSTEPS = 2 + STEPS_PER_SLAB * NSLAB;
#define GEMM_PHASE(EPI_T, AOFF, BOFF, N_, K_, ...) do { pg8::Gemm g{(const pg8::bf16_t*)(F.ws + (AOFF)), (const pg8::bf16_t*)(F.ws + (BOFF)), R, (N_), (K_)}; \
    pg8::StaticOrder S; S.init(R, (N_), F.G, F.bid); epi::EPI_T E{__VA_ARGS__}; pg8::gemm_phase<epi::EPI_T, pg8::StaticOrder, true, true>(F.lds, g, S, E, F.tid); if (GEMM_REPS > 1) { __syncthreads(); pg8::gemm_phase<epi::EPI_T, pg8::StaticOrder, true, true>(F.lds, g, S, E, F.tid); } } while (0)
__device__ __forceinline__ void run_step(Frame& F, int st) {
    if (st == 0) { if constexpr (PM(10)) phase_prologue0(F); return; }
    if (st == 1) { if constexpr (PM(11)) phase_prologue1(F); return; }
    const int s = (st - 2) / STEPS_PER_SLAB, k = (st - 2) % STEPS_PER_SLAB, R = slab_rows(s);
    unsigned char* ws = F.ws;
    switch (k) {
    case 0: if constexpr (PM(0)) phase_norm1(F, s); break;
    case 1: if constexpr (PM(1)) GEMM_PHASE(EpiProj, WS_HB, WS_WIN, NIN, D, (bf16*)(ws + WS_PROJ), (float*)(ws + WS_SM)); break;
    case 2: if constexpr (PM(2)) {
#if !defined(GDN_NAIVE) && !defined(EXP_NO_PRE)
        for (int rep_ = 0; rep_ < PRE_REPS; ++rep_) phase_gdn_pre(F, s);
        phase_ssd_pre(F, s);
#endif
        } break;
    case 3: if constexpr (PM(2)) {
#ifndef EXP_NO_SCAN
        phase_scan(F, s);
#endif
        phase_mix_carry(F, s); } break;
    case 4: if constexpr (PM(3)) GEMM_PHASE(EpiGate1, WS_OG, WS_WG, D, D, (const bf16*)(ws + WS_PROJ), (float*)(ws + WS_T1)); break;
    case 5: if constexpr (PM(4)) GEMM_PHASE(EpiGate2, WS_YS, WS_WS, D, 2048, (const bf16*)(ws + WS_PROJ), (const float*)(ws + WS_T1), (bf16*)(ws + WS_MIX)); break;
    case 6: if constexpr (PM(5)) GEMM_PHASE(EpiOut, WS_MIX, WS_WOUT, D, D, F.A.in[0], F.A.in[1], (const float*)(ws + WS_MODV), (const float*)(ws + WS_G2), (float*)(ws + WS_X1), (bf16*)(ws + WS_X1G), (float*)(ws + WS_SS1), s); break;
    case 7: if constexpr (PM(6)) GEMM_PHASE(EpiUp, WS_X1G, WS_WUP, NUP, D, (const float*)(ws + WS_SS1), (const float*)(ws + WS_SHW), (bf16*)(ws + WS_U)); break;
    case 8: if constexpr (PM(7)) phase_convact(F, s); break;
    case 9: if constexpr (PM(8)) GEMM_PHASE(EpiDown, WS_ACT, WS_WDN, D, DFF, (const float*)(ws + WS_X1), (const float*)(ws + WS_MODV), F.out + O_YP, F.out + O_YS, (float*)(ws + WS_SS2), s); break;
    default: if constexpr (PM(9)) phase_final(F, s); break;
    }
}
__global__ void __launch_bounds__(NTHR, 2) mk_fwd(Args a) {
    extern __shared__ __attribute__((aligned(16))) unsigned char lds[];
    Frame F(a);
    F.lds = (LAS unsigned char*)lds; F.MISC = (volatile LAS unsigned*)(F.lds + MISC_OFF);
    F.tid = threadIdx.x; F.lane = F.tid & 63; F.wave = __builtin_amdgcn_readfirstlane(F.tid >> 6); F.G = gridDim.x; F.bid = blockIdx.x;
    F.out = a.out; F.ws = a.ws; F.ctl = (gu32*)(a.ws + WS_CTL);
    for (int u = F.tid; u < (LDS_BYTES - LDSCTL_OFF) / 4; u += NTHR) ((LAS unsigned*)(F.lds + LDSCTL_OFF))[u] = 0u;
    __syncthreads();
    XcdBarrier bar; bar.bar = (unsigned*)(F.ctl + CW_BAR); bar.x = 0; bar.st = nullptr;
    const bool multi = (a.ph_hi - a.ph_lo) > 1;
    if (multi) bar = xcd_barrier_post((unsigned*)(F.ctl + CW_BAR), F.MISC + 8);
    for (int st = a.ph_lo; st < a.ph_hi; ++st) {
        { int t_ = threadIdx.x, b_ = blockIdx.x; unsigned char* w_ = a.ws; float* o_ = a.out; asm volatile("" : "+v"(t_), "+s"(b_), "+s"(w_), "+s"(o_));
          F.tid = t_; F.lane = t_ & 63; F.wave = __builtin_amdgcn_readfirstlane(t_ >> 6); F.bid = b_; F.ws = w_; F.out = o_; }
        run_step(F, st);
        if (st + 1 < a.ph_hi) { if (st == a.ph_lo) cooperative_groups::this_grid().sync(); else xcd_barrier(bar); }
    }
}
#ifndef MK_SINGLE
#define MK_SINGLE 1
#endif
extern "C" void kernel_launch(void* const* d_in, const int* in_sizes, int n_in, void* d_out, int out_size, void* d_ws, size_t ws_size, hipStream_t stream) {
    static int grid = 0;
    if (grid == 0) {
        if (n_in != 30 || (size_t)out_size != O_END || ws_size < WS_END3) { fprintf(stderr, "kernel_launch: unexpected shapes: n_in %d out %d ws %zu (need %zu)\n", n_in, out_size, ws_size, (size_t)WS_END3); grid = -1; return; }
        int dev = 0, cus = 0;
        if (hipGetDevice(&dev) != hipSuccess || hipDeviceGetAttribute(&cus, hipDeviceAttributeMultiprocessorCount, dev) != hipSuccess) { grid = -1; return; }
        if (hipFuncSetAttribute((const void*)mk_fwd, hipFuncAttributeMaxDynamicSharedMemorySize, LDS_BYTES) != hipSuccess) { fprintf(stderr, "kernel_launch: hipFuncSetAttribute failed\n"); grid = -1; return; }
        int per_cu = 0;
        if (hipOccupancyMaxActiveBlocksPerMultiprocessor(&per_cu, (const void*)mk_fwd, NTHR, LDS_BYTES) != hipSuccess || per_cu < 1) fprintf(stderr, "kernel_launch: occupancy query says %d\n", per_cu);
        (void)hipGetLastError();
        grid = cus * (per_cu < 1 ? 1 : per_cu);
    }
    if (grid < 0) return;
    (void)hipMemsetAsync((char*)d_ws + WS_CTL, 0, CTL_ZERO_BYTES, stream);
    Args a{};
    for (int i = 0; i < 30; ++i) a.in[i] = (const float*)d_in[i];
    a.out = (float*)d_out; a.ws = (unsigned char*)d_ws;
#if MK_SINGLE
    a.ph_lo = 0; a.ph_hi = NSTEPS;
    void* kargs[] = {(void*)&a};
    hipError_t le = hipLaunchCooperativeKernel((const void*)mk_fwd, dim3(grid), dim3(NTHR), kargs, LDS_BYTES, stream);
    if (le != hipSuccess) fprintf(stderr, "kernel_launch: cooperative launch failed: %s (grid %d)\n", hipGetErrorString(le), grid);
#else
    for (int st = 0; st < NSTEPS; ++st) { a.ph_lo = st; a.ph_hi = st + 1; hipLaunchKernelGGL(mk_fwd, dim3(grid), dim3(NTHR), LDS_BYTES, stream, a); }
#endif
}
```

```cpp
#include <hip/hip_runtime.h>
#include <hip/hip_cooperative_groups.h>
#include <cstdio>
#include <cstdint>

namespace pg8 {
#define PG8_LAS __attribute__((address_space(3)))
typedef unsigned short bf16_t;
typedef short bf16x8 __attribute__((ext_vector_type(8)));
typedef float f32x4 __attribute__((ext_vector_type(4)));
typedef unsigned u32x4 __attribute__((ext_vector_type(4)));
typedef unsigned u32x2 __attribute__((ext_vector_type(2)));
constexpr int BM = 256, BK = 64, HALF = 128, HTB = HALF * BK * 2, STAGE_BYTES = 8 * HTB, NXCD = 8, WGM = 8;

__host__ __device__ __forceinline__ int lds_byte(int r, int c) { const int st = (r >> 4) * 2 + (c >> 5), rr = r & 15, cc = c & 31, ob = rr * 64 + cc * 2; return st * 1024 + (ob ^ (((ob >> 9) & 1) << 5)); }
__host__ __device__ __forceinline__ void stage_rc(int b, int& R, int& C) { const int st = b / 1024, sb = b % 1024, swz = sb ^ (((sb >> 9) & 1) << 5); R = (st >> 1) * 16 + swz / 64; C = (st & 1) * 32 + (swz % 64) / 2; }
__host__ __device__ __forceinline__ int perm32(int rho) { const int n = rho >> 4, i = rho & 15; return 8 * (i >> 2) + 4 * n + (i & 3); }

struct Unit { int pm, pn; };
struct Gemm { const bf16_t* A; const bf16_t* Bt; int M, N, K, ld; };

struct StaticOrder {
    int nM, nN, nwg, G, c;
    __host__ __device__ void init(int M, int N, int G_, int c_) { nM = M / BM; nN = N / BM; nwg = nM * nN; G = G_; c = c_; }
    __host__ __device__ bool next(int i, Unit& u) const {
        const long L = (long)i * G + c; if (L >= nwg) return false;
        int wgid = (int)L; { const int q = nwg / NXCD, r = nwg % NXCD, xcd = wgid % NXCD, off = wgid / NXCD; wgid = (xcd < r ? xcd * (q + 1) : r * (q + 1) + (xcd - r) * q) + off; }
        const int nig = WGM * nN, gid = wgid / nig, fm = gid * WGM, gsz = (nM - fm) < WGM ? (nM - fm) : WGM;
        u.pm = fm + ((wgid % nig) % gsz); u.pn = (wgid % nig) / gsz; return true;
    }
    __device__ __forceinline__ void a_ready(const Unit&) const {}
    __device__ __forceinline__ void done(const Unit&) const {}
};

typedef float f32x2_t __attribute__((ext_vector_type(2))); typedef __bf16 bf16x2_t __attribute__((ext_vector_type(2)));
struct ListOrder {
    int nM, nN, nwg, j0, n, st;
    __host__ __device__ void init(int M, int N, int j0_, int n_, int st_ = 1) { nM = M / BM; nN = N / BM; nwg = nM * nN; j0 = j0_; n = n_; st = st_; }
    __host__ __device__ bool next(int i, Unit& u) const {
        const int L = j0 + i * st; if (i >= n || L < 0 || L >= nwg) return false;
        int wgid = L; { const int q = nwg / NXCD, r = nwg % NXCD, xcd = wgid % NXCD, off = wgid / NXCD; wgid = (xcd < r ? xcd * (q + 1) : r * (q + 1) + (xcd - r) * q) + off; }
        const int nig = WGM * nN, gid = wgid / nig, fm = gid * WGM, gsz = (nM - fm) < WGM ? (nM - fm) : WGM;
        u.pm = fm + ((wgid % nig) % gsz); u.pn = (wgid % nig) / gsz; return true;
    }
    __device__ __forceinline__ void a_ready(const Unit&) const {}
    __device__ __forceinline__ void done(const Unit&) const {}
};
__device__ __forceinline__ unsigned cvt_pk_bf16(float lo, float hi) { f32x2_t v = {lo, hi}; bf16x2_t b = __builtin_convertvector(v, bf16x2_t); return __builtin_bit_cast(unsigned, b); }

template <class Epi, class Sched, bool ALIGN_EPI = false, bool SP2 = false>
__device__ __forceinline__ void gemm_phase(PG8_LAS unsigned char* lds, const Gemm g, const Sched& S, const Epi& E, const int tid) {
    const int wid = __builtin_amdgcn_readfirstlane(tid >> 6), lane = tid & 63, wr = wid >> 2, wc = wid & 3, fr = lane & 15, fq = lane >> 4;
    const int K = g.K, nt = K / BK, LD = g.ld;
    unsigned voffA[2], voffB[2];
#pragma unroll
    for (int i = 0; i < 2; ++i) { int R, C; stage_rc(tid * 16 + i * 8192, R, C); const int Rb = Epi::PERM ? ((R & ~31) + perm32(R & 31)) : R;
        voffA[i] = (unsigned)(R * LD + C) * 2u; voffB[i] = (unsigned)(Rb * LD + C) * 2u; }
    const size_t kstep = (size_t)(BK * 2);
    const size_t hstep = (size_t)HALF * LD * 2;
    const size_t tstep = 2 * hstep;
    const unsigned ldsw = (unsigned)wid * 1024u;
    const int aoff = lds_byte(wr * 64 + fr, fq * 8), boff = lds_byte(wc * 32 + fr, fq * 8);
#define PG8_SA(b, h) (((b) * 2 + (h)) * HTB)
#define PG8_SB(b, h) ((4 + (b) * 2 + (h)) * HTB)
#define PG8_STAGE(bufoff, gbase, voff) do { _Pragma("unroll") for (int _i = 0; _i < 2; ++_i) \
        __builtin_amdgcn_global_load_lds((const unsigned*)((const char*)(gbase) + (voff)[_i]), (PG8_LAS unsigned*)(lds + (bufoff) + ldsw + _i * 8192), 16, 0, 0); } while (0)
#define PG8_LDA(dst, b, h) do { _Pragma("unroll") for (int m = 0; m < 4; ++m) _Pragma("unroll") for (int k = 0; k < 2; ++k) dst[m][k] = *(const PG8_LAS bf16x8*)(lds + PG8_SA(b, h) + aoff + m * 2048 + k * 1024); } while (0)
#define PG8_LDB(dst, b, h) do { _Pragma("unroll") for (int n = 0; n < 2; ++n) _Pragma("unroll") for (int k = 0; k < 2; ++k) dst[n][k] = *(const PG8_LAS bf16x8*)(lds + PG8_SB(b, h) + boff + n * 2048 + k * 1024); } while (0)
#define PG8_MMA(ai, bj, At, Bt) do { __builtin_amdgcn_s_setprio(1); _Pragma("unroll") for (int m = 0; m < 4; ++m) _Pragma("unroll") for (int n = 0; n < 2; ++n) _Pragma("unroll") for (int k = 0; k < 2; ++k) \
        acc[ai][bj][m][n] = __builtin_amdgcn_mfma_f32_16x16x32_bf16(Bt[n][k], At[m][k], acc[ai][bj][m][n], 0, 0, 0); __builtin_amdgcn_s_setprio(0); } while (0)
#define PG8_WAIT_V(n) asm volatile("s_waitcnt vmcnt(" #n ")" ::: "memory")
#define PG8_WAIT_L(n) asm volatile("s_waitcnt lgkmcnt(" #n ")" ::: "memory")
#define PG8_BAR __builtin_amdgcn_s_barrier()
#define PG8_SCHED __builtin_amdgcn_sched_barrier(0)
    Unit cur, nxt; int ui = 0;
    if (!S.next(0, cur)) return;
    f32x4 acc[2][2][4][2];
#pragma unroll
    for (int a = 0; a < 2; ++a)
#pragma unroll
        for (int b = 0; b < 2; ++b)
#pragma unroll
            for (int m = 0; m < 4; ++m)
#pragma unroll
                for (int n = 0; n < 2; ++n) acc[a][b][m][n] = (f32x4){0.f, 0.f, 0.f, 0.f};
    bf16x8 At[4][2], B0[2][2], B1[2][2];
    const char* cA = (const char*)g.A + (size_t)cur.pm * tstep; const char* cB = (const char*)g.Bt + (size_t)cur.pn * tstep;
    S.a_ready(cur);
    if constexpr (SP2) {
        PG8_STAGE(PG8_SB(0, 0), cB, voffB); PG8_STAGE(PG8_SB(0, 1), cB + hstep, voffB); PG8_STAGE(PG8_SA(0, 0), cA, voffA); PG8_STAGE(PG8_SA(0, 1), cA + hstep, voffA);
        if (wr == 1) PG8_BAR;
        PG8_WAIT_V(2); PG8_BAR;
        PG8_STAGE(PG8_SB(1, 0), cB + kstep, voffB); PG8_STAGE(PG8_SA(1, 0), cA + kstep, voffA); PG8_STAGE(PG8_SB(1, 1), cB + hstep + kstep, voffB);
        PG8_WAIT_V(6); PG8_BAR;
    } else {
        PG8_STAGE(PG8_SB(0, 0), cB, voffB); PG8_STAGE(PG8_SA(0, 0), cA, voffA); PG8_STAGE(PG8_SB(0, 1), cB + hstep, voffB); PG8_STAGE(PG8_SA(0, 1), cA + hstep, voffA);
        if (wr == 1) PG8_BAR;
        PG8_WAIT_V(4); PG8_BAR;
        PG8_STAGE(PG8_SB(1, 0), cB + kstep, voffB); PG8_STAGE(PG8_SA(1, 0), cA + kstep, voffA); PG8_STAGE(PG8_SB(1, 1), cB + hstep + kstep, voffB);
        PG8_WAIT_V(6); PG8_BAR;
    }
    for (;;) {
        const bool has_next = S.next(ui + 1, nxt);
        const char* nA = has_next ? (const char*)g.A + (size_t)nxt.pm * tstep : cA; const char* nB = has_next ? (const char*)g.Bt + (size_t)nxt.pn * tstep : cB;
        for (int t = 0; t < nt; t += 2) {
            const bool last = (t == nt - 2);
            const char* a1 = cA + (size_t)(t + 1) * kstep;
            const char* a2 = last ? nA : cA + (size_t)(t + 2) * kstep; const char* b2 = last ? nB : cB + (size_t)(t + 2) * kstep;
            const char* a3 = a2 + kstep; const char* b3 = b2 + kstep;
            if (last && has_next) S.a_ready(nxt);
            if constexpr (SP2) {
            PG8_LDB(B0, 0, 0); PG8_LDB(B1, 0, 1); PG8_SCHED; PG8_LDA(At, 0, 0); PG8_STAGE(PG8_SA(1, 1), a1 + hstep, voffA);
            PG8_WAIT_V(8); PG8_WAIT_L(0); PG8_BAR; PG8_MMA(0, 0, At, B0); PG8_MMA(0, 1, At, B1); PG8_BAR; PG8_SCHED;
            PG8_LDA(At, 0, 1); PG8_STAGE(PG8_SB(0, 0), b2, voffB); PG8_STAGE(PG8_SB(0, 1), b2 + hstep, voffB); PG8_STAGE(PG8_SA(0, 0), a2, voffA);
            PG8_WAIT_V(8); PG8_WAIT_L(0); PG8_BAR; PG8_MMA(1, 0, At, B0); PG8_MMA(1, 1, At, B1); PG8_BAR; PG8_SCHED;
            PG8_LDB(B0, 1, 0); PG8_LDB(B1, 1, 1); PG8_SCHED; PG8_LDA(At, 1, 0); PG8_STAGE(PG8_SA(0, 1), a2 + hstep, voffA);
            PG8_WAIT_V(8); PG8_WAIT_L(0); PG8_BAR; PG8_MMA(0, 0, At, B0); PG8_MMA(0, 1, At, B1); PG8_BAR; PG8_SCHED;
            PG8_LDA(At, 1, 1); PG8_STAGE(PG8_SB(1, 0), b3, voffB); PG8_STAGE(PG8_SB(1, 1), b3 + hstep, voffB); PG8_STAGE(PG8_SA(1, 0), a3, voffA);
            PG8_WAIT_V(8); PG8_WAIT_L(0); PG8_BAR; PG8_MMA(1, 0, At, B0); PG8_MMA(1, 1, At, B1); PG8_BAR; PG8_SCHED;
            } else {
            PG8_LDB(B0, 0, 0); PG8_SCHED; PG8_LDA(At, 0, 0); PG8_STAGE(PG8_SA(1, 1), a1 + hstep, voffA);
            PG8_WAIT_L(8); PG8_BAR; PG8_WAIT_L(0); PG8_MMA(0, 0, At, B0); PG8_BAR; PG8_SCHED;
            PG8_LDB(B1, 0, 1); PG8_STAGE(PG8_SB(0, 0), b2, voffB);
            PG8_BAR; PG8_WAIT_L(0); PG8_MMA(0, 1, At, B1); PG8_BAR;
            PG8_LDA(At, 0, 1); PG8_STAGE(PG8_SA(0, 0), a2, voffA);
            PG8_BAR; PG8_WAIT_L(0); PG8_MMA(1, 0, At, B0); PG8_BAR; PG8_SCHED;
            PG8_STAGE(PG8_SB(0, 1), b2 + hstep, voffB);
            PG8_WAIT_V(6); PG8_BAR; PG8_MMA(1, 1, At, B1); PG8_BAR;
            PG8_LDB(B0, 1, 0); PG8_SCHED; PG8_LDA(At, 1, 0); PG8_STAGE(PG8_SA(0, 1), a2 + hstep, voffA);
            PG8_WAIT_L(8); PG8_BAR; PG8_WAIT_L(0); PG8_MMA(0, 0, At, B0); PG8_BAR; PG8_SCHED;
            PG8_LDB(B1, 1, 1); PG8_STAGE(PG8_SB(1, 0), b3, voffB);
            PG8_BAR; PG8_WAIT_L(0); PG8_MMA(0, 1, At, B1); PG8_BAR;
            PG8_LDA(At, 1, 1); PG8_STAGE(PG8_SA(1, 0), a3, voffA);
            PG8_BAR; PG8_WAIT_L(0); PG8_MMA(1, 0, At, B0); PG8_BAR; PG8_SCHED;
            PG8_STAGE(PG8_SB(1, 1), b3 + hstep, voffB);
            PG8_WAIT_V(6); PG8_BAR; PG8_MMA(1, 1, At, B1); PG8_BAR;
            }
        }
        if constexpr (ALIGN_EPI) { if (wr == 0) PG8_BAR; }
        E(acc, cur, wr, wc, fr, fq); S.done(cur);
        if (!has_next) break;
#pragma unroll
        for (int a = 0; a < 2; ++a)
#pragma unroll
            for (int b = 0; b < 2; ++b)
#pragma unroll
                for (int m = 0; m < 4; ++m)
#pragma unroll
                    for (int n = 0; n < 2; ++n) acc[a][b][m][n] = (f32x4){0.f, 0.f, 0.f, 0.f};
        cur = nxt; cA = nA; cB = nB; ++ui;
        if constexpr (ALIGN_EPI) { if (wr == 1) PG8_BAR; }
    }
    PG8_WAIT_V(0);
    if constexpr (!ALIGN_EPI) { if (wr == 0) PG8_BAR; }
    PG8_BAR;
#undef PG8_SA
#undef PG8_SB
#undef PG8_STAGE
#undef PG8_LDA
#undef PG8_LDB
#undef PG8_MMA
#undef PG8_WAIT_V
#undef PG8_WAIT_L
#undef PG8_BAR
#undef PG8_SCHED
}
}
constexpr int D = 1024, NB = 4, SEQ = 8192, DB = 8, DSEQ = 64, NMB = NB + DB;
constexpr int GH = 8, GDK = 128, GDV = 128;
constexpr int SH = 32, SP = 64, SN = 128, SG = 8;
constexpr int DFF = 2816, CONV_CH = 7168, IN_COLS = 12336;
constexpr int NPROJ = 12288;
constexpr int NIN = 12544;
constexpr int NUP = 2 * DFF;
constexpr float EPS = 1e-6f;
#ifndef SLAB_T
#define SLAB_T 512
#endif
constexpr int NSLAB = SEQ / SLAB_T, RP = NB * SLAB_T, RS = DB * DSEQ, RMAX = RP + RS;
constexpr size_t O_YP = 0, O_YS = O_YP + (size_t)NB * SEQ * D, O_CMP = O_YS + (size_t)DB * DSEQ * D, O_GP = O_CMP + (size_t)NB * 3 * CONV_CH,
                 O_SP = O_GP + (size_t)NB * GH * GDK * GDV, O_CFP = O_SP + (size_t)NB * SH * SN * SP, O_CMS = O_CFP + (size_t)NB * 2 * NUP,
                 O_GS = O_CMS + (size_t)DB * 3 * CONV_CH, O_SS = O_GS + (size_t)DB * GH * GDK * GDV, O_CFS = O_SS + (size_t)DB * SH * SN * SP,
                 O_END = O_CFS + (size_t)DB * 2 * NUP;
constexpr size_t MiB = 1u << 20;
constexpr size_t WS_CTL = 0, CTL_ZERO_BYTES = 1 * MiB;
constexpr size_t WS_MODV = 1 * MiB;
constexpr size_t WS_G1 = WS_MODV + 512 * 1024;
constexpr size_t WS_G2 = WS_G1 + 64 * 1024;
constexpr size_t WS_SHW = WS_G2 + 64 * 1024;
constexpr size_t WS_CARRY_MIX = 2 * MiB;
constexpr size_t WS_CARRY_FFN = 3 * MiB;
constexpr size_t WS_WIN = 4 * MiB;
constexpr size_t WS_WG = WS_WIN + (size_t)NIN * D * 2;
constexpr size_t WS_WS = WS_WG + (size_t)D * D * 2;
constexpr size_t WS_WOUT = WS_WS + (size_t)D * 2048 * 2;
constexpr size_t WS_WUP = WS_WOUT + (size_t)D * D * 2;
constexpr size_t WS_WDN = WS_WUP + (size_t)NUP * D * 2;
constexpr size_t WS_SLAB = 56 * MiB;
static_assert(WS_WDN + (size_t)D * DFF * 2 <= WS_SLAB, "weights fit");
constexpr int NXC = 7168, NZG = 3072, NGT = 2048, NCH = SLAB_T / 64;
constexpr int GI_STRIDE_C = 62464 + 32768 + 256, SI_STRIDE_C = 47104 + 32768, GDN_ITEMS = NCH * NB * GH + DB * GH, SSD_ITEMS = NCH * NB * SG + DB * SG;
constexpr size_t SZ_HB = (size_t)RMAX * D * 2, SZ_XC = (size_t)RMAX * NXC * 2, SZ_ZG = (size_t)RMAX * NZG * 2, SZ_GT = (size_t)RMAX * NGT * 2, SZ_SM = (size_t)RMAX * 64 * 4, SZ_OG = (size_t)RMAX * D * 2,
                 SZ_YS = (size_t)RMAX * 2048 * 2, SZ_T1 = (size_t)RMAX * D * 4, SZ_MIX = (size_t)RMAX * D * 2, SZ_X1G = (size_t)RMAX * D * 2, SZ_SS = (size_t)RMAX * 16 * 4,
                 SZ_U = (size_t)RMAX * NUP * 2, SZ_ACT = (size_t)RMAX * DFF * 2, SZ_GIMG = (size_t)GDN_ITEMS * GI_STRIDE_C, SZ_SIMG = (size_t)SSD_ITEMS * SI_STRIDE_C, SZ_PD = (size_t)RMAX * D * 4;
constexpr int G_HB = 2, G_XC = 2, G_ZG = 3, G_GT = 4, G_SM = 2, G_OG = 2, G_YS = 2, G_T1 = 1, G_MIX = 2, G_X1G = 2, G_SS = 2, G_U = 2, G_ACT = 2, G_IMG = 2, G_PD = 2;
constexpr size_t WS_HB = WS_SLAB, WS_XC = WS_HB + G_HB * SZ_HB, WS_ZG = WS_XC + G_XC * SZ_XC, WS_GT = WS_ZG + G_ZG * SZ_ZG, WS_SM = WS_GT + G_GT * SZ_GT, WS_OG = WS_SM + G_SM * SZ_SM,
                 WS_YS = WS_OG + G_OG * SZ_OG, WS_T1 = WS_YS + G_YS * SZ_YS, WS_MIX = WS_T1 + G_T1 * SZ_T1, WS_X1G = WS_MIX + G_MIX * SZ_MIX, WS_SS1 = WS_X1G + G_X1G * SZ_X1G,
                 WS_SS2 = WS_SS1 + G_SS * SZ_SS, WS_U = WS_SS2 + G_SS * SZ_SS, WS_ACT = WS_U + G_U * SZ_U, WS_GDN = WS_ACT + G_ACT * SZ_ACT, WS_SSD = WS_GDN + G_IMG * SZ_GIMG,
                 WS_PD = WS_SSD + G_IMG * SZ_SIMG, WS_END = WS_PD + G_PD * SZ_PD;
static_assert(WS_END <= 512 * MiB, "workspace map fits");
#define GENP(ws, base, sz, n, s) ((ws) + (base) + (size_t)((s) % (n)) * (sz))
constexpr int LDS_BYTES = 147456, LDSCTL_OFF = LDS_BYTES - 512, MISC_OFF = LDSCTL_OFF + 320, RING_BYTES = LDSCTL_OFF;
constexpr int NWAVES = 8, NTHR = 512;

#define GAS __attribute__((address_space(1)))
#define LAS __attribute__((address_space(3)))
typedef unsigned short bf16;
typedef unsigned v4u __attribute__((ext_vector_type(4)));
typedef unsigned v2u __attribute__((ext_vector_type(2)));
typedef float f32x4 __attribute__((ext_vector_type(4)));
typedef GAS unsigned gu32;
#define RLX_AGENT __ATOMIC_RELAXED, __HIP_MEMORY_SCOPE_AGENT
#define LDS_WAIT() asm volatile("s_waitcnt lgkmcnt(0)" ::: "memory")
#define VM_WAIT() asm volatile("s_waitcnt vmcnt(0)" ::: "memory")
__device__ __forceinline__ unsigned pk2(float lo, float hi) { return pg8::cvt_pk_bf16(lo, hi); }
__device__ __forceinline__ unsigned f2bf(float f) { return pk2(f, f) & 0xffffu; }
__device__ __forceinline__ float bf2f(unsigned short h) { return __builtin_bit_cast(float, (unsigned)h << 16); }
__device__ __forceinline__ float bflo(unsigned w) { return __builtin_bit_cast(float, w << 16); }
__device__ __forceinline__ float bfhi(unsigned w) { return __builtin_bit_cast(float, w & 0xffff0000u); }
__device__ __forceinline__ float sigmoidf_(float x) { return __builtin_amdgcn_rcpf(1.f + __expf(-x)); }
__device__ __forceinline__ float siluf_(float x) { return x * __builtin_amdgcn_rcpf(1.f + __expf(-x)); }
__device__ __forceinline__ float softplusf_(float x) { const float e = __expf(-fabsf(x)), u = 1.f + e, d = u - 1.f; const float l = (d == 0.f) ? e : __logf(u) * (e * __builtin_amdgcn_rcpf(d)); return fmaxf(x, 0.f) + l; }
__device__ __forceinline__ float wave_sum(float v) {
#pragma unroll
    for (int o = 1; o < 64; o <<= 1) v += __shfl_xor(v, o);
    return v;
}

#ifndef PROF_SEL
#define PROF_SEL 0
#endif
#ifndef PROF_MULT
#define PROF_MULT 10
#endif
#define PROF_BEGIN(id) unsigned long long prof_t0_##id = 0; if (PROF_SEL == (id)) prof_t0_##id = __builtin_amdgcn_s_memrealtime()
#define PROF_END(id) do { if (PROF_SEL == (id)) F.prof += __builtin_amdgcn_s_memrealtime() - prof_t0_##id; } while (0)
struct Args { const float* in[30]; float* out; unsigned char* ws; int ph_lo, ph_hi; };

struct Frame {
    LAS unsigned char* lds;
    volatile LAS unsigned* MISC;
    gu32* ctl;
    int tid, lane, wave, G, bid;
    const Args& A;
    float* out; unsigned char* ws;
    unsigned long long prof;
    __device__ __forceinline__ Frame(const Args& a) : A(a) {}
};
__device__ __forceinline__ int row_mb(int r) { return r < RP ? (r / SLAB_T) : NB + ((r - RP) / DSEQ); }
__device__ __forceinline__ size_t row_goff(int s, int r) {
    if (r < RP) { const int b = r / SLAB_T, tl = r % SLAB_T; return ((size_t)b * SEQ + (size_t)s * SLAB_T + tl) * D; }
    return (size_t)(r - RP) * D;
}
#ifndef DSLAB
#define DSLAB (NSLAB - 1)
#endif
__device__ __forceinline__ int slab_rows(int s) { return s == DSLAB ? RMAX : RP; }
struct MapWin { __device__ __forceinline__ int operator()(int n) const { return n < 10240 ? n : (n < 12288 ? n + 48 : (n < 12336 ? n - 2048 : -1)); } };
struct MapId  { __device__ __forceinline__ int operator()(int n) const { return n; } };
struct MapUp  { __device__ __forceinline__ int operator()(int n) const { const int j = n >> 8, c = n & 255; return c < 128 ? 128 * j + c : DFF + 128 * j + (c - 128); } };
template <class Map>
__device__ __forceinline__ void p0_transpose_item(const float* W, int ldw, int K, bf16* WT, Map map, LAS float* scr, int item, int nblk, int lane) {
    const int kb = item / nblk, nb = item % nblk, k0 = 64 * kb, n0 = 32 * nb;
    const int sc = map(n0 + (lane & 31));
    float v[32];
    const float* wp = W + (size_t)(k0 + (lane >> 5)) * ldw + (sc >= 0 ? sc : 0);
#pragma unroll
    for (int i = 0; i < 32; ++i) v[i] = wp[(size_t)(2 * i) * ldw];
#pragma unroll
    for (int i = 0; i < 32; ++i) scr[(2 * i + (lane >> 5)) * 33 + (lane & 31)] = sc >= 0 ? v[i] : 0.f;
    LDS_WAIT(); asm volatile("" ::: "memory");
    const int c = lane & 7;
#pragma unroll
    for (int j = 0; j < 4; ++j) { const int n = (lane >> 3) + 8 * j; const LAS float* s = scr + (8 * c) * 33 + n;
        v4u o; o.x = pk2(s[0 * 33], s[1 * 33]); o.y = pk2(s[2 * 33], s[3 * 33]); o.z = pk2(s[4 * 33], s[5 * 33]); o.w = pk2(s[6 * 33], s[7 * 33]);
        *(GAS v4u*)(WT + (size_t)(n0 + n) * K + k0 + 8 * c) = o; }
    LDS_WAIT(); asm volatile("" ::: "memory");
}
__device__ __forceinline__ void p0_mod_item(Frame& F, int item) {
    LAS float* sc = (LAS float*)F.lds; LAS float* red = (LAS float*)(F.lds + 49152);
    const float* cp = F.A.in[6]; const float* cs = F.A.in[7]; const float* w_ada = F.A.in[8]; const float* b_ada = F.A.in[9];
    for (int idx = F.tid; idx < NMB * D; idx += NTHR) { const int b = idx / D, k = idx % D; const float c = b < NB ? cp[b * D + k] : cs[(b - NB) * D + k]; sc[idx] = siluf_(c); }
    __syncthreads();
    float acc[NMB];
#pragma unroll
    for (int b = 0; b < NMB; ++b) acc[b] = 0.f;
    const int col = item * 64 + F.lane, kb = F.wave * 128;
#pragma unroll 1
    for (int k8 = 0; k8 < 128; k8 += 16) { float wv[16];
#pragma unroll
        for (int k = 0; k < 16; ++k) wv[k] = w_ada[(size_t)(kb + k8 + k) * 6144 + col];
#pragma unroll
        for (int k = 0; k < 16; ++k) {
#pragma unroll
            for (int b = 0; b < NMB; ++b) acc[b] += sc[b * D + kb + k8 + k] * wv[k]; } }
#pragma unroll
    for (int b = 0; b < NMB; ++b) red[(F.wave * NMB + b) * 64 + F.lane] = acc[b];
    __syncthreads();
    float* modv = (float*)(F.ws + WS_MODV);
    for (int idx = F.tid; idx < NMB * 64; idx += NTHR) { const int b = idx / 64, l = idx % 64; float s = b_ada[item * 64 + l];
#pragma unroll
        for (int w = 0; w < 8; ++w) s += red[(w * NMB + b) * 64 + l];
        modv[b * 6144 + item * 64 + l] = s; }
    __syncthreads();
}
constexpr int P0_I_IN = (D / 64) * (NIN / 32), P0_I_G = (D / 64) * (D / 32), P0_I_S = (2048 / 64) * (D / 32), P0_I_O = P0_I_G, P0_I_UP = (D / 64) * (NUP / 32), P0_I_DN = (DFF / 64) * (D / 32);
constexpr int P0_NITEMS = P0_I_IN + P0_I_G + P0_I_S + P0_I_O + P0_I_UP + P0_I_DN;
__device__ __forceinline__ void p0_item(Frame& F, LAS float* scr, int it) {
    int r = it;
    if (r < P0_I_IN) { p0_transpose_item(F.A.in[11], IN_COLS, D, (bf16*)(F.ws + WS_WIN), MapWin(), scr, r, NIN / 32, F.lane); return; } r -= P0_I_IN;
    if (r < P0_I_G) { p0_transpose_item(F.A.in[21], D, D, (bf16*)(F.ws + WS_WG), MapId(), scr, r, D / 32, F.lane); return; } r -= P0_I_G;
    if (r < P0_I_S) { p0_transpose_item(F.A.in[22], D, 2048, (bf16*)(F.ws + WS_WS), MapId(), scr, r, D / 32, F.lane); return; } r -= P0_I_S;
    if (r < P0_I_O) { p0_transpose_item(F.A.in[23], D, D, (bf16*)(F.ws + WS_WOUT), MapId(), scr, r, D / 32, F.lane); return; } r -= P0_I_O;
    if (r < P0_I_UP) { p0_transpose_item(F.A.in[25], NUP, D, (bf16*)(F.ws + WS_WUP), MapUp(), scr, r, NUP / 32, F.lane); return; } r -= P0_I_UP;
    p0_transpose_item(F.A.in[28], D, DFF, (bf16*)(F.ws + WS_WDN), MapId(), scr, r, D / 32, F.lane);
}
__device__ __forceinline__ void phase_prologue0(Frame& F) {
    for (int it = F.bid; it < 96; it += F.G) p0_mod_item(F, it);
    LAS float* scr = (LAS float*)(F.lds + F.wave * 16384);
    const int gw = F.bid * NWAVES + F.wave, NGW = F.G * NWAVES;
#pragma unroll 1
    for (int it = gw; it < P0_I_IN; it += NGW) p0_item(F, scr, it);
}
__device__ __forceinline__ void phase_convert_rest(Frame& F, int part, int nparts) {
    LAS float* scr = (LAS float*)(F.lds + F.wave * 16384);
    const int gw = part * NWAVES + F.wave, NGW = nparts * NWAVES;
#pragma unroll 1
    for (int it = P0_I_IN + gw; it < P0_NITEMS; it += NGW) p0_item(F, scr, it);
    __syncthreads();
}
__device__ __forceinline__ void phase_prologue1(Frame& F, int part, int nparts) {
    const float* modv = (const float*)(F.ws + WS_MODV);
    float* g1 = (float*)(F.ws + WS_G1); float* g2 = (float*)(F.ws + WS_G2); float* shw = (float*)(F.ws + WS_SHW);
    for (int idx = part * NTHR + F.tid; idx < NMB * D; idx += nparts * NTHR) { const int b = idx / D, k = idx % D;
        g1[idx] = F.A.in[10][k] * (1.f + modv[b * 6144 + 1024 + k]); g2[idx] = F.A.in[24][k] * (1.f + modv[b * 6144 + 4096 + k]); }
    LAS float* sh = (LAS float*)F.lds;
    for (int idx = F.tid; idx < NMB * D; idx += NTHR) sh[idx] = modv[(idx / D) * 6144 + 3072 + (idx % D)];
    __syncthreads();
    const bf16* wup = (const bf16*)(F.ws + WS_WUP);
    const int gw = part * NWAVES + F.wave, NGW = nparts * NWAVES;
    for (int n = gw; n < NUP; n += NGW) {
        const GAS v4u* wr = (const GAS v4u*)(wup + (size_t)n * D + F.lane * 16);
        const v4u w0 = wr[0], w1 = wr[1];
        float wf[16] = {bflo(w0.x), bfhi(w0.x), bflo(w0.y), bfhi(w0.y), bflo(w0.z), bfhi(w0.z), bflo(w0.w), bfhi(w0.w), bflo(w1.x), bfhi(w1.x), bflo(w1.y), bfhi(w1.y), bflo(w1.z), bfhi(w1.z), bflo(w1.w), bfhi(w1.w)};
        float res = 0.f;
#pragma unroll 1
        for (int b = 0; b < NMB; ++b) { float a = 0.f;
#pragma unroll
            for (int i = 0; i < 16; ++i) a += wf[i] * sh[b * D + F.lane * 16 + i];
            a = wave_sum(a); if (F.lane == b) res = a; }
        if (F.lane < NMB) shw[F.lane * NUP + n] = res;
    }
    __syncthreads();
}
__device__ __forceinline__ void phase_norm1(Frame& F, int s, int part, int nparts) {
    const float* modv = (const float*)(F.ws + WS_MODV); bf16* hb = (bf16*)GENP(F.ws, WS_HB, SZ_HB, G_HB, s);
    const int gw = part * NWAVES + F.wave, NGW = nparts * NWAVES, R = slab_rows(s);
    for (int r = gw; r < R; r += 2 * NGW) {
        const int r2 = r + NGW < R ? r + NGW : r;
        const GAS f32x4* xa = (const GAS f32x4*)((r < RP ? F.A.in[0] : F.A.in[1]) + row_goff(s, r)) + F.lane;
        const GAS f32x4* xb = (const GAS f32x4*)((r2 < RP ? F.A.in[0] : F.A.in[1]) + row_goff(s, r2)) + F.lane;
        f32x4 va[4], vb[4]; float sa = 0.f, sb = 0.f;
#pragma unroll
        for (int j = 0; j < 4; ++j) { va[j] = xa[64 * j]; vb[j] = xb[64 * j]; }
#pragma unroll
        for (int j = 0; j < 4; ++j) { sa += (va[j].x * va[j].x + va[j].y * va[j].y) + (va[j].z * va[j].z + va[j].w * va[j].w); sb += (vb[j].x * vb[j].x + vb[j].y * vb[j].y) + (vb[j].z * vb[j].z + vb[j].w * vb[j].w); }
        const float ra = rsqrtf(wave_sum(sa) * (1.f / D) + EPS), rb = rsqrtf(wave_sum(sb) * (1.f / D) + EPS);
#pragma unroll
        for (int q = 0; q < 2; ++q) { if (q == 1 && r2 == r) break; const int rr = q ? r2 : r; const int mb = row_mb(rr); const float rs = q ? rb : ra;
            GAS v2u* o8 = (GAS v2u*)(hb + (size_t)rr * D) + F.lane;
#pragma unroll
            for (int j = 0; j < 4; ++j) { const int k = 4 * F.lane + 256 * j; const f32x4 v = q ? vb[j] : va[j];
                const f32x4 g = *(const GAS f32x4*)(F.A.in[10] + k) * (*(const GAS f32x4*)(modv + mb * 6144 + 1024 + k) + 1.f); const f32x4 sh = *(const GAS f32x4*)(modv + mb * 6144 + k);
                v2u o; o.x = pk2(v.x * rs * g.x + sh.x, v.y * rs * g.y + sh.y); o.y = pk2(v.z * rs * g.z + sh.z, v.w * rs * g.w + sh.w); o8[64 * j] = o; } }
    }
}
__device__ __forceinline__ void phase_final(Frame& F, int s, int part, int nparts) {
    const float* wf = F.A.in[29]; const float* modv = (const float*)(F.ws + WS_MODV); const float* PD = (const float*)GENP(F.ws, WS_PD, SZ_PD, G_PD, s);
    const int gw = part * NWAVES + F.wave, NGW = nparts * NWAVES, R = slab_rows(s);
    for (int r = gw; r < R; r += NGW) {
        float* yrow = F.out + (r < RP ? O_YP : O_YS) + row_goff(s, r); const int mb = row_mb(r);
        GAS f32x4* yr = (GAS f32x4*)yrow + F.lane; const GAS f32x4* pr = (const GAS f32x4*)(PD + (size_t)r * D) + F.lane; const GAS f32x4* gr = (const GAS f32x4*)(modv + mb * 6144 + 5120) + F.lane;
        f32x4 v[4]; float ss = 0.f;
#pragma unroll
        for (int j = 0; j < 4; ++j) { v[j] = yr[64 * j] + gr[64 * j] * pr[64 * j]; ss += (v[j].x * v[j].x + v[j].y * v[j].y) + (v[j].z * v[j].z + v[j].w * v[j].w); }
        const float rs = rsqrtf(wave_sum(ss) * (1.f / D) + EPS);
#pragma unroll
        for (int j = 0; j < 4; ++j) { const f32x4 w = *(const GAS f32x4*)(wf + 4 * F.lane + 256 * j); f32x4 o = v[j]; o.x *= rs * w.x; o.y *= rs * w.y; o.z *= rs * w.z; o.w *= rs * w.w; yr[64 * j] = o; }
    }
}
__device__ __forceinline__ void u_hist_row(Frame& F, int s, int r, int back, int c8, int j, int cc, float (&ua)[8], float (&uv)[8]) {
    const bf16* U = (const bf16*)GENP(F.ws, WS_U, SZ_U, G_U, s);
    int tl, b; bool samp = r >= RP;
    if (!samp) { b = r / SLAB_T; tl = r % SLAB_T; } else { b = (r - RP) / DSEQ; tl = (r - RP) % DSEQ; }
    if (tl - back >= 0) {
        const bf16* p = U + (size_t)(r - back) * NUP + 256 * j + cc;
        const v4u a = *(const GAS v4u*)p, v = *(const GAS v4u*)(p + 128);
        ua[0] = bflo(a.x); ua[1] = bfhi(a.x); ua[2] = bflo(a.y); ua[3] = bfhi(a.y); ua[4] = bflo(a.z); ua[5] = bfhi(a.z); ua[6] = bflo(a.w); ua[7] = bfhi(a.w);
        uv[0] = bflo(v.x); uv[1] = bfhi(v.x); uv[2] = bflo(v.y); uv[3] = bfhi(v.y); uv[4] = bflo(v.z); uv[5] = bfhi(v.z); uv[6] = bflo(v.w); uv[7] = bfhi(v.w);
        return;
    }
    const int hi = 2 + (tl - back);
    if (samp) { const float* st = F.A.in[5] + ((size_t)b * 2 + hi) * NUP;
#pragma unroll
        for (int i = 0; i < 8; ++i) { ua[i] = st[c8 + i]; uv[i] = st[DFF + c8 + i]; } return; }
    if (s == 0) {
#pragma unroll
        for (int i = 0; i < 8; ++i) { ua[i] = 0.f; uv[i] = 0.f; } return; }
    const float* cf = (const float*)(F.ws + WS_CARRY_FFN) + (((size_t)(s & 1) * NB + b) * 2 + hi) * NUP + 256 * j + cc;
#pragma unroll
    for (int i = 0; i < 8; ++i) { ua[i] = cf[i]; uv[i] = cf[128 + i]; }
}
__device__ __forceinline__ void phase_convact(Frame& F, int s, int part, int nparts) {
    const bf16* U = (const bf16*)GENP(F.ws, WS_U, SZ_U, G_U, s); bf16* ACT = (bf16*)GENP(F.ws, WS_ACT, SZ_ACT, G_ACT, s);
    const float* wc = F.A.in[26]; const float* bc = F.A.in[27];
    constexpr int rpp = 8; const int r0 = part * rpp;
    if (F.tid < DFF / 8) {
        const int c8 = F.tid * 8, j = c8 >> 7, cc = c8 & 127;
        float wa0[8], wa1[8], wa2[8], wv0[8], wv1[8], wv2[8], ba[8], bv[8];
#define LD8(dst, p) do { const f32x4 t0_ = *(const GAS f32x4*)(p), t1_ = *(const GAS f32x4*)((p) + 4); dst[0] = t0_.x; dst[1] = t0_.y; dst[2] = t0_.z; dst[3] = t0_.w; dst[4] = t1_.x; dst[5] = t1_.y; dst[6] = t1_.z; dst[7] = t1_.w; } while (0)
        LD8(wa0, wc + c8); LD8(wa1, wc + NUP + c8); LD8(wa2, wc + 2 * NUP + c8); LD8(wv0, wc + DFF + c8); LD8(wv1, wc + NUP + DFF + c8); LD8(wv2, wc + 2 * NUP + DFF + c8); LD8(ba, bc + c8); LD8(bv, bc + DFF + c8);
#undef LD8
        float a0[8], v0[8], a1[8], v1[8];
        v4u axr[rpp], vxr[rpp];
#pragma unroll
        for (int q = 0; q < rpp; ++q) { const bf16* p = U + (size_t)(r0 + q) * NUP + 256 * j + cc; axr[q] = *(const GAS v4u*)p; vxr[q] = *(const GAS v4u*)(p + 128); }
        u_hist_row(F, s, r0, 2, c8, j, cc, a0, v0); u_hist_row(F, s, r0, 1, c8, j, cc, a1, v1);
#pragma unroll
        for (int q = 0; q < rpp; ++q) {
            const v4u ax = axr[q], vx = vxr[q];
            const float a2[8] = {bflo(ax.x), bfhi(ax.x), bflo(ax.y), bfhi(ax.y), bflo(ax.z), bfhi(ax.z), bflo(ax.w), bfhi(ax.w)};
            const float v2[8] = {bflo(vx.x), bfhi(vx.x), bflo(vx.y), bfhi(vx.y), bflo(vx.z), bfhi(vx.z), bflo(vx.w), bfhi(vx.w)};
            float o[8];
#pragma unroll
            for (int i = 0; i < 8; ++i) { const float xa = ba[i] + wa0[i] * a0[i] + wa1[i] * a1[i] + wa2[i] * a2[i];
                const float xv = bv[i] + wv0[i] * v0[i] + wv1[i] * v1[i] + wv2[i] * v2[i];
                o[i] = siluf_(xa) * xv; a0[i] = a1[i]; v0[i] = v1[i]; a1[i] = a2[i]; v1[i] = v2[i]; }
            v4u w; w.x = pk2(o[0], o[1]); w.y = pk2(o[2], o[3]); w.z = pk2(o[4], o[5]); w.w = pk2(o[6], o[7]);
            *(GAS v4u*)(ACT + (size_t)(r0 + q) * DFF + c8) = w;
        }
    }
    float* cfn = (float*)(F.ws + WS_CARRY_FFN) + (size_t)((s + 1) & 1) * NB * 2 * NUP;
    for (int idx = part * NTHR + F.tid; idx < NB * 2 * NUP; idx += nparts * NTHR) {
        const int b = idx / (2 * NUP), i = (idx / NUP) % 2, c = idx % NUP; const int r = b * SLAB_T + SLAB_T - 2 + i;
        const float v = bf2f(U[(size_t)r * NUP + c]); cfn[idx] = v;
        if (s == NSLAB - 1) { const int j = c >> 8, cc = c & 255; const int oc = cc < 128 ? 128 * j + cc : DFF + 128 * j + (cc - 128); F.out[O_CFP + ((size_t)b * 2 + i) * NUP + oc] = v; }
    }
    if (s == DSLAB) for (int idx = part * NTHR + F.tid; idx < DB * 2 * NUP; idx += nparts * NTHR) {
        const int b = idx / (2 * NUP), i = (idx / NUP) % 2, c = idx % NUP; const int r = RP + b * DSEQ + DSEQ - 2 + i;
        const int j = c >> 8, cc = c & 255; const int oc = cc < 128 ? 128 * j + cc : DFF + 128 * j + (cc - 128);
        F.out[O_CFS + ((size_t)b * 2 + i) * NUP + oc] = bf2f(U[(size_t)r * NUP + c]);
    }
}
__device__ __forceinline__ void phase_mix_carry(Frame& F, int s, int part, int nparts) {
    const bf16* P = (const bf16*)GENP(F.ws, WS_XC, SZ_XC, G_XC, s);
    float* cmn = (float*)(F.ws + WS_CARRY_MIX) + (size_t)((s + 1) & 1) * NB * 3 * CONV_CH;
    for (int idx = part * NTHR + F.tid; idx < NB * 3 * CONV_CH; idx += nparts * NTHR) {
        const int b = idx / (3 * CONV_CH), i = (idx / CONV_CH) % 3, c = idx % CONV_CH; const int r = b * SLAB_T + SLAB_T - 3 + i;
        const float v = bf2f(P[(size_t)r * NXC + c]); cmn[idx] = v;
        if (s == NSLAB - 1) F.out[O_CMP + idx] = v;
    }
    if (s == DSLAB) for (int idx = part * NTHR + F.tid; idx < DB * 3 * CONV_CH; idx += nparts * NTHR) {
        const int b = idx / (3 * CONV_CH), i = (idx / CONV_CH) % 3, c = idx % CONV_CH; const int r = RP + b * DSEQ + DSEQ - 3 + i;
        F.out[O_CMS + idx] = bf2f(P[(size_t)r * NXC + c]);
    }
}
namespace epi {
using pg8::f32x4; using pg8::Unit; using pg8::BM; using pg8::HALF; using pg8::cvt_pk_bf16; using pg8::u32x4; using pg8::u32x2;
struct EpiProj {
    static constexpr bool PERM = true;
    bf16* XC; bf16* ZG; bf16* GT; float* SM;
    __device__ __forceinline__ void operator()(const f32x4 (&acc)[2][2][4][2], const Unit& u, int wr, int wc, int fr, int fq) const {
        const int row0 = u.pm * BM + wr * 64 + fr;
        if (u.pn == 48) {
            if (wc < 2) {
#pragma unroll
                for (int ai = 0; ai < 2; ++ai)
#pragma unroll
                    for (int m = 0; m < 4; ++m) { float* rp = SM + (size_t)(row0 + ai * HALF + m * 16) * 64 + wc * 32 + 8 * fq;
                        *(f32x4*)rp = acc[ai][0][m][0]; *(f32x4*)(rp + 4) = acc[ai][0][m][1]; }
            }
            return;
        }
        const bool sg = u.pn >= 40;
        bf16* base; int ld, col0;
        if (u.pn < 28) { base = XC; ld = NXC; col0 = u.pn * BM; } else if (u.pn < 40) { base = ZG; ld = NZG; col0 = (u.pn - 28) * BM; } else { base = GT; ld = NGT; col0 = (u.pn - 40) * BM; }
        col0 += wc * 32 + 8 * fq;
#pragma unroll
        for (int ai = 0; ai < 2; ++ai)
#pragma unroll
            for (int m = 0; m < 4; ++m) { bf16* rowp = base + (size_t)(row0 + ai * HALF + m * 16) * ld + col0;
#pragma unroll
                for (int bj = 0; bj < 2; ++bj) { f32x4 v0 = acc[ai][bj][m][0], v1 = acc[ai][bj][m][1];
                    if (sg) {
#pragma unroll
                        for (int i = 0; i < 4; ++i) { v0[i] = sigmoidf_(v0[i]); v1[i] = sigmoidf_(v1[i]); } }
                    u32x4 w; w.x = cvt_pk_bf16(v0[0], v0[1]); w.y = cvt_pk_bf16(v0[2], v0[3]); w.z = cvt_pk_bf16(v1[0], v1[1]); w.w = cvt_pk_bf16(v1[2], v1[3]);
                    *(u32x4*)(rowp + bj * HALF) = w; } }
    }
};
struct EpiGate1 {
    static constexpr bool PERM = false;
    const bf16* P; float* T1;
    __device__ __forceinline__ void operator()(const f32x4 (&acc)[2][2][4][2], const Unit& u, int wr, int wc, int fr, int fq) const {
        const int row0 = u.pm * BM + wr * 64 + fr, col0 = u.pn * BM + wc * 32 + 4 * fq;
        u32x2 g0[4][2][2], g1[4][2][2];
#pragma unroll
        for (int m = 0; m < 4; ++m)
#pragma unroll
            for (int bj = 0; bj < 2; ++bj)
#pragma unroll
                for (int n = 0; n < 2; ++n) g0[m][bj][n] = *(const u32x2*)(P + (size_t)(row0 + m * 16) * NGT + col0 + bj * HALF + n * 16);
#pragma unroll
        for (int m = 0; m < 4; ++m)
#pragma unroll
            for (int bj = 0; bj < 2; ++bj)
#pragma unroll
                for (int n = 0; n < 2; ++n) g1[m][bj][n] = *(const u32x2*)(P + (size_t)(row0 + HALF + m * 16) * NGT + col0 + bj * HALF + n * 16);
#pragma unroll
        for (int q = 0; q < 8; ++q) { const int ai = q >> 2, m = q & 3; const size_t r = (size_t)(row0 + ai * HALF + m * 16);
#pragma unroll
            for (int bj = 0; bj < 2; ++bj)
#pragma unroll
                for (int n = 0; n < 2; ++n) { const int c = col0 + bj * HALF + n * 16; const u32x2 g = ai == 0 ? g0[m][bj][n] : g1[m][bj][n]; const f32x4 a = acc[ai][bj][m][n];
                    f32x4 o; o.x = a.x * bflo(g.x); o.y = a.y * bfhi(g.x); o.z = a.z * bflo(g.y); o.w = a.w * bfhi(g.y); *(f32x4*)(T1 + r * D + c) = o; } }
    }
};
struct EpiGate2 {
    static constexpr bool PERM = false;
    const bf16* P; const float* T1; bf16* MIX; LAS unsigned char* lds;
    __device__ __forceinline__ void operator()(const f32x4 (&acc)[2][2][4][2], const Unit& u, int wr, int wc, int fr, int fq) const {
        const int row0 = u.pm * BM + wr * 64 + fr, col0 = u.pn * BM + wc * 32 + 4 * fq;
        LAS unsigned char* wl = lds + (wr * 4 + wc) * 16384; const int lane16 = (fq * 16 + fr) * 16;
        u32x2 g0[4][2][2], g1[4][2][2];
#pragma unroll
        for (int m = 0; m < 4; ++m)
#pragma unroll
            for (int bj = 0; bj < 2; ++bj)
#pragma unroll
                for (int n = 0; n < 2; ++n) { g0[m][bj][n] = *(const u32x2*)(P + (size_t)(row0 + m * 16) * NGT + 1024 + col0 + bj * HALF + n * 16);
                                              g1[m][bj][n] = *(const u32x2*)(P + (size_t)(row0 + HALF + m * 16) * NGT + 1024 + col0 + bj * HALF + n * 16); }
        asm volatile("s_waitcnt vmcnt(0)" ::: "memory"); __builtin_amdgcn_s_barrier();
#pragma unroll
        for (int ai = 0; ai < 2; ++ai) {
            if (ai == 1) asm volatile("s_waitcnt lgkmcnt(0)" ::: "memory");
#pragma unroll
            for (int m = 0; m < 4; ++m)
#pragma unroll
                for (int bj = 0; bj < 2; ++bj)
#pragma unroll
                    for (int n = 0; n < 2; ++n) __builtin_amdgcn_global_load_lds((const unsigned*)(T1 + (size_t)(row0 + ai * HALF + m * 16) * D + col0 + bj * HALF + n * 16), (LAS unsigned*)(wl + ((m * 2 + bj) * 2 + n) * 1024), 16, 0, 0);
            asm volatile("s_waitcnt vmcnt(0)" ::: "memory");
#pragma unroll
            for (int m = 0; m < 4; ++m) { const size_t r = (size_t)(row0 + ai * HALF + m * 16);
#pragma unroll
                for (int bj = 0; bj < 2; ++bj)
#pragma unroll
                    for (int n = 0; n < 2; ++n) { const int c = col0 + bj * HALF + n * 16; const u32x2 g = ai == 0 ? g0[m][bj][n] : g1[m][bj][n]; const f32x4 a = acc[ai][bj][m][n];
                        const f32x4 t = *(const LAS f32x4*)(wl + ((m * 2 + bj) * 2 + n) * 1024 + lane16);
                        u32x2 o; o.x = cvt_pk_bf16(t.x + a.x * bflo(g.x), t.y + a.y * bfhi(g.x)); o.y = cvt_pk_bf16(t.z + a.z * bflo(g.y), t.w + a.w * bfhi(g.y)); *(u32x2*)(MIX + r * D + c) = o; } }
        }
    }
};
struct EpiGate2S {
    static constexpr bool PERM = false;
    const bf16* P; const float* T1; float* Tout; bf16* MIX; const unsigned* wflag;
    __device__ __forceinline__ void operator()(const f32x4 (&acc)[2][2][4][2], const Unit& u, int wr, int wc, int fr, int fq) const {
        { unsigned sp = 0; while (__hip_atomic_load(wflag, __ATOMIC_RELAXED, __HIP_MEMORY_SCOPE_AGENT) == 0u && ++sp < (1u << 17)) __builtin_amdgcn_s_sleep(4);
          __builtin_amdgcn_fence(__ATOMIC_ACQUIRE, "agent"); }
        const int row0 = u.pm * BM + wr * 64 + fr, col0 = u.pn * BM + wc * 32 + 4 * fq;
        u32x2 gv[2][2], gn[2][2]; f32x4 tv[2][2], tn[2][2];
#pragma unroll
        for (int bj = 0; bj < 2; ++bj)
#pragma unroll
            for (int n = 0; n < 2; ++n) { const int c = col0 + bj * HALF + n * 16; gv[bj][n] = *(const u32x2*)(P + (size_t)row0 * NGT + 1024 + c); tv[bj][n] = *(const f32x4*)(T1 + (size_t)row0 * D + c); }
#pragma unroll
        for (int q = 0; q < 8; ++q) { const int ai = q >> 2, m = q & 3; const size_t r = (size_t)(row0 + ai * HALF + m * 16);
            if (q < 7) { const size_t r2 = (size_t)(row0 + ((q + 1) >> 2) * HALF + ((q + 1) & 3) * 16);
#pragma unroll
                for (int bj = 0; bj < 2; ++bj)
#pragma unroll
                    for (int n = 0; n < 2; ++n) { const int c = col0 + bj * HALF + n * 16; gn[bj][n] = *(const u32x2*)(P + r2 * NGT + 1024 + c); tn[bj][n] = *(const f32x4*)(T1 + r2 * D + c); } }
#pragma unroll
            for (int bj = 0; bj < 2; ++bj)
#pragma unroll
                for (int n = 0; n < 2; ++n) { const int c = col0 + bj * HALF + n * 16; const u32x2 g = gv[bj][n]; const f32x4 a = acc[ai][bj][m][n]; const f32x4 t = tv[bj][n];
                    f32x4 w; w.x = t.x + a.x * bflo(g.x); w.y = t.y + a.y * bfhi(g.x); w.z = t.z + a.z * bflo(g.y); w.w = t.w + a.w * bfhi(g.y);
                    if (Tout) *(f32x4*)(Tout + r * D + c) = w;
                    else { u32x2 o; o.x = cvt_pk_bf16(w.x, w.y); o.y = cvt_pk_bf16(w.z, w.w); *(u32x2*)(MIX + r * D + c) = o; } }
            if (q < 7) {
#pragma unroll
                for (int bj = 0; bj < 2; ++bj)
#pragma unroll
                    for (int n = 0; n < 2; ++n) { gv[bj][n] = gn[bj][n]; tv[bj][n] = tn[bj][n]; } } }
    }
};
struct EpiOut {
    static constexpr bool PERM = false;
    const float* xp; const float* xs; const float* modv; const float* g2; float* yp; float* ys; bf16* X1G; float* SS; int slab; LAS unsigned char* lds; unsigned long long* prof;
    __device__ __forceinline__ void operator()(const f32x4 (&acc)[2][2][4][2], const Unit& u, int wr, int wc, int fr, int fq) const {
        const int col0 = u.pn * BM + wc * 32 + 4 * fq;
        LAS unsigned char* wl = lds + (wr * 4 + wc) * 16384; const int lane16 = (fq * 16 + fr) * 16;
        unsigned long long pt0_ = 0; if (PROF_SEL == 32) pt0_ = __builtin_amdgcn_s_memrealtime();
        asm volatile("s_waitcnt vmcnt(0)" ::: "memory"); __builtin_amdgcn_s_barrier();
#pragma unroll
        for (int ai = 0; ai < 2; ++ai) {
            const int rb = u.pm * BM + ai * HALF + wr * 64; const int mb = row_mb(rb);
            f32x4 gtv[2][2], ggv[2][2];
#pragma unroll
            for (int bj = 0; bj < 2; ++bj)
#pragma unroll
                for (int n = 0; n < 2; ++n) { const int c = col0 + bj * HALF + n * 16; gtv[bj][n] = *(const f32x4*)(modv + mb * 6144 + 2048 + c); ggv[bj][n] = *(const f32x4*)(g2 + mb * D + c); }
            if (ai == 1) asm volatile("s_waitcnt lgkmcnt(0)" ::: "memory");
#pragma unroll
            for (int m = 0; m < 4; ++m) { const int r = rb + m * 16 + fr; const float* xr = (r < RP ? xp : xs) + row_goff(slab, r);
#pragma unroll
                for (int bj = 0; bj < 2; ++bj)
#pragma unroll
                    for (int n = 0; n < 2; ++n) __builtin_amdgcn_global_load_lds((const unsigned*)(xr + col0 + bj * HALF + n * 16), (LAS unsigned*)(wl + ((m * 2 + bj) * 2 + n) * 1024), 16, 0, 0); }
            asm volatile("s_waitcnt vmcnt(0)" ::: "memory");
#pragma unroll
            for (int m = 0; m < 4; ++m) { const int r = rb + m * 16 + fr; const size_t go = row_goff(slab, r); float* x1row = (r < RP ? yp : ys) + go; float sq = 0.f;
#pragma unroll
                for (int bj = 0; bj < 2; ++bj)
#pragma unroll
                    for (int n = 0; n < 2; ++n) { const int c = col0 + bj * HALF + n * 16; const f32x4 a = acc[ai][bj][m][n];
                        const f32x4 xv = *(const LAS f32x4*)(wl + ((m * 2 + bj) * 2 + n) * 1024 + lane16);
                        f32x4 o = xv + gtv[bj][n] * a; *(f32x4*)(x1row + c) = o; sq += (o.x * o.x + o.y * o.y) + (o.z * o.z + o.w * o.w);
                        const f32x4 gg = ggv[bj][n]; u32x2 w; w.x = cvt_pk_bf16(o.x * gg.x, o.y * gg.y); w.y = cvt_pk_bf16(o.z * gg.z, o.w * gg.w); *(u32x2*)(X1G + (size_t)r * D + c) = w; }
                sq += __shfl_xor(sq, 16); sq += __shfl_xor(sq, 32);
                if (fq == 0) SS[(size_t)r * 16 + u.pn * 4 + wc] = sq; }
        }
        if (PROF_SEL == 32) { asm volatile("s_waitcnt vmcnt(0)" ::: "memory"); *prof += __builtin_amdgcn_s_memrealtime() - pt0_; }
    }
};
struct EpiUp {
    static constexpr bool PERM = true;
    const float* SS; const float* shw; bf16* U;
    __device__ __forceinline__ void operator()(const f32x4 (&acc)[2][2][4][2], const Unit& u, int wr, int wc, int fr, int fq) const {
        const int col0 = u.pn * BM + wc * 32 + 8 * fq;
        f32x4 pq[2][4];
#pragma unroll
        for (int ai = 0; ai < 2; ++ai)
#pragma unroll
            for (int m = 0; m < 4; ++m) pq[ai][m] = *(const f32x4*)(SS + (size_t)(u.pm * BM + ai * HALF + wr * 64 + m * 16 + fr) * 16 + 4 * fq);
#pragma unroll
        for (int ai = 0; ai < 2; ++ai) {
            const int rb = u.pm * BM + ai * HALF + wr * 64; const int mb = row_mb(rb);
            f32x4 sv[2][2];
#pragma unroll
            for (int bj = 0; bj < 2; ++bj)
#pragma unroll
                for (int n = 0; n < 2; ++n) sv[bj][n] = *(const f32x4*)(shw + mb * NUP + col0 + bj * HALF + 4 * n);
#pragma unroll
            for (int m = 0; m < 4; ++m) { const int r = rb + m * 16 + fr;
                float tot = (pq[ai][m].x + pq[ai][m].y) + (pq[ai][m].z + pq[ai][m].w); tot += __shfl_xor(tot, 16); tot += __shfl_xor(tot, 32);
                const float rs = rsqrtf(tot * (1.f / D) + EPS);
#pragma unroll
                for (int bj = 0; bj < 2; ++bj) { const f32x4 v0 = acc[ai][bj][m][0] * rs + sv[bj][0], v1 = acc[ai][bj][m][1] * rs + sv[bj][1];
                    u32x4 w; w.x = cvt_pk_bf16(v0[0], v0[1]); w.y = cvt_pk_bf16(v0[2], v0[3]); w.z = cvt_pk_bf16(v1[0], v1[1]); w.w = cvt_pk_bf16(v1[2], v1[3]);
                    *(u32x4*)(U + (size_t)r * NUP + col0 + bj * HALF) = w; } }
        }
    }
};
struct EpiDown0 {
    static constexpr bool PERM = false;
    const float* modv; float* yp; float* ys; int slab;
    __device__ __forceinline__ void operator()(const f32x4 (&acc)[2][2][4][2], const Unit& u, int wr, int wc, int fr, int fq) const {
        const int col0 = u.pn * BM + wc * 32 + 4 * fq;
#pragma unroll
        for (int ai = 0; ai < 2; ++ai) {
            const int rb = u.pm * BM + ai * HALF + wr * 64; const int mb = row_mb(rb);
            f32x4 gtv[2][2], xv[2][2], xn[2][2];
#pragma unroll
            for (int bj = 0; bj < 2; ++bj)
#pragma unroll
                for (int n = 0; n < 2; ++n) { const int c = col0 + bj * HALF + n * 16; gtv[bj][n] = *(const f32x4*)(modv + mb * 6144 + 5120 + c);
                    xv[bj][n] = *(const f32x4*)((rb + fr < RP ? yp : ys) + row_goff(slab, rb + fr) + c); }
#pragma unroll
            for (int m = 0; m < 4; ++m) { const int r = rb + m * 16 + fr; float* yrow = (r < RP ? yp : ys) + row_goff(slab, r);
                if (m < 3) { const int r2 = r + 16; const float* yr2 = (r2 < RP ? yp : ys) + row_goff(slab, r2);
#pragma unroll
                    for (int bj = 0; bj < 2; ++bj)
#pragma unroll
                        for (int n = 0; n < 2; ++n) xn[bj][n] = *(const f32x4*)(yr2 + col0 + bj * HALF + n * 16); }
#pragma unroll
                for (int bj = 0; bj < 2; ++bj)
#pragma unroll
                    for (int n = 0; n < 2; ++n) *(f32x4*)(yrow + col0 + bj * HALF + n * 16) = xv[bj][n] + gtv[bj][n] * acc[ai][bj][m][n];
                if (m < 3) {
#pragma unroll
                    for (int bj = 0; bj < 2; ++bj)
#pragma unroll
                        for (int n = 0; n < 2; ++n) xv[bj][n] = xn[bj][n]; } }
        }
    }
};
struct EpiDown1 {
    static constexpr bool PERM = false;
    float* PD;
    __device__ __forceinline__ void operator()(const f32x4 (&acc)[2][2][4][2], const Unit& u, int wr, int wc, int fr, int fq) const {
        const int row0 = u.pm * BM + wr * 64 + fr, col0 = u.pn * BM + wc * 32 + 4 * fq;
#pragma unroll
        for (int ai = 0; ai < 2; ++ai)
#pragma unroll
            for (int m = 0; m < 4; ++m) { const size_t r = (size_t)(row0 + ai * HALF + m * 16);
#pragma unroll
                for (int bj = 0; bj < 2; ++bj)
#pragma unroll
                    for (int n = 0; n < 2; ++n) *(f32x4*)(PD + r * D + col0 + bj * HALF + n * 16) = acc[ai][bj][m][n]; }
    }
};
}
typedef short bf16x8 __attribute__((ext_vector_type(8)));
#define MFMA16(a, b, c) __builtin_amdgcn_mfma_f32_16x16x32_bf16((a), (b), (c), 0, 0, 0)
__device__ __forceinline__ bf16x8 ldfrag(const LAS bf16* base, int ld, int row0, int k0, int lane) {
    return *(const LAS bf16x8*)(base + (row0 + (lane & 15)) * ld + k0 + 8 * (lane >> 4));
}
__device__ __forceinline__ bf16x8 ldfrag_perm(const LAS bf16* base, int ld, int row0, int k0, int lane) {
    const LAS v2u* p = (const LAS v2u*)(base + (row0 + (lane & 15)) * ld + k0 + 4 * (lane >> 4));
    const v2u a = p[0], b = p[4];
    v4u w; w.x = a.x; w.y = a.y; w.z = b.x; w.w = b.y; return __builtin_bit_cast(bf16x8, w);
}
__device__ __forceinline__ bf16x8 acc2frag(f32x4 t0, f32x4 t1) {
    v4u w; w.x = pg8::cvt_pk_bf16(t0.x, t0.y); w.y = pg8::cvt_pk_bf16(t0.z, t0.w); w.z = pg8::cvt_pk_bf16(t1.x, t1.y); w.w = pg8::cvt_pk_bf16(t1.z, t1.w); return __builtin_bit_cast(bf16x8, w);
}
__device__ __forceinline__ int kpos(int o) { return (o & ~31) | (8 * ((o >> 2) & 3) + 4 * ((o >> 4) & 1) + (o & 3)); }
__device__ __forceinline__ float wave_incl_scan(float v, int lane) {
#pragma unroll
    for (int o = 1; o < 64; o <<= 1) { const float t = __shfl_up(v, o); if (lane >= o) v += t; }
    return v;
}
__device__ __forceinline__ float dpp_f(float v, int ctrl_sel) {
    const int x = __builtin_bit_cast(int, v); int r;
    switch (ctrl_sel) { case 0: r = __builtin_amdgcn_mov_dpp(x, 0xB1, 0xF, 0xF, true); break; case 1: r = __builtin_amdgcn_mov_dpp(x, 0x4E, 0xF, 0xF, true); break;
                        case 2: r = __builtin_amdgcn_mov_dpp(x, 0x141, 0xF, 0xF, true); break; default: r = __builtin_amdgcn_mov_dpp(x, 0x140, 0xF, 0xF, true); break; }
    return __builtin_bit_cast(float, r);
}
__device__ __forceinline__ float row16_sum(float v) { v += dpp_f(v, 0); v += dpp_f(v, 1); v += dpp_f(v, 2); v += dpp_f(v, 3); return v; }

constexpr int GI_WKN = 0, GI_QG = 17408, GI_KT = 34816, GI_QKM = 53248, GI_IMG = 62464, GI_WV = GI_IMG, GI_SC = GI_IMG + 32768, GI_STRIDE = GI_SC + 256;
constexpr int GDN_ITEMS_MAX = GDN_ITEMS;
static_assert(GI_STRIDE == GI_STRIDE_C, "image stride");
constexpr int GP_QS = 0, GP_KS = 17408, GP_LS = 34816, GP_SC = 51200, GP_HALF = 52736;

__device__ __forceinline__ void gdn_pre_pair(Frame& F, int s, int pair) {
    const bf16* P = (const bf16*)GENP(F.ws, WS_XC, SZ_XC, G_XC, s); const float* SM = (const float*)GENP(F.ws, WS_SM, SZ_SM, G_SM, s);
    const int tid = F.tid, hb = tid >> 8, ht = tid & 255, wl = (tid >> 6) & 3;
    int lane = F.lane; asm volatile("" : "+v"(lane)); const int quad = lane >> 4, l15 = lane & 15;
    const int it = 2 * pair + hb;
    int bsel, h, r0, c; bool samp;
    if (it < NCH * NB * GH) { samp = false; const int bh = it / NCH; c = it % NCH; bsel = bh >> 3; h = bh & 7; r0 = bsel * SLAB_T + 64 * c; }
    else { samp = true; const int q = it - NCH * NB * GH; bsel = q >> 3; h = q & 7; c = 0; r0 = RP + bsel * DSEQ; }
    unsigned char* img = GENP(F.ws, WS_GDN, SZ_GIMG, G_IMG, s) + (size_t)it * GI_STRIDE;
    LAS unsigned char* hbase = F.lds + hb * GP_HALF;
    LAS bf16* QS = (LAS bf16*)(hbase + GP_QS); LAS bf16* KS = (LAS bf16*)(hbase + GP_KS); LAS float* LS = (LAS float*)(hbase + GP_LS);
    LAS float* NQ = (LAS float*)(hbase + GP_SC); LAS float* NK = NQ + 64; LAS float* GAMS = NK + 64; LAS float* BTS = GAMS + 64; LAS float* EG = BTS + 64; LAS float* EL = EG + 64;
    if (ht < 64) { const size_t r = (size_t)(r0 + lane); const float beta = sigmoidf_(SM[r * 64 + h]); const float g = -__expf(F.A.in[14][h]) * softplusf_(SM[r * 64 + 8 + h] + F.A.in[15][h]);
        const float ga = wave_incl_scan(g, lane); const float la = __shfl(ga, 63); GAMS[lane] = ga; BTS[lane] = beta; EG[lane] = __expf(ga); EL[lane] = __expf(la - ga); }
    float y[64];
    {
        const float* wcv = F.A.in[12]; const float* bcv = F.A.in[13];
        LAS bf16* RAW0 = (LAS bf16*)(hbase + GP_LS); LAS bf16* RAW1 = (LAS bf16*)(hbase + GP_KS);
#pragma unroll
        for (int rnd = 0; rnd < 2; ++rnd) {
#pragma unroll
            for (int i = 0; i < 4; ++i) { const int id = ht + 256 * i, row = id >> 4, c16 = id & 15;
                *(LAS v4u*)(RAW0 + row * 128 + 8 * c16) = *(const GAS v4u*)(P + (size_t)(r0 + row) * NXC + (rnd == 0 ? 0 : 1024) + h * 128 + 8 * c16);
                if (rnd == 0) *(LAS v4u*)(RAW1 + row * 128 + 8 * c16) = *(const GAS v4u*)(P + (size_t)(r0 + row) * NXC + 2048 + h * 128 + 8 * c16); }
            __syncthreads();
            if (rnd == 0 || ht < 128) {
                const int role = rnd == 1 ? 1 : (ht < 128 ? 0 : 2), ch = ht & 127;
                const int cidx = role * 1024 + h * 128 + ch;
                const float w0 = wcv[cidx], w1 = wcv[CONV_CH + cidx], w2 = wcv[2 * CONV_CH + cidx], w3 = wcv[3 * CONV_CH + cidx], bias = bcv[cidx];
                float h0 = 0.f, h1 = 0.f, h2 = 0.f;
                if (c > 0) { const bf16* pp = P + (size_t)(r0 - 3) * NXC + cidx; h0 = bf2f(pp[0]); h1 = bf2f(pp[NXC]); h2 = bf2f(pp[2 * NXC]); }
                else if (samp) { const float* st = F.A.in[2] + (size_t)bsel * 3 * CONV_CH + cidx; h0 = st[0]; h1 = st[CONV_CH]; h2 = st[2 * CONV_CH]; }
                else if (s > 0) { const float* st = (const float*)(F.ws + WS_CARRY_MIX) + ((size_t)(s & 1) * NB + bsel) * 3 * CONV_CH + cidx; h0 = st[0]; h1 = st[CONV_CH]; h2 = st[2 * CONV_CH]; }
                const LAS bf16* src = (role == 2 ? RAW1 : RAW0) + ch;
                LAS bf16* dst = (role == 0 ? QS : KS) + ch;
#pragma unroll
                for (int t = 0; t < 64; ++t) { const float raw = bf2f(src[t * 128]); float val = bias + w0 * h0 + w1 * h1 + w2 * h2 + w3 * raw; h0 = h1; h1 = h2; h2 = raw; val = siluf_(val);
                    if (role == 0) dst[t * 136] = (bf16)f2bf(val); else y[t] = val; }
            }
            __syncthreads();
            if (rnd == 1 && ht < 128) {
#pragma unroll
                for (int t = 0; t < 64; ++t) KS[t * 136 + ht] = (bf16)f2bf(y[t]);
            }
        }
    }
    __syncthreads();
    f32x4 kk[4], qk[4];
    {
        bf16x8 ak[4], aq[4];
#pragma unroll
        for (int ks = 0; ks < 4; ++ks) { ak[ks] = ldfrag(KS, 136, 16 * wl, 32 * ks, lane); aq[ks] = ldfrag(QS, 136, 16 * wl, 32 * ks, lane); }
        f32x4 qq = {0.f, 0.f, 0.f, 0.f};
#pragma unroll
        for (int ks = 0; ks < 4; ++ks) qq = MFMA16(aq[ks], aq[ks], qq);
#pragma unroll
        for (int nt = 0; nt < 4; ++nt) {
            if (nt <= wl) { f32x4 a0 = {0.f, 0.f, 0.f, 0.f}, a1 = {0.f, 0.f, 0.f, 0.f};
#pragma unroll
                for (int ks = 0; ks < 4; ++ks) { const bf16x8 bk = ldfrag(KS, 136, 16 * nt, 32 * ks, lane); a0 = MFMA16(ak[ks], bk, a0); a1 = MFMA16(aq[ks], bk, a1); }
                kk[nt] = a0; qk[nt] = a1; } else { kk[nt] = qq; qk[nt] = qq; } }
        float dk = 0.f, dq = 0.f;
#pragma unroll
        for (int nt = 0; nt < 4; ++nt) if (nt == wl) {
#pragma unroll
            for (int r = 0; r < 4; ++r) if (4 * quad + r == l15) { dk = kk[nt][r]; dq = qq[r]; } }
        if ((l15 >> 2) == quad) { NK[16 * wl + l15] = rsqrtf(dk + EPS); NQ[16 * wl + l15] = rsqrtf(dq + EPS) * 0.08838834764831845f; }
    }
    __syncthreads();
    {
        bf16* QKM = (bf16*)(img + GI_QKM);
#pragma unroll
        for (int nt = 0; nt < 4; ++nt) { const int j = 16 * nt + l15; const float nkj = NK[j], gj = GAMS[j];
#pragma unroll
            for (int r = 0; r < 4; ++r) { const int i = 16 * wl + 4 * quad + r; const float e = __expf(GAMS[i] - gj);
                LS[i * 64 + j] = i > j ? kk[nt][r] * NK[i] * nkj * e * BTS[i] : 0.f;
                QKM[i * 72 + kpos(j)] = (bf16)f2bf(i >= j ? qk[nt][r] * NQ[i] * nkj * e : 0.f); } }
    }
    const float last = GAMS[63];
    if (ht < 128) {
        bf16* KT = (bf16*)(img + GI_KT) + ht * 72;
#pragma unroll
        for (int i8 = 0; i8 < 8; ++i8) { float t[8];
#pragma unroll
            for (int e = 0; e < 8; ++e) { const int j = 32 * (i8 >> 2) + 16 * (e >> 2) + 4 * (i8 & 3) + (e & 3); const float kh = y[j] * NK[j]; t[e] = kh * EL[j]; y[j] = kh * BTS[j] * EG[j]; }
            v4u o; o.x = pk2(t[0], t[1]); o.y = pk2(t[2], t[3]); o.z = pk2(t[4], t[5]); o.w = pk2(t[6], t[7]); *(GAS v4u*)(KT + 8 * i8) = o; }
    } else {
#pragma unroll
        for (int j = 0; j < 64; ++j) y[j] *= BTS[j];
    }
    __syncthreads();
#pragma unroll
    for (int i = 1; i < 64; ++i) { float acc = y[i];
#pragma unroll
        for (int j4 = 0; j4 < (i + 3) / 4; ++j4) { const f32x4 l = *(const LAS f32x4*)(LS + i * 64 + 4 * j4);
            acc -= l.x * y[4 * j4]; if (4 * j4 + 1 < i) acc -= l.y * y[4 * j4 + 1]; if (4 * j4 + 2 < i) acc -= l.z * y[4 * j4 + 2]; if (4 * j4 + 3 < i) acc -= l.w * y[4 * j4 + 3]; }
        y[i] = acc; }
    if (ht < 128) { LAS bf16* WS_ = KS + kpos(ht);
#pragma unroll
        for (int i = 0; i < 64; ++i) WS_[i * 136] = (bf16)f2bf(-y[i]); }
    else { const int v = ht - 128; float* WV = (float*)(img + GI_WV) + ((v >> 4) * 64 + (v & 15)) * 16;
#pragma unroll
        for (int i = 0; i < 64; ++i) WV[(((i >> 2) & 3) << 4) * 16 + (i >> 4) * 4 + (i & 3)] = y[i]; }
    {
        bf16* QG = (bf16*)(img + GI_QG);
#pragma unroll
        for (int q = 0; q < 4; ++q) { const int idx = ht + 256 * q, i = idx >> 4, d8 = (idx & 15) * 8; const int o0 = (d8 & ~31) + 4 * ((d8 >> 3) & 3);
            const v2u xa = *(const LAS v2u*)(QS + i * 136 + o0), xb = *(const LAS v2u*)(QS + i * 136 + o0 + 16); v4u x; x.x = xa.x; x.y = xa.y; x.z = xb.x; x.w = xb.y; const float sc = NQ[i] * EG[i];
            v4u o; o.x = pk2(bflo(x.x) * sc, bfhi(x.x) * sc); o.y = pk2(bflo(x.y) * sc, bfhi(x.y) * sc); o.z = pk2(bflo(x.z) * sc, bfhi(x.z) * sc); o.w = pk2(bflo(x.w) * sc, bfhi(x.w) * sc);
            *(GAS v4u*)(QG + i * 136 + d8) = o; }
        if (ht == 0) *(float*)(img + GI_SC) = EG[63];
    }
    __syncthreads();
    for (int i = ht; i < 17408 / 16; i += 256) *(GAS v4u*)(img + GI_WKN + 16 * i) = *(const LAS v4u*)(hbase + GP_KS + 16 * i);
    __syncthreads();
}
__device__ __forceinline__ void phase_gdn_pre(Frame& F, int s) {
    const int npairs = (s == DSLAB ? GDN_ITEMS_MAX : NCH * NB * GH) / 2;
    for (int p = F.bid; p < npairs; p += F.G) gdn_pre_pair(F, s, p);
}

constexpr int GS_BUF = 0, GS_PSQ = 2 * GI_IMG, GS_ZS = GS_PSQ + 4096, GS_RS = GS_ZS + 8 * 2048;
static_assert(GS_RS + 256 <= RING_BYTES, "GDN sequential LDS map fits");
__device__ __forceinline__ void gdn_seq_job(Frame& F, int s, bool samp, int bb, int h, bool dry = false) {
    const bf16* ZGp = (const bf16*)GENP(F.ws, WS_ZG, SZ_ZG, G_ZG, s); bf16* OG = (bf16*)GENP(F.ws, WS_OG, SZ_OG, G_OG, s);
    const int w = F.wave;
    int lane = F.lane; asm volatile("" : "+v"(lane)); int quad = lane >> 4, l15 = lane & 15;
    const int nchunk = samp ? 1 : NCH, row0 = samp ? RP + bb * DSEQ : bb * SLAB_T;
    const int item0 = samp ? NCH * NB * GH + bb * GH + h : (bb * GH + h) * NCH;
    const unsigned char* img0 = GENP(F.ws, WS_GDN, SZ_GIMG, G_IMG, s) + (size_t)item0 * GI_STRIDE;
    LAS float* PSQ = (LAS float*)(F.lds + GS_PSQ); LAS bf16* ZS = (LAS bf16*)(F.lds + GS_ZS) + w * 1024; LAS float* RS = (LAS float*)(F.lds + GS_RS);
    f32x4 Sacc[8];
    {
        const float* st = samp ? F.A.in[3] : F.out + O_GP; const size_t sb = (size_t)(bb * GH + h) * GDK * GDV;
#pragma unroll
        for (int mt = 0; mt < 8; ++mt)
#pragma unroll
            for (int r = 0; r < 4; ++r) Sacc[mt][r] = (samp || s > 0) ? st[sb + (size_t)(16 * mt + 4 * quad + r) * GDV + 16 * w + l15] : 0.f;
    }
    const float gn = F.A.in[16][16 * w + l15];
#define GDN_STAGE(imgp, bufi) do { for (int pc_ = w; pc_ < GI_IMG / 1024; pc_ += 8) \
        __builtin_amdgcn_global_load_lds((const unsigned*)((imgp) + pc_ * 1024 + lane * 16), (LAS unsigned*)(F.lds + GS_BUF + (bufi) * GI_IMG + pc_ * 1024), 16, 0, 0); } while (0)
    PROF_BEGIN(1);
    GDN_STAGE(img0, 0);
    f32x4 wv[4];
    { const GAS f32x4* WV = (const GAS f32x4*)(img0 + GI_WV) + (w * 64 + lane) * 4;
#pragma unroll
      for (int mt = 0; mt < 4; ++mt) wv[mt] = WV[mt]; }
    v4u zr0, zr1;
    { const GAS v4u* zp = (const GAS v4u*)(ZGp + (size_t)(row0 + lane) * NZG + h * 128 + 16 * w); zr0 = zp[0]; zr1 = zp[1]; }
    float el_next = *(const float*)(img0 + GI_SC);
    f32x4 Oprev[4];
#pragma unroll
    for (int mt = 0; mt < 4; ++mt) Oprev[mt] = wv[mt];
#define GDN_FINISH(cc) do { const LAS float* ps = PSQ + ((cc) & 1) * 512; const int rb = row0 + 64 * (cc); \
        { const f32x4 p0 = *(const LAS f32x4*)(ps + lane * 8), p1 = *(const LAS f32x4*)(ps + lane * 8 + 4);     \
          RS[lane] = rsqrtf((((p0.x + p0.y) + (p0.z + p0.w)) + ((p1.x + p1.y) + (p1.z + p1.w))) * (1.f / GDV) + EPS); } \
        _Pragma("unroll") for (int mt = 0; mt < 4; ++mt) { const f32x4 rs4 = *(const LAS f32x4*)(RS + 16 * mt + 4 * quad); \
            _Pragma("unroll") for (int r = 0; r < 4; ++r) { const int i = 16 * mt + 4 * quad + r; const float z = bf2f(ZS[i * 16 + l15]); \
            ZS[i * 16 + l15] = (bf16)f2bf(Oprev[mt][r] * rs4[r] * gn * siluf_(z)); } } \
        { const v4u o0_ = *(const LAS v4u*)(ZS + lane * 16), o1_ = *(const LAS v4u*)(ZS + lane * 16 + 8); GAS v4u* op_ = (GAS v4u*)(OG + (size_t)(rb + lane) * D + h * 128 + 16 * w); op_[0] = o0_; op_[1] = o1_; } } while (0)
    for (int c = 0; c < nchunk; ++c) {
        asm volatile("" : "+v"(lane)); quad = lane >> 4; l15 = lane & 15;
        PROF_BEGIN(2);
        asm volatile("s_waitcnt vmcnt(0)" ::: "memory");
        __syncthreads();
        PROF_END(2);
        PROF_BEGIN(3);
        const unsigned char* img = img0 + (size_t)c * GI_STRIDE;
        f32x4 wvn[4];
        const float el = el_next;
        if (c + 1 < nchunk) { GDN_STAGE(img + GI_STRIDE, (c + 1) & 1); el_next = *(const float*)(img + GI_STRIDE + GI_SC);
            const GAS f32x4* WV = (const GAS f32x4*)(img + GI_STRIDE + GI_WV) + (w * 64 + lane) * 4;
#pragma unroll
            for (int mt = 0; mt < 4; ++mt) wvn[mt] = WV[mt]; }
        else {
#pragma unroll
            for (int mt = 0; mt < 4; ++mt) wvn[mt] = wv[mt]; }
        if (c > 0) GDN_FINISH(c - 1);
        PROF_END(3);
        PROF_BEGIN(4);
        *(LAS v4u*)(ZS + lane * 16) = zr0; *(LAS v4u*)(ZS + lane * 16 + 8) = zr1;
        if (c + 1 < nchunk) { const GAS v4u* zp = (const GAS v4u*)(ZGp + (size_t)(row0 + 64 * (c + 1) + lane) * NZG + h * 128 + 16 * w); zr0 = zp[0]; zr1 = zp[1]; }
        const LAS unsigned char* buf = F.lds + GS_BUF + (c & 1) * GI_IMG;
        const LAS bf16* WKN = (const LAS bf16*)(buf + GI_WKN); const LAS bf16* QG = (const LAS bf16*)(buf + GI_QG); const LAS bf16* KT = (const LAS bf16*)(buf + GI_KT); const LAS bf16* QKM = (const LAS bf16*)(buf + GI_QKM);
        f32x4 U[4], O[4];
#pragma unroll
        for (int mt = 0; mt < 4; ++mt) { U[mt] = wv[mt]; O[mt] = (f32x4){0.f, 0.f, 0.f, 0.f}; }
#pragma unroll
        for (int ks = 0; ks < 4; ++ks) { const bf16x8 Sb = acc2frag(Sacc[2 * ks], Sacc[2 * ks + 1]);
#pragma unroll
            for (int mt = 0; mt < 4; ++mt) { U[mt] = MFMA16(ldfrag(WKN, 136, 16 * mt, 32 * ks, lane), Sb, U[mt]); O[mt] = MFMA16(ldfrag(QG, 136, 16 * mt, 32 * ks, lane), Sb, O[mt]); } }
        bf16x8 Ub[2];
#pragma unroll
        for (int ks = 0; ks < 2; ++ks) Ub[ks] = acc2frag(U[2 * ks], U[2 * ks + 1]);
#pragma unroll
        for (int ks = 0; ks < 2; ++ks)
#pragma unroll
            for (int mt = 0; mt < 4; ++mt) O[mt] = MFMA16(ldfrag(QKM, 72, 16 * mt, 32 * ks, lane), Ub[ks], O[mt]);
#pragma unroll
        for (int mt = 0; mt < 8; ++mt) { Sacc[mt] = Sacc[mt] * el;
#pragma unroll
            for (int ks = 0; ks < 2; ++ks) Sacc[mt] = MFMA16(ldfrag(KT, 72, 16 * mt, 32 * ks, lane), Ub[ks], Sacc[mt]); }
        { LAS float* ps = PSQ + (c & 1) * 512;
#pragma unroll
          for (int mt = 0; mt < 4; ++mt)
#pragma unroll
              for (int r = 0; r < 4; ++r) { const float sq = row16_sum(O[mt][r] * O[mt][r]); if (l15 == 0) ps[(16 * mt + 4 * quad + r) * 8 + w] = sq; Oprev[mt][r] = O[mt][r]; } }
        PROF_END(4);
#pragma unroll
        for (int mt = 0; mt < 4; ++mt) wv[mt] = wvn[mt];
    }
    __syncthreads();
    GDN_FINISH(nchunk - 1);
    PROF_END(1);
#undef GDN_FINISH
#undef GDN_STAGE
    {
        float* so = (dry ? (float*)(F.ws + WS_T1) : F.out) + (samp ? O_GS : O_GP) - (dry ? O_GP : 0) + (size_t)(bb * GH + h) * GDK * GDV;
#pragma unroll
        for (int mt = 0; mt < 8; ++mt)
#pragma unroll
            for (int r = 0; r < 4; ++r) so[(size_t)(16 * mt + 4 * quad + r) * GDV + 16 * w + l15] = Sacc[mt][r];
    }
    __syncthreads();
}
constexpr int SI_CS = 0, SI_BT = 17408, SI_CB = 35840, SI_DT = 45056, SI_GAM = 46080, SI_IMG = 47104, SI_XT = SI_IMG, SI_STRIDE = SI_IMG + 32768;
constexpr int SSD_ITEMS_MAX = SSD_ITEMS;
static_assert(SI_STRIDE == SI_STRIDE_C, "image stride");
constexpr int SP_CS = 0, SP_BS = 17408, SP_DT = 34816, SP_GAM = 35840, SP_RAW = 40960;
static_assert(SP_RAW + 65536 <= RING_BYTES, "SSD precompute LDS map fits");

__device__ __forceinline__ void ssd_pre_item(Frame& F, int s, int it) {
    const bf16* P = (const bf16*)GENP(F.ws, WS_XC, SZ_XC, G_XC, s); const float* SM = (const float*)GENP(F.ws, WS_SM, SZ_SM, G_SM, s);
    const int tid = F.tid, w = F.wave;
    int lane = F.lane; asm volatile("" : "+v"(lane)); const int quad = lane >> 4, l15 = lane & 15;
    int bsel, g, r0, c; bool samp;
    if (it < NCH * NB * SG) { samp = false; const int bg = it / NCH; c = it % NCH; bsel = bg >> 3; g = bg & 7; r0 = bsel * SLAB_T + 64 * c; }
    else { samp = true; const int q = it - NCH * NB * SG; bsel = q >> 3; g = q & 7; c = 0; r0 = RP + bsel * DSEQ; }
    unsigned char* img = GENP(F.ws, WS_SSD, SZ_SIMG, G_IMG, s) + (size_t)it * SI_STRIDE;
    LAS bf16* CS = (LAS bf16*)(F.lds + SP_CS); LAS bf16* BS = (LAS bf16*)(F.lds + SP_BS); LAS float* DTV = (LAS float*)(F.lds + SP_DT); LAS float* GAM = (LAS float*)(F.lds + SP_GAM);
    v4u rawr[8];
#pragma unroll
    for (int i = 0; i < 8; ++i) { const int id = tid + NTHR * i, row = id >> 6, j = id & 63;
        const int col = j < 32 ? 3072 + g * 256 + 8 * j : (j < 48 ? 5120 + g * 128 + 8 * (j - 32) : 6144 + g * 128 + 8 * (j - 48));
        rawr[i] = *(const GAS v4u*)(P + (size_t)(r0 + row) * NXC + col); }
    const int cidx = tid < 256 ? 3072 + g * 256 + tid : (tid < 384 ? 5120 + g * 128 + (tid - 256) : 6144 + g * 128 + (tid - 384));
    const float* wcv = F.A.in[12]; const float w0 = wcv[cidx], w1 = wcv[CONV_CH + cidx], w2 = wcv[2 * CONV_CH + cidx], w3 = wcv[3 * CONV_CH + cidx], bias = F.A.in[13][cidx];
    float h0 = 0.f, h1 = 0.f, h2 = 0.f;
    if (c > 0) { const bf16* pp = P + (size_t)(r0 - 3) * NXC + cidx; h0 = bf2f(pp[0]); h1 = bf2f(pp[NXC]); h2 = bf2f(pp[2 * NXC]); }
    else if (samp) { const float* st = F.A.in[2] + (size_t)bsel * 3 * CONV_CH + cidx; h0 = st[0]; h1 = st[CONV_CH]; h2 = st[2 * CONV_CH]; }
    else if (s > 0) { const float* st = (const float*)(F.ws + WS_CARRY_MIX) + ((size_t)(s & 1) * NB + bsel) * 3 * CONV_CH + cidx; h0 = st[0]; h1 = st[CONV_CH]; h2 = st[2 * CONV_CH]; }
    if (tid < 256) { const int hh = 4 * g + (tid >> 6); const float dt = softplusf_(SM[(size_t)(r0 + lane) * 64 + 16 + hh] + F.A.in[18][hh]);
        const float ga = wave_incl_scan(dt * (-__expf(F.A.in[17][hh])), lane); DTV[(tid >> 6) * 64 + lane] = dt; GAM[(tid >> 6) * 64 + lane] = ga;
        ((float*)(img + SI_DT))[(tid >> 6) * 64 + lane] = dt; ((float*)(img + SI_GAM))[(tid >> 6) * 64 + lane] = ga; }
    { LAS bf16* RAW = (LAS bf16*)(F.lds + SP_RAW);
#pragma unroll
      for (int i = 0; i < 8; ++i) { const int id = tid + NTHR * i, row = id >> 6, j = id & 63; *(LAS v4u*)(RAW + row * 512 + 8 * j) = rawr[i]; } }
    __syncthreads();
    {
        unsigned colp2[32];
        LAS bf16* RAW = (LAS bf16*)(F.lds + SP_RAW);
        const LAS float* dtp = DTV + (tid < 256 ? (tid >> 6) * 64 : 0);
#pragma unroll
        for (int t = 0; t < 64; t += 2) { const float ra = bf2f(RAW[t * 512 + tid]), rb = bf2f(RAW[(t + 1) * 512 + tid]);
            float va = bias + w0 * h0 + w1 * h1 + w2 * h2 + w3 * ra; float vb = bias + w0 * h1 + w1 * h2 + w2 * ra + w3 * rb; h0 = h2; h1 = ra; h2 = rb;
            va = siluf_(va); vb = siluf_(vb); if (tid < 256) { va *= dtp[t]; vb *= dtp[t + 1]; }
            colp2[t >> 1] = pk2(va, vb); }
        if (tid < 384) {
            bf16* rowp = tid < 256 ? (bf16*)(img + SI_XT) + tid * 64 : (bf16*)(img + SI_BT) + (tid - 256) * 72;
#pragma unroll
            for (int i = 0; i < 8; ++i) { v4u o; o.x = colp2[4 * i]; o.y = colp2[4 * i + 1]; o.z = colp2[4 * i + 2]; o.w = colp2[4 * i + 3]; *(GAS v4u*)(rowp + 8 * i) = o; }
        }
        if (tid >= 256) {
            LAS bf16* colp = tid < 384 ? BS + kpos(tid - 256) : CS + kpos(tid - 384);
#pragma unroll
            for (int t = 0; t < 32; ++t) { colp[(2 * t) * 136] = (bf16)(colp2[t] & 0xffffu); colp[(2 * t + 1) * 136] = (bf16)(colp2[t] >> 16); }
        }
    }
    __syncthreads();
    {
        const int mt = w >> 1; bf16* CBG = (bf16*)(img + SI_CB);
#pragma unroll
        for (int q = 0; q < 2; ++q) { const int nt = 2 * (w & 1) + q; f32x4 acc = {0.f, 0.f, 0.f, 0.f};
#pragma unroll
            for (int ks = 0; ks < 4; ++ks) acc = MFMA16(ldfrag(CS, 136, 16 * mt, 32 * ks, lane), ldfrag(BS, 136, 16 * nt, 32 * ks, lane), acc);
#pragma unroll
            for (int r = 0; r < 4; ++r) CBG[(16 * mt + 4 * quad + r) * 72 + 16 * nt + l15] = (bf16)f2bf(acc[r]); }
    }
    for (int i = tid; i < 17408 / 16; i += NTHR) *(GAS v4u*)(img + SI_CS + 16 * i) = *(const LAS v4u*)(F.lds + SP_CS + 16 * i);
    __syncthreads();
}
__device__ __forceinline__ void phase_ssd_pre(Frame& F, int s) {
    const int nitems = s == DSLAB ? SSD_ITEMS_MAX : NCH * NB * SG;
    for (int it = F.bid; it < nitems; it += F.G) ssd_pre_item(F, s, it);
}

constexpr int SQ_BUF = 0, SQ_PS = 2 * SI_IMG, SQ_ZS = SQ_PS + 2048, SQ_RS = SQ_ZS + 8 * 4096;
static_assert(SQ_RS + 256 <= RING_BYTES, "SSD sequential LDS map fits");
__device__ __forceinline__ void ssd_seq_job(Frame& F, int s, bool samp, int bb, int g, bool dry = false) {
    const bf16* ZGp = (const bf16*)GENP(F.ws, WS_ZG, SZ_ZG, G_ZG, s); bf16* YS = (bf16*)GENP(F.ws, WS_YS, SZ_YS, G_YS, s);
    const int w = F.wave;
    int lane = F.lane; asm volatile("" : "+v"(lane)); int quad = lane >> 4, l15 = lane & 15;
    const int hl = w >> 1, ph = w & 1, head = 4 * g + hl;
    const int nchunk = samp ? 1 : NCH, row0 = samp ? RP + bb * DSEQ : bb * SLAB_T;
    const int item0 = samp ? NCH * NB * SG + bb * SG + g : (bb * SG + g) * NCH;
    const unsigned char* img0 = GENP(F.ws, WS_SSD, SZ_SIMG, G_IMG, s) + (size_t)item0 * SI_STRIDE;
    LAS float* PS = (LAS float*)(F.lds + SQ_PS); LAS bf16* ZS = (LAS bf16*)(F.lds + SQ_ZS) + w * 2048; LAS float* RS = (LAS float*)(F.lds + SQ_RS);
    f32x4 hacc[8][2];
    {
        const float* st = samp ? F.A.in[4] : F.out + O_SP;
        const size_t sb = (size_t)(bb * SH + head) * SN * SP;
#pragma unroll
        for (int mt = 0; mt < 8; ++mt)
#pragma unroll
            for (int nt = 0; nt < 2; ++nt)
#pragma unroll
                for (int r = 0; r < 4; ++r) { const int n = 16 * mt + 4 * quad + r, p = 32 * ph + 16 * nt + l15; hacc[mt][nt][r] = (samp || s > 0) ? st[sb + (size_t)n * SP + p] : 0.f; }
    }
    const float Dh = F.A.in[19][head];
    const int prow = hl * 64 + 32 * ph;
#define SSD_STAGE(imgp, bufi) do { for (int pc_ = w; pc_ < SI_IMG / 1024; pc_ += 8) \
        __builtin_amdgcn_global_load_lds((const unsigned*)((imgp) + pc_ * 1024 + lane * 16), (LAS unsigned*)(F.lds + SQ_BUF + (bufi) * SI_IMG + pc_ * 1024), 16, 0, 0); } while (0)
#define SSD_LOADXT(dst, imgp) do { const bf16* xb_ = (const bf16*)((imgp) + SI_XT); _Pragma("unroll") for (int nt = 0; nt < 2; ++nt) _Pragma("unroll") for (int ks = 0; ks < 2; ++ks) \
        dst[nt][ks] = *(const GAS v4u*)(xb_ + (prow + 16 * nt + l15) * 64 + 32 * ks + 8 * quad); } while (0)
    PROF_BEGIN(5);
    SSD_STAGE(img0, 0);
    v4u xt[2][2];
    SSD_LOADXT(xt, img0);
    v4u zr[4];
    { const GAS v4u* zp = (const GAS v4u*)(ZGp + (size_t)(row0 + lane) * NZG + 1024 + head * 64 + 32 * ph);
#pragma unroll
      for (int i = 0; i < 4; ++i) zr[i] = zp[i]; }
    const float nw0 = F.A.in[20][head * 64 + 32 * ph + l15], nw1 = F.A.in[20][head * 64 + 32 * ph + 16 + l15];
    for (int c = 0; c < nchunk; ++c) {
        asm volatile("" : "+v"(lane)); quad = lane >> 4; l15 = lane & 15;
        PROF_BEGIN(6);
        asm volatile("s_waitcnt vmcnt(0)" ::: "memory");
        __syncthreads();
        PROF_END(6);
        PROF_BEGIN(7);
        const unsigned char* img = img0 + (size_t)c * SI_STRIDE;
        const int r0 = row0 + 64 * c;
        v4u xtn[2][2];
        if (c + 1 < nchunk) { SSD_STAGE(img + SI_STRIDE, (c + 1) & 1); SSD_LOADXT(xtn, img + SI_STRIDE); }
        else {
#pragma unroll
            for (int nt = 0; nt < 2; ++nt)
#pragma unroll
                for (int ks = 0; ks < 2; ++ks) xtn[nt][ks] = xt[nt][ks]; }
#pragma unroll
        for (int i = 0; i < 4; ++i) *(LAS v4u*)(ZS + lane * 32 + 8 * i) = zr[i];
        if (c + 1 < nchunk) { const GAS v4u* zp = (const GAS v4u*)(ZGp + (size_t)(r0 + 64 + lane) * NZG + 1024 + head * 64 + 32 * ph);
#pragma unroll
          for (int i = 0; i < 4; ++i) zr[i] = zp[i]; }
        const LAS unsigned char* buf = F.lds + SQ_BUF + (c & 1) * SI_IMG;
        const LAS bf16* CS = (const LAS bf16*)(buf + SI_CS); const LAS bf16* BT = (const LAS bf16*)(buf + SI_BT); const LAS bf16* CBS = (const LAS bf16*)(buf + SI_CB);
        const LAS float* gm = (const LAS float*)(buf + SI_GAM) + hl * 64; const LAS float* dv = (const LAS float*)(buf + SI_DT) + hl * 64;
        const float last = gm[63];
        f32x4 y[4][2];
#pragma unroll
        for (int mt = 0; mt < 4; ++mt)
#pragma unroll
            for (int nt = 0; nt < 2; ++nt) y[mt][nt] = (f32x4){0.f, 0.f, 0.f, 0.f};
#pragma unroll
        for (int ks = 0; ks < 4; ++ks) { const bf16x8 hb0 = acc2frag(hacc[2 * ks][0], hacc[2 * ks + 1][0]), hb1 = acc2frag(hacc[2 * ks][1], hacc[2 * ks + 1][1]);
#pragma unroll
            for (int mt = 0; mt < 4; ++mt) { const bf16x8 a = ldfrag(CS, 136, 16 * mt, 32 * ks, lane); y[mt][0] = MFMA16(a, hb0, y[mt][0]); y[mt][1] = MFMA16(a, hb1, y[mt][1]); }
            __builtin_amdgcn_sched_barrier(0); }
#pragma unroll
        for (int mt = 0; mt < 4; ++mt)
#pragma unroll
            for (int r = 0; r < 4; ++r) { const float eg = __expf(gm[16 * mt + 4 * quad + r]); y[mt][0][r] *= eg; y[mt][1][r] *= eg; }
        PROF_END(7);
        PROF_BEGIN(8);
#pragma unroll
        for (int mt = 0; mt < 4; ++mt) { const int i = 16 * mt + l15; const float gi = gm[i], dti = dv[i], ddt = dti > 1e-30f ? Dh * __builtin_amdgcn_rcpf(dti) : 0.f;
#pragma unroll
            for (int ks = 0; ks < 2; ++ks) { if (32 * ks > 16 * mt + 15) continue;
                const v4u aw = __builtin_bit_cast(v4u, ldfrag(CBS, 72, 16 * mt, 32 * ks, lane));
                const f32x4 g0 = *(const LAS f32x4*)(gm + 32 * ks + 8 * quad), g1 = *(const LAS f32x4*)(gm + 32 * ks + 8 * quad + 4);
                float cv[8] = {bflo(aw.x), bfhi(aw.x), bflo(aw.y), bfhi(aw.y), bflo(aw.z), bfhi(aw.z), bflo(aw.w), bfhi(aw.w)};
                const float gj[8] = {g0.x, g0.y, g0.z, g0.w, g1.x, g1.y, g1.z, g1.w};
#pragma unroll
                for (int jj = 0; jj < 8; ++jj) { const int j = 32 * ks + 8 * quad + jj; float v = i >= j ? cv[jj] * __expf(gi - gj[jj]) : 0.f; if (i == j) v += ddt; cv[jj] = v; }
                v4u bw; bw.x = pk2(cv[0], cv[1]); bw.y = pk2(cv[2], cv[3]); bw.z = pk2(cv[4], cv[5]); bw.w = pk2(cv[6], cv[7]); const bf16x8 a1 = __builtin_bit_cast(bf16x8, bw);
#pragma unroll
                for (int nt = 0; nt < 2; ++nt) y[mt][nt] = MFMA16(a1, __builtin_bit_cast(bf16x8, xt[nt][ks]), y[mt][nt]); }
            __builtin_amdgcn_sched_barrier(0); }
        PROF_END(8);
        PROF_BEGIN(9);
#pragma unroll
        for (int mt = 0; mt < 4; ++mt)
#pragma unroll
            for (int r = 0; r < 4; ++r) { const int i = 16 * mt + 4 * quad + r; float sq = 0.f;
#pragma unroll
                for (int nt = 0; nt < 2; ++nt) { const float z = bf2f(ZS[i * 32 + 16 * nt + l15]); const float yz = y[mt][nt][r] * siluf_(z); y[mt][nt][r] = yz; sq += yz * yz; }
                sq = row16_sum(sq); if (l15 == 0) PS[i * 8 + w] = sq; }
        PROF_END(9);
        PROF_BEGIN(10);
        {
            const float el = __expf(last);
#pragma unroll
            for (int mt = 0; mt < 8; ++mt)
#pragma unroll
                for (int nt = 0; nt < 2; ++nt) hacc[mt][nt] = hacc[mt][nt] * el;
#pragma unroll
            for (int ks = 0; ks < 2; ++ks) { const f32x4 g0 = *(const LAS f32x4*)(gm + 32 * ks + 8 * quad), g1 = *(const LAS f32x4*)(gm + 32 * ks + 8 * quad + 4);
                const float ed[8] = {__expf(last - g0.x), __expf(last - g0.y), __expf(last - g0.z), __expf(last - g0.w), __expf(last - g1.x), __expf(last - g1.y), __expf(last - g1.z), __expf(last - g1.w)};
                bf16x8 xw[2];
#pragma unroll
                for (int nt = 0; nt < 2; ++nt) { const v4u xv = xt[nt][ks];
                    v4u o; o.x = pk2(bflo(xv.x) * ed[0], bfhi(xv.x) * ed[1]); o.y = pk2(bflo(xv.y) * ed[2], bfhi(xv.y) * ed[3]); o.z = pk2(bflo(xv.z) * ed[4], bfhi(xv.z) * ed[5]); o.w = pk2(bflo(xv.w) * ed[6], bfhi(xv.w) * ed[7]);
                    xw[nt] = __builtin_bit_cast(bf16x8, o); }
#pragma unroll
                for (int mt = 0; mt < 8; ++mt) { const bf16x8 a = ldfrag(BT, 72, 16 * mt, 32 * ks, lane); hacc[mt][0] = MFMA16(a, xw[0], hacc[mt][0]); hacc[mt][1] = MFMA16(a, xw[1], hacc[mt][1]); }
                __builtin_amdgcn_sched_barrier(0); }
        }
        PROF_END(10);
        PROF_BEGIN(11);
        __syncthreads();
        { const f32x4 p0 = *(const LAS f32x4*)(PS + lane * 8), p1 = *(const LAS f32x4*)(PS + lane * 8 + 4);
          RS[lane] = rsqrtf((((p0.x + p0.y) + (p0.z + p0.w)) + ((p1.x + p1.y) + (p1.z + p1.w))) * (1.f / 256.f) + EPS); }
#pragma unroll
        for (int mt = 0; mt < 4; ++mt) { const f32x4 rs4 = *(const LAS f32x4*)(RS + 16 * mt + 4 * quad);
#pragma unroll
            for (int r = 0; r < 4; ++r) { const int i = 16 * mt + 4 * quad + r;
#pragma unroll
                for (int nt = 0; nt < 2; ++nt) ZS[i * 32 + 16 * nt + l15] = (bf16)f2bf(y[mt][nt][r] * rs4[r] * (nt ? nw1 : nw0)); } }
        { GAS v4u* op = (GAS v4u*)(YS + (size_t)(r0 + lane) * 2048 + head * 64 + 32 * ph);
#pragma unroll
          for (int i = 0; i < 4; ++i) op[i] = *(const LAS v4u*)(ZS + lane * 32 + 8 * i); }
        PROF_END(11);
#pragma unroll
        for (int nt = 0; nt < 2; ++nt)
#pragma unroll
            for (int ks = 0; ks < 2; ++ks) xt[nt][ks] = xtn[nt][ks];
    }
    PROF_END(5);
#undef SSD_STAGE
#undef SSD_LOADXT
    {
        float* so = (dry ? (float*)(F.ws + WS_T1) : F.out) + (samp ? O_SS : O_SP) - (dry ? O_GP : 0) + (size_t)(bb * SH + head) * SN * SP;
#pragma unroll
        for (int mt = 0; mt < 8; ++mt)
#pragma unroll
            for (int nt = 0; nt < 2; ++nt)
#pragma unroll
                for (int r = 0; r < 4; ++r) so[(size_t)(16 * mt + 4 * quad + r) * SP + 32 * ph + 16 * nt + l15] = hacc[mt][nt][r];
    }
    __syncthreads();
}
#ifndef SCAN_REP_GDN
#define SCAN_REP_GDN 0
#endif
#ifndef SCAN_REP_SSD
#define SCAN_REP_SSD 0
#endif
__device__ __forceinline__ void scan_job(Frame& F, int s, int j) {
    if (j < 32) {
#if SCAN_REP_GDN
        gdn_seq_job(F, s, false, j >> 3, j & 7, true);
#endif
        gdn_seq_job(F, s, false, j >> 3, j & 7);
    } else if (j < 64) {
#if SCAN_REP_SSD
        ssd_seq_job(F, s, false, (j - 32) >> 3, (j - 32) & 7, true);
#endif
        ssd_seq_job(F, s, false, (j - 32) >> 3, (j - 32) & 7);
    } else if (j < 128) gdn_seq_job(F, s, true, (j - 64) >> 3, (j - 64) & 7);
    else ssd_seq_job(F, s, true, (j - 128) >> 3, (j - 128) & 7);
}
__device__ __forceinline__ void phase_scan(Frame& F, int s) {
    const int njobs = s == DSLAB ? 192 : 64;
    for (int j = F.bid; j < njobs; j += F.G) scan_job(F, s, j);
}
#define XB_TMO      128
#define XB_XCNT(j)  (256  + 64 * (j))
#define XB_XSUB(j)  (1280 + 64 * (j))
#define XB_XGEN(j)  (2304 + 64 * (j))
#define XB_TOP      3328
#define XB_TOPGEN   3392
#define XCD_BAR_WORDS 3456
#define XB_SPIN_CAP (1u << 18)
__device__ __forceinline__ unsigned xb_ld(unsigned* p)              { return __hip_atomic_load(p, __ATOMIC_RELAXED, __HIP_MEMORY_SCOPE_AGENT); }
__device__ __forceinline__ unsigned xb_add(unsigned* p, unsigned v) { return __hip_atomic_fetch_add(p, v, __ATOMIC_RELAXED, __HIP_MEMORY_SCOPE_AGENT); }
__device__ __forceinline__ unsigned xb_xcc_id() { return (unsigned)__builtin_amdgcn_s_getreg((3 << 11) | 20) & 0xFu; }
#define XB_SPIN(cond, bar) do { unsigned _sp = 0; while (cond) { __builtin_amdgcn_s_sleep(1); \
    if ((++_sp & 255u) == 0u) { if (xb_ld(&(bar)[XB_TMO])) break; if (_sp > XB_SPIN_CAP) { atomicAdd(&(bar)[XB_TMO], 1u); break; } } } } while (0)
struct XcdBarrier { unsigned* bar; unsigned x; volatile LAS unsigned* st; };
__device__ __forceinline__ XcdBarrier xcd_barrier_post(unsigned* bar, volatile LAS unsigned* st) {
    XcdBarrier b; b.bar = bar; b.x = xb_xcc_id(); b.st = st;
    if (threadIdx.x == 0) (void)xb_add(&bar[XB_XCNT(b.x)], 1u);
    return b;
}
__device__ __forceinline__ void xcd_barrier_complete(unsigned* bar, unsigned x, unsigned& nloc, unsigned& nx) {
    const unsigned G = gridDim.x * gridDim.y * gridDim.z;
    unsigned sum, cnt, mine, sp = 0u;
    for (;;) {
        sum = 0u; cnt = 0u; mine = 0u;
#pragma unroll
        for (unsigned j = 0; j < 16; ++j) { const unsigned c = xb_ld(&bar[XB_XCNT(j)]); sum += c; cnt += (c > 0u) ? 1u : 0u; mine = (j == x) ? c : mine; }
        if (sum == G) break;
        __builtin_amdgcn_s_sleep(1);
        if ((++sp & 255u) == 0u) { if (xb_ld(&bar[XB_TMO])) break; if (sp > XB_SPIN_CAP) { atomicAdd(&bar[XB_TMO], 1u); break; } }
    }
    nloc = mine > 0u ? mine : 1u; nx = cnt > 0u ? cnt : 1u;
}
__device__ __forceinline__ void xcd_barrier(const XcdBarrier& b) {
    asm volatile("s_waitcnt vmcnt(0)" ::: "memory");
    __syncthreads();
    if (threadIdx.x == 0) {
        unsigned* bar = b.bar;
        __builtin_amdgcn_s_waitcnt(0);
        unsigned nloc = b.st[0], nx = b.st[1];
        if (nloc == 0u) { xcd_barrier_complete(bar, b.x, nloc, nx); b.st[0] = nloc; b.st[1] = nx; }
        const unsigned old = xb_add(&bar[XB_XSUB(b.x)], 1u);
        const unsigned gen = old / nloc;
        if (old + 1u == (gen + 1u) * nloc) {
            __builtin_amdgcn_fence(__ATOMIC_RELEASE, "agent");
            asm volatile("s_waitcnt vmcnt(0)" ::: "memory");
            const unsigned og = xb_add(&bar[XB_TOP], 1u);
            const unsigned tg = og / nx;
            if (og + 1u == (tg + 1u) * nx) xb_add(&bar[XB_TOPGEN], 1u);
            else XB_SPIN(xb_ld(&bar[XB_TOPGEN]) == tg, bar);
            __builtin_amdgcn_fence(__ATOMIC_ACQUIRE, "agent");
            xb_add(&bar[XB_XGEN(b.x)], 1u);
            asm volatile("s_waitcnt vmcnt(0)" ::: "memory");
        } else {
            XB_SPIN(xb_ld(&bar[XB_XGEN(b.x)]) == gen, bar);
            __builtin_amdgcn_fence(__ATOMIC_ACQUIRE, "agent");
            asm volatile("s_waitcnt vmcnt(0)" ::: "memory");
        }
    }
    __syncthreads();
}
constexpr int CW_BAR = 4096;
#ifndef PHASE_MASK
#define PHASE_MASK 0xFFF
#endif
#define PM(k) ((PHASE_MASK >> (k)) & 1)
#ifndef GEMM_REPS
#define GEMM_REPS 1
#endif
#ifndef LIGHT_REPS
#define LIGHT_REPS 1
#endif
#ifndef BAR_REPS
#define BAR_REPS 1
#endif
#ifndef PROF_MAX
#define PROF_MAX 0
#endif
#ifndef PROF_PH
#define PROF_PH 0
#endif
#ifndef PROF_ONLY_PH
#define PROF_ONLY_PH -1
#endif
#ifndef GU_STEADY
#define GU_STEADY 2
#endif
#ifndef GSPLIT_P0
#define GSPLIT_P0 18
#endif
#ifndef GU1_P0
#define GU1_P0 18
#endif
#ifndef PRE_REPS
#define PRE_REPS 1
#endif

#define GEMM_PHASE(EPI_T, APTR, BOFF, N_, K_, ...) do { pg8::Gemm g{(const pg8::bf16_t*)(APTR), (const pg8::bf16_t*)(F.ws + (BOFF)), R, (N_), (K_), (K_)}; \
    pg8::ListOrder S; S.init(R, (N_), j0, j1, j1 > 1 ? 8 : 1); epi::EPI_T E{__VA_ARGS__}; pg8::gemm_phase<epi::EPI_T, pg8::ListOrder, true, true>(F.lds, g, S, E, F.tid); if (GEMM_REPS > 1) { __syncthreads(); pg8::gemm_phase<epi::EPI_T, pg8::ListOrder, true, true>(F.lds, g, S, E, F.tid); } } while (0)
#define GP(name, s) GENP(ws, WS_##name, SZ_##name, G_##name, s)
__device__ __forceinline__ void stage_inproj(Frame& F, int s, int j0, int j1) { unsigned char* ws = F.ws; const int R = slab_rows(s);
    GEMM_PHASE(EpiProj, GP(HB, s), WS_WIN, NIN, D, (bf16*)GP(XC, s), (bf16*)GP(ZG, s), (bf16*)GP(GT, s), (float*)GP(SM, s)); }
__device__ __forceinline__ void stage_gate(Frame& F, int s, int j0, int j1) { unsigned char* ws = F.ws; const int R = slab_rows(s);
    GEMM_PHASE(EpiGate1, GP(OG, s), WS_WG, D, D, (const bf16*)GP(GT, s), (float*)GP(T1, s));
    __syncthreads();
    GEMM_PHASE(EpiGate2, GP(YS, s), WS_WS, D, 2048, (const bf16*)GP(GT, s), (const float*)GP(T1, s), (bf16*)GP(MIX, s), F.lds); }
__device__ __forceinline__ void stage_out(Frame& F, int s, int j0, int j1) { unsigned char* ws = F.ws; const int R = slab_rows(s);
    GEMM_PHASE(EpiOut, GP(MIX, s), WS_WOUT, D, D, F.A.in[0], F.A.in[1], (const float*)(ws + WS_MODV), (const float*)(ws + WS_G2), F.out + O_YP, F.out + O_YS, (bf16*)GP(X1G, s), (float*)GENP(ws, WS_SS1, SZ_SS, G_SS, s), s, F.lds, &F.prof); }
__device__ __forceinline__ void stage_up(Frame& F, int s, int j0, int j1) { unsigned char* ws = F.ws; const int R = slab_rows(s);
    GEMM_PHASE(EpiUp, GP(X1G, s), WS_WUP, NUP, D, (const float*)GENP(ws, WS_SS1, SZ_SS, G_SS, s), (const float*)(ws + WS_SHW), (bf16*)GP(U, s)); }
constexpr int CW_GFLAG = 65536;
__device__ __forceinline__ void gate_set_flag(Frame& F, gu32* flag) {
    asm volatile("s_waitcnt vmcnt(0)" ::: "memory"); __syncthreads();
    if (F.tid == 0) { __builtin_amdgcn_fence(__ATOMIC_RELEASE, "agent"); __hip_atomic_store(flag, 1u, __ATOMIC_RELAXED, __HIP_MEMORY_SCOPE_AGENT); }
}
__device__ __forceinline__ void stage_gate_split(Frame& F, int s, int p, int T) { unsigned char* ws = F.ws; const int R = slab_rows(s); const int nun = (R / 256) * 4, part = T / nun, j = T % nun;
    gu32* flA = F.ctl + CW_GFLAG + ((p * 2 + 0) * 64 + j) * 32; gu32* flB = F.ctl + CW_GFLAG + ((p * 2 + 1) * 64 + j) * 32;
    if (part == 0) { pg8::Gemm g{(const pg8::bf16_t*)GP(OG, s), (const pg8::bf16_t*)(ws + WS_WG), R, D, D, D};
        pg8::ListOrder S; S.init(R, D, j, 1); epi::EpiGate1 E{(const bf16*)GP(GT, s), (float*)GP(T1, s)}; pg8::gemm_phase<epi::EpiGate1, pg8::ListOrder, true, true>(F.lds, g, S, E, F.tid); gate_set_flag(F, flA); }
    else { const int ko = part == 2 ? 1024 : 0; pg8::Gemm g{(const pg8::bf16_t*)GP(YS, s) + ko, (const pg8::bf16_t*)(ws + WS_WS) + ko, R, D, 1024, 2048};
        pg8::ListOrder S; S.init(R, D, j, 1); epi::EpiGate2S E{(const bf16*)GP(GT, s), (const float*)GP(T1, s), part == 1 ? (float*)GP(T1, s) : (float*)nullptr, (bf16*)GP(MIX, s), (const unsigned*)(part == 1 ? flA : flB)};
        pg8::gemm_phase<epi::EpiGate2S, pg8::ListOrder, true, true>(F.lds, g, S, E, F.tid); if (part == 1) gate_set_flag(F, flB); } }
__device__ __forceinline__ void stage_down(Frame& F, int s, int j, int nper) { unsigned char* ws = F.ws; const int R = slab_rows(s); constexpr int KP = DFF / 2;
    if (j < nper) { pg8::Gemm g{(const pg8::bf16_t*)GP(ACT, s), (const pg8::bf16_t*)(ws + WS_WDN), R, D, KP, DFF};
        pg8::ListOrder S; S.init(R, D, j, 1); epi::EpiDown0 E{(const float*)(ws + WS_MODV), F.out + O_YP, F.out + O_YS, s}; pg8::gemm_phase<epi::EpiDown0, pg8::ListOrder, true, true>(F.lds, g, S, E, F.tid); }
    else { pg8::Gemm g{(const pg8::bf16_t*)GP(ACT, s) + KP, (const pg8::bf16_t*)(ws + WS_WDN) + KP, R, D, KP, DFF};
        pg8::ListOrder S; S.init(R, D, j - nper, 1); epi::EpiDown1 E{(float*)GP(PD, s)}; pg8::gemm_phase<epi::EpiDown1, pg8::ListOrder, true, true>(F.lds, g, S, E, F.tid); } }
constexpr int NSTAGE = 10, NPHASE = NSLAB + NSTAGE - 1, NSTEPS = 1 + NPHASE;
constexpr int CW_TICKET = 16384;
#define SV(k) ((p - (k)) >= 0 && (p - (k)) < NSLAB)
__device__ __forceinline__ int rup8(int n) { return (n + 7) & ~7; }
__device__ __forceinline__ void run_phase(Frame& F, int p) {
    const int n_scan = SV(3) ? ((p - 3) == DSLAB ? 192 : 64) : 0;
    const int nper_dn = SV(8) ? rup8((slab_rows(p - 8) / 256) * 4) : 0, n_dn = 2 * nper_dn;
    const bool gsplit = p >= GSPLIT_P0; const int n_g2 = SV(4) ? (gsplit ? 3 * ((slab_rows(p - 4) / 256) * 4) : rup8((slab_rows(p - 4) / 256) * 4)) : 0;
    const int n_gp = SV(2) ? ((p - 2) == DSLAB ? GDN_ITEMS : NCH * NB * GH) / 2 : 0;
    const int GA = p >= 4 ? 4 : 1; const int GU = p >= GU1_P0 ? 1 : GU_STEADY;
    const int n_in = SV(1) ? 8 * (((((slab_rows(p - 1) / 256) * (NIN / 256) + 7) / 8) + GA - 1) / GA) : 0;
    const int n_up = SV(6) ? 8 * (((((slab_rows(p - 6) / 256) * (NUP / 256) + 7) / 8) + GU - 1) / GU) : 0;
    const int n_g1 = 0;
    const int n_ou = SV(5) ? rup8((slab_rows(p - 5) / 256) * 4) : 0;
    const int n_sp = SV(2) ? ((p - 2) == DSLAB ? SSD_ITEMS : NCH * NB * SG) : 0;
    constexpr int P_CA = 256, P_N1 = 128, P_FI = 128, P_MC = 16, P_P1 = 88, P_CV = 512;
    const int n_ca = SV(7) ? slab_rows(p - 7) / 8 : 0, n_n1 = SV(0) ? P_N1 : 0, n_fi = SV(9) ? P_FI : 0, n_mc = SV(2) ? P_MC : 0, n_p1 = p == 1 ? P_P1 : 0, n_cv = p == 0 ? P_CV : 0;
    const int oA = n_scan + n_ou;
    const int o1 = n_scan, o2 = oA + n_dn, o3 = o2 + n_g2, o4 = o3 + n_gp, o5 = o4 + n_in, o6 = o5 + n_up, o7 = o6 + n_g1, o8 = o7, o9 = o8 + n_sp,
              o10 = o9 + n_ca, o11 = o10 + n_n1, o12 = o11 + n_fi, o13 = o12 + n_mc, o14 = o13 + n_p1, total = o14 + n_cv;
    const int label = F.bid & 7;
    gu32* ctr = F.ctl + CW_TICKET + (p * 8 + label) * 64;
    volatile LAS unsigned* slot = F.MISC + 16;
    PROF_BEGIN(12);
#define NEXT_TASK(T_, it_) do { if (F.tid == 0) slot[(it_) & 1] = __hip_atomic_fetch_add(ctr, 1u, __ATOMIC_RELAXED, __HIP_MEMORY_SCOPE_AGENT); __syncthreads(); \
        T_ = (int)__builtin_amdgcn_readfirstlane(slot[(it_) & 1]) * 8 + label; } while (0)
    int T, it = 0;
    NEXT_TASK(T, it);
    while (T < total) {
        { int t_ = F.tid; unsigned char* w_ = F.ws; float* o_ = F.out; asm volatile("" : "+v"(t_), "+s"(w_), "+s"(o_));
          F.tid = t_; F.lane = t_ & 63; F.wave = __builtin_amdgcn_readfirstlane(t_ >> 6); F.ws = w_; F.out = o_; }
        const int kind_ = T < o1 ? 20 : T < oA ? 27 : T < o2 ? 21 : T < o3 ? 22 : T < o4 ? 23 : T < o5 ? 24 : T < o6 ? 25 : T < o7 ? 26 : T < o8 ? 27 : T < o9 ? 28 : 30;
        unsigned long long tk0_ = 0; if (PROF_SEL >= 20 && PROF_SEL <= 30) tk0_ = __builtin_amdgcn_s_memrealtime();
        if (T < o1) scan_job(F, p - 3, T);
        else if (T < oA) stage_out(F, p - 5, T - o1, 1);
        else if (T < o2) stage_down(F, p - 8, T - oA, nper_dn);
        else if (T < o3) { if (gsplit) stage_gate_split(F, p - 4, p, T - o2); else stage_gate(F, p - 4, T - o2, 1); }
        else if (T < o4) gdn_pre_pair(F, p - 2, T - o3);
        else if (T < o5) stage_inproj(F, p - 1, ((T - o4) & 7) + 8 * GA * ((T - o4) >> 3), GA);
        else if (T < o6) stage_up(F, p - 6, ((T - o5) & 7) + 8 * GU * ((T - o5) >> 3), GU);
        else if (T < o7) { }
        else if (T < o9) ssd_pre_item(F, p - 2, T - o8);
        else if (T < o10) phase_convact(F, p - 7, T - o9, n_ca);
        else if (T < o11) phase_norm1(F, p, T - o10, P_N1);
        else if (T < o12) phase_final(F, p - 9, T - o11, P_FI);
        else if (T < o13) phase_mix_carry(F, p - 2, T - o12, P_MC);
        else if (T < o14) phase_prologue1(F, T - o13, P_P1);
        else phase_convert_rest(F, T - o14, P_CV);
        if (PROF_SEL >= 20 && PROF_SEL <= 30 && kind_ == PROF_SEL && (PROF_ONLY_PH < 0 || p == PROF_ONLY_PH)) F.prof += __builtin_amdgcn_s_memrealtime() - tk0_;
        ++it; { PROF_BEGIN(29); NEXT_TASK(T, it); PROF_END(29); }
    }
#undef NEXT_TASK
    PROF_END(12);
}
__device__ __forceinline__ void run_step(Frame& F, int st) {
    if (st == 0) { PROF_BEGIN(17); phase_prologue0(F); PROF_END(17); return; }
    run_phase(F, st - 1);
}
__global__ void __launch_bounds__(NTHR, 2) mk_fwd(Args a) {
    extern __shared__ __attribute__((aligned(16))) unsigned char lds[];
    Frame F(a); F.prof = 0;
    F.lds = (LAS unsigned char*)lds; F.MISC = (volatile LAS unsigned*)(F.lds + MISC_OFF);
    F.tid = threadIdx.x; F.lane = F.tid & 63; F.wave = __builtin_amdgcn_readfirstlane(F.tid >> 6); F.G = gridDim.x; F.bid = blockIdx.x;
    F.out = a.out; F.ws = a.ws; F.ctl = (gu32*)(a.ws + WS_CTL);
    for (int u = F.tid; u < (LDS_BYTES - LDSCTL_OFF) / 4; u += NTHR) ((LAS unsigned*)(F.lds + LDSCTL_OFF))[u] = 0u;
    __syncthreads();
    XcdBarrier bar; bar.bar = (unsigned*)(F.ctl + CW_BAR); bar.x = 0; bar.st = nullptr;
    const bool multi = (a.ph_hi - a.ph_lo) > 1;
    if (multi) bar = xcd_barrier_post((unsigned*)(F.ctl + CW_BAR), F.MISC + 8);
    for (int st = a.ph_lo; st < a.ph_hi; ++st) {
        { int t_ = threadIdx.x, b_ = blockIdx.x; unsigned char* w_ = a.ws; float* o_ = a.out; asm volatile("" : "+v"(t_), "+s"(b_), "+s"(w_), "+s"(o_));
          F.tid = t_; F.lane = t_ & 63; F.wave = __builtin_amdgcn_readfirstlane(t_ >> 6); F.bid = b_; F.ws = w_; F.out = o_; }
        unsigned long long tph_ = 0; if (PROF_SEL >= 39) tph_ = __builtin_amdgcn_s_memrealtime();
        run_step(F, st);
        if (st + 1 < a.ph_hi) { if (st == a.ph_lo) cooperative_groups::this_grid().sync(); else { PROF_BEGIN(16); xcd_barrier(bar); if (BAR_REPS > 1) xcd_barrier(bar); PROF_END(16); } }
        if (PROF_SEL == 39 && st - 1 == PROF_PH) F.prof += __builtin_amdgcn_s_memrealtime() - tph_;
        if (PROF_SEL >= 40) { const int ph_ = st - 1; const int grp_ = st < 1 ? 0 : ph_ < 4 ? 1 : ph_ < 10 ? 2 : ph_ < 16 ? 3 : ph_ < 20 ? 4 : 5; if (PROF_SEL - 40 == grp_) F.prof += __builtin_amdgcn_s_memrealtime() - tph_; }
    }
    if (PROF_SEL != 0) {
#if PROF_MAX
        if (F.tid == 0) __hip_atomic_fetch_max((unsigned long long*)(F.ctl + 8192), F.prof * F.G, __ATOMIC_RELAXED, __HIP_MEMORY_SCOPE_AGENT);
#else
        if (F.tid == 0) __hip_atomic_fetch_add((unsigned long long*)(F.ctl + 8192), F.prof, __ATOMIC_RELAXED, __HIP_MEMORY_SCOPE_AGENT);
#endif
        xcd_barrier(bar);
        const unsigned long long tot = __hip_atomic_load((unsigned long long*)(F.ctl + 8192), __ATOMIC_RELAXED, __HIP_MEMORY_SCOPE_AGENT);
        const unsigned long long t0 = __builtin_amdgcn_s_memrealtime(), dur = tot * PROF_MULT / F.G; while (__builtin_amdgcn_s_memrealtime() - t0 < dur) __builtin_amdgcn_s_sleep(8); }
}
#ifndef MK_SINGLE
#define MK_SINGLE 1
#endif
extern "C" void kernel_launch(void* const* d_in, const int* in_sizes, int n_in, void* d_out, int out_size, void* d_ws, size_t ws_size, hipStream_t stream) {
    static int grid = 0;
    if (grid == 0) {
        if (n_in != 30 || (size_t)out_size != O_END || ws_size < WS_END) { fprintf(stderr, "kernel_launch: unexpected shapes: n_in %d out %d ws %zu (need %zu)\n", n_in, out_size, ws_size, (size_t)WS_END); grid = -1; return; }
        int dev = 0, cus = 0;
        if (hipGetDevice(&dev) != hipSuccess || hipDeviceGetAttribute(&cus, hipDeviceAttributeMultiprocessorCount, dev) != hipSuccess) { grid = -1; return; }
        if (hipFuncSetAttribute((const void*)mk_fwd, hipFuncAttributeMaxDynamicSharedMemorySize, LDS_BYTES) != hipSuccess) { fprintf(stderr, "kernel_launch: hipFuncSetAttribute failed\n"); grid = -1; return; }
        int per_cu = 0;
        if (hipOccupancyMaxActiveBlocksPerMultiprocessor(&per_cu, (const void*)mk_fwd, NTHR, LDS_BYTES) != hipSuccess || per_cu < 1) fprintf(stderr, "kernel_launch: occupancy query says %d\n", per_cu);
        (void)hipGetLastError();
        grid = cus * (per_cu < 1 ? 1 : per_cu);
    }
    if (grid < 0) return;
    (void)hipMemsetAsync((char*)d_ws + WS_CTL, 0, CTL_ZERO_BYTES, stream);
    Args a{};
    for (int i = 0; i < 30; ++i) a.in[i] = (const float*)d_in[i];
    a.out = (float*)d_out; a.ws = (unsigned char*)d_ws;
#if MK_SINGLE
    a.ph_lo = 0; a.ph_hi = NSTEPS;
    void* kargs[] = {(void*)&a};
    hipError_t le = hipLaunchCooperativeKernel((const void*)mk_fwd, dim3(grid), dim3(NTHR), kargs, LDS_BYTES, stream);
    if (le != hipSuccess) fprintf(stderr, "kernel_launch: cooperative launch failed: %s (grid %d)\n", hipGetErrorString(le), grid);
#else
    for (int st = 0; st < NSTEPS; ++st) { a.ph_lo = st; a.ph_hi = st + 1; hipLaunchKernelGGL(mk_fwd, dim3(grid), dim3(NTHR), LDS_BYTES, stream, a); }
#endif
}
```

```cpp
#include <hip/hip_runtime.h>
#include <hip/hip_cooperative_groups.h>
#include <cstdio>
#include <cstdint>

namespace pg8 {
#define PG8_LAS __attribute__((address_space(3)))
typedef unsigned short bf16_t;
typedef short bf16x8 __attribute__((ext_vector_type(8)));
typedef float f32x4 __attribute__((ext_vector_type(4)));
typedef unsigned u32x4 __attribute__((ext_vector_type(4)));
typedef unsigned u32x2 __attribute__((ext_vector_type(2)));
constexpr int BM = 256, BK = 64, HALF = 128, HTB = HALF * BK * 2, STAGE_BYTES = 8 * HTB, NXCD = 8, WGM = 8;

__host__ __device__ __forceinline__ int lds_byte(int r, int c) { const int st = (r >> 4) * 2 + (c >> 5), rr = r & 15, cc = c & 31, ob = rr * 64 + cc * 2; return st * 1024 + (ob ^ (((ob >> 9) & 1) << 5)); }
__host__ __device__ __forceinline__ void stage_rc(int b, int& R, int& C) { const int st = b / 1024, sb = b % 1024, swz = sb ^ (((sb >> 9) & 1) << 5); R = (st >> 1) * 16 + swz / 64; C = (st & 1) * 32 + (swz % 64) / 2; }
__host__ __device__ __forceinline__ int perm32(int rho) { const int n = rho >> 4, i = rho & 15; return 8 * (i >> 2) + 4 * n + (i & 3); }

struct Unit { int pm, pn; };
struct Gemm { const bf16_t* A; const bf16_t* Bt; int M, N, K, ld; };

struct StaticOrder {
    int nM, nN, nwg, G, c;
    __host__ __device__ void init(int M, int N, int G_, int c_) { nM = M / BM; nN = N / BM; nwg = nM * nN; G = G_; c = c_; }
    __host__ __device__ bool next(int i, Unit& u) const {
        const long L = (long)i * G + c; if (L >= nwg) return false;
        int wgid = (int)L; { const int q = nwg / NXCD, r = nwg % NXCD, xcd = wgid % NXCD, off = wgid / NXCD; wgid = (xcd < r ? xcd * (q + 1) : r * (q + 1) + (xcd - r) * q) + off; }
        const int nig = WGM * nN, gid = wgid / nig, fm = gid * WGM, gsz = (nM - fm) < WGM ? (nM - fm) : WGM;
        u.pm = fm + ((wgid % nig) % gsz); u.pn = (wgid % nig) / gsz; return true;
    }
    __device__ __forceinline__ void a_ready(const Unit&) const {}
    __device__ __forceinline__ void done(const Unit&) const {}
};

typedef float f32x2_t __attribute__((ext_vector_type(2))); typedef __bf16 bf16x2_t __attribute__((ext_vector_type(2)));
struct ListOrder {
    int nM, nN, nwg, j0, n, st;
    __host__ __device__ void init(int M, int N, int j0_, int n_, int st_ = 1) { nM = M / BM; nN = N / BM; nwg = nM * nN; j0 = j0_; n = n_; st = st_; }
    __host__ __device__ bool next(int i, Unit& u) const {
        const int L = j0 + i * st; if (i >= n || L < 0 || L >= nwg) return false;
        int wgid = L; { const int q = nwg / NXCD, r = nwg % NXCD, xcd = wgid % NXCD, off = wgid / NXCD; wgid = (xcd < r ? xcd * (q + 1) : r * (q + 1) + (xcd - r) * q) + off; }
        const int nig = WGM * nN, gid = wgid / nig, fm = gid * WGM, gsz = (nM - fm) < WGM ? (nM - fm) : WGM;
        u.pm = fm + ((wgid % nig) % gsz); u.pn = (wgid % nig) / gsz; return true;
    }
    __device__ __forceinline__ void a_ready(const Unit&) const {}
    __device__ __forceinline__ void done(const Unit&) const {}
};
__device__ __forceinline__ unsigned cvt_pk_bf16(float lo, float hi) { f32x2_t v = {lo, hi}; bf16x2_t b = __builtin_convertvector(v, bf16x2_t); return __builtin_bit_cast(unsigned, b); }

template <class Epi, class Sched, bool ALIGN_EPI = false, bool SP2 = false>
__device__ __forceinline__ void gemm_phase(PG8_LAS unsigned char* lds, const Gemm g, const Sched& S, const Epi& E, const int tid) {
    const int wid = __builtin_amdgcn_readfirstlane(tid >> 6), lane = tid & 63, wr = wid >> 2, wc = wid & 3, fr = lane & 15, fq = lane >> 4;
    const int K = g.K, nt = K / BK, LD = g.ld;
    unsigned voffA[2], voffB[2];
#pragma unroll
    for (int i = 0; i < 2; ++i) { int R, C; stage_rc(tid * 16 + i * 8192, R, C); const int Rb = Epi::PERM ? ((R & ~31) + perm32(R & 31)) : R;
        voffA[i] = (unsigned)(R * LD + C) * 2u; voffB[i] = (unsigned)(Rb * LD + C) * 2u; }
    const size_t kstep = (size_t)(BK * 2);
    const size_t hstep = (size_t)HALF * LD * 2;
    const size_t tstep = 2 * hstep;
    const unsigned ldsw = (unsigned)wid * 1024u;
    const int aoff = lds_byte(wr * 64 + fr, fq * 8), boff = lds_byte(wc * 32 + fr, fq * 8);
#define PG8_SA(b, h) (((b) * 2 + (h)) * HTB)
#define PG8_SB(b, h) ((4 + (b) * 2 + (h)) * HTB)
#define PG8_STAGE(bufoff, gbase, voff) do { _Pragma("unroll") for (int _i = 0; _i < 2; ++_i) \
        __builtin_amdgcn_global_load_lds((const unsigned*)((const char*)(gbase) + (voff)[_i]), (PG8_LAS unsigned*)(lds + (bufoff) + ldsw + _i * 8192), 16, 0, 0); } while (0)
#define PG8_LDA(dst, b, h) do { _Pragma("unroll") for (int m = 0; m < 4; ++m) _Pragma("unroll") for (int k = 0; k < 2; ++k) dst[m][k] = *(const PG8_LAS bf16x8*)(lds + PG8_SA(b, h) + aoff + m * 2048 + k * 1024); } while (0)
#define PG8_LDB(dst, b, h) do { _Pragma("unroll") for (int n = 0; n < 2; ++n) _Pragma("unroll") for (int k = 0; k < 2; ++k) dst[n][k] = *(const PG8_LAS bf16x8*)(lds + PG8_SB(b, h) + boff + n * 2048 + k * 1024); } while (0)
#define PG8_MMA(ai, bj, At, Bt) do { __builtin_amdgcn_s_setprio(1); _Pragma("unroll") for (int m = 0; m < 4; ++m) _Pragma("unroll") for (int n = 0; n < 2; ++n) _Pragma("unroll") for (int k = 0; k < 2; ++k) \
        acc[ai][bj][m][n] = __builtin_amdgcn_mfma_f32_16x16x32_bf16(Bt[n][k], At[m][k], acc[ai][bj][m][n], 0, 0, 0); __builtin_amdgcn_s_setprio(0); } while (0)
#define PG8_WAIT_V(n) asm volatile("s_waitcnt vmcnt(" #n ")" ::: "memory")
#define PG8_WAIT_L(n) asm volatile("s_waitcnt lgkmcnt(" #n ")" ::: "memory")
#define PG8_BAR __builtin_amdgcn_s_barrier()
#define PG8_SCHED __builtin_amdgcn_sched_barrier(0)
    Unit cur, nxt; int ui = 0;
    if (!S.next(0, cur)) return;
    f32x4 acc[2][2][4][2];
#pragma unroll
    for (int a = 0; a < 2; ++a)
#pragma unroll
        for (int b = 0; b < 2; ++b)
#pragma unroll
            for (int m = 0; m < 4; ++m)
#pragma unroll
                for (int n = 0; n < 2; ++n) acc[a][b][m][n] = (f32x4){0.f, 0.f, 0.f, 0.f};
    bf16x8 At[4][2], B0[2][2], B1[2][2];
    const char* cA = (const char*)g.A + (size_t)cur.pm * tstep; const char* cB = (const char*)g.Bt + (size_t)cur.pn * tstep;
    S.a_ready(cur);
    if constexpr (SP2) {
        PG8_STAGE(PG8_SB(0, 0), cB, voffB); PG8_STAGE(PG8_SB(0, 1), cB + hstep, voffB); PG8_STAGE(PG8_SA(0, 0), cA, voffA); PG8_STAGE(PG8_SA(0, 1), cA + hstep, voffA);
        if (wr == 1) PG8_BAR;
        PG8_WAIT_V(2); PG8_BAR;
        PG8_STAGE(PG8_SB(1, 0), cB + kstep, voffB); PG8_STAGE(PG8_SA(1, 0), cA + kstep, voffA); PG8_STAGE(PG8_SB(1, 1), cB + hstep + kstep, voffB);
        PG8_WAIT_V(6); PG8_BAR;
    } else {
        PG8_STAGE(PG8_SB(0, 0), cB, voffB); PG8_STAGE(PG8_SA(0, 0), cA, voffA); PG8_STAGE(PG8_SB(0, 1), cB + hstep, voffB); PG8_STAGE(PG8_SA(0, 1), cA + hstep, voffA);
        if (wr == 1) PG8_BAR;
        PG8_WAIT_V(4); PG8_BAR;
        PG8_STAGE(PG8_SB(1, 0), cB + kstep, voffB); PG8_STAGE(PG8_SA(1, 0), cA + kstep, voffA); PG8_STAGE(PG8_SB(1, 1), cB + hstep + kstep, voffB);
        PG8_WAIT_V(6); PG8_BAR;
    }
    for (;;) {
        const bool has_next = S.next(ui + 1, nxt);
        const char* nA = has_next ? (const char*)g.A + (size_t)nxt.pm * tstep : cA; const char* nB = has_next ? (const char*)g.Bt + (size_t)nxt.pn * tstep : cB;
        for (int t = 0; t < nt; t += 2) {
            const bool last = (t == nt - 2);
            const char* a1 = cA + (size_t)(t + 1) * kstep;
            const char* a2 = last ? nA : cA + (size_t)(t + 2) * kstep; const char* b2 = last ? nB : cB + (size_t)(t + 2) * kstep;
            const char* a3 = a2 + kstep; const char* b3 = b2 + kstep;
            if (last && has_next) S.a_ready(nxt);
            if constexpr (SP2) {
            PG8_LDB(B0, 0, 0); PG8_LDB(B1, 0, 1); PG8_SCHED; PG8_LDA(At, 0, 0); PG8_STAGE(PG8_SA(1, 1), a1 + hstep, voffA);
            PG8_WAIT_V(8); PG8_WAIT_L(0); PG8_BAR; PG8_MMA(0, 0, At, B0); PG8_MMA(0, 1, At, B1); PG8_BAR; PG8_SCHED;
            PG8_LDA(At, 0, 1); PG8_STAGE(PG8_SB(0, 0), b2, voffB); PG8_STAGE(PG8_SB(0, 1), b2 + hstep, voffB); PG8_STAGE(PG8_SA(0, 0), a2, voffA);
            PG8_WAIT_V(8); PG8_WAIT_L(0); PG8_BAR; PG8_MMA(1, 0, At, B0); PG8_MMA(1, 1, At, B1); PG8_BAR; PG8_SCHED;
            PG8_LDB(B0, 1, 0); PG8_LDB(B1, 1, 1); PG8_SCHED; PG8_LDA(At, 1, 0); PG8_STAGE(PG8_SA(0, 1), a2 + hstep, voffA);
            PG8_WAIT_V(8); PG8_WAIT_L(0); PG8_BAR; PG8_MMA(0, 0, At, B0); PG8_MMA(0, 1, At, B1); PG8_BAR; PG8_SCHED;
            PG8_LDA(At, 1, 1); PG8_STAGE(PG8_SB(1, 0), b3, voffB); PG8_STAGE(PG8_SB(1, 1), b3 + hstep, voffB); PG8_STAGE(PG8_SA(1, 0), a3, voffA);
            PG8_WAIT_V(8); PG8_WAIT_L(0); PG8_BAR; PG8_MMA(1, 0, At, B0); PG8_MMA(1, 1, At, B1); PG8_BAR; PG8_SCHED;
            } else {
            PG8_LDB(B0, 0, 0); PG8_SCHED; PG8_LDA(At, 0, 0); PG8_STAGE(PG8_SA(1, 1), a1 + hstep, voffA);
            PG8_WAIT_L(8); PG8_BAR; PG8_WAIT_L(0); PG8_MMA(0, 0, At, B0); PG8_BAR; PG8_SCHED;
            PG8_LDB(B1, 0, 1); PG8_STAGE(PG8_SB(0, 0), b2, voffB);
            PG8_BAR; PG8_WAIT_L(0); PG8_MMA(0, 1, At, B1); PG8_BAR;
            PG8_LDA(At, 0, 1); PG8_STAGE(PG8_SA(0, 0), a2, voffA);
            PG8_BAR; PG8_WAIT_L(0); PG8_MMA(1, 0, At, B0); PG8_BAR; PG8_SCHED;
            PG8_STAGE(PG8_SB(0, 1), b2 + hstep, voffB);
            PG8_WAIT_V(6); PG8_BAR; PG8_MMA(1, 1, At, B1); PG8_BAR;
            PG8_LDB(B0, 1, 0); PG8_SCHED; PG8_LDA(At, 1, 0); PG8_STAGE(PG8_SA(0, 1), a2 + hstep, voffA);
            PG8_WAIT_L(8); PG8_BAR; PG8_WAIT_L(0); PG8_MMA(0, 0, At, B0); PG8_BAR; PG8_SCHED;
            PG8_LDB(B1, 1, 1); PG8_STAGE(PG8_SB(1, 0), b3, voffB);
            PG8_BAR; PG8_WAIT_L(0); PG8_MMA(0, 1, At, B1); PG8_BAR;
            PG8_LDA(At, 1, 1); PG8_STAGE(PG8_SA(1, 0), a3, voffA);
            PG8_BAR; PG8_WAIT_L(0); PG8_MMA(1, 0, At, B0); PG8_BAR; PG8_SCHED;
            PG8_STAGE(PG8_SB(1, 1), b3 + hstep, voffB);
            PG8_WAIT_V(6); PG8_BAR; PG8_MMA(1, 1, At, B1); PG8_BAR;
            }
        }
        if constexpr (ALIGN_EPI) { if (wr == 0) PG8_BAR; }
        E(acc, cur, wr, wc, fr, fq); S.done(cur);
        if (!has_next) break;
#pragma unroll
        for (int a = 0; a < 2; ++a)
#pragma unroll
            for (int b = 0; b < 2; ++b)
#pragma unroll
                for (int m = 0; m < 4; ++m)
#pragma unroll
                    for (int n = 0; n < 2; ++n) acc[a][b][m][n] = (f32x4){0.f, 0.f, 0.f, 0.f};
        cur = nxt; cA = nA; cB = nB; ++ui;
        if constexpr (ALIGN_EPI) { if (wr == 1) PG8_BAR; }
    }
    PG8_WAIT_V(0);
    if constexpr (!ALIGN_EPI) { if (wr == 0) PG8_BAR; }
    PG8_BAR;
#undef PG8_SA
#undef PG8_SB
#undef PG8_STAGE
#undef PG8_LDA
#undef PG8_LDB
#undef PG8_MMA
#undef PG8_WAIT_V
#undef PG8_WAIT_L
#undef PG8_BAR
#undef PG8_SCHED
}
}
constexpr int D = 1024, NB = 4, SEQ = 8192, DB = 8, DSEQ = 64, NMB = NB + DB;
constexpr int GH = 8, GDK = 128, GDV = 128;
constexpr int SH = 32, SP = 64, SN = 128, SG = 8;
constexpr int DFF = 2816, CONV_CH = 7168, IN_COLS = 12336;
constexpr int NPROJ = 12288;
constexpr int NIN = 12544;
constexpr int NUP = 2 * DFF;
constexpr float EPS = 1e-6f;
#ifndef SLAB_T
#define SLAB_T 512
#endif
constexpr int NSLAB = SEQ / SLAB_T, RP = NB * SLAB_T, RS = DB * DSEQ, RMAX = RP + RS;
constexpr size_t O_YP = 0, O_YS = O_YP + (size_t)NB * SEQ * D, O_CMP = O_YS + (size_t)DB * DSEQ * D, O_GP = O_CMP + (size_t)NB * 3 * CONV_CH,
                 O_SP = O_GP + (size_t)NB * GH * GDK * GDV, O_CFP = O_SP + (size_t)NB * SH * SN * SP, O_CMS = O_CFP + (size_t)NB * 2 * NUP,
                 O_GS = O_CMS + (size_t)DB * 3 * CONV_CH, O_SS = O_GS + (size_t)DB * GH * GDK * GDV, O_CFS = O_SS + (size_t)DB * SH * SN * SP,
                 O_END = O_CFS + (size_t)DB * 2 * NUP;
constexpr size_t MiB = 1u << 20;
constexpr size_t WS_CTL = 0, CTL_ZERO_BYTES = 1 * MiB;
constexpr size_t WS_MODV = 1 * MiB;
constexpr size_t WS_G1 = WS_MODV + 512 * 1024;
constexpr size_t WS_G2 = WS_G1 + 64 * 1024;
constexpr size_t WS_SHW = WS_G2 + 64 * 1024;
constexpr size_t WS_CARRY_MIX = 2 * MiB;
constexpr size_t WS_CARRY_FFN = 3 * MiB;
constexpr size_t WS_WIN = 4 * MiB;
constexpr size_t WS_WG = WS_WIN + (size_t)NIN * D * 2;
constexpr size_t WS_WS = WS_WG + (size_t)D * D * 2;
constexpr size_t WS_WOUT = WS_WS + (size_t)D * 2048 * 2;
constexpr size_t WS_WUP = WS_WOUT + (size_t)D * D * 2;
constexpr size_t WS_WDN = WS_WUP + (size_t)NUP * D * 2;
constexpr size_t WS_SLAB = 56 * MiB;
static_assert(WS_WDN + (size_t)D * DFF * 2 <= WS_SLAB, "weights fit");
constexpr int NXC = 7168, NZG = 3072, NGT = 2048, NCH = SLAB_T / 64;
constexpr int GI_STRIDE_C = 62464 + 32768 + 256, SI_STRIDE_C = 47104 + 32768, GDN_ITEMS = NCH * NB * GH + DB * GH, SSD_ITEMS = NCH * NB * SG + DB * SG;
constexpr size_t SZ_HB = (size_t)RMAX * D * 2, SZ_XC = (size_t)RMAX * NXC * 2, SZ_ZG = (size_t)RMAX * NZG * 2, SZ_GT = (size_t)RMAX * NGT * 2, SZ_SM = (size_t)RMAX * 64 * 4, SZ_OG = (size_t)RMAX * D * 2,
                 SZ_YS = (size_t)RMAX * 2048 * 2, SZ_T1 = (size_t)RMAX * D * 4, SZ_MIX = (size_t)RMAX * D * 2, SZ_X1G = (size_t)RMAX * D * 2, SZ_SS = (size_t)RMAX * 16 * 4,
                 SZ_U = (size_t)RMAX * NUP * 2, SZ_ACT = (size_t)RMAX * DFF * 2, SZ_GIMG = (size_t)GDN_ITEMS * GI_STRIDE_C, SZ_SIMG = (size_t)SSD_ITEMS * SI_STRIDE_C, SZ_PD = (size_t)RMAX * D * 4;
constexpr int G_HB = 2, G_XC = 2, G_ZG = 3, G_GT = 4, G_SM = 2, G_OG = 2, G_YS = 2, G_T1 = 1, G_MIX = 2, G_X1G = 2, G_SS = 2, G_U = 2, G_ACT = 2, G_IMG = 2, G_PD = 2;
constexpr size_t WS_HB = WS_SLAB, WS_XC = WS_HB + G_HB * SZ_HB, WS_ZG = WS_XC + G_XC * SZ_XC, WS_GT = WS_ZG + G_ZG * SZ_ZG, WS_SM = WS_GT + G_GT * SZ_GT, WS_OG = WS_SM + G_SM * SZ_SM,
                 WS_YS = WS_OG + G_OG * SZ_OG, WS_T1 = WS_YS + G_YS * SZ_YS, WS_MIX = WS_T1 + G_T1 * SZ_T1, WS_X1G = WS_MIX + G_MIX * SZ_MIX, WS_SS1 = WS_X1G + G_X1G * SZ_X1G,
                 WS_SS2 = WS_SS1 + G_SS * SZ_SS, WS_U = WS_SS2 + G_SS * SZ_SS, WS_ACT = WS_U + G_U * SZ_U, WS_GDN = WS_ACT + G_ACT * SZ_ACT, WS_SSD = WS_GDN + G_IMG * SZ_GIMG,
                 WS_PD = WS_SSD + G_IMG * SZ_SIMG, WS_END = WS_PD + G_PD * SZ_PD;
static_assert(WS_END <= 512 * MiB, "workspace map fits");
#define GENP(ws, base, sz, n, s) ((ws) + (base) + (size_t)((s) % (n)) * (sz))
constexpr int LDS_BYTES = 147456, LDSCTL_OFF = LDS_BYTES - 512, MISC_OFF = LDSCTL_OFF + 320, RING_BYTES = LDSCTL_OFF;
constexpr int NWAVES = 8, NTHR = 512;

#define GAS __attribute__((address_space(1)))
#define LAS __attribute__((address_space(3)))
typedef unsigned short bf16;
typedef unsigned v4u __attribute__((ext_vector_type(4)));
typedef unsigned v2u __attribute__((ext_vector_type(2)));
typedef float f32x4 __attribute__((ext_vector_type(4)));
typedef GAS unsigned gu32;
#define RLX_AGENT __ATOMIC_RELAXED, __HIP_MEMORY_SCOPE_AGENT
#define LDS_WAIT() asm volatile("s_waitcnt lgkmcnt(0)" ::: "memory")
#define VM_WAIT() asm volatile("s_waitcnt vmcnt(0)" ::: "memory")
__device__ __forceinline__ unsigned pk2(float lo, float hi) { return pg8::cvt_pk_bf16(lo, hi); }
__device__ __forceinline__ unsigned f2bf(float f) { return pk2(f, f) & 0xffffu; }
__device__ __forceinline__ float bf2f(unsigned short h) { return __builtin_bit_cast(float, (unsigned)h << 16); }
__device__ __forceinline__ float bflo(unsigned w) { return __builtin_bit_cast(float, w << 16); }
__device__ __forceinline__ float bfhi(unsigned w) { return __builtin_bit_cast(float, w & 0xffff0000u); }
__device__ __forceinline__ float sigmoidf_(float x) { return __builtin_amdgcn_rcpf(1.f + __expf(-x)); }
__device__ __forceinline__ float siluf_(float x) { return x * __builtin_amdgcn_rcpf(1.f + __expf(-x)); }
__device__ __forceinline__ float softplusf_(float x) { const float e = __expf(-fabsf(x)), u = 1.f + e, d = u - 1.f; const float l = (d == 0.f) ? e : __logf(u) * (e * __builtin_amdgcn_rcpf(d)); return fmaxf(x, 0.f) + l; }
__device__ __forceinline__ float wave_sum(float v) {
#pragma unroll
    for (int o = 1; o < 64; o <<= 1) v += __shfl_xor(v, o);
    return v;
}

#ifndef PROF_SEL
#define PROF_SEL 0
#endif
#ifndef PROF_MULT
#define PROF_MULT 10
#endif
#define PROF_BEGIN(id) unsigned long long prof_t0_##id = 0; if (PROF_SEL == (id)) prof_t0_##id = __builtin_amdgcn_s_memrealtime()
#define PROF_END(id) do { if (PROF_SEL == (id)) F.prof += __builtin_amdgcn_s_memrealtime() - prof_t0_##id; } while (0)
struct Args { const float* in[30]; float* out; unsigned char* ws; int ph_lo, ph_hi; };

struct Frame {
    LAS unsigned char* lds;
    volatile LAS unsigned* MISC;
    gu32* ctl;
    int tid, lane, wave, G, bid;
    const Args& A;
    float* out; unsigned char* ws;
    unsigned long long prof;
    __device__ __forceinline__ Frame(const Args& a) : A(a) {}
};
__device__ __forceinline__ int row_mb(int r) { return r < RP ? (r / SLAB_T) : NB + ((r - RP) / DSEQ); }
__device__ __forceinline__ size_t row_goff(int s, int r) {
    if (r < RP) { const int b = r / SLAB_T, tl = r % SLAB_T; return ((size_t)b * SEQ + (size_t)s * SLAB_T + tl) * D; }
    return (size_t)(r - RP) * D;
}
#ifndef DSLAB
#define DSLAB (NSLAB - 1)
#endif
__device__ __forceinline__ int slab_rows(int s) { return s == DSLAB ? RMAX : RP; }
struct MapWin { __device__ __forceinline__ int operator()(int n) const { return n < 10240 ? n : (n < 12288 ? n + 48 : (n < 12336 ? n - 2048 : -1)); } };
struct MapId  { __device__ __forceinline__ int operator()(int n) const { return n; } };
struct MapUp  { __device__ __forceinline__ int operator()(int n) const { const int j = n >> 8, c = n & 255; return c < 128 ? 128 * j + c : DFF + 128 * j + (c - 128); } };
template <class Map>
__device__ __forceinline__ void p0_transpose_item(const float* W, int ldw, int K, bf16* WT, Map map, LAS float* scr, int item, int nblk, int lane) {
    const int kb = item / nblk, nb = item % nblk, k0 = 64 * kb, n0 = 32 * nb;
    const int sc = map(n0 + (lane & 31));
    float v[32];
    const float* wp = W + (size_t)(k0 + (lane >> 5)) * ldw + (sc >= 0 ? sc : 0);
#pragma unroll
    for (int i = 0; i < 32; ++i) v[i] = wp[(size_t)(2 * i) * ldw];
#pragma unroll
    for (int i = 0; i < 32; ++i) scr[(2 * i + (lane >> 5)) * 33 + (lane & 31)] = sc >= 0 ? v[i] : 0.f;
    LDS_WAIT(); asm volatile("" ::: "memory");
    const int c = lane & 7;
#pragma unroll
    for (int j = 0; j < 4; ++j) { const int n = (lane >> 3) + 8 * j; const LAS float* s = scr + (8 * c) * 33 + n;
        v4u o; o.x = pk2(s[0 * 33], s[1 * 33]); o.y = pk2(s[2 * 33], s[3 * 33]); o.z = pk2(s[4 * 33], s[5 * 33]); o.w = pk2(s[6 * 33], s[7 * 33]);
        *(GAS v4u*)(WT + (size_t)(n0 + n) * K + k0 + 8 * c) = o; }
    LDS_WAIT(); asm volatile("" ::: "memory");
}
__device__ __forceinline__ void p0_mod_item(Frame& F, int item) {
    LAS float* sc = (LAS float*)F.lds; LAS float* red = (LAS float*)(F.lds + 49152);
    const float* cp = F.A.in[6]; const float* cs = F.A.in[7]; const float* w_ada = F.A.in[8]; const float* b_ada = F.A.in[9];
    for (int idx = F.tid; idx < NMB * D; idx += NTHR) { const int b = idx / D, k = idx % D; const float c = b < NB ? cp[b * D + k] : cs[(b - NB) * D + k]; sc[idx] = siluf_(c); }
    __syncthreads();
    float acc[NMB];
#pragma unroll
    for (int b = 0; b < NMB; ++b) acc[b] = 0.f;
    const int col = item * 64 + F.lane, kb = F.wave * 128;
#pragma unroll 1
    for (int k8 = 0; k8 < 128; k8 += 16) { float wv[16];
#pragma unroll
        for (int k = 0; k < 16; ++k) wv[k] = w_ada[(size_t)(kb + k8 + k) * 6144 + col];
#pragma unroll
        for (int k = 0; k < 16; ++k) {
#pragma unroll
            for (int b = 0; b < NMB; ++b) acc[b] += sc[b * D + kb + k8 + k] * wv[k]; } }
#pragma unroll
    for (int b = 0; b < NMB; ++b) red[(F.wave * NMB + b) * 64 + F.lane] = acc[b];
    __syncthreads();
    float* modv = (float*)(F.ws + WS_MODV);
    for (int idx = F.tid; idx < NMB * 64; idx += NTHR) { const int b = idx / 64, l = idx % 64; float s = b_ada[item * 64 + l];
#pragma unroll
        for (int w = 0; w < 8; ++w) s += red[(w * NMB + b) * 64 + l];
        modv[b * 6144 + item * 64 + l] = s; }
    __syncthreads();
}
constexpr int P0_I_IN = (D / 64) * (NIN / 32), P0_I_G = (D / 64) * (D / 32), P0_I_S = (2048 / 64) * (D / 32), P0_I_O = P0_I_G, P0_I_UP = (D / 64) * (NUP / 32), P0_I_DN = (DFF / 64) * (D / 32);
constexpr int P0_NITEMS = P0_I_IN + P0_I_G + P0_I_S + P0_I_O + P0_I_UP + P0_I_DN;
__device__ __forceinline__ void p0_item(Frame& F, LAS float* scr, int it) {
    int r = it;
    if (r < P0_I_IN) { p0_transpose_item(F.A.in[11], IN_COLS, D, (bf16*)(F.ws + WS_WIN), MapWin(), scr, r, NIN / 32, F.lane); return; } r -= P0_I_IN;
    if (r < P0_I_G) { p0_transpose_item(F.A.in[21], D, D, (bf16*)(F.ws + WS_WG), MapId(), scr, r, D / 32, F.lane); return; } r -= P0_I_G;
    if (r < P0_I_S) { p0_transpose_item(F.A.in[22], D, 2048, (bf16*)(F.ws + WS_WS), MapId(), scr, r, D / 32, F.lane); return; } r -= P0_I_S;
    if (r < P0_I_O) { p0_transpose_item(F.A.in[23], D, D, (bf16*)(F.ws + WS_WOUT), MapId(), scr, r, D / 32, F.lane); return; } r -= P0_I_O;
    if (r < P0_I_UP) { p0_transpose_item(F.A.in[25], NUP, D, (bf16*)(F.ws + WS_WUP), MapUp(), scr, r, NUP / 32, F.lane); return; } r -= P0_I_UP;
    p0_transpose_item(F.A.in[28], D, DFF, (bf16*)(F.ws + WS_WDN), MapId(), scr, r, D / 32, F.lane);
}
__device__ __forceinline__ void phase_prologue0(Frame& F) {
    for (int it = F.bid; it < 96; it += F.G) p0_mod_item(F, it);
    LAS float* scr = (LAS float*)(F.lds + F.wave * 16384);
    const int gw = F.bid * NWAVES + F.wave, NGW = F.G * NWAVES;
#pragma unroll 1
    for (int it = gw; it < P0_I_IN; it += NGW) p0_item(F, scr, it);
}
__device__ __forceinline__ void phase_convert_rest(Frame& F, int part, int nparts) {
    LAS float* scr = (LAS float*)(F.lds + F.wave * 16384);
    const int gw = part * NWAVES + F.wave, NGW = nparts * NWAVES;
#pragma unroll 1
    for (int it = P0_I_IN + gw; it < P0_NITEMS; it += NGW) p0_item(F, scr, it);
    __syncthreads();
}
__device__ __forceinline__ void phase_prologue1(Frame& F, int part, int nparts) {
    const float* modv = (const float*)(F.ws + WS_MODV);
    float* g1 = (float*)(F.ws + WS_G1); float* g2 = (float*)(F.ws + WS_G2); float* shw = (float*)(F.ws + WS_SHW);
    for (int idx = part * NTHR + F.tid; idx < NMB * D; idx += nparts * NTHR) { const int b = idx / D, k = idx % D;
        g1[idx] = F.A.in[10][k] * (1.f + modv[b * 6144 + 1024 + k]); g2[idx] = F.A.in[24][k] * (1.f + modv[b * 6144 + 4096 + k]); }
    LAS float* sh = (LAS float*)F.lds;
    for (int idx = F.tid; idx < NMB * D; idx += NTHR) sh[idx] = modv[(idx / D) * 6144 + 3072 + (idx % D)];
    __syncthreads();
    const bf16* wup = (const bf16*)(F.ws + WS_WUP);
    const int gw = part * NWAVES + F.wave, NGW = nparts * NWAVES;
    for (int n = gw; n < NUP; n += NGW) {
        const GAS v4u* wr = (const GAS v4u*)(wup + (size_t)n * D + F.lane * 16);
        const v4u w0 = wr[0], w1 = wr[1];
        float wf[16] = {bflo(w0.x), bfhi(w0.x), bflo(w0.y), bfhi(w0.y), bflo(w0.z), bfhi(w0.z), bflo(w0.w), bfhi(w0.w), bflo(w1.x), bfhi(w1.x), bflo(w1.y), bfhi(w1.y), bflo(w1.z), bfhi(w1.z), bflo(w1.w), bfhi(w1.w)};
        float res = 0.f;
#pragma unroll 1
        for (int b = 0; b < NMB; ++b) { float a = 0.f;
#pragma unroll
            for (int i = 0; i < 16; ++i) a += wf[i] * sh[b * D + F.lane * 16 + i];
            a = wave_sum(a); if (F.lane == b) res = a; }
        if (F.lane < NMB) shw[F.lane * NUP + n] = res;
    }
    __syncthreads();
}
__device__ __forceinline__ void phase_norm1(Frame& F, int s, int part, int nparts) {
    const float* modv = (const float*)(F.ws + WS_MODV); bf16* hb = (bf16*)GENP(F.ws, WS_HB, SZ_HB, G_HB, s);
    const int gw = part * NWAVES + F.wave, NGW = nparts * NWAVES, R = slab_rows(s);
    for (int r = gw; r < R; r += 2 * NGW) {
        const int r2 = r + NGW < R ? r + NGW : r;
        const GAS f32x4* xa = (const GAS f32x4*)((r < RP ? F.A.in[0] : F.A.in[1]) + row_goff(s, r)) + F.lane;
        const GAS f32x4* xb = (const GAS f32x4*)((r2 < RP ? F.A.in[0] : F.A.in[1]) + row_goff(s, r2)) + F.lane;
        f32x4 va[4], vb[4]; float sa = 0.f, sb = 0.f;
#pragma unroll
        for (int j = 0; j < 4; ++j) { va[j] = xa[64 * j]; vb[j] = xb[64 * j]; }
#pragma unroll
        for (int j = 0; j < 4; ++j) { sa += (va[j].x * va[j].x + va[j].y * va[j].y) + (va[j].z * va[j].z + va[j].w * va[j].w); sb += (vb[j].x * vb[j].x + vb[j].y * vb[j].y) + (vb[j].z * vb[j].z + vb[j].w * vb[j].w); }
        const float ra = rsqrtf(wave_sum(sa) * (1.f / D) + EPS), rb = rsqrtf(wave_sum(sb) * (1.f / D) + EPS);
#pragma unroll
        for (int q = 0; q < 2; ++q) { if (q == 1 && r2 == r) break; const int rr = q ? r2 : r; const int mb = row_mb(rr); const float rs = q ? rb : ra;
            GAS v2u* o8 = (GAS v2u*)(hb + (size_t)rr * D) + F.lane;
#pragma unroll
            for (int j = 0; j < 4; ++j) { const int k = 4 * F.lane + 256 * j; const f32x4 v = q ? vb[j] : va[j];
                const f32x4 g = *(const GAS f32x4*)(F.A.in[10] + k) * (*(const GAS f32x4*)(modv + mb * 6144 + 1024 + k) + 1.f); const f32x4 sh = *(const GAS f32x4*)(modv + mb * 6144 + k);
                v2u o; o.x = pk2(v.x * rs * g.x + sh.x, v.y * rs * g.y + sh.y); o.y = pk2(v.z * rs * g.z + sh.z, v.w * rs * g.w + sh.w); o8[64 * j] = o; } }
    }
}
__device__ __forceinline__ void phase_final(Frame& F, int s, int part, int nparts) {
    const float* wf = F.A.in[29]; const float* modv = (const float*)(F.ws + WS_MODV); const float* PD = (const float*)GENP(F.ws, WS_PD, SZ_PD, G_PD, s);
    const int gw = part * NWAVES + F.wave, NGW = nparts * NWAVES, R = slab_rows(s);
    for (int r = gw; r < R; r += NGW) {
        float* yrow = F.out + (r < RP ? O_YP : O_YS) + row_goff(s, r); const int mb = row_mb(r);
        GAS f32x4* yr = (GAS f32x4*)yrow + F.lane; const GAS f32x4* pr = (const GAS f32x4*)(PD + (size_t)r * D) + F.lane; const GAS f32x4* gr = (const GAS f32x4*)(modv + mb * 6144 + 5120) + F.lane;
        f32x4 v[4]; float ss = 0.f;
#pragma unroll
        for (int j = 0; j < 4; ++j) { v[j] = yr[64 * j] + gr[64 * j] * pr[64 * j]; ss += (v[j].x * v[j].x + v[j].y * v[j].y) + (v[j].z * v[j].z + v[j].w * v[j].w); }
        const float rs = rsqrtf(wave_sum(ss) * (1.f / D) + EPS);
#pragma unroll
        for (int j = 0; j < 4; ++j) { const f32x4 w = *(const GAS f32x4*)(wf + 4 * F.lane + 256 * j); f32x4 o = v[j]; o.x *= rs * w.x; o.y *= rs * w.y; o.z *= rs * w.z; o.w *= rs * w.w; yr[64 * j] = o; }
    }
}
__device__ __forceinline__ void u_hist_row(Frame& F, int s, int r, int back, int c8, int j, int cc, float (&ua)[8], float (&uv)[8]) {
    const bf16* U = (const bf16*)GENP(F.ws, WS_U, SZ_U, G_U, s);
    int tl, b; bool samp = r >= RP;
    if (!samp) { b = r / SLAB_T; tl = r % SLAB_T; } else { b = (r - RP) / DSEQ; tl = (r - RP) % DSEQ; }
    if (tl - back >= 0) {
        const bf16* p = U + (size_t)(r - back) * NUP + 256 * j + cc;
        const v4u a = *(const GAS v4u*)p, v = *(const GAS v4u*)(p + 128);
        ua[0] = bflo(a.x); ua[1] = bfhi(a.x); ua[2] = bflo(a.y); ua[3] = bfhi(a.y); ua[4] = bflo(a.z); ua[5] = bfhi(a.z); ua[6] = bflo(a.w); ua[7] = bfhi(a.w);
        uv[0] = bflo(v.x); uv[1] = bfhi(v.x); uv[2] = bflo(v.y); uv[3] = bfhi(v.y); uv[4] = bflo(v.z); uv[5] = bfhi(v.z); uv[6] = bflo(v.w); uv[7] = bfhi(v.w);
        return;
    }
    const int hi = 2 + (tl - back);
    if (samp) { const float* st = F.A.in[5] + ((size_t)b * 2 + hi) * NUP;
#pragma unroll
        for (int i = 0; i < 8; ++i) { ua[i] = st[c8 + i]; uv[i] = st[DFF + c8 + i]; } return; }
    if (s == 0) {
#pragma unroll
        for (int i = 0; i < 8; ++i) { ua[i] = 0.f; uv[i] = 0.f; } return; }
    const float* cf = (const float*)(F.ws + WS_CARRY_FFN) + (((size_t)(s & 1) * NB + b) * 2 + hi) * NUP + 256 * j + cc;
#pragma unroll
    for (int i = 0; i < 8; ++i) { ua[i] = cf[i]; uv[i] = cf[128 + i]; }
}
__device__ __forceinline__ void phase_convact(Frame& F, int s, int part, int nparts) {
    const bf16* U = (const bf16*)GENP(F.ws, WS_U, SZ_U, G_U, s); bf16* ACT = (bf16*)GENP(F.ws, WS_ACT, SZ_ACT, G_ACT, s);
    const float* wc = F.A.in[26]; const float* bc = F.A.in[27];
    constexpr int rpp = 8; const int r0 = part * rpp;
    if (F.tid < DFF / 8) {
        const int c8 = F.tid * 8, j = c8 >> 7, cc = c8 & 127;
        float wa0[8], wa1[8], wa2[8], wv0[8], wv1[8], wv2[8], ba[8], bv[8];
#define LD8(dst, p) do { const f32x4 t0_ = *(const GAS f32x4*)(p), t1_ = *(const GAS f32x4*)((p) + 4); dst[0] = t0_.x; dst[1] = t0_.y; dst[2] = t0_.z; dst[3] = t0_.w; dst[4] = t1_.x; dst[5] = t1_.y; dst[6] = t1_.z; dst[7] = t1_.w; } while (0)
        LD8(wa0, wc + c8); LD8(wa1, wc + NUP + c8); LD8(wa2, wc + 2 * NUP + c8); LD8(wv0, wc + DFF + c8); LD8(wv1, wc + NUP + DFF + c8); LD8(wv2, wc + 2 * NUP + DFF + c8); LD8(ba, bc + c8); LD8(bv, bc + DFF + c8);
#undef LD8
        float a0[8], v0[8], a1[8], v1[8];
        v4u axr[rpp], vxr[rpp];
#pragma unroll
        for (int q = 0; q < rpp; ++q) { const bf16* p = U + (size_t)(r0 + q) * NUP + 256 * j + cc; axr[q] = *(const GAS v4u*)p; vxr[q] = *(const GAS v4u*)(p + 128); }
        u_hist_row(F, s, r0, 2, c8, j, cc, a0, v0); u_hist_row(F, s, r0, 1, c8, j, cc, a1, v1);
#pragma unroll
        for (int q = 0; q < rpp; ++q) {
            const v4u ax = axr[q], vx = vxr[q];
            const float a2[8] = {bflo(ax.x), bfhi(ax.x), bflo(ax.y), bfhi(ax.y), bflo(ax.z), bfhi(ax.z), bflo(ax.w), bfhi(ax.w)};
            const float v2[8] = {bflo(vx.x), bfhi(vx.x), bflo(vx.y), bfhi(vx.y), bflo(vx.z), bfhi(vx.z), bflo(vx.w), bfhi(vx.w)};
            float o[8];
#pragma unroll
            for (int i = 0; i < 8; ++i) { const float xa = ba[i] + wa0[i] * a0[i] + wa1[i] * a1[i] + wa2[i] * a2[i];
                const float xv = bv[i] + wv0[i] * v0[i] + wv1[i] * v1[i] + wv2[i] * v2[i];
                o[i] = siluf_(xa) * xv; a0[i] = a1[i]; v0[i] = v1[i]; a1[i] = a2[i]; v1[i] = v2[i]; }
            v4u w; w.x = pk2(o[0], o[1]); w.y = pk2(o[2], o[3]); w.z = pk2(o[4], o[5]); w.w = pk2(o[6], o[7]);
            *(GAS v4u*)(ACT + (size_t)(r0 + q) * DFF + c8) = w;
        }
    }
    float* cfn = (float*)(F.ws + WS_CARRY_FFN) + (size_t)((s + 1) & 1) * NB * 2 * NUP;
    for (int idx = part * NTHR + F.tid; idx < NB * 2 * NUP; idx += nparts * NTHR) {
        const int b = idx / (2 * NUP), i = (idx / NUP) % 2, c = idx % NUP; const int r = b * SLAB_T + SLAB_T - 2 + i;
        const float v = bf2f(U[(size_t)r * NUP + c]); cfn[idx] = v;
        if (s == NSLAB - 1) { const int j = c >> 8, cc = c & 255; const int oc = cc < 128 ? 128 * j + cc : DFF + 128 * j + (cc - 128); F.out[O_CFP + ((size_t)b * 2 + i) * NUP + oc] = v; }
    }
    if (s == DSLAB) for (int idx = part * NTHR + F.tid; idx < DB * 2 * NUP; idx += nparts * NTHR) {
        const int b = idx / (2 * NUP), i = (idx / NUP) % 2, c = idx % NUP; const int r = RP + b * DSEQ + DSEQ - 2 + i;
        const int j = c >> 8, cc = c & 255; const int oc = cc < 128 ? 128 * j + cc : DFF + 128 * j + (cc - 128);
        F.out[O_CFS + ((size_t)b * 2 + i) * NUP + oc] = bf2f(U[(size_t)r * NUP + c]);
    }
}
__device__ __forceinline__ void phase_mix_carry(Frame& F, int s, int part, int nparts) {
    const bf16* P = (const bf16*)GENP(F.ws, WS_XC, SZ_XC, G_XC, s);
    float* cmn = (float*)(F.ws + WS_CARRY_MIX) + (size_t)((s + 1) & 1) * NB * 3 * CONV_CH;
    for (int idx = part * NTHR + F.tid; idx < NB * 3 * CONV_CH; idx += nparts * NTHR) {
        const int b = idx / (3 * CONV_CH), i = (idx / CONV_CH) % 3, c = idx % CONV_CH; const int r = b * SLAB_T + SLAB_T - 3 + i;
        const float v = bf2f(P[(size_t)r * NXC + c]); cmn[idx] = v;
        if (s == NSLAB - 1) F.out[O_CMP + idx] = v;
    }
    if (s == DSLAB) for (int idx = part * NTHR + F.tid; idx < DB * 3 * CONV_CH; idx += nparts * NTHR) {
        const int b = idx / (3 * CONV_CH), i = (idx / CONV_CH) % 3, c = idx % CONV_CH; const int r = RP + b * DSEQ + DSEQ - 3 + i;
        F.out[O_CMS + idx] = bf2f(P[(size_t)r * NXC + c]);
    }
}
namespace epi {
using pg8::f32x4; using pg8::Unit; using pg8::BM; using pg8::HALF; using pg8::cvt_pk_bf16; using pg8::u32x4; using pg8::u32x2;
struct EpiProj {
    static constexpr bool PERM = true;
    bf16* XC; bf16* ZG; bf16* GT; float* SM;
    __device__ __forceinline__ void operator()(const f32x4 (&acc)[2][2][4][2], const Unit& u, int wr, int wc, int fr, int fq) const {
        const int row0 = u.pm * BM + wr * 64 + fr;
        if (u.pn == 48) {
            if (wc < 2) {
#pragma unroll
                for (int ai = 0; ai < 2; ++ai)
#pragma unroll
                    for (int m = 0; m < 4; ++m) { float* rp = SM + (size_t)(row0 + ai * HALF + m * 16) * 64 + wc * 32 + 8 * fq;
                        *(f32x4*)rp = acc[ai][0][m][0]; *(f32x4*)(rp + 4) = acc[ai][0][m][1]; }
            }
            return;
        }
        const bool sg = u.pn >= 40;
        bf16* base; int ld, col0;
        if (u.pn < 28) { base = XC; ld = NXC; col0 = u.pn * BM; } else if (u.pn < 40) { base = ZG; ld = NZG; col0 = (u.pn - 28) * BM; } else { base = GT; ld = NGT; col0 = (u.pn - 40) * BM; }
        col0 += wc * 32 + 8 * fq;
#pragma unroll
        for (int ai = 0; ai < 2; ++ai)
#pragma unroll
            for (int m = 0; m < 4; ++m) { bf16* rowp = base + (size_t)(row0 + ai * HALF + m * 16) * ld + col0;
#pragma unroll
                for (int bj = 0; bj < 2; ++bj) { f32x4 v0 = acc[ai][bj][m][0], v1 = acc[ai][bj][m][1];
                    if (sg) {
#pragma unroll
                        for (int i = 0; i < 4; ++i) { v0[i] = sigmoidf_(v0[i]); v1[i] = sigmoidf_(v1[i]); } }
                    u32x4 w; w.x = cvt_pk_bf16(v0[0], v0[1]); w.y = cvt_pk_bf16(v0[2], v0[3]); w.z = cvt_pk_bf16(v1[0], v1[1]); w.w = cvt_pk_bf16(v1[2], v1[3]);
                    *(u32x4*)(rowp + bj * HALF) = w; } }
    }
};
struct EpiGate1 {
    static constexpr bool PERM = false;
    const bf16* P; float* T1;
    __device__ __forceinline__ void operator()(const f32x4 (&acc)[2][2][4][2], const Unit& u, int wr, int wc, int fr, int fq) const {
        const int row0 = u.pm * BM + wr * 64 + fr, col0 = u.pn * BM + wc * 32 + 4 * fq;
        u32x2 g0[4][2][2], g1[4][2][2];
#pragma unroll
        for (int m = 0; m < 4; ++m)
#pragma unroll
            for (int bj = 0; bj < 2; ++bj)
#pragma unroll
                for (int n = 0; n < 2; ++n) g0[m][bj][n] = *(const u32x2*)(P + (size_t)(row0 + m * 16) * NGT + col0 + bj * HALF + n * 16);
#pragma unroll
        for (int m = 0; m < 4; ++m)
#pragma unroll
            for (int bj = 0; bj < 2; ++bj)
#pragma unroll
                for (int n = 0; n < 2; ++n) g1[m][bj][n] = *(const u32x2*)(P + (size_t)(row0 + HALF + m * 16) * NGT + col0 + bj * HALF + n * 16);
#pragma unroll
        for (int q = 0; q < 8; ++q) { const int ai = q >> 2, m = q & 3; const size_t r = (size_t)(row0 + ai * HALF + m * 16);
#pragma unroll
            for (int bj = 0; bj < 2; ++bj)
#pragma unroll
                for (int n = 0; n < 2; ++n) { const int c = col0 + bj * HALF + n * 16; const u32x2 g = ai == 0 ? g0[m][bj][n] : g1[m][bj][n]; const f32x4 a = acc[ai][bj][m][n];
                    f32x4 o; o.x = a.x * bflo(g.x); o.y = a.y * bfhi(g.x); o.z = a.z * bflo(g.y); o.w = a.w * bfhi(g.y); *(f32x4*)(T1 + r * D + c) = o; } }
    }
};
struct EpiGate2 {
    static constexpr bool PERM = false;
    const bf16* P; const float* T1; bf16* MIX;
    __device__ __forceinline__ void operator()(const f32x4 (&acc)[2][2][4][2], const Unit& u, int wr, int wc, int fr, int fq) const {
        const int row0 = u.pm * BM + wr * 64 + fr, col0 = u.pn * BM + wc * 32 + 4 * fq;
        u32x2 gv[2][2], gn[2][2]; f32x4 tv[2][2], tn[2][2];
#pragma unroll
        for (int bj = 0; bj < 2; ++bj)
#pragma unroll
            for (int n = 0; n < 2; ++n) { const int c = col0 + bj * HALF + n * 16; gv[bj][n] = *(const u32x2*)(P + (size_t)row0 * NGT + 1024 + c); tv[bj][n] = *(const f32x4*)(T1 + (size_t)row0 * D + c); }
#pragma unroll
        for (int q = 0; q < 8; ++q) { const int ai = q >> 2, m = q & 3; const size_t r = (size_t)(row0 + ai * HALF + m * 16);
            if (q < 7) { const size_t r2 = (size_t)(row0 + ((q + 1) >> 2) * HALF + ((q + 1) & 3) * 16);
#pragma unroll
                for (int bj = 0; bj < 2; ++bj)
#pragma unroll
                    for (int n = 0; n < 2; ++n) { const int c = col0 + bj * HALF + n * 16; gn[bj][n] = *(const u32x2*)(P + r2 * NGT + 1024 + c); tn[bj][n] = *(const f32x4*)(T1 + r2 * D + c); } }
#pragma unroll
            for (int bj = 0; bj < 2; ++bj)
#pragma unroll
                for (int n = 0; n < 2; ++n) { const int c = col0 + bj * HALF + n * 16; const u32x2 g = gv[bj][n]; const f32x4 a = acc[ai][bj][m][n]; const f32x4 t = tv[bj][n];
                    u32x2 o; o.x = cvt_pk_bf16(t.x + a.x * bflo(g.x), t.y + a.y * bfhi(g.x)); o.y = cvt_pk_bf16(t.z + a.z * bflo(g.y), t.w + a.w * bfhi(g.y)); *(u32x2*)(MIX + r * D + c) = o; }
            if (q < 7) {
#pragma unroll
                for (int bj = 0; bj < 2; ++bj)
#pragma unroll
                    for (int n = 0; n < 2; ++n) { gv[bj][n] = gn[bj][n]; tv[bj][n] = tn[bj][n]; } } }
    }
};
struct EpiGate2S {
    static constexpr bool PERM = false;
    const bf16* P; const float* T1; float* Tout; bf16* MIX; const unsigned* wflag;
    __device__ __forceinline__ void operator()(const f32x4 (&acc)[2][2][4][2], const Unit& u, int wr, int wc, int fr, int fq) const {
        { unsigned sp = 0; while (__hip_atomic_load(wflag, __ATOMIC_RELAXED, __HIP_MEMORY_SCOPE_AGENT) == 0u && ++sp < (1u << 17)) __builtin_amdgcn_s_sleep(4);
          __builtin_amdgcn_fence(__ATOMIC_ACQUIRE, "agent"); }
        const int row0 = u.pm * BM + wr * 64 + fr, col0 = u.pn * BM + wc * 32 + 4 * fq;
        u32x2 gv[2][2], gn[2][2]; f32x4 tv[2][2], tn[2][2];
#pragma unroll
        for (int bj = 0; bj < 2; ++bj)
#pragma unroll
            for (int n = 0; n < 2; ++n) { const int c = col0 + bj * HALF + n * 16; gv[bj][n] = *(const u32x2*)(P + (size_t)row0 * NGT + 1024 + c); tv[bj][n] = *(const f32x4*)(T1 + (size_t)row0 * D + c); }
#pragma unroll
        for (int q = 0; q < 8; ++q) { const int ai = q >> 2, m = q & 3; const size_t r = (size_t)(row0 + ai * HALF + m * 16);
            if (q < 7) { const size_t r2 = (size_t)(row0 + ((q + 1) >> 2) * HALF + ((q + 1) & 3) * 16);
#pragma unroll
                for (int bj = 0; bj < 2; ++bj)
#pragma unroll
                    for (int n = 0; n < 2; ++n) { const int c = col0 + bj * HALF + n * 16; gn[bj][n] = *(const u32x2*)(P + r2 * NGT + 1024 + c); tn[bj][n] = *(const f32x4*)(T1 + r2 * D + c); } }
#pragma unroll
            for (int bj = 0; bj < 2; ++bj)
#pragma unroll
                for (int n = 0; n < 2; ++n) { const int c = col0 + bj * HALF + n * 16; const u32x2 g = gv[bj][n]; const f32x4 a = acc[ai][bj][m][n]; const f32x4 t = tv[bj][n];
                    f32x4 w; w.x = t.x + a.x * bflo(g.x); w.y = t.y + a.y * bfhi(g.x); w.z = t.z + a.z * bflo(g.y); w.w = t.w + a.w * bfhi(g.y);
                    if (Tout) *(f32x4*)(Tout + r * D + c) = w;
                    else { u32x2 o; o.x = cvt_pk_bf16(w.x, w.y); o.y = cvt_pk_bf16(w.z, w.w); *(u32x2*)(MIX + r * D + c) = o; } }
            if (q < 7) {
#pragma unroll
                for (int bj = 0; bj < 2; ++bj)
#pragma unroll
                    for (int n = 0; n < 2; ++n) { gv[bj][n] = gn[bj][n]; tv[bj][n] = tn[bj][n]; } } }
    }
};
struct EpiOut {
    static constexpr bool PERM = false;
    const float* xp; const float* xs; const float* modv; const float* g2; float* yp; float* ys; bf16* X1G; float* SS; int slab; LAS unsigned char* lds; unsigned long long* prof;
    __device__ __forceinline__ void operator()(const f32x4 (&acc)[2][2][4][2], const Unit& u, int wr, int wc, int fr, int fq) const {
        const int col0 = u.pn * BM + wc * 32 + 4 * fq;
        LAS unsigned char* wl = lds + (wr * 4 + wc) * 16384; const int lane16 = (fq * 16 + fr) * 16;
        unsigned long long pt0_ = 0; if (PROF_SEL == 32) pt0_ = __builtin_amdgcn_s_memrealtime();
        asm volatile("s_waitcnt vmcnt(0)" ::: "memory"); __builtin_amdgcn_s_barrier();
#pragma unroll
        for (int ai = 0; ai < 2; ++ai) {
            const int rb = u.pm * BM + ai * HALF + wr * 64; const int mb = row_mb(rb);
            f32x4 gtv[2][2], ggv[2][2];
#pragma unroll
            for (int bj = 0; bj < 2; ++bj)
#pragma unroll
                for (int n = 0; n < 2; ++n) { const int c = col0 + bj * HALF + n * 16; gtv[bj][n] = *(const f32x4*)(modv + mb * 6144 + 2048 + c); ggv[bj][n] = *(const f32x4*)(g2 + mb * D + c); }
            if (ai == 1) asm volatile("s_waitcnt lgkmcnt(0)" ::: "memory");
#pragma unroll
            for (int m = 0; m < 4; ++m) { const int r = rb + m * 16 + fr; const float* xr = (r < RP ? xp : xs) + row_goff(slab, r);
#pragma unroll
                for (int bj = 0; bj < 2; ++bj)
#pragma unroll
                    for (int n = 0; n < 2; ++n) __builtin_amdgcn_global_load_lds((const unsigned*)(xr + col0 + bj * HALF + n * 16), (LAS unsigned*)(wl + ((m * 2 + bj) * 2 + n) * 1024), 16, 0, 0); }
            asm volatile("s_waitcnt vmcnt(0)" ::: "memory");
#pragma unroll
            for (int m = 0; m < 4; ++m) { const int r = rb + m * 16 + fr; const size_t go = row_goff(slab, r); float* x1row = (r < RP ? yp : ys) + go; float sq = 0.f;
#pragma unroll
                for (int bj = 0; bj < 2; ++bj)
#pragma unroll
                    for (int n = 0; n < 2; ++n) { const int c = col0 + bj * HALF + n * 16; const f32x4 a = acc[ai][bj][m][n];
                        const f32x4 xv = *(const LAS f32x4*)(wl + ((m * 2 + bj) * 2 + n) * 1024 + lane16);
                        f32x4 o = xv + gtv[bj][n] * a; *(f32x4*)(x1row + c) = o; sq += (o.x * o.x + o.y * o.y) + (o.z * o.z + o.w * o.w);
                        const f32x4 gg = ggv[bj][n]; u32x2 w; w.x = cvt_pk_bf16(o.x * gg.x, o.y * gg.y); w.y = cvt_pk_bf16(o.z * gg.z, o.w * gg.w); *(u32x2*)(X1G + (size_t)r * D + c) = w; }
                sq += __shfl_xor(sq, 16); sq += __shfl_xor(sq, 32);
                if (fq == 0) SS[(size_t)r * 16 + u.pn * 4 + wc] = sq; }
        }
        if (PROF_SEL == 32) { asm volatile("s_waitcnt vmcnt(0)" ::: "memory"); *prof += __builtin_amdgcn_s_memrealtime() - pt0_; }
    }
};
struct EpiUp {
    static constexpr bool PERM = true;
    const float* SS; const float* shw; bf16* U;
    __device__ __forceinline__ void operator()(const f32x4 (&acc)[2][2][4][2], const Unit& u, int wr, int wc, int fr, int fq) const {
        const int col0 = u.pn * BM + wc * 32 + 8 * fq;
        f32x4 pq[2][4];
#pragma unroll
        for (int ai = 0; ai < 2; ++ai)
#pragma unroll
            for (int m = 0; m < 4; ++m) pq[ai][m] = *(const f32x4*)(SS + (size_t)(u.pm * BM + ai * HALF + wr * 64 + m * 16 + fr) * 16 + 4 * fq);
#pragma unroll
        for (int ai = 0; ai < 2; ++ai) {
            const int rb = u.pm * BM + ai * HALF + wr * 64; const int mb = row_mb(rb);
            f32x4 sv[2][2];
#pragma unroll
            for (int bj = 0; bj < 2; ++bj)
#pragma unroll
                for (int n = 0; n < 2; ++n) sv[bj][n] = *(const f32x4*)(shw + mb * NUP + col0 + bj * HALF + 4 * n);
#pragma unroll
            for (int m = 0; m < 4; ++m) { const int r = rb + m * 16 + fr;
                float tot = (pq[ai][m].x + pq[ai][m].y) + (pq[ai][m].z + pq[ai][m].w); tot += __shfl_xor(tot, 16); tot += __shfl_xor(tot, 32);
                const float rs = rsqrtf(tot * (1.f / D) + EPS);
#pragma unroll
                for (int bj = 0; bj < 2; ++bj) { const f32x4 v0 = acc[ai][bj][m][0] * rs + sv[bj][0], v1 = acc[ai][bj][m][1] * rs + sv[bj][1];
                    u32x4 w; w.x = cvt_pk_bf16(v0[0], v0[1]); w.y = cvt_pk_bf16(v0[2], v0[3]); w.z = cvt_pk_bf16(v1[0], v1[1]); w.w = cvt_pk_bf16(v1[2], v1[3]);
                    *(u32x4*)(U + (size_t)r * NUP + col0 + bj * HALF) = w; } }
        }
    }
};
struct EpiDown0 {
    static constexpr bool PERM = false;
    const float* modv; float* yp; float* ys; int slab;
    __device__ __forceinline__ void operator()(const f32x4 (&acc)[2][2][4][2], const Unit& u, int wr, int wc, int fr, int fq) const {
        const int col0 = u.pn * BM + wc * 32 + 4 * fq;
#pragma unroll
        for (int ai = 0; ai < 2; ++ai) {
            const int rb = u.pm * BM + ai * HALF + wr * 64; const int mb = row_mb(rb);
            f32x4 gtv[2][2], xv[4][2][2];
#pragma unroll
            for (int bj = 0; bj < 2; ++bj)
#pragma unroll
                for (int n = 0; n < 2; ++n) gtv[bj][n] = *(const f32x4*)(modv + mb * 6144 + 5120 + col0 + bj * HALF + n * 16);
#pragma unroll
            for (int m = 0; m < 4; ++m) { const int r = rb + m * 16 + fr; const float* yrow = (r < RP ? yp : ys) + row_goff(slab, r);
#pragma unroll
                for (int bj = 0; bj < 2; ++bj)
#pragma unroll
                    for (int n = 0; n < 2; ++n) xv[m][bj][n] = *(const f32x4*)(yrow + col0 + bj * HALF + n * 16); }
#pragma unroll
            for (int m = 0; m < 4; ++m) { const int r = rb + m * 16 + fr; float* yrow = (r < RP ? yp : ys) + row_goff(slab, r);
#pragma unroll
                for (int bj = 0; bj < 2; ++bj)
#pragma unroll
                    for (int n = 0; n < 2; ++n) *(f32x4*)(yrow + col0 + bj * HALF + n * 16) = xv[m][bj][n] + gtv[bj][n] * acc[ai][bj][m][n]; }
        }
    }
};
struct EpiDown1 {
    static constexpr bool PERM = false;
    float* PD;
    __device__ __forceinline__ void operator()(const f32x4 (&acc)[2][2][4][2], const Unit& u, int wr, int wc, int fr, int fq) const {
        const int row0 = u.pm * BM + wr * 64 + fr, col0 = u.pn * BM + wc * 32 + 4 * fq;
#pragma unroll
        for (int ai = 0; ai < 2; ++ai)
#pragma unroll
            for (int m = 0; m < 4; ++m) { const size_t r = (size_t)(row0 + ai * HALF + m * 16);
#pragma unroll
                for (int bj = 0; bj < 2; ++bj)
#pragma unroll
                    for (int n = 0; n < 2; ++n) *(f32x4*)(PD + r * D + col0 + bj * HALF + n * 16) = acc[ai][bj][m][n]; }
    }
};
}
typedef short bf16x8 __attribute__((ext_vector_type(8)));
#define MFMA16(a, b, c) __builtin_amdgcn_mfma_f32_16x16x32_bf16((a), (b), (c), 0, 0, 0)
__device__ __forceinline__ bf16x8 ldfrag(const LAS bf16* base, int ld, int row0, int k0, int lane) {
    return *(const LAS bf16x8*)(base + (row0 + (lane & 15)) * ld + k0 + 8 * (lane >> 4));
}
__device__ __forceinline__ bf16x8 ldfrag_perm(const LAS bf16* base, int ld, int row0, int k0, int lane) {
    const LAS v2u* p = (const LAS v2u*)(base + (row0 + (lane & 15)) * ld + k0 + 4 * (lane >> 4));
    const v2u a = p[0], b = p[4];
    v4u w; w.x = a.x; w.y = a.y; w.z = b.x; w.w = b.y; return __builtin_bit_cast(bf16x8, w);
}
__device__ __forceinline__ bf16x8 acc2frag(f32x4 t0, f32x4 t1) {
    v4u w; w.x = pg8::cvt_pk_bf16(t0.x, t0.y); w.y = pg8::cvt_pk_bf16(t0.z, t0.w); w.z = pg8::cvt_pk_bf16(t1.x, t1.y); w.w = pg8::cvt_pk_bf16(t1.z, t1.w); return __builtin_bit_cast(bf16x8, w);
}
__device__ __forceinline__ int kpos(int o) { return (o & ~31) | (8 * ((o >> 2) & 3) + 4 * ((o >> 4) & 1) + (o & 3)); }
__device__ __forceinline__ float wave_incl_scan(float v, int lane) {
#pragma unroll
    for (int o = 1; o < 64; o <<= 1) { const float t = __shfl_up(v, o); if (lane >= o) v += t; }
    return v;
}
__device__ __forceinline__ float dpp_f(float v, int ctrl_sel) {
    const int x = __builtin_bit_cast(int, v); int r;
    switch (ctrl_sel) { case 0: r = __builtin_amdgcn_mov_dpp(x, 0xB1, 0xF, 0xF, true); break; case 1: r = __builtin_amdgcn_mov_dpp(x, 0x4E, 0xF, 0xF, true); break;
                        case 2: r = __builtin_amdgcn_mov_dpp(x, 0x141, 0xF, 0xF, true); break; default: r = __builtin_amdgcn_mov_dpp(x, 0x140, 0xF, 0xF, true); break; }
    return __builtin_bit_cast(float, r);
}
__device__ __forceinline__ float row16_sum(float v) { v += dpp_f(v, 0); v += dpp_f(v, 1); v += dpp_f(v, 2); v += dpp_f(v, 3); return v; }

constexpr int GI_WKN = 0, GI_QG = 17408, GI_KT = 34816, GI_QKM = 53248, GI_IMG = 62464, GI_WV = GI_IMG, GI_SC = GI_IMG + 32768, GI_STRIDE = GI_SC + 256;
constexpr int GDN_ITEMS_MAX = GDN_ITEMS;
static_assert(GI_STRIDE == GI_STRIDE_C, "image stride");
constexpr int GP_QS = 0, GP_KS = 17408, GP_LS = 34816, GP_SC = 51200, GP_HALF = 52736;

__device__ __forceinline__ void gdn_pre_pair(Frame& F, int s, int pair) {
    const bf16* P = (const bf16*)GENP(F.ws, WS_XC, SZ_XC, G_XC, s); const float* SM = (const float*)GENP(F.ws, WS_SM, SZ_SM, G_SM, s);
    const int tid = F.tid, hb = tid >> 8, ht = tid & 255, wl = (tid >> 6) & 3;
    int lane = F.lane; asm volatile("" : "+v"(lane)); const int quad = lane >> 4, l15 = lane & 15;
    const int it = 2 * pair + hb;
    int bsel, h, r0, c; bool samp;
    if (it < NCH * NB * GH) { samp = false; const int bh = it / NCH; c = it % NCH; bsel = bh >> 3; h = bh & 7; r0 = bsel * SLAB_T + 64 * c; }
    else { samp = true; const int q = it - NCH * NB * GH; bsel = q >> 3; h = q & 7; c = 0; r0 = RP + bsel * DSEQ; }
    unsigned char* img = GENP(F.ws, WS_GDN, SZ_GIMG, G_IMG, s) + (size_t)it * GI_STRIDE;
    LAS unsigned char* hbase = F.lds + hb * GP_HALF;
    LAS bf16* QS = (LAS bf16*)(hbase + GP_QS); LAS bf16* KS = (LAS bf16*)(hbase + GP_KS); LAS float* LS = (LAS float*)(hbase + GP_LS);
    LAS float* NQ = (LAS float*)(hbase + GP_SC); LAS float* NK = NQ + 64; LAS float* GAMS = NK + 64; LAS float* BTS = GAMS + 64; LAS float* EG = BTS + 64; LAS float* EL = EG + 64;
    if (ht < 64) { const size_t r = (size_t)(r0 + lane); const float beta = sigmoidf_(SM[r * 64 + h]); const float g = -__expf(F.A.in[14][h]) * softplusf_(SM[r * 64 + 8 + h] + F.A.in[15][h]);
        const float ga = wave_incl_scan(g, lane); const float la = __shfl(ga, 63); GAMS[lane] = ga; BTS[lane] = beta; EG[lane] = __expf(ga); EL[lane] = __expf(la - ga); }
    float y[64];
    {
        const float* wcv = F.A.in[12]; const float* bcv = F.A.in[13];
        LAS bf16* RAW0 = (LAS bf16*)(hbase + GP_LS); LAS bf16* RAW1 = (LAS bf16*)(hbase + GP_KS);
#pragma unroll
        for (int rnd = 0; rnd < 2; ++rnd) {
#pragma unroll
            for (int i = 0; i < 4; ++i) { const int id = ht + 256 * i, row = id >> 4, c16 = id & 15;
                *(LAS v4u*)(RAW0 + row * 128 + 8 * c16) = *(const GAS v4u*)(P + (size_t)(r0 + row) * NXC + (rnd == 0 ? 0 : 1024) + h * 128 + 8 * c16);
                if (rnd == 0) *(LAS v4u*)(RAW1 + row * 128 + 8 * c16) = *(const GAS v4u*)(P + (size_t)(r0 + row) * NXC + 2048 + h * 128 + 8 * c16); }
            __syncthreads();
            if (rnd == 0 || ht < 128) {
                const int role = rnd == 1 ? 1 : (ht < 128 ? 0 : 2), ch = ht & 127;
                const int cidx = role * 1024 + h * 128 + ch;
                const float w0 = wcv[cidx], w1 = wcv[CONV_CH + cidx], w2 = wcv[2 * CONV_CH + cidx], w3 = wcv[3 * CONV_CH + cidx], bias = bcv[cidx];
                float h0 = 0.f, h1 = 0.f, h2 = 0.f;
                if (c > 0) { const bf16* pp = P + (size_t)(r0 - 3) * NXC + cidx; h0 = bf2f(pp[0]); h1 = bf2f(pp[NXC]); h2 = bf2f(pp[2 * NXC]); }
                else if (samp) { const float* st = F.A.in[2] + (size_t)bsel * 3 * CONV_CH + cidx; h0 = st[0]; h1 = st[CONV_CH]; h2 = st[2 * CONV_CH]; }
                else if (s > 0) { const float* st = (const float*)(F.ws + WS_CARRY_MIX) + ((size_t)(s & 1) * NB + bsel) * 3 * CONV_CH + cidx; h0 = st[0]; h1 = st[CONV_CH]; h2 = st[2 * CONV_CH]; }
                const LAS bf16* src = (role == 2 ? RAW1 : RAW0) + ch;
                LAS bf16* dst = (role == 0 ? QS : KS) + ch;
#pragma unroll
                for (int t = 0; t < 64; ++t) { const float raw = bf2f(src[t * 128]); float val = bias + w0 * h0 + w1 * h1 + w2 * h2 + w3 * raw; h0 = h1; h1 = h2; h2 = raw; val = siluf_(val);
                    if (role == 0) dst[t * 136] = (bf16)f2bf(val); else y[t] = val; }
            }
            __syncthreads();
            if (rnd == 1 && ht < 128) {
#pragma unroll
                for (int t = 0; t < 64; ++t) KS[t * 136 + ht] = (bf16)f2bf(y[t]);
            }
        }
    }
    __syncthreads();
    f32x4 kk[4], qk[4];
    {
        bf16x8 ak[4], aq[4];
#pragma unroll
        for (int ks = 0; ks < 4; ++ks) { ak[ks] = ldfrag(KS, 136, 16 * wl, 32 * ks, lane); aq[ks] = ldfrag(QS, 136, 16 * wl, 32 * ks, lane); }
        f32x4 qq = {0.f, 0.f, 0.f, 0.f};
#pragma unroll
        for (int ks = 0; ks < 4; ++ks) qq = MFMA16(aq[ks], aq[ks], qq);
#pragma unroll
        for (int nt = 0; nt < 4; ++nt) {
            if (nt <= wl) { f32x4 a0 = {0.f, 0.f, 0.f, 0.f}, a1 = {0.f, 0.f, 0.f, 0.f};
#pragma unroll
                for (int ks = 0; ks < 4; ++ks) { const bf16x8 bk = ldfrag(KS, 136, 16 * nt, 32 * ks, lane); a0 = MFMA16(ak[ks], bk, a0); a1 = MFMA16(aq[ks], bk, a1); }
                kk[nt] = a0; qk[nt] = a1; } else { kk[nt] = qq; qk[nt] = qq; } }
        float dk = 0.f, dq = 0.f;
#pragma unroll
        for (int nt = 0; nt < 4; ++nt) if (nt == wl) {
#pragma unroll
            for (int r = 0; r < 4; ++r) if (4 * quad + r == l15) { dk = kk[nt][r]; dq = qq[r]; } }
        if ((l15 >> 2) == quad) { NK[16 * wl + l15] = rsqrtf(dk + EPS); NQ[16 * wl + l15] = rsqrtf(dq + EPS) * 0.08838834764831845f; }
    }
    __syncthreads();
    {
        bf16* QKM = (bf16*)(img + GI_QKM);
#pragma unroll
        for (int nt = 0; nt < 4; ++nt) { const int j = 16 * nt + l15; const float nkj = NK[j], gj = GAMS[j];
#pragma unroll
            for (int r = 0; r < 4; ++r) { const int i = 16 * wl + 4 * quad + r; const float e = __expf(GAMS[i] - gj);
                LS[i * 64 + j] = i > j ? kk[nt][r] * NK[i] * nkj * e * BTS[i] : 0.f;
                QKM[i * 72 + kpos(j)] = (bf16)f2bf(i >= j ? qk[nt][r] * NQ[i] * nkj * e : 0.f); } }
    }
    const float last = GAMS[63];
    if (ht < 128) {
        bf16* KT = (bf16*)(img + GI_KT) + ht * 72;
#pragma unroll
        for (int i8 = 0; i8 < 8; ++i8) { float t[8];
#pragma unroll
            for (int e = 0; e < 8; ++e) { const int j = 32 * (i8 >> 2) + 16 * (e >> 2) + 4 * (i8 & 3) + (e & 3); const float kh = y[j] * NK[j]; t[e] = kh * EL[j]; y[j] = kh * BTS[j] * EG[j]; }
            v4u o; o.x = pk2(t[0], t[1]); o.y = pk2(t[2], t[3]); o.z = pk2(t[4], t[5]); o.w = pk2(t[6], t[7]); *(GAS v4u*)(KT + 8 * i8) = o; }
    } else {
#pragma unroll
        for (int j = 0; j < 64; ++j) y[j] *= BTS[j];
    }
    __syncthreads();
#pragma unroll
    for (int i = 1; i < 64; ++i) { float acc = y[i];
#pragma unroll
        for (int j4 = 0; j4 < (i + 3) / 4; ++j4) { const f32x4 l = *(const LAS f32x4*)(LS + i * 64 + 4 * j4);
            acc -= l.x * y[4 * j4]; if (4 * j4 + 1 < i) acc -= l.y * y[4 * j4 + 1]; if (4 * j4 + 2 < i) acc -= l.z * y[4 * j4 + 2]; if (4 * j4 + 3 < i) acc -= l.w * y[4 * j4 + 3]; }
        y[i] = acc; }
    if (ht < 128) { LAS bf16* WS_ = KS + kpos(ht);
#pragma unroll
        for (int i = 0; i < 64; ++i) WS_[i * 136] = (bf16)f2bf(-y[i]); }
    else { const int v = ht - 128; float* WV = (float*)(img + GI_WV) + ((v >> 4) * 64 + (v & 15)) * 16;
#pragma unroll
        for (int i = 0; i < 64; ++i) WV[(((i >> 2) & 3) << 4) * 16 + (i >> 4) * 4 + (i & 3)] = y[i]; }
    {
        bf16* QG = (bf16*)(img + GI_QG);
#pragma unroll
        for (int q = 0; q < 4; ++q) { const int idx = ht + 256 * q, i = idx >> 4, d8 = (idx & 15) * 8; const int o0 = (d8 & ~31) + 4 * ((d8 >> 3) & 3);
            const v2u xa = *(const LAS v2u*)(QS + i * 136 + o0), xb = *(const LAS v2u*)(QS + i * 136 + o0 + 16); v4u x; x.x = xa.x; x.y = xa.y; x.z = xb.x; x.w = xb.y; const float sc = NQ[i] * EG[i];
            v4u o; o.x = pk2(bflo(x.x) * sc, bfhi(x.x) * sc); o.y = pk2(bflo(x.y) * sc, bfhi(x.y) * sc); o.z = pk2(bflo(x.z) * sc, bfhi(x.z) * sc); o.w = pk2(bflo(x.w) * sc, bfhi(x.w) * sc);
            *(GAS v4u*)(QG + i * 136 + d8) = o; }
        if (ht == 0) *(float*)(img + GI_SC) = EG[63];
    }
    __syncthreads();
    for (int i = ht; i < 17408 / 16; i += 256) *(GAS v4u*)(img + GI_WKN + 16 * i) = *(const LAS v4u*)(hbase + GP_KS + 16 * i);
    __syncthreads();
}
__device__ __forceinline__ void phase_gdn_pre(Frame& F, int s) {
    const int npairs = (s == DSLAB ? GDN_ITEMS_MAX : NCH * NB * GH) / 2;
    for (int p = F.bid; p < npairs; p += F.G) gdn_pre_pair(F, s, p);
}

constexpr int GS_BUF = 0, GS_PSQ = 2 * GI_IMG, GS_ZS = GS_PSQ + 4096, GS_RS = GS_ZS + 8 * 2048;
static_assert(GS_RS + 256 <= RING_BYTES, "GDN sequential LDS map fits");
__device__ __forceinline__ void gdn_seq_job(Frame& F, int s, bool samp, int bb, int h, bool dry = false) {
    const bf16* ZGp = (const bf16*)GENP(F.ws, WS_ZG, SZ_ZG, G_ZG, s); bf16* OG = (bf16*)GENP(F.ws, WS_OG, SZ_OG, G_OG, s);
    const int w = F.wave;
    int lane = F.lane; asm volatile("" : "+v"(lane)); int quad = lane >> 4, l15 = lane & 15;
    const int nchunk = samp ? 1 : NCH, row0 = samp ? RP + bb * DSEQ : bb * SLAB_T;
    const int item0 = samp ? NCH * NB * GH + bb * GH + h : (bb * GH + h) * NCH;
    const unsigned char* img0 = GENP(F.ws, WS_GDN, SZ_GIMG, G_IMG, s) + (size_t)item0 * GI_STRIDE;
    LAS float* PSQ = (LAS float*)(F.lds + GS_PSQ); LAS bf16* ZS = (LAS bf16*)(F.lds + GS_ZS) + w * 1024; LAS float* RS = (LAS float*)(F.lds + GS_RS);
    f32x4 Sacc[8];
    {
        const float* st = samp ? F.A.in[3] : F.out + O_GP; const size_t sb = (size_t)(bb * GH + h) * GDK * GDV;
#pragma unroll
        for (int mt = 0; mt < 8; ++mt)
#pragma unroll
            for (int r = 0; r < 4; ++r) Sacc[mt][r] = (samp || s > 0) ? st[sb + (size_t)(16 * mt + 4 * quad + r) * GDV + 16 * w + l15] : 0.f;
    }
    const float gn = F.A.in[16][16 * w + l15];
#define GDN_STAGE(imgp, bufi) do { for (int pc_ = w; pc_ < GI_IMG / 1024; pc_ += 8) \
        __builtin_amdgcn_global_load_lds((const unsigned*)((imgp) + pc_ * 1024 + lane * 16), (LAS unsigned*)(F.lds + GS_BUF + (bufi) * GI_IMG + pc_ * 1024), 16, 0, 0); } while (0)
    PROF_BEGIN(1);
    GDN_STAGE(img0, 0);
    f32x4 wv[4];
    { const GAS f32x4* WV = (const GAS f32x4*)(img0 + GI_WV) + (w * 64 + lane) * 4;
#pragma unroll
      for (int mt = 0; mt < 4; ++mt) wv[mt] = WV[mt]; }
    v4u zr0, zr1;
    { const GAS v4u* zp = (const GAS v4u*)(ZGp + (size_t)(row0 + lane) * NZG + h * 128 + 16 * w); zr0 = zp[0]; zr1 = zp[1]; }
    float el_next = *(const float*)(img0 + GI_SC);
    f32x4 Oprev[4];
#pragma unroll
    for (int mt = 0; mt < 4; ++mt) Oprev[mt] = wv[mt];
#define GDN_FINISH(cc) do { const LAS float* ps = PSQ + ((cc) & 1) * 512; const int rb = row0 + 64 * (cc); \
        { const f32x4 p0 = *(const LAS f32x4*)(ps + lane * 8), p1 = *(const LAS f32x4*)(ps + lane * 8 + 4);     \
          RS[lane] = rsqrtf((((p0.x + p0.y) + (p0.z + p0.w)) + ((p1.x + p1.y) + (p1.z + p1.w))) * (1.f / GDV) + EPS); } \
        _Pragma("unroll") for (int mt = 0; mt < 4; ++mt) { const f32x4 rs4 = *(const LAS f32x4*)(RS + 16 * mt + 4 * quad); \
            _Pragma("unroll") for (int r = 0; r < 4; ++r) { const int i = 16 * mt + 4 * quad + r; const float z = bf2f(ZS[i * 16 + l15]); \
            ZS[i * 16 + l15] = (bf16)f2bf(Oprev[mt][r] * rs4[r] * gn * siluf_(z)); } } \
        { const v4u o0_ = *(const LAS v4u*)(ZS + lane * 16), o1_ = *(const LAS v4u*)(ZS + lane * 16 + 8); GAS v4u* op_ = (GAS v4u*)(OG + (size_t)(rb + lane) * D + h * 128 + 16 * w); op_[0] = o0_; op_[1] = o1_; } } while (0)
    for (int c = 0; c < nchunk; ++c) {
        asm volatile("" : "+v"(lane)); quad = lane >> 4; l15 = lane & 15;
        PROF_BEGIN(2);
        asm volatile("s_waitcnt vmcnt(0)" ::: "memory");
        __syncthreads();
        PROF_END(2);
        PROF_BEGIN(3);
        const unsigned char* img = img0 + (size_t)c * GI_STRIDE;
        f32x4 wvn[4];
        const float el = el_next;
        if (c + 1 < nchunk) { GDN_STAGE(img + GI_STRIDE, (c + 1) & 1); el_next = *(const float*)(img + GI_STRIDE + GI_SC);
            const GAS f32x4* WV = (const GAS f32x4*)(img + GI_STRIDE + GI_WV) + (w * 64 + lane) * 4;
#pragma unroll
            for (int mt = 0; mt < 4; ++mt) wvn[mt] = WV[mt]; }
        else {
#pragma unroll
            for (int mt = 0; mt < 4; ++mt) wvn[mt] = wv[mt]; }
        if (c > 0) GDN_FINISH(c - 1);
        PROF_END(3);
        PROF_BEGIN(4);
        *(LAS v4u*)(ZS + lane * 16) = zr0; *(LAS v4u*)(ZS + lane * 16 + 8) = zr1;
        if (c + 1 < nchunk) { const GAS v4u* zp = (const GAS v4u*)(ZGp + (size_t)(row0 + 64 * (c + 1) + lane) * NZG + h * 128 + 16 * w); zr0 = zp[0]; zr1 = zp[1]; }
        const LAS unsigned char* buf = F.lds + GS_BUF + (c & 1) * GI_IMG;
        const LAS bf16* WKN = (const LAS bf16*)(buf + GI_WKN); const LAS bf16* QG = (const LAS bf16*)(buf + GI_QG); const LAS bf16* KT = (const LAS bf16*)(buf + GI_KT); const LAS bf16* QKM = (const LAS bf16*)(buf + GI_QKM);
        f32x4 U[4], O[4];
#pragma unroll
        for (int mt = 0; mt < 4; ++mt) { U[mt] = wv[mt]; O[mt] = (f32x4){0.f, 0.f, 0.f, 0.f}; }
#pragma unroll
        for (int ks = 0; ks < 4; ++ks) { const bf16x8 Sb = acc2frag(Sacc[2 * ks], Sacc[2 * ks + 1]);
#pragma unroll
            for (int mt = 0; mt < 4; ++mt) { U[mt] = MFMA16(ldfrag(WKN, 136, 16 * mt, 32 * ks, lane), Sb, U[mt]); O[mt] = MFMA16(ldfrag(QG, 136, 16 * mt, 32 * ks, lane), Sb, O[mt]); } }
        bf16x8 Ub[2];
#pragma unroll
        for (int ks = 0; ks < 2; ++ks) Ub[ks] = acc2frag(U[2 * ks], U[2 * ks + 1]);
#pragma unroll
        for (int ks = 0; ks < 2; ++ks)
#pragma unroll
            for (int mt = 0; mt < 4; ++mt) O[mt] = MFMA16(ldfrag(QKM, 72, 16 * mt, 32 * ks, lane), Ub[ks], O[mt]);
#pragma unroll
        for (int mt = 0; mt < 8; ++mt) { Sacc[mt] = Sacc[mt] * el;
#pragma unroll
            for (int ks = 0; ks < 2; ++ks) Sacc[mt] = MFMA16(ldfrag(KT, 72, 16 * mt, 32 * ks, lane), Ub[ks], Sacc[mt]); }
        { LAS float* ps = PSQ + (c & 1) * 512;
#pragma unroll
          for (int mt = 0; mt < 4; ++mt)
#pragma unroll
              for (int r = 0; r < 4; ++r) { const float sq = row16_sum(O[mt][r] * O[mt][r]); if (l15 == 0) ps[(16 * mt + 4 * quad + r) * 8 + w] = sq; Oprev[mt][r] = O[mt][r]; } }
        PROF_END(4);
#pragma unroll
        for (int mt = 0; mt < 4; ++mt) wv[mt] = wvn[mt];
    }
    __syncthreads();
    GDN_FINISH(nchunk - 1);
    PROF_END(1);
#undef GDN_FINISH
#undef GDN_STAGE
    {
        float* so = (dry ? (float*)(F.ws + WS_T1) : F.out) + (samp ? O_GS : O_GP) - (dry ? O_GP : 0) + (size_t)(bb * GH + h) * GDK * GDV;
#pragma unroll
        for (int mt = 0; mt < 8; ++mt)
#pragma unroll
            for (int r = 0; r < 4; ++r) so[(size_t)(16 * mt + 4 * quad + r) * GDV + 16 * w + l15] = Sacc[mt][r];
    }
    __syncthreads();
}
constexpr int SI_CS = 0, SI_BT = 17408, SI_CB = 35840, SI_DT = 45056, SI_GAM = 46080, SI_IMG = 47104, SI_XT = SI_IMG, SI_STRIDE = SI_IMG + 32768;
constexpr int SSD_ITEMS_MAX = SSD_ITEMS;
static_assert(SI_STRIDE == SI_STRIDE_C, "image stride");
constexpr int SP_CS = 0, SP_BS = 17408, SP_DT = 34816, SP_GAM = 35840, SP_RAW = 40960;
static_assert(SP_RAW + 65536 <= RING_BYTES, "SSD precompute LDS map fits");

__device__ __forceinline__ void ssd_pre_item(Frame& F, int s, int it) {
    const bf16* P = (const bf16*)GENP(F.ws, WS_XC, SZ_XC, G_XC, s); const float* SM = (const float*)GENP(F.ws, WS_SM, SZ_SM, G_SM, s);
    const int tid = F.tid, w = F.wave;
    int lane = F.lane; asm volatile("" : "+v"(lane)); const int quad = lane >> 4, l15 = lane & 15;
    int bsel, g, r0, c; bool samp;
    if (it < NCH * NB * SG) { samp = false; const int bg = it / NCH; c = it % NCH; bsel = bg >> 3; g = bg & 7; r0 = bsel * SLAB_T + 64 * c; }
    else { samp = true; const int q = it - NCH * NB * SG; bsel = q >> 3; g = q & 7; c = 0; r0 = RP + bsel * DSEQ; }
    unsigned char* img = GENP(F.ws, WS_SSD, SZ_SIMG, G_IMG, s) + (size_t)it * SI_STRIDE;
    LAS bf16* CS = (LAS bf16*)(F.lds + SP_CS); LAS bf16* BS = (LAS bf16*)(F.lds + SP_BS); LAS float* DTV = (LAS float*)(F.lds + SP_DT); LAS float* GAM = (LAS float*)(F.lds + SP_GAM);
    v4u rawr[8];
#pragma unroll
    for (int i = 0; i < 8; ++i) { const int id = tid + NTHR * i, row = id >> 6, j = id & 63;
        const int col = j < 32 ? 3072 + g * 256 + 8 * j : (j < 48 ? 5120 + g * 128 + 8 * (j - 32) : 6144 + g * 128 + 8 * (j - 48));
        rawr[i] = *(const GAS v4u*)(P + (size_t)(r0 + row) * NXC + col); }
    const int cidx = tid < 256 ? 3072 + g * 256 + tid : (tid < 384 ? 5120 + g * 128 + (tid - 256) : 6144 + g * 128 + (tid - 384));
    const float* wcv = F.A.in[12]; const float w0 = wcv[cidx], w1 = wcv[CONV_CH + cidx], w2 = wcv[2 * CONV_CH + cidx], w3 = wcv[3 * CONV_CH + cidx], bias = F.A.in[13][cidx];
    float h0 = 0.f, h1 = 0.f, h2 = 0.f;
    if (c > 0) { const bf16* pp = P + (size_t)(r0 - 3) * NXC + cidx; h0 = bf2f(pp[0]); h1 = bf2f(pp[NXC]); h2 = bf2f(pp[2 * NXC]); }
    else if (samp) { const float* st = F.A.in[2] + (size_t)bsel * 3 * CONV_CH + cidx; h0 = st[0]; h1 = st[CONV_CH]; h2 = st[2 * CONV_CH]; }
    else if (s > 0) { const float* st = (const float*)(F.ws + WS_CARRY_MIX) + ((size_t)(s & 1) * NB + bsel) * 3 * CONV_CH + cidx; h0 = st[0]; h1 = st[CONV_CH]; h2 = st[2 * CONV_CH]; }
    if (tid < 256) { const int hh = 4 * g + (tid >> 6); const float dt = softplusf_(SM[(size_t)(r0 + lane) * 64 + 16 + hh] + F.A.in[18][hh]);
        const float ga = wave_incl_scan(dt * (-__expf(F.A.in[17][hh])), lane); DTV[(tid >> 6) * 64 + lane] = dt; GAM[(tid >> 6) * 64 + lane] = ga;
        ((float*)(img + SI_DT))[(tid >> 6) * 64 + lane] = dt; ((float*)(img + SI_GAM))[(tid >> 6) * 64 + lane] = ga; }
    { LAS bf16* RAW = (LAS bf16*)(F.lds + SP_RAW);
#pragma unroll
      for (int i = 0; i < 8; ++i) { const int id = tid + NTHR * i, row = id >> 6, j = id & 63; *(LAS v4u*)(RAW + row * 512 + 8 * j) = rawr[i]; } }
    __syncthreads();
    {
        unsigned colp2[32];
        LAS bf16* RAW = (LAS bf16*)(F.lds + SP_RAW);
        const LAS float* dtp = DTV + (tid < 256 ? (tid >> 6) * 64 : 0);
#pragma unroll
        for (int t = 0; t < 64; t += 2) { const float ra = bf2f(RAW[t * 512 + tid]), rb = bf2f(RAW[(t + 1) * 512 + tid]);
            float va = bias + w0 * h0 + w1 * h1 + w2 * h2 + w3 * ra; float vb = bias + w0 * h1 + w1 * h2 + w2 * ra + w3 * rb; h0 = h2; h1 = ra; h2 = rb;
            va = siluf_(va); vb = siluf_(vb); if (tid < 256) { va *= dtp[t]; vb *= dtp[t + 1]; }
            colp2[t >> 1] = pk2(va, vb); }
        if (tid < 384) {
            bf16* rowp = tid < 256 ? (bf16*)(img + SI_XT) + tid * 64 : (bf16*)(img + SI_BT) + (tid - 256) * 72;
#pragma unroll
            for (int i = 0; i < 8; ++i) { v4u o; o.x = colp2[4 * i]; o.y = colp2[4 * i + 1]; o.z = colp2[4 * i + 2]; o.w = colp2[4 * i + 3]; *(GAS v4u*)(rowp + 8 * i) = o; }
        }
        if (tid >= 256) {
            LAS bf16* colp = tid < 384 ? BS + kpos(tid - 256) : CS + kpos(tid - 384);
#pragma unroll
            for (int t = 0; t < 32; ++t) { colp[(2 * t) * 136] = (bf16)(colp2[t] & 0xffffu); colp[(2 * t + 1) * 136] = (bf16)(colp2[t] >> 16); }
        }
    }
    __syncthreads();
    {
        const int mt = w >> 1; bf16* CBG = (bf16*)(img + SI_CB);
#pragma unroll
        for (int q = 0; q < 2; ++q) { const int nt = 2 * (w & 1) + q; f32x4 acc = {0.f, 0.f, 0.f, 0.f};
#pragma unroll
            for (int ks = 0; ks < 4; ++ks) acc = MFMA16(ldfrag(CS, 136, 16 * mt, 32 * ks, lane), ldfrag(BS, 136, 16 * nt, 32 * ks, lane), acc);
#pragma unroll
            for (int r = 0; r < 4; ++r) CBG[(16 * mt + 4 * quad + r) * 72 + 16 * nt + l15] = (bf16)f2bf(acc[r]); }
    }
    for (int i = tid; i < 17408 / 16; i += NTHR) *(GAS v4u*)(img + SI_CS + 16 * i) = *(const LAS v4u*)(F.lds + SP_CS + 16 * i);
    __syncthreads();
}
__device__ __forceinline__ void phase_ssd_pre(Frame& F, int s) {
    const int nitems = s == DSLAB ? SSD_ITEMS_MAX : NCH * NB * SG;
    for (int it = F.bid; it < nitems; it += F.G) ssd_pre_item(F, s, it);
}

constexpr int SQ_BUF = 0, SQ_PS = 2 * SI_IMG, SQ_ZS = SQ_PS + 2048, SQ_RS = SQ_ZS + 8 * 4096;
static_assert(SQ_RS + 256 <= RING_BYTES, "SSD sequential LDS map fits");
__device__ __forceinline__ void ssd_seq_job(Frame& F, int s, bool samp, int bb, int g, bool dry = false) {
    const bf16* ZGp = (const bf16*)GENP(F.ws, WS_ZG, SZ_ZG, G_ZG, s); bf16* YS = (bf16*)GENP(F.ws, WS_YS, SZ_YS, G_YS, s);
    const int w = F.wave;
    int lane = F.lane; asm volatile("" : "+v"(lane)); int quad = lane >> 4, l15 = lane & 15;
    const int hl = w >> 1, ph = w & 1, head = 4 * g + hl;
    const int nchunk = samp ? 1 : NCH, row0 = samp ? RP + bb * DSEQ : bb * SLAB_T;
    const int item0 = samp ? NCH * NB * SG + bb * SG + g : (bb * SG + g) * NCH;
    const unsigned char* img0 = GENP(F.ws, WS_SSD, SZ_SIMG, G_IMG, s) + (size_t)item0 * SI_STRIDE;
    LAS float* PS = (LAS float*)(F.lds + SQ_PS); LAS bf16* ZS = (LAS bf16*)(F.lds + SQ_ZS) + w * 2048; LAS float* RS = (LAS float*)(F.lds + SQ_RS);
    f32x4 hacc[8][2];
    {
        const float* st = samp ? F.A.in[4] : F.out + O_SP;
        const size_t sb = (size_t)(bb * SH + head) * SN * SP;
#pragma unroll
        for (int mt = 0; mt < 8; ++mt)
#pragma unroll
            for (int nt = 0; nt < 2; ++nt)
#pragma unroll
                for (int r = 0; r < 4; ++r) { const int n = 16 * mt + 4 * quad + r, p = 32 * ph + 16 * nt + l15; hacc[mt][nt][r] = (samp || s > 0) ? st[sb + (size_t)n * SP + p] : 0.f; }
    }
    const float Dh = F.A.in[19][head];
    const int prow = hl * 64 + 32 * ph;
#define SSD_STAGE(imgp, bufi) do { for (int pc_ = w; pc_ < SI_IMG / 1024; pc_ += 8) \
        __builtin_amdgcn_global_load_lds((const unsigned*)((imgp) + pc_ * 1024 + lane * 16), (LAS unsigned*)(F.lds + SQ_BUF + (bufi) * SI_IMG + pc_ * 1024), 16, 0, 0); } while (0)
#define SSD_LOADXT(dst, imgp) do { const bf16* xb_ = (const bf16*)((imgp) + SI_XT); _Pragma("unroll") for (int nt = 0; nt < 2; ++nt) _Pragma("unroll") for (int ks = 0; ks < 2; ++ks) \
        dst[nt][ks] = *(const GAS v4u*)(xb_ + (prow + 16 * nt + l15) * 64 + 32 * ks + 8 * quad); } while (0)
    PROF_BEGIN(5);
    SSD_STAGE(img0, 0);
    v4u xt[2][2];
    SSD_LOADXT(xt, img0);
    v4u zr[4];
    { const GAS v4u* zp = (const GAS v4u*)(ZGp + (size_t)(row0 + lane) * NZG + 1024 + head * 64 + 32 * ph);
#pragma unroll
      for (int i = 0; i < 4; ++i) zr[i] = zp[i]; }
    const float nw0 = F.A.in[20][head * 64 + 32 * ph + l15], nw1 = F.A.in[20][head * 64 + 32 * ph + 16 + l15];
    for (int c = 0; c < nchunk; ++c) {
        asm volatile("" : "+v"(lane)); quad = lane >> 4; l15 = lane & 15;
        PROF_BEGIN(6);
        asm volatile("s_waitcnt vmcnt(0)" ::: "memory");
        __syncthreads();
        PROF_END(6);
        PROF_BEGIN(7);
        const unsigned char* img = img0 + (size_t)c * SI_STRIDE;
        const int r0 = row0 + 64 * c;
        v4u xtn[2][2];
        if (c + 1 < nchunk) { SSD_STAGE(img + SI_STRIDE, (c + 1) & 1); SSD_LOADXT(xtn, img + SI_STRIDE); }
        else {
#pragma unroll
            for (int nt = 0; nt < 2; ++nt)
#pragma unroll
                for (int ks = 0; ks < 2; ++ks) xtn[nt][ks] = xt[nt][ks]; }
#pragma unroll
        for (int i = 0; i < 4; ++i) *(LAS v4u*)(ZS + lane * 32 + 8 * i) = zr[i];
        if (c + 1 < nchunk) { const GAS v4u* zp = (const GAS v4u*)(ZGp + (size_t)(r0 + 64 + lane) * NZG + 1024 + head * 64 + 32 * ph);
#pragma unroll
          for (int i = 0; i < 4; ++i) zr[i] = zp[i]; }
        const LAS unsigned char* buf = F.lds + SQ_BUF + (c & 1) * SI_IMG;
        const LAS bf16* CS = (const LAS bf16*)(buf + SI_CS); const LAS bf16* BT = (const LAS bf16*)(buf + SI_BT); const LAS bf16* CBS = (const LAS bf16*)(buf + SI_CB);
        const LAS float* gm = (const LAS float*)(buf + SI_GAM) + hl * 64; const LAS float* dv = (const LAS float*)(buf + SI_DT) + hl * 64;
        const float last = gm[63];
        f32x4 y[4][2];
#pragma unroll
        for (int mt = 0; mt < 4; ++mt)
#pragma unroll
            for (int nt = 0; nt < 2; ++nt) y[mt][nt] = (f32x4){0.f, 0.f, 0.f, 0.f};
#pragma unroll
        for (int ks = 0; ks < 4; ++ks) { const bf16x8 hb0 = acc2frag(hacc[2 * ks][0], hacc[2 * ks + 1][0]), hb1 = acc2frag(hacc[2 * ks][1], hacc[2 * ks + 1][1]);
#pragma unroll
            for (int mt = 0; mt < 4; ++mt) { const bf16x8 a = ldfrag(CS, 136, 16 * mt, 32 * ks, lane); y[mt][0] = MFMA16(a, hb0, y[mt][0]); y[mt][1] = MFMA16(a, hb1, y[mt][1]); }
            __builtin_amdgcn_sched_barrier(0); }
#pragma unroll
        for (int mt = 0; mt < 4; ++mt)
#pragma unroll
            for (int r = 0; r < 4; ++r) { const float eg = __expf(gm[16 * mt + 4 * quad + r]); y[mt][0][r] *= eg; y[mt][1][r] *= eg; }
        PROF_END(7);
        PROF_BEGIN(8);
#pragma unroll
        for (int mt = 0; mt < 4; ++mt) { const int i = 16 * mt + l15; const float gi = gm[i], dti = dv[i], ddt = dti > 1e-30f ? Dh * __builtin_amdgcn_rcpf(dti) : 0.f;
#pragma unroll
            for (int ks = 0; ks < 2; ++ks) { if (32 * ks > 16 * mt + 15) continue;
                const v4u aw = __builtin_bit_cast(v4u, ldfrag(CBS, 72, 16 * mt, 32 * ks, lane));
                const f32x4 g0 = *(const LAS f32x4*)(gm + 32 * ks + 8 * quad), g1 = *(const LAS f32x4*)(gm + 32 * ks + 8 * quad + 4);
                float cv[8] = {bflo(aw.x), bfhi(aw.x), bflo(aw.y), bfhi(aw.y), bflo(aw.z), bfhi(aw.z), bflo(aw.w), bfhi(aw.w)};
                const float gj[8] = {g0.x, g0.y, g0.z, g0.w, g1.x, g1.y, g1.z, g1.w};
#pragma unroll
                for (int jj = 0; jj < 8; ++jj) { const int j = 32 * ks + 8 * quad + jj; float v = i >= j ? cv[jj] * __expf(gi - gj[jj]) : 0.f; if (i == j) v += ddt; cv[jj] = v; }
                v4u bw; bw.x = pk2(cv[0], cv[1]); bw.y = pk2(cv[2], cv[3]); bw.z = pk2(cv[4], cv[5]); bw.w = pk2(cv[6], cv[7]); const bf16x8 a1 = __builtin_bit_cast(bf16x8, bw);
#pragma unroll
                for (int nt = 0; nt < 2; ++nt) y[mt][nt] = MFMA16(a1, __builtin_bit_cast(bf16x8, xt[nt][ks]), y[mt][nt]); }
            __builtin_amdgcn_sched_barrier(0); }
        PROF_END(8);
        PROF_BEGIN(9);
#pragma unroll
        for (int mt = 0; mt < 4; ++mt)
#pragma unroll
            for (int r = 0; r < 4; ++r) { const int i = 16 * mt + 4 * quad + r; float sq = 0.f;
#pragma unroll
                for (int nt = 0; nt < 2; ++nt) { const float z = bf2f(ZS[i * 32 + 16 * nt + l15]); const float yz = y[mt][nt][r] * siluf_(z); y[mt][nt][r] = yz; sq += yz * yz; }
                sq = row16_sum(sq); if (l15 == 0) PS[i * 8 + w] = sq; }
        PROF_END(9);
        PROF_BEGIN(10);
        {
            const float el = __expf(last);
#pragma unroll
            for (int mt = 0; mt < 8; ++mt)
#pragma unroll
                for (int nt = 0; nt < 2; ++nt) hacc[mt][nt] = hacc[mt][nt] * el;
#pragma unroll
            for (int ks = 0; ks < 2; ++ks) { const f32x4 g0 = *(const LAS f32x4*)(gm + 32 * ks + 8 * quad), g1 = *(const LAS f32x4*)(gm + 32 * ks + 8 * quad + 4);
                const float ed[8] = {__expf(last - g0.x), __expf(last - g0.y), __expf(last - g0.z), __expf(last - g0.w), __expf(last - g1.x), __expf(last - g1.y), __expf(last - g1.z), __expf(last - g1.w)};
                bf16x8 xw[2];
#pragma unroll
                for (int nt = 0; nt < 2; ++nt) { const v4u xv = xt[nt][ks];
                    v4u o; o.x = pk2(bflo(xv.x) * ed[0], bfhi(xv.x) * ed[1]); o.y = pk2(bflo(xv.y) * ed[2], bfhi(xv.y) * ed[3]); o.z = pk2(bflo(xv.z) * ed[4], bfhi(xv.z) * ed[5]); o.w = pk2(bflo(xv.w) * ed[6], bfhi(xv.w) * ed[7]);
                    xw[nt] = __builtin_bit_cast(bf16x8, o); }
#pragma unroll
                for (int mt = 0; mt < 8; ++mt) { const bf16x8 a = ldfrag(BT, 72, 16 * mt, 32 * ks, lane); hacc[mt][0] = MFMA16(a, xw[0], hacc[mt][0]); hacc[mt][1] = MFMA16(a, xw[1], hacc[mt][1]); }
                __builtin_amdgcn_sched_barrier(0); }
        }
        PROF_END(10);
        PROF_BEGIN(11);
        __syncthreads();
        { const f32x4 p0 = *(const LAS f32x4*)(PS + lane * 8), p1 = *(const LAS f32x4*)(PS + lane * 8 + 4);
          RS[lane] = rsqrtf((((p0.x + p0.y) + (p0.z + p0.w)) + ((p1.x + p1.y) + (p1.z + p1.w))) * (1.f / 256.f) + EPS); }
#pragma unroll
        for (int mt = 0; mt < 4; ++mt) { const f32x4 rs4 = *(const LAS f32x4*)(RS + 16 * mt + 4 * quad);
#pragma unroll
            for (int r = 0; r < 4; ++r) { const int i = 16 * mt + 4 * quad + r;
#pragma unroll
                for (int nt = 0; nt < 2; ++nt) ZS[i * 32 + 16 * nt + l15] = (bf16)f2bf(y[mt][nt][r] * rs4[r] * (nt ? nw1 : nw0)); } }
        { GAS v4u* op = (GAS v4u*)(YS + (size_t)(r0 + lane) * 2048 + head * 64 + 32 * ph);
#pragma unroll
          for (int i = 0; i < 4; ++i) op[i] = *(const LAS v4u*)(ZS + lane * 32 + 8 * i); }
        PROF_END(11);
#pragma unroll
        for (int nt = 0; nt < 2; ++nt)
#pragma unroll
            for (int ks = 0; ks < 2; ++ks) xt[nt][ks] = xtn[nt][ks];
    }
    PROF_END(5);
#undef SSD_STAGE
#undef SSD_LOADXT
    {
        float* so = (dry ? (float*)(F.ws + WS_T1) : F.out) + (samp ? O_SS : O_SP) - (dry ? O_GP : 0) + (size_t)(bb * SH + head) * SN * SP;
#pragma unroll
        for (int mt = 0; mt < 8; ++mt)
#pragma unroll
            for (int nt = 0; nt < 2; ++nt)
#pragma unroll
                for (int r = 0; r < 4; ++r) so[(size_t)(16 * mt + 4 * quad + r) * SP + 32 * ph + 16 * nt + l15] = hacc[mt][nt][r];
    }
    __syncthreads();
}
#ifndef SCAN_REP_GDN
#define SCAN_REP_GDN 0
#endif
#ifndef SCAN_REP_SSD
#define SCAN_REP_SSD 0
#endif
__device__ __forceinline__ void scan_job(Frame& F, int s, int j) {
    if (j < 32) {
#if SCAN_REP_GDN
        gdn_seq_job(F, s, false, j >> 3, j & 7, true);
#endif
        gdn_seq_job(F, s, false, j >> 3, j & 7);
    } else if (j < 64) {
#if SCAN_REP_SSD
        ssd_seq_job(F, s, false, (j - 32) >> 3, (j - 32) & 7, true);
#endif
        ssd_seq_job(F, s, false, (j - 32) >> 3, (j - 32) & 7);
    } else if (j < 128) gdn_seq_job(F, s, true, (j - 64) >> 3, (j - 64) & 7);
    else ssd_seq_job(F, s, true, (j - 128) >> 3, (j - 128) & 7);
}
__device__ __forceinline__ void phase_scan(Frame& F, int s) {
    const int njobs = s == DSLAB ? 192 : 64;
    for (int j = F.bid; j < njobs; j += F.G) scan_job(F, s, j);
}
#define XB_TMO      128
#define XB_XCNT(j)  (256  + 64 * (j))
#define XB_XSUB(j)  (1280 + 64 * (j))
#define XB_XGEN(j)  (2304 + 64 * (j))
#define XB_TOP      3328
#define XB_TOPGEN   3392
#define XCD_BAR_WORDS 3456
#define XB_SPIN_CAP (1u << 18)
__device__ __forceinline__ unsigned xb_ld(unsigned* p)              { return __hip_atomic_load(p, __ATOMIC_RELAXED, __HIP_MEMORY_SCOPE_AGENT); }
__device__ __forceinline__ unsigned xb_add(unsigned* p, unsigned v) { return __hip_atomic_fetch_add(p, v, __ATOMIC_RELAXED, __HIP_MEMORY_SCOPE_AGENT); }
__device__ __forceinline__ unsigned xb_xcc_id() { return (unsigned)__builtin_amdgcn_s_getreg((3 << 11) | 20) & 0xFu; }
#define XB_SPIN(cond, bar) do { unsigned _sp = 0; while (cond) { __builtin_amdgcn_s_sleep(1); \
    if ((++_sp & 255u) == 0u) { if (xb_ld(&(bar)[XB_TMO])) break; if (_sp > XB_SPIN_CAP) { atomicAdd(&(bar)[XB_TMO], 1u); break; } } } } while (0)
struct XcdBarrier { unsigned* bar; unsigned x; volatile LAS unsigned* st; };
__device__ __forceinline__ XcdBarrier xcd_barrier_post(unsigned* bar, volatile LAS unsigned* st) {
    XcdBarrier b; b.bar = bar; b.x = xb_xcc_id(); b.st = st;
    if (threadIdx.x == 0) (void)xb_add(&bar[XB_XCNT(b.x)], 1u);
    return b;
}
__device__ __forceinline__ void xcd_barrier_complete(unsigned* bar, unsigned x, unsigned& nloc, unsigned& nx) {
    const unsigned G = gridDim.x * gridDim.y * gridDim.z;
    unsigned sum, cnt, mine, sp = 0u;
    for (;;) {
        sum = 0u; cnt = 0u; mine = 0u;
#pragma unroll
        for (unsigned j = 0; j < 16; ++j) { const unsigned c = xb_ld(&bar[XB_XCNT(j)]); sum += c; cnt += (c > 0u) ? 1u : 0u; mine = (j == x) ? c : mine; }
        if (sum == G) break;
        __builtin_amdgcn_s_sleep(1);
        if ((++sp & 255u) == 0u) { if (xb_ld(&bar[XB_TMO])) break; if (sp > XB_SPIN_CAP) { atomicAdd(&bar[XB_TMO], 1u); break; } }
    }
    nloc = mine > 0u ? mine : 1u; nx = cnt > 0u ? cnt : 1u;
}
__device__ __forceinline__ void xcd_barrier(const XcdBarrier& b) {
    asm volatile("s_waitcnt vmcnt(0)" ::: "memory");
    __syncthreads();
    if (threadIdx.x == 0) {
        unsigned* bar = b.bar;
        __builtin_amdgcn_s_waitcnt(0);
        unsigned nloc = b.st[0], nx = b.st[1];
        if (nloc == 0u) { xcd_barrier_complete(bar, b.x, nloc, nx); b.st[0] = nloc; b.st[1] = nx; }
        const unsigned old = xb_add(&bar[XB_XSUB(b.x)], 1u);
        const unsigned gen = old / nloc;
        if (old + 1u == (gen + 1u) * nloc) {
            __builtin_amdgcn_fence(__ATOMIC_RELEASE, "agent");
            asm volatile("s_waitcnt vmcnt(0)" ::: "memory");
            const unsigned og = xb_add(&bar[XB_TOP], 1u);
            const unsigned tg = og / nx;
            if (og + 1u == (tg + 1u) * nx) xb_add(&bar[XB_TOPGEN], 1u);
            else XB_SPIN(xb_ld(&bar[XB_TOPGEN]) == tg, bar);
            __builtin_amdgcn_fence(__ATOMIC_ACQUIRE, "agent");
            xb_add(&bar[XB_XGEN(b.x)], 1u);
            asm volatile("s_waitcnt vmcnt(0)" ::: "memory");
        } else {
            XB_SPIN(xb_ld(&bar[XB_XGEN(b.x)]) == gen, bar);
            __builtin_amdgcn_fence(__ATOMIC_ACQUIRE, "agent");
            asm volatile("s_waitcnt vmcnt(0)" ::: "memory");
        }
    }
    __syncthreads();
}
constexpr int CW_BAR = 4096;
#ifndef PHASE_MASK
#define PHASE_MASK 0xFFF
#endif
#define PM(k) ((PHASE_MASK >> (k)) & 1)
#ifndef GEMM_REPS
#define GEMM_REPS 1
#endif
#ifndef LIGHT_REPS
#define LIGHT_REPS 1
#endif
#ifndef BAR_REPS
#define BAR_REPS 1
#endif
#ifndef PROF_MAX
#define PROF_MAX 0
#endif
#ifndef PROF_PH
#define PROF_PH 0
#endif
#ifndef PROF_ONLY_PH
#define PROF_ONLY_PH -1
#endif
#ifndef GU_STEADY
#define GU_STEADY 2
#endif
#ifndef GSPLIT_P0
#define GSPLIT_P0 18
#endif
#ifndef GU1_P0
#define GU1_P0 18
#endif
#ifndef PRE_REPS
#define PRE_REPS 1
#endif

#define GEMM_PHASE(EPI_T, APTR, BOFF, N_, K_, ...) do { pg8::Gemm g{(const pg8::bf16_t*)(APTR), (const pg8::bf16_t*)(F.ws + (BOFF)), R, (N_), (K_), (K_)}; \
    pg8::ListOrder S; S.init(R, (N_), j0, j1, j1 > 1 ? 8 : 1); epi::EPI_T E{__VA_ARGS__}; pg8::gemm_phase<epi::EPI_T, pg8::ListOrder, true, true>(F.lds, g, S, E, F.tid); if (GEMM_REPS > 1) { __syncthreads(); pg8::gemm_phase<epi::EPI_T, pg8::ListOrder, true, true>(F.lds, g, S, E, F.tid); } } while (0)
#define GP(name, s) GENP(ws, WS_##name, SZ_##name, G_##name, s)
__device__ __forceinline__ void stage_inproj(Frame& F, int s, int j0, int j1) { unsigned char* ws = F.ws; const int R = slab_rows(s);
    GEMM_PHASE(EpiProj, GP(HB, s), WS_WIN, NIN, D, (bf16*)GP(XC, s), (bf16*)GP(ZG, s), (bf16*)GP(GT, s), (float*)GP(SM, s)); }
__device__ __forceinline__ void stage_gate(Frame& F, int s, int j0, int j1) { unsigned char* ws = F.ws; const int R = slab_rows(s);
    GEMM_PHASE(EpiGate1, GP(OG, s), WS_WG, D, D, (const bf16*)GP(GT, s), (float*)GP(T1, s));
    __syncthreads();
    GEMM_PHASE(EpiGate2, GP(YS, s), WS_WS, D, 2048, (const bf16*)GP(GT, s), (const float*)GP(T1, s), (bf16*)GP(MIX, s)); }
__device__ __forceinline__ void stage_out(Frame& F, int s, int j0, int j1) { unsigned char* ws = F.ws; const int R = slab_rows(s);
    GEMM_PHASE(EpiOut, GP(MIX, s), WS_WOUT, D, D, F.A.in[0], F.A.in[1], (const float*)(ws + WS_MODV), (const float*)(ws + WS_G2), F.out + O_YP, F.out + O_YS, (bf16*)GP(X1G, s), (float*)GENP(ws, WS_SS1, SZ_SS, G_SS, s), s, F.lds, &F.prof); }
__device__ __forceinline__ void stage_up(Frame& F, int s, int j0, int j1) { unsigned char* ws = F.ws; const int R = slab_rows(s);
    GEMM_PHASE(EpiUp, GP(X1G, s), WS_WUP, NUP, D, (const float*)GENP(ws, WS_SS1, SZ_SS, G_SS, s), (const float*)(ws + WS_SHW), (bf16*)GP(U, s)); }
constexpr int CW_GFLAG = 65536;
__device__ __forceinline__ void gate_set_flag(Frame& F, gu32* flag) {
    asm volatile("s_waitcnt vmcnt(0)" ::: "memory"); __syncthreads();
    if (F.tid == 0) { __builtin_amdgcn_fence(__ATOMIC_RELEASE, "agent"); __hip_atomic_store(flag, 1u, __ATOMIC_RELAXED, __HIP_MEMORY_SCOPE_AGENT); }
}
__device__ __forceinline__ void stage_gate_split(Frame& F, int s, int p, int T) { unsigned char* ws = F.ws; const int R = slab_rows(s); const int nun = (R / 256) * 4, part = T / nun, j = T % nun;
    gu32* flA = F.ctl + CW_GFLAG + ((p * 2 + 0) * 64 + j) * 32; gu32* flB = F.ctl + CW_GFLAG + ((p * 2 + 1) * 64 + j) * 32;
    if (part == 0) { pg8::Gemm g{(const pg8::bf16_t*)GP(OG, s), (const pg8::bf16_t*)(ws + WS_WG), R, D, D, D};
        pg8::ListOrder S; S.init(R, D, j, 1); epi::EpiGate1 E{(const bf16*)GP(GT, s), (float*)GP(T1, s)}; pg8::gemm_phase<epi::EpiGate1, pg8::ListOrder, true, true>(F.lds, g, S, E, F.tid); gate_set_flag(F, flA); }
    else { const int ko = part == 2 ? 1024 : 0; pg8::Gemm g{(const pg8::bf16_t*)GP(YS, s) + ko, (const pg8::bf16_t*)(ws + WS_WS) + ko, R, D, 1024, 2048};
        pg8::ListOrder S; S.init(R, D, j, 1); epi::EpiGate2S E{(const bf16*)GP(GT, s), (const float*)GP(T1, s), part == 1 ? (float*)GP(T1, s) : (float*)nullptr, (bf16*)GP(MIX, s), (const unsigned*)(part == 1 ? flA : flB)};
        pg8::gemm_phase<epi::EpiGate2S, pg8::ListOrder, true, true>(F.lds, g, S, E, F.tid); if (part == 1) gate_set_flag(F, flB); } }
__device__ __forceinline__ void stage_down(Frame& F, int s, int j, int nper) { unsigned char* ws = F.ws; const int R = slab_rows(s); constexpr int KP = DFF / 2;
    if (j < nper) { pg8::Gemm g{(const pg8::bf16_t*)GP(ACT, s), (const pg8::bf16_t*)(ws + WS_WDN), R, D, KP, DFF};
        pg8::ListOrder S; S.init(R, D, j, 1); epi::EpiDown0 E{(const float*)(ws + WS_MODV), F.out + O_YP, F.out + O_YS, s}; pg8::gemm_phase<epi::EpiDown0, pg8::ListOrder, true, true>(F.lds, g, S, E, F.tid); }
    else { pg8::Gemm g{(const pg8::bf16_t*)GP(ACT, s) + KP, (const pg8::bf16_t*)(ws + WS_WDN) + KP, R, D, KP, DFF};
        pg8::ListOrder S; S.init(R, D, j - nper, 1); epi::EpiDown1 E{(float*)GP(PD, s)}; pg8::gemm_phase<epi::EpiDown1, pg8::ListOrder, true, true>(F.lds, g, S, E, F.tid); } }
constexpr int NSTAGE = 10, NPHASE = NSLAB + NSTAGE - 1, NSTEPS = 1 + NPHASE;
constexpr int CW_TICKET = 16384;
#define SV(k) ((p - (k)) >= 0 && (p - (k)) < NSLAB)
__device__ __forceinline__ int rup8(int n) { return (n + 7) & ~7; }
__device__ __forceinline__ void run_phase(Frame& F, int p) {
    const int n_scan = SV(3) ? ((p - 3) == DSLAB ? 192 : 64) : 0;
    const int nper_dn = SV(8) ? rup8((slab_rows(p - 8) / 256) * 4) : 0, n_dn = 2 * nper_dn;
    const bool gsplit = p >= GSPLIT_P0; const int n_g2 = SV(4) ? (gsplit ? 3 * ((slab_rows(p - 4) / 256) * 4) : rup8((slab_rows(p - 4) / 256) * 4)) : 0;
    const int n_gp = SV(2) ? ((p - 2) == DSLAB ? GDN_ITEMS : NCH * NB * GH) / 2 : 0;
    const int GA = p >= 4 ? 4 : 1; const int GU = p >= GU1_P0 ? 1 : GU_STEADY;
    const int n_in = SV(1) ? 8 * (((((slab_rows(p - 1) / 256) * (NIN / 256) + 7) / 8) + GA - 1) / GA) : 0;
    const int n_up = SV(6) ? 8 * (((((slab_rows(p - 6) / 256) * (NUP / 256) + 7) / 8) + GU - 1) / GU) : 0;
    const int n_g1 = 0;
    const int n_ou = SV(5) ? rup8((slab_rows(p - 5) / 256) * 4) : 0;
    const int n_sp = SV(2) ? ((p - 2) == DSLAB ? SSD_ITEMS : NCH * NB * SG) : 0;
    constexpr int P_CA = 256, P_N1 = 128, P_FI = 128, P_MC = 16, P_P1 = 88, P_CV = 512;
    const int n_ca = SV(7) ? slab_rows(p - 7) / 8 : 0, n_n1 = SV(0) ? P_N1 : 0, n_fi = SV(9) ? P_FI : 0, n_mc = SV(2) ? P_MC : 0, n_p1 = p == 1 ? P_P1 : 0, n_cv = p == 0 ? P_CV : 0;
    const int oA = n_scan + n_ou;
    const int o1 = n_scan, o2 = oA + n_dn, o3 = o2 + n_g2, o4 = o3 + n_gp, o5 = o4 + n_in, o6 = o5 + n_up, o7 = o6 + n_g1, o8 = o7, o9 = o8 + n_sp,
              o10 = o9 + n_ca, o11 = o10 + n_n1, o12 = o11 + n_fi, o13 = o12 + n_mc, o14 = o13 + n_p1, total = o14 + n_cv;
    const int label = F.bid & 7;
    gu32* ctr = F.ctl + CW_TICKET + (p * 8 + label) * 64;
    volatile LAS unsigned* slot = F.MISC + 16;
    PROF_BEGIN(12);
#define NEXT_TASK(T_, it_) do { if (F.tid == 0) slot[(it_) & 1] = __hip_atomic_fetch_add(ctr, 1u, __ATOMIC_RELAXED, __HIP_MEMORY_SCOPE_AGENT); __syncthreads(); \
        T_ = (int)__builtin_amdgcn_readfirstlane(slot[(it_) & 1]) * 8 + label; } while (0)
    int T, it = 0;
    NEXT_TASK(T, it);
    while (T < total) {
        { int t_ = F.tid; unsigned char* w_ = F.ws; float* o_ = F.out; asm volatile("" : "+v"(t_), "+s"(w_), "+s"(o_));
          F.tid = t_; F.lane = t_ & 63; F.wave = __builtin_amdgcn_readfirstlane(t_ >> 6); F.ws = w_; F.out = o_; }
        const int kind_ = T < o1 ? 20 : T < oA ? 27 : T < o2 ? 21 : T < o3 ? 22 : T < o4 ? 23 : T < o5 ? 24 : T < o6 ? 25 : T < o7 ? 26 : T < o8 ? 27 : T < o9 ? 28 : 30;
        unsigned long long tk0_ = 0; if (PROF_SEL >= 20 && PROF_SEL <= 30) tk0_ = __builtin_amdgcn_s_memrealtime();
        if (T < o1) scan_job(F, p - 3, T);
        else if (T < oA) stage_out(F, p - 5, T - o1, 1);
        else if (T < o2) stage_down(F, p - 8, T - oA, nper_dn);
        else if (T < o3) { if (gsplit) stage_gate_split(F, p - 4, p, T - o2); else stage_gate(F, p - 4, T - o2, 1); }
        else if (T < o4) gdn_pre_pair(F, p - 2, T - o3);
        else if (T < o5) stage_inproj(F, p - 1, ((T - o4) & 7) + 8 * GA * ((T - o4) >> 3), GA);
        else if (T < o6) stage_up(F, p - 6, ((T - o5) & 7) + 8 * GU * ((T - o5) >> 3), GU);
        else if (T < o7) { }
        else if (T < o9) ssd_pre_item(F, p - 2, T - o8);
        else if (T < o10) phase_convact(F, p - 7, T - o9, n_ca);
        else if (T < o11) phase_norm1(F, p, T - o10, P_N1);
        else if (T < o12) phase_final(F, p - 9, T - o11, P_FI);
        else if (T < o13) phase_mix_carry(F, p - 2, T - o12, P_MC);
        else if (T < o14) phase_prologue1(F, T - o13, P_P1);
        else phase_convert_rest(F, T - o14, P_CV);
        if (PROF_SEL >= 20 && PROF_SEL <= 30 && kind_ == PROF_SEL && (PROF_ONLY_PH < 0 || p == PROF_ONLY_PH)) F.prof += __builtin_amdgcn_s_memrealtime() - tk0_;
        ++it; { PROF_BEGIN(29); NEXT_TASK(T, it); PROF_END(29); }
    }
#undef NEXT_TASK
    PROF_END(12);
}
__device__ __forceinline__ void run_step(Frame& F, int st) {
    if (st == 0) { PROF_BEGIN(17); phase_prologue0(F); PROF_END(17); return; }
    run_phase(F, st - 1);
}
__global__ void __launch_bounds__(NTHR, 2) mk_fwd(Args a) {
    extern __shared__ __attribute__((aligned(16))) unsigned char lds[];
    Frame F(a); F.prof = 0;
    F.lds = (LAS unsigned char*)lds; F.MISC = (volatile LAS unsigned*)(F.lds + MISC_OFF);
    F.tid = threadIdx.x; F.lane = F.tid & 63; F.wave = __builtin_amdgcn_readfirstlane(F.tid >> 6); F.G = gridDim.x; F.bid = blockIdx.x;
    F.out = a.out; F.ws = a.ws; F.ctl = (gu32*)(a.ws + WS_CTL);
    for (int u = F.tid; u < (LDS_BYTES - LDSCTL_OFF) / 4; u += NTHR) ((LAS unsigned*)(F.lds + LDSCTL_OFF))[u] = 0u;
    __syncthreads();
    XcdBarrier bar; bar.bar = (unsigned*)(F.ctl + CW_BAR); bar.x = 0; bar.st = nullptr;
    const bool multi = (a.ph_hi - a.ph_lo) > 1;
    if (multi) bar = xcd_barrier_post((unsigned*)(F.ctl + CW_BAR), F.MISC + 8);
    for (int st = a.ph_lo; st < a.ph_hi; ++st) {
        { int t_ = threadIdx.x, b_ = blockIdx.x; unsigned char* w_ = a.ws; float* o_ = a.out; asm volatile("" : "+v"(t_), "+s"(b_), "+s"(w_), "+s"(o_));
          F.tid = t_; F.lane = t_ & 63; F.wave = __builtin_amdgcn_readfirstlane(t_ >> 6); F.bid = b_; F.ws = w_; F.out = o_; }
        unsigned long long tph_ = 0; if (PROF_SEL >= 39) tph_ = __builtin_amdgcn_s_memrealtime();
        run_step(F, st);
        if (st + 1 < a.ph_hi) { if (st == a.ph_lo) cooperative_groups::this_grid().sync(); else { PROF_BEGIN(16); xcd_barrier(bar); if (BAR_REPS > 1) xcd_barrier(bar); PROF_END(16); } }
        if (PROF_SEL == 39 && st - 1 == PROF_PH) F.prof += __builtin_amdgcn_s_memrealtime() - tph_;
        if (PROF_SEL >= 40) { const int ph_ = st - 1; const int grp_ = st < 1 ? 0 : ph_ < 4 ? 1 : ph_ < 10 ? 2 : ph_ < 16 ? 3 : ph_ < 20 ? 4 : 5; if (PROF_SEL - 40 == grp_) F.prof += __builtin_amdgcn_s_memrealtime() - tph_; }
    }
    if (PROF_SEL != 0) {
#if PROF_MAX
        if (F.tid == 0) __hip_atomic_fetch_max((unsigned long long*)(F.ctl + 8192), F.prof * F.G, __ATOMIC_RELAXED, __HIP_MEMORY_SCOPE_AGENT);
#else
        if (F.tid == 0) __hip_atomic_fetch_add((unsigned long long*)(F.ctl + 8192), F.prof, __ATOMIC_RELAXED, __HIP_MEMORY_SCOPE_AGENT);
#endif
        xcd_barrier(bar);
        const unsigned long long tot = __hip_atomic_load((unsigned long long*)(F.ctl + 8192), __ATOMIC_RELAXED, __HIP_MEMORY_SCOPE_AGENT);
        const unsigned long long t0 = __builtin_amdgcn_s_memrealtime(), dur = tot * PROF_MULT / F.G; while (__builtin_amdgcn_s_memrealtime() - t0 < dur) __builtin_amdgcn_s_sleep(8); }
}
#ifndef MK_SINGLE
#define MK_SINGLE 1
#endif
extern "C" void kernel_launch(void* const* d_in, const int* in_sizes, int n_in, void* d_out, int out_size, void* d_ws, size_t ws_size, hipStream_t stream) {
    static int grid = 0;
    if (grid == 0) {
        if (n_in != 30 || (size_t)out_size != O_END || ws_size < WS_END) { fprintf(stderr, "kernel_launch: unexpected shapes: n_in %d out %d ws %zu (need %zu)\n", n_in, out_size, ws_size, (size_t)WS_END); grid = -1; return; }
        int dev = 0, cus = 0;
        if (hipGetDevice(&dev) != hipSuccess || hipDeviceGetAttribute(&cus, hipDeviceAttributeMultiprocessorCount, dev) != hipSuccess) { grid = -1; return; }
        if (hipFuncSetAttribute((const void*)mk_fwd, hipFuncAttributeMaxDynamicSharedMemorySize, LDS_BYTES) != hipSuccess) { fprintf(stderr, "kernel_launch: hipFuncSetAttribute failed\n"); grid = -1; return; }
        int per_cu = 0;
        if (hipOccupancyMaxActiveBlocksPerMultiprocessor(&per_cu, (const void*)mk_fwd, NTHR, LDS_BYTES) != hipSuccess || per_cu < 1) fprintf(stderr, "kernel_launch: occupancy query says %d\n", per_cu);
        (void)hipGetLastError();
        grid = cus * (per_cu < 1 ? 1 : per_cu);
    }
    if (grid < 0) return;
    (void)hipMemsetAsync((char*)d_ws + WS_CTL, 0, CTL_ZERO_BYTES, stream);
    Args a{};
    for (int i = 0; i < 30; ++i) a.in[i] = (const float*)d_in[i];
    a.out = (float*)d_out; a.ws = (unsigned char*)d_ws;
#if MK_SINGLE
    a.ph_lo = 0; a.ph_hi = NSTEPS;
    void* kargs[] = {(void*)&a};
    hipError_t le = hipLaunchCooperativeKernel((const void*)mk_fwd, dim3(grid), dim3(NTHR), kargs, LDS_BYTES, stream);
    if (le != hipSuccess) fprintf(stderr, "kernel_launch: cooperative launch failed: %s (grid %d)\n", hipGetErrorString(le), grid);
#else
    for (int st = 0; st < NSTEPS; ++st) { a.ph_lo = st; a.ph_hi = st + 1; hipLaunchKernelGGL(mk_fwd, dim3(grid), dim3(NTHR), LDS_BYTES, stream, a); }
#endif
}
```

```cpp
#include <hip/hip_runtime.h>
#include <hip/hip_cooperative_groups.h>
#include <cstdio>
#include <cstdint>

namespace pg8 {
#define PG8_LAS __attribute__((address_space(3)))
typedef unsigned short bf16_t;
typedef short bf16x8 __attribute__((ext_vector_type(8)));
typedef float f32x4 __attribute__((ext_vector_type(4)));
typedef unsigned u32x4 __attribute__((ext_vector_type(4)));
typedef unsigned u32x2 __attribute__((ext_vector_type(2)));
constexpr int BM = 256, BK = 64, HALF = 128, HTB = HALF * BK * 2, STAGE_BYTES = 8 * HTB, NXCD = 8, WGM = 8;

__host__ __device__ __forceinline__ int lds_byte(int r, int c) { const int st = (r >> 4) * 2 + (c >> 5), rr = r & 15, cc = c & 31, ob = rr * 64 + cc * 2; return st * 1024 + (ob ^ (((ob >> 9) & 1) << 5)); }
__host__ __device__ __forceinline__ void stage_rc(int b, int& R, int& C) { const int st = b / 1024, sb = b % 1024, swz = sb ^ (((sb >> 9) & 1) << 5); R = (st >> 1) * 16 + swz / 64; C = (st & 1) * 32 + (swz % 64) / 2; }
__host__ __device__ __forceinline__ int perm32(int rho) { const int n = rho >> 4, i = rho & 15; return 8 * (i >> 2) + 4 * n + (i & 3); }

struct Unit { int pm, pn; };
struct Gemm { const bf16_t* A; const bf16_t* Bt; int M, N, K, ld; };

struct StaticOrder {
    int nM, nN, nwg, G, c;
    __host__ __device__ void init(int M, int N, int G_, int c_) { nM = M / BM; nN = N / BM; nwg = nM * nN; G = G_; c = c_; }
    __host__ __device__ bool next(int i, Unit& u) const {
        const long L = (long)i * G + c; if (L >= nwg) return false;
        int wgid = (int)L; { const int q = nwg / NXCD, r = nwg % NXCD, xcd = wgid % NXCD, off = wgid / NXCD; wgid = (xcd < r ? xcd * (q + 1) : r * (q + 1) + (xcd - r) * q) + off; }
        const int nig = WGM * nN, gid = wgid / nig, fm = gid * WGM, gsz = (nM - fm) < WGM ? (nM - fm) : WGM;
        u.pm = fm + ((wgid % nig) % gsz); u.pn = (wgid % nig) / gsz; return true;
    }
    __device__ __forceinline__ void a_ready(const Unit&) const {}
    __device__ __forceinline__ void done(const Unit&) const {}
};

typedef float f32x2_t __attribute__((ext_vector_type(2))); typedef __bf16 bf16x2_t __attribute__((ext_vector_type(2)));
struct ListOrder {
    int nM, nN, nwg, j0, n, st;
    __host__ __device__ void init(int M, int N, int j0_, int n_, int st_ = 1) { nM = M / BM; nN = N / BM; nwg = nM * nN; j0 = j0_; n = n_; st = st_; }
    __host__ __device__ bool next(int i, Unit& u) const {
        const int L = j0 + i * st; if (i >= n || L < 0 || L >= nwg) return false;
        int wgid = L; { const int q = nwg / NXCD, r = nwg % NXCD, xcd = wgid % NXCD, off = wgid / NXCD; wgid = (xcd < r ? xcd * (q + 1) : r * (q + 1) + (xcd - r) * q) + off; }
        const int nig = WGM * nN, gid = wgid / nig, fm = gid * WGM, gsz = (nM - fm) < WGM ? (nM - fm) : WGM;
        u.pm = fm + ((wgid % nig) % gsz); u.pn = (wgid % nig) / gsz; return true;
    }
    __device__ __forceinline__ void a_ready(const Unit&) const {}
    __device__ __forceinline__ void done(const Unit&) const {}
};
__device__ __forceinline__ unsigned cvt_pk_bf16(float lo, float hi) { f32x2_t v = {lo, hi}; bf16x2_t b = __builtin_convertvector(v, bf16x2_t); return __builtin_bit_cast(unsigned, b); }

template <class Epi, class Sched, bool ALIGN_EPI = false, bool SP2 = false>
__device__ __forceinline__ void gemm_phase(PG8_LAS unsigned char* lds, const Gemm g, const Sched& S, const Epi& E, const int tid) {
    const int wid = __builtin_amdgcn_readfirstlane(tid >> 6), lane = tid & 63, wr = wid >> 2, wc = wid & 3, fr = lane & 15, fq = lane >> 4;
    const int K = g.K, nt = K / BK, LD = g.ld;
    unsigned voffA[2], voffB[2];
#pragma unroll
    for (int i = 0; i < 2; ++i) { int R, C; stage_rc(tid * 16 + i * 8192, R, C); const int Rb = Epi::PERM ? ((R & ~31) + perm32(R & 31)) : R;
        voffA[i] = (unsigned)(R * LD + C) * 2u; voffB[i] = (unsigned)(Rb * LD + C) * 2u; }
    const size_t kstep = (size_t)(BK * 2);
    const size_t hstep = (size_t)HALF * LD * 2;
    const size_t tstep = 2 * hstep;
    const unsigned ldsw = (unsigned)wid * 1024u;
    const int aoff = lds_byte(wr * 64 + fr, fq * 8), boff = lds_byte(wc * 32 + fr, fq * 8);
#define PG8_SA(b, h) (((b) * 2 + (h)) * HTB)
#define PG8_SB(b, h) ((4 + (b) * 2 + (h)) * HTB)
#define PG8_STAGE(bufoff, gbase, voff) do { _Pragma("unroll") for (int _i = 0; _i < 2; ++_i) \
        __builtin_amdgcn_global_load_lds((const unsigned*)((const char*)(gbase) + (voff)[_i]), (PG8_LAS unsigned*)(lds + (bufoff) + ldsw + _i * 8192), 16, 0, 0); } while (0)
#define PG8_LDA(dst, b, h) do { _Pragma("unroll") for (int m = 0; m < 4; ++m) _Pragma("unroll") for (int k = 0; k < 2; ++k) dst[m][k] = *(const PG8_LAS bf16x8*)(lds + PG8_SA(b, h) + aoff + m * 2048 + k * 1024); } while (0)
#define PG8_LDB(dst, b, h) do { _Pragma("unroll") for (int n = 0; n < 2; ++n) _Pragma("unroll") for (int k = 0; k < 2; ++k) dst[n][k] = *(const PG8_LAS bf16x8*)(lds + PG8_SB(b, h) + boff + n * 2048 + k * 1024); } while (0)
#define PG8_MMA(ai, bj, At, Bt) do { __builtin_amdgcn_s_setprio(1); _Pragma("unroll") for (int m = 0; m < 4; ++m) _Pragma("unroll") for (int n = 0; n < 2; ++n) _Pragma("unroll") for (int k = 0; k < 2; ++k) \
        acc[ai][bj][m][n] = __builtin_amdgcn_mfma_f32_16x16x32_bf16(Bt[n][k], At[m][k], acc[ai][bj][m][n], 0, 0, 0); __builtin_amdgcn_s_setprio(0); } while (0)
#define PG8_WAIT_V(n) asm volatile("s_waitcnt vmcnt(" #n ")" ::: "memory")
#define PG8_WAIT_L(n) asm volatile("s_waitcnt lgkmcnt(" #n ")" ::: "memory")
#define PG8_BAR __builtin_amdgcn_s_barrier()
#define PG8_SCHED __builtin_amdgcn_sched_barrier(0)
    Unit cur, nxt; int ui = 0;
    if (!S.next(0, cur)) return;
    f32x4 acc[2][2][4][2];
#pragma unroll
    for (int a = 0; a < 2; ++a)
#pragma unroll
        for (int b = 0; b < 2; ++b)
#pragma unroll
            for (int m = 0; m < 4; ++m)
#pragma unroll
                for (int n = 0; n < 2; ++n) acc[a][b][m][n] = (f32x4){0.f, 0.f, 0.f, 0.f};
    bf16x8 At[4][2], B0[2][2], B1[2][2];
    const char* cA = (const char*)g.A + (size_t)cur.pm * tstep; const char* cB = (const char*)g.Bt + (size_t)cur.pn * tstep;
    S.a_ready(cur);
    if constexpr (SP2) {
        PG8_STAGE(PG8_SB(0, 0), cB, voffB); PG8_STAGE(PG8_SB(0, 1), cB + hstep, voffB); PG8_STAGE(PG8_SA(0, 0), cA, voffA); PG8_STAGE(PG8_SA(0, 1), cA + hstep, voffA);
        if (wr == 1) PG8_BAR;
        PG8_WAIT_V(2); PG8_BAR;
        PG8_STAGE(PG8_SB(1, 0), cB + kstep, voffB); PG8_STAGE(PG8_SA(1, 0), cA + kstep, voffA); PG8_STAGE(PG8_SB(1, 1), cB + hstep + kstep, voffB);
        PG8_WAIT_V(6); PG8_BAR;
    } else {
        PG8_STAGE(PG8_SB(0, 0), cB, voffB); PG8_STAGE(PG8_SA(0, 0), cA, voffA); PG8_STAGE(PG8_SB(0, 1), cB + hstep, voffB); PG8_STAGE(PG8_SA(0, 1), cA + hstep, voffA);
        if (wr == 1) PG8_BAR;
        PG8_WAIT_V(4); PG8_BAR;
        PG8_STAGE(PG8_SB(1, 0), cB + kstep, voffB); PG8_STAGE(PG8_SA(1, 0), cA + kstep, voffA); PG8_STAGE(PG8_SB(1, 1), cB + hstep + kstep, voffB);
        PG8_WAIT_V(6); PG8_BAR;
    }
    for (;;) {
        const bool has_next = S.next(ui + 1, nxt);
        const char* nA = has_next ? (const char*)g.A + (size_t)nxt.pm * tstep : cA; const char* nB = has_next ? (const char*)g.Bt + (size_t)nxt.pn * tstep : cB;
        for (int t = 0; t < nt; t += 2) {
            const bool last = (t == nt - 2);
            const char* a1 = cA + (size_t)(t + 1) * kstep;
            const char* a2 = last ? nA : cA + (size_t)(t + 2) * kstep; const char* b2 = last ? nB : cB + (size_t)(t + 2) * kstep;
            const char* a3 = a2 + kstep; const char* b3 = b2 + kstep;
            if (last && has_next) S.a_ready(nxt);
            if constexpr (SP2) {
            PG8_LDB(B0, 0, 0); PG8_LDB(B1, 0, 1); PG8_SCHED; PG8_LDA(At, 0, 0); PG8_STAGE(PG8_SA(1, 1), a1 + hstep, voffA);
            PG8_WAIT_V(8); PG8_WAIT_L(0); PG8_BAR; PG8_MMA(0, 0, At, B0); PG8_MMA(0, 1, At, B1); PG8_BAR; PG8_SCHED;
            PG8_LDA(At, 0, 1); PG8_STAGE(PG8_SB(0, 0), b2, voffB); PG8_STAGE(PG8_SB(0, 1), b2 + hstep, voffB); PG8_STAGE(PG8_SA(0, 0), a2, voffA);
            PG8_WAIT_V(8); PG8_WAIT_L(0); PG8_BAR; PG8_MMA(1, 0, At, B0); PG8_MMA(1, 1, At, B1); PG8_BAR; PG8_SCHED;
            PG8_LDB(B0, 1, 0); PG8_LDB(B1, 1, 1); PG8_SCHED; PG8_LDA(At, 1, 0); PG8_STAGE(PG8_SA(0, 1), a2 + hstep, voffA);
            PG8_WAIT_V(8); PG8_WAIT_L(0); PG8_BAR; PG8_MMA(0, 0, At, B0); PG8_MMA(0, 1, At, B1); PG8_BAR; PG8_SCHED;
            PG8_LDA(At, 1, 1); PG8_STAGE(PG8_SB(1, 0), b3, voffB); PG8_STAGE(PG8_SB(1, 1), b3 + hstep, voffB); PG8_STAGE(PG8_SA(1, 0), a3, voffA);
            PG8_WAIT_V(8); PG8_WAIT_L(0); PG8_BAR; PG8_MMA(1, 0, At, B0); PG8_MMA(1, 1, At, B1); PG8_BAR; PG8_SCHED;
            } else {
            PG8_LDB(B0, 0, 0); PG8_SCHED; PG8_LDA(At, 0, 0); PG8_STAGE(PG8_SA(1, 1), a1 + hstep, voffA);
            PG8_WAIT_L(8); PG8_BAR; PG8_WAIT_L(0); PG8_MMA(0, 0, At, B0); PG8_BAR; PG8_SCHED;
            PG8_LDB(B1, 0, 1); PG8_STAGE(PG8_SB(0, 0), b2, voffB);
            PG8_BAR; PG8_WAIT_L(0); PG8_MMA(0, 1, At, B1); PG8_BAR;
            PG8_LDA(At, 0, 1); PG8_STAGE(PG8_SA(0, 0), a2, voffA);
            PG8_BAR; PG8_WAIT_L(0); PG8_MMA(1, 0, At, B0); PG8_BAR; PG8_SCHED;
            PG8_STAGE(PG8_SB(0, 1), b2 + hstep, voffB);
            PG8_WAIT_V(6); PG8_BAR; PG8_MMA(1, 1, At, B1); PG8_BAR;
            PG8_LDB(B0, 1, 0); PG8_SCHED; PG8_LDA(At, 1, 0); PG8_STAGE(PG8_SA(0, 1), a2 + hstep, voffA);
            PG8_WAIT_L(8); PG8_BAR; PG8_WAIT_L(0); PG8_MMA(0, 0, At, B0); PG8_BAR; PG8_SCHED;
            PG8_LDB(B1, 1, 1); PG8_STAGE(PG8_SB(1, 0), b3, voffB);
            PG8_BAR; PG8_WAIT_L(0); PG8_MMA(0, 1, At, B1); PG8_BAR;
            PG8_LDA(At, 1, 1); PG8_STAGE(PG8_SA(1, 0), a3, voffA);
            PG8_BAR; PG8_WAIT_L(0); PG8_MMA(1, 0, At, B0); PG8_BAR; PG8_SCHED;
            PG8_STAGE(PG8_SB(1, 1), b3 + hstep, voffB);
            PG8_WAIT_V(6); PG8_BAR; PG8_MMA(1, 1, At, B1); PG8_BAR;
            }
        }
        if constexpr (ALIGN_EPI) { if (wr == 0) PG8_BAR; }
        E(acc, cur, wr, wc, fr, fq); S.done(cur);
        if (!has_next) break;
#pragma unroll
        for (int a = 0; a < 2; ++a)
#pragma unroll
            for (int b = 0; b < 2; ++b)
#pragma unroll
                for (int m = 0; m < 4; ++m)
#pragma unroll
                    for (int n = 0; n < 2; ++n) acc[a][b][m][n] = (f32x4){0.f, 0.f, 0.f, 0.f};
        cur = nxt; cA = nA; cB = nB; ++ui;
        if constexpr (ALIGN_EPI) { if (wr == 1) PG8_BAR; }
    }
    PG8_WAIT_V(0);
    if constexpr (!ALIGN_EPI) { if (wr == 0) PG8_BAR; }
    PG8_BAR;
#undef PG8_SA
#undef PG8_SB
#undef PG8_STAGE
#undef PG8_LDA
#undef PG8_LDB
#undef PG8_MMA
#undef PG8_WAIT_V
#undef PG8_WAIT_L
#undef PG8_BAR
#undef PG8_SCHED
}
}
constexpr int D = 1024, NB = 4, SEQ = 8192, DB = 8, DSEQ = 64, NMB = NB + DB;
constexpr int GH = 8, GDK = 128, GDV = 128;
constexpr int SH = 32, SP = 64, SN = 128, SG = 8;
constexpr int DFF = 2816, CONV_CH = 7168, IN_COLS = 12336;
constexpr int NPROJ = 12288;
constexpr int NIN = 12544;
constexpr int NUP = 2 * DFF;
constexpr float EPS = 1e-6f;
#ifndef SLAB_T
#define SLAB_T 512
#endif
constexpr int NSLAB = SEQ / SLAB_T, RP = NB * SLAB_T, RS = DB * DSEQ, RMAX = RP + RS;
constexpr size_t O_YP = 0, O_YS = O_YP + (size_t)NB * SEQ * D, O_CMP = O_YS + (size_t)DB * DSEQ * D, O_GP = O_CMP + (size_t)NB * 3 * CONV_CH,
                 O_SP = O_GP + (size_t)NB * GH * GDK * GDV, O_CFP = O_SP + (size_t)NB * SH * SN * SP, O_CMS = O_CFP + (size_t)NB * 2 * NUP,
                 O_GS = O_CMS + (size_t)DB * 3 * CONV_CH, O_SS = O_GS + (size_t)DB * GH * GDK * GDV, O_CFS = O_SS + (size_t)DB * SH * SN * SP,
                 O_END = O_CFS + (size_t)DB * 2 * NUP;
constexpr size_t MiB = 1u << 20;
constexpr size_t WS_CTL = 0, CTL_ZERO_BYTES = 1 * MiB;
constexpr size_t WS_MODV = 1 * MiB;
constexpr size_t WS_G1 = WS_MODV + 512 * 1024;
constexpr size_t WS_G2 = WS_G1 + 64 * 1024;
constexpr size_t WS_SHW = WS_G2 + 64 * 1024;
constexpr size_t WS_CARRY_MIX = 2 * MiB;
constexpr size_t WS_CARRY_FFN = 3 * MiB;
constexpr size_t WS_WIN = 4 * MiB;
constexpr size_t WS_WG = WS_WIN + (size_t)NIN * D * 2;
constexpr size_t WS_WS = WS_WG + (size_t)D * D * 2;
constexpr size_t WS_WOUT = WS_WS + (size_t)D * 2048 * 2;
constexpr size_t WS_WUP = WS_WOUT + (size_t)D * D * 2;
constexpr size_t WS_WDN = WS_WUP + (size_t)NUP * D * 2;
constexpr size_t WS_SLAB = 56 * MiB;
static_assert(WS_WDN + (size_t)D * DFF * 2 <= WS_SLAB, "weights fit");
constexpr int NXC = 7168, NZG = 3072, NGT = 2048, NCH = SLAB_T / 64;
constexpr int GI_STRIDE_C = 62464 + 16384 + 256, SI_STRIDE_C = 47104 + 32768, GDN_ITEMS = NCH * NB * GH + DB * GH, SSD_ITEMS = NCH * NB * SG + DB * SG;
constexpr size_t SZ_HB = (size_t)RMAX * D * 2, SZ_XC = (size_t)RMAX * NXC * 2, SZ_ZG = (size_t)RMAX * NZG * 2, SZ_GT = (size_t)RMAX * NGT * 2, SZ_SM = (size_t)RMAX * 64 * 4, SZ_OG = (size_t)RMAX * D * 2,
                 SZ_YS = (size_t)RMAX * 2048 * 2, SZ_T1 = (size_t)RMAX * D * 4, SZ_MIX = (size_t)RMAX * D * 2, SZ_X1G = (size_t)RMAX * D * 2, SZ_SS = (size_t)RMAX * 16 * 4,
                 SZ_U = (size_t)2 * MiB  , SZ_ACT = (size_t)RMAX * DFF * 2, SZ_GIMG = (size_t)GDN_ITEMS * GI_STRIDE_C, SZ_SIMG = (size_t)SSD_ITEMS * SI_STRIDE_C, SZ_PD = (size_t)RMAX * D * 4;
constexpr int G_HB = 2, G_XC = 2, G_ZG = 3, G_GT = 4, G_SM = 2, G_OG = 2, G_YS = 2, G_T1 = 1, G_MIX = 2, G_X1G = 2, G_SS = 2, G_U = 2, G_ACT = 2, G_IMG = 2, G_PD = 2;
constexpr size_t WS_HB = WS_SLAB, WS_XC = WS_HB + G_HB * SZ_HB, WS_ZG = WS_XC + G_XC * SZ_XC, WS_GT = WS_ZG + G_ZG * SZ_ZG, WS_SM = WS_GT + G_GT * SZ_GT, WS_OG = WS_SM + G_SM * SZ_SM,
                 WS_YS = WS_OG + G_OG * SZ_OG, WS_T1 = WS_YS + G_YS * SZ_YS, WS_MIX = WS_T1 + G_T1 * SZ_T1, WS_X1G = WS_MIX + G_MIX * SZ_MIX, WS_SS1 = WS_X1G + G_X1G * SZ_X1G,
                 WS_SS2 = WS_SS1 + G_SS * SZ_SS, WS_U = WS_SS2 + G_SS * SZ_SS, WS_ACT = WS_U + G_U * SZ_U, WS_GDN = WS_ACT + G_ACT * SZ_ACT, WS_SSD = WS_GDN + G_IMG * SZ_GIMG,
                 WS_PD = WS_SSD + G_IMG * SZ_SIMG, WS_PX = WS_PD + G_PD * SZ_PD, WS_END = WS_PX + 2 * SZ_PD;
static_assert(WS_END <= 512 * MiB, "workspace map fits");
#define GENP(ws, base, sz, n, s) ((ws) + (base) + (size_t)((s) % (n)) * (sz))
constexpr int LDS_BYTES = 147456, LDSCTL_OFF = LDS_BYTES - 512, MISC_OFF = LDSCTL_OFF + 320, RING_BYTES = LDSCTL_OFF;
constexpr int NWAVES = 8, NTHR = 512;

#define GAS __attribute__((address_space(1)))
#define LAS __attribute__((address_space(3)))
typedef unsigned short bf16;
typedef unsigned v4u __attribute__((ext_vector_type(4)));
typedef unsigned v2u __attribute__((ext_vector_type(2)));
typedef float f32x4 __attribute__((ext_vector_type(4)));
typedef GAS unsigned gu32;
#define RLX_AGENT __ATOMIC_RELAXED, __HIP_MEMORY_SCOPE_AGENT
#define LDS_WAIT() asm volatile("s_waitcnt lgkmcnt(0)" ::: "memory")
#define VM_WAIT() asm volatile("s_waitcnt vmcnt(0)" ::: "memory")
__device__ __forceinline__ unsigned pk2(float lo, float hi) { return pg8::cvt_pk_bf16(lo, hi); }
__device__ __forceinline__ unsigned f2bf(float f) { return pk2(f, f) & 0xffffu; }
__device__ __forceinline__ float bf2f(unsigned short h) { return __builtin_bit_cast(float, (unsigned)h << 16); }
__device__ __forceinline__ float bflo(unsigned w) { return __builtin_bit_cast(float, w << 16); }
__device__ __forceinline__ float bfhi(unsigned w) { return __builtin_bit_cast(float, w & 0xffff0000u); }
__device__ __forceinline__ float sigmoidf_(float x) { return __builtin_amdgcn_rcpf(1.f + __expf(-x)); }
__device__ __forceinline__ float siluf_(float x) { return x * __builtin_amdgcn_rcpf(1.f + __expf(-x)); }
__device__ __forceinline__ float softplusf_(float x) { const float e = __expf(-fabsf(x)), u = 1.f + e, d = u - 1.f; const float l = (d == 0.f) ? e : __logf(u) * (e * __builtin_amdgcn_rcpf(d)); return fmaxf(x, 0.f) + l; }
__device__ __forceinline__ float wave_sum(float v) {
#pragma unroll
    for (int o = 1; o < 64; o <<= 1) v += __shfl_xor(v, o);
    return v;
}

#ifndef DOWN4
#define DOWN4 1
#endif
#ifndef DOWN4_S0
#define DOWN4_S0 13
#endif
#ifndef PROF_SEL
#define PROF_SEL 0
#endif
#ifndef PROF_MULT
#define PROF_MULT 10
#endif
#define PROF_BEGIN(id) unsigned long long prof_t0_##id = 0; if (PROF_SEL == (id)) prof_t0_##id = __builtin_amdgcn_s_memrealtime()
#define PROF_END(id) do { if (PROF_SEL == (id)) F.prof += __builtin_amdgcn_s_memrealtime() - prof_t0_##id; } while (0)
struct Args { const float* in[30]; float* out; unsigned char* ws; int ph_lo, ph_hi; };

struct Frame {
    LAS unsigned char* lds;
    volatile LAS unsigned* MISC;
    gu32* ctl;
    int tid, lane, wave, G, bid;
    const Args& A;
    float* out; unsigned char* ws;
    unsigned long long prof;
    __device__ __forceinline__ Frame(const Args& a) : A(a) {}
};
__device__ __forceinline__ int row_mb(int r) { return r < RP ? (r / SLAB_T) : NB + ((r - RP) / DSEQ); }
__device__ __forceinline__ size_t row_goff(int s, int r) {
    if (r < RP) { const int b = r / SLAB_T, tl = r % SLAB_T; return ((size_t)b * SEQ + (size_t)s * SLAB_T + tl) * D; }
    return (size_t)(r - RP) * D;
}
#ifndef DSLAB
#define DSLAB (NSLAB - 1)
#endif
__device__ __forceinline__ int slab_rows(int s) { return s == DSLAB ? RMAX : RP; }
struct MapWin { __device__ __forceinline__ int operator()(int n) const { return n < 10240 ? n : (n < 12288 ? n + 48 : (n < 12336 ? n - 2048 : -1)); } };
struct MapId  { __device__ __forceinline__ int operator()(int n) const { return n; } };
struct MapUp  { __device__ __forceinline__ int operator()(int n) const { const int j = n >> 8, c = n & 255; return c < 128 ? 128 * j + c : DFF + 128 * j + (c - 128); } };
template <class Map>
__device__ __forceinline__ void p0_transpose_item(const float* W, int ldw, int K, bf16* WT, Map map, LAS float* scr, int item, int nblk, int lane) {
    const int kb = item / nblk, nb = item % nblk, k0 = 64 * kb, n0 = 32 * nb;
    const int sc = map(n0 + (lane & 31));
    float v[32];
    const float* wp = W + (size_t)(k0 + (lane >> 5)) * ldw + (sc >= 0 ? sc : 0);
#pragma unroll
    for (int i = 0; i < 32; ++i) v[i] = wp[(size_t)(2 * i) * ldw];
#pragma unroll
    for (int i = 0; i < 32; ++i) scr[(2 * i + (lane >> 5)) * 33 + (lane & 31)] = sc >= 0 ? v[i] : 0.f;
    LDS_WAIT(); asm volatile("" ::: "memory");
    const int c = lane & 7;
#pragma unroll
    for (int j = 0; j < 4; ++j) { const int n = (lane >> 3) + 8 * j; const LAS float* s = scr + (8 * c) * 33 + n;
        v4u o; o.x = pk2(s[0 * 33], s[1 * 33]); o.y = pk2(s[2 * 33], s[3 * 33]); o.z = pk2(s[4 * 33], s[5 * 33]); o.w = pk2(s[6 * 33], s[7 * 33]);
        *(GAS v4u*)(WT + (size_t)(n0 + n) * K + k0 + 8 * c) = o; }
    LDS_WAIT(); asm volatile("" ::: "memory");
}
__device__ __forceinline__ void p0_mod_item(Frame& F, int item) {
    LAS float* sc = (LAS float*)F.lds; LAS float* red = (LAS float*)(F.lds + 49152);
    const float* cp = F.A.in[6]; const float* cs = F.A.in[7]; const float* w_ada = F.A.in[8]; const float* b_ada = F.A.in[9];
    for (int idx = F.tid; idx < NMB * D; idx += NTHR) { const int b = idx / D, k = idx % D; const float c = b < NB ? cp[b * D + k] : cs[(b - NB) * D + k]; sc[idx] = siluf_(c); }
    __syncthreads();
    float acc[NMB];
#pragma unroll
    for (int b = 0; b < NMB; ++b) acc[b] = 0.f;
    const int col = item * 64 + F.lane, kb = F.wave * 128;
#pragma unroll 1
    for (int k8 = 0; k8 < 128; k8 += 16) { float wv[16];
#pragma unroll
        for (int k = 0; k < 16; ++k) wv[k] = w_ada[(size_t)(kb + k8 + k) * 6144 + col];
#pragma unroll
        for (int k = 0; k < 16; ++k) {
#pragma unroll
            for (int b = 0; b < NMB; ++b) acc[b] += sc[b * D + kb + k8 + k] * wv[k]; } }
#pragma unroll
    for (int b = 0; b < NMB; ++b) red[(F.wave * NMB + b) * 64 + F.lane] = acc[b];
    __syncthreads();
    float* modv = (float*)(F.ws + WS_MODV);
    for (int idx = F.tid; idx < NMB * 64; idx += NTHR) { const int b = idx / 64, l = idx % 64; float s = b_ada[item * 64 + l];
#pragma unroll
        for (int w = 0; w < 8; ++w) s += red[(w * NMB + b) * 64 + l];
        modv[b * 6144 + item * 64 + l] = s; }
    __syncthreads();
}
constexpr int P0_I_IN = (D / 64) * (NIN / 32), P0_I_G = (D / 64) * (D / 32), P0_I_S = (2048 / 64) * (D / 32), P0_I_O = P0_I_G, P0_I_UP = (D / 64) * (NUP / 32), P0_I_DN = (DFF / 64) * (D / 32);
constexpr int P0_NITEMS = P0_I_IN + P0_I_G + P0_I_S + P0_I_O + P0_I_UP + P0_I_DN;
__device__ __forceinline__ void p0_item(Frame& F, LAS float* scr, int it) {
    int r = it;
    if (r < P0_I_IN) { p0_transpose_item(F.A.in[11], IN_COLS, D, (bf16*)(F.ws + WS_WIN), MapWin(), scr, r, NIN / 32, F.lane); return; } r -= P0_I_IN;
    if (r < P0_I_G) { p0_transpose_item(F.A.in[21], D, D, (bf16*)(F.ws + WS_WG), MapId(), scr, r, D / 32, F.lane); return; } r -= P0_I_G;
    if (r < P0_I_S) { p0_transpose_item(F.A.in[22], D, 2048, (bf16*)(F.ws + WS_WS), MapId(), scr, r, D / 32, F.lane); return; } r -= P0_I_S;
    if (r < P0_I_O) { p0_transpose_item(F.A.in[23], D, D, (bf16*)(F.ws + WS_WOUT), MapId(), scr, r, D / 32, F.lane); return; } r -= P0_I_O;
    if (r < P0_I_UP) { p0_transpose_item(F.A.in[25], NUP, D, (bf16*)(F.ws + WS_WUP), MapUp(), scr, r, NUP / 32, F.lane); return; } r -= P0_I_UP;
    p0_transpose_item(F.A.in[28], D, DFF, (bf16*)(F.ws + WS_WDN), MapId(), scr, r, D / 32, F.lane);
}
__device__ __forceinline__ void phase_prologue0(Frame& F) {
    for (int it = F.bid; it < 96; it += F.G) p0_mod_item(F, it);
    LAS float* scr = (LAS float*)(F.lds + F.wave * 16384);
    const int gw = F.bid * NWAVES + F.wave, NGW = F.G * NWAVES;
#pragma unroll 1
    for (int it = gw; it < P0_I_IN; it += NGW) p0_item(F, scr, it);
}
__device__ __forceinline__ void phase_convert_rest(Frame& F, int part, int nparts) {
    LAS float* scr = (LAS float*)(F.lds + F.wave * 16384);
    const int gw = part * NWAVES + F.wave, NGW = nparts * NWAVES;
#pragma unroll 1
    for (int it = P0_I_IN + gw; it < P0_NITEMS; it += NGW) p0_item(F, scr, it);
    __syncthreads();
}
__device__ __forceinline__ void phase_prologue1(Frame& F, int part, int nparts) {
    const float* modv = (const float*)(F.ws + WS_MODV);
    float* g1 = (float*)(F.ws + WS_G1); float* g2 = (float*)(F.ws + WS_G2); float* shw = (float*)(F.ws + WS_SHW);
    for (int idx = part * NTHR + F.tid; idx < NMB * D; idx += nparts * NTHR) { const int b = idx / D, k = idx % D;
        g1[idx] = F.A.in[10][k] * (1.f + modv[b * 6144 + 1024 + k]); g2[idx] = F.A.in[24][k] * (1.f + modv[b * 6144 + 4096 + k]); }
    LAS float* sh = (LAS float*)F.lds;
    for (int idx = F.tid; idx < NMB * D; idx += NTHR) sh[idx] = modv[(idx / D) * 6144 + 3072 + (idx % D)];
    __syncthreads();
    const bf16* wup = (const bf16*)(F.ws + WS_WUP);
    const int gw = part * NWAVES + F.wave, NGW = nparts * NWAVES;
    for (int n = gw; n < NUP; n += NGW) {
        const GAS v4u* wr = (const GAS v4u*)(wup + (size_t)n * D + F.lane * 16);
        const v4u w0 = wr[0], w1 = wr[1];
        float wf[16] = {bflo(w0.x), bfhi(w0.x), bflo(w0.y), bfhi(w0.y), bflo(w0.z), bfhi(w0.z), bflo(w0.w), bfhi(w0.w), bflo(w1.x), bfhi(w1.x), bflo(w1.y), bfhi(w1.y), bflo(w1.z), bfhi(w1.z), bflo(w1.w), bfhi(w1.w)};
        float res = 0.f;
#pragma unroll 1
        for (int b = 0; b < NMB; ++b) { float a = 0.f;
#pragma unroll
            for (int i = 0; i < 16; ++i) a += wf[i] * sh[b * D + F.lane * 16 + i];
            a = wave_sum(a); if (F.lane == b) res = a; }
        if (F.lane < NMB) shw[F.lane * NUP + n] = res;
    }
    __syncthreads();
}
__device__ __forceinline__ void phase_norm1(Frame& F, int s, int part, int nparts) {
    const float* modv = (const float*)(F.ws + WS_MODV); bf16* hb = (bf16*)GENP(F.ws, WS_HB, SZ_HB, G_HB, s);
    const int gw = part * NWAVES + F.wave, NGW = nparts * NWAVES, R = slab_rows(s);
    for (int r = gw; r < R; r += 2 * NGW) {
        const int r2 = r + NGW < R ? r + NGW : r;
        const GAS f32x4* xa = (const GAS f32x4*)((r < RP ? F.A.in[0] : F.A.in[1]) + row_goff(s, r)) + F.lane;
        const GAS f32x4* xb = (const GAS f32x4*)((r2 < RP ? F.A.in[0] : F.A.in[1]) + row_goff(s, r2)) + F.lane;
        f32x4 va[4], vb[4]; float sa = 0.f, sb = 0.f;
#pragma unroll
        for (int j = 0; j < 4; ++j) { va[j] = __builtin_nontemporal_load(xa + 64 * j); vb[j] = __builtin_nontemporal_load(xb + 64 * j); }
#pragma unroll
        for (int j = 0; j < 4; ++j) { sa += (va[j].x * va[j].x + va[j].y * va[j].y) + (va[j].z * va[j].z + va[j].w * va[j].w); sb += (vb[j].x * vb[j].x + vb[j].y * vb[j].y) + (vb[j].z * vb[j].z + vb[j].w * vb[j].w); }
        const float ra = rsqrtf(wave_sum(sa) * (1.f / D) + EPS), rb = rsqrtf(wave_sum(sb) * (1.f / D) + EPS);
#pragma unroll
        for (int q = 0; q < 2; ++q) { if (q == 1 && r2 == r) break; const int rr = q ? r2 : r; const int mb = row_mb(rr); const float rs = q ? rb : ra;
            GAS v2u* o8 = (GAS v2u*)(hb + (size_t)rr * D) + F.lane;
#pragma unroll
            for (int j = 0; j < 4; ++j) { const int k = 4 * F.lane + 256 * j; const f32x4 v = q ? vb[j] : va[j];
                const f32x4 g = *(const GAS f32x4*)(F.A.in[10] + k) * (*(const GAS f32x4*)(modv + mb * 6144 + 1024 + k) + 1.f); const f32x4 sh = *(const GAS f32x4*)(modv + mb * 6144 + k);
                v2u o; o.x = pk2(v.x * rs * g.x + sh.x, v.y * rs * g.y + sh.y); o.y = pk2(v.z * rs * g.z + sh.z, v.w * rs * g.w + sh.w); o8[64 * j] = o; } }
    }
}
__device__ __forceinline__ void phase_final(Frame& F, int s, int part, int nparts) {
    const float* wf = F.A.in[29]; const float* modv = (const float*)(F.ws + WS_MODV); const bf16* PD = (const bf16*)GENP(F.ws, WS_PD, SZ_PD, G_PD, s); const bf16* PX = (const bf16*)GENP(F.ws, WS_PX, SZ_PD, 2, s); const bool four = DOWN4 && s >= DOWN4_S0;
    const int gw = part * NWAVES + F.wave, NGW = nparts * NWAVES, R = slab_rows(s);
    for (int r = gw; r < R; r += NGW) {
        float* yrow = F.out + (r < RP ? O_YP : O_YS) + row_goff(s, r); const int mb = row_mb(r);
        GAS f32x4* yr = (GAS f32x4*)yrow + F.lane; const GAS v2u* pr = (const GAS v2u*)(PD + (size_t)r * D) + F.lane; const GAS v2u* pr0 = (const GAS v2u*)(PD + (size_t)RMAX * D + (size_t)r * D) + F.lane; const GAS v2u* pr2 = (const GAS v2u*)(PX + (size_t)r * D) + F.lane; const GAS v2u* pr3 = (const GAS v2u*)(PX + (size_t)RMAX * D + (size_t)r * D) + F.lane; const GAS f32x4* gr = (const GAS f32x4*)(modv + mb * 6144 + 5120) + F.lane;
        f32x4 v[4]; float ss = 0.f;
#pragma unroll
        for (int j = 0; j < 4; ++j) { const v2u pb = __builtin_nontemporal_load(pr + 64 * j), pc = __builtin_nontemporal_load(pr0 + 64 * j); f32x4 pf; pf.x = bflo(pb.x) + bflo(pc.x); pf.y = bfhi(pb.x) + bfhi(pc.x); pf.z = bflo(pb.y) + bflo(pc.y); pf.w = bfhi(pb.y) + bfhi(pc.y); if (four) { const v2u pd = __builtin_nontemporal_load(pr2 + 64 * j), pe = __builtin_nontemporal_load(pr3 + 64 * j); pf.x += bflo(pd.x) + bflo(pe.x); pf.y += bfhi(pd.x) + bfhi(pe.x); pf.z += bflo(pd.y) + bflo(pe.y); pf.w += bfhi(pd.y) + bfhi(pe.y); } v[j] = __builtin_nontemporal_load(yr + 64 * j) + gr[64 * j] * pf; ss += (v[j].x * v[j].x + v[j].y * v[j].y) + (v[j].z * v[j].z + v[j].w * v[j].w); }
        const float rs = rsqrtf(wave_sum(ss) * (1.f / D) + EPS);
#pragma unroll
        for (int j = 0; j < 4; ++j) { const f32x4 w = *(const GAS f32x4*)(wf + 4 * F.lane + 256 * j); f32x4 o = v[j]; o.x *= rs * w.x; o.y *= rs * w.y; o.z *= rs * w.z; o.w *= rs * w.w; yr[64 * j] = o; }
    }
}
__device__ __forceinline__ void u_hist_row(Frame& F, int s, int r, int back, int c8, int j, int cc, float (&ua)[8], float (&uv)[8]) {
    const bf16* U = (const bf16*)GENP(F.ws, WS_U, SZ_U, G_U, s);
    int tl, b; bool samp = r >= RP;
    if (!samp) { b = r / SLAB_T; tl = r % SLAB_T; } else { b = (r - RP) / DSEQ; tl = (r - RP) % DSEQ; }
    if (tl - back >= 0) {
        const bf16* p = U + (size_t)(r - back) * NUP + 256 * j + cc;
        const v4u a = *(const GAS v4u*)p, v = *(const GAS v4u*)(p + 128);
        ua[0] = bflo(a.x); ua[1] = bfhi(a.x); ua[2] = bflo(a.y); ua[3] = bfhi(a.y); ua[4] = bflo(a.z); ua[5] = bfhi(a.z); ua[6] = bflo(a.w); ua[7] = bfhi(a.w);
        uv[0] = bflo(v.x); uv[1] = bfhi(v.x); uv[2] = bflo(v.y); uv[3] = bfhi(v.y); uv[4] = bflo(v.z); uv[5] = bfhi(v.z); uv[6] = bflo(v.w); uv[7] = bfhi(v.w);
        return;
    }
    const int hi = 2 + (tl - back);
    if (samp) { const float* st = F.A.in[5] + ((size_t)b * 2 + hi) * NUP;
#pragma unroll
        for (int i = 0; i < 8; ++i) { ua[i] = st[c8 + i]; uv[i] = st[DFF + c8 + i]; } return; }
    if (s == 0) {
#pragma unroll
        for (int i = 0; i < 8; ++i) { ua[i] = 0.f; uv[i] = 0.f; } return; }
    const float* cf = (const float*)(F.ws + WS_CARRY_FFN) + (((size_t)(s & 1) * NB + b) * 2 + hi) * NUP + 256 * j + cc;
#pragma unroll
    for (int i = 0; i < 8; ++i) { ua[i] = cf[i]; uv[i] = cf[128 + i]; }
}
__device__ __forceinline__ void ub_row8(const bf16* p, float (&ua)[8], float (&uv)[8]) {
    const v4u a = *(const GAS v4u*)p, v = *(const GAS v4u*)(p + 128);
    ua[0] = bflo(a.x); ua[1] = bfhi(a.x); ua[2] = bflo(a.y); ua[3] = bfhi(a.y); ua[4] = bflo(a.z); ua[5] = bfhi(a.z); ua[6] = bflo(a.w); ua[7] = bfhi(a.w);
    uv[0] = bflo(v.x); uv[1] = bfhi(v.x); uv[2] = bflo(v.y); uv[3] = bfhi(v.y); uv[4] = bflo(v.z); uv[5] = bfhi(v.z); uv[6] = bflo(v.w); uv[7] = bfhi(v.w);
}
__device__ __forceinline__ void ffn_fixup_tile(Frame& F, int s, int pm, int ch0, int noct) {
    const bf16* UB = (const bf16*)GENP(F.ws, WS_U, SZ_U, G_U, s); bf16* ACT = (bf16*)GENP(F.ws, WS_ACT, SZ_ACT, G_ACT, s);
    const float* wc = F.A.in[26]; const float* bc = F.A.in[27];
#pragma unroll 1
    for (int item = F.tid; item < 4 * noct; item += NTHR) {
        const int gi = item / noct, oc = item % noct; const int g = pm * 4 + gi, r0 = 64 * g;
        const int c8 = ch0 + oc * 8, j = c8 >> 7, cc = c8 & 127;
        float wa0[8], wa1[8], wa2[8], wv0[8], wv1[8], wv2[8], ba[8], bv[8];
#define LD8(dst, p) do { const f32x4 t0_ = *(const GAS f32x4*)(p), t1_ = *(const GAS f32x4*)((p) + 4); dst[0] = t0_.x; dst[1] = t0_.y; dst[2] = t0_.z; dst[3] = t0_.w; dst[4] = t1_.x; dst[5] = t1_.y; dst[6] = t1_.z; dst[7] = t1_.w; } while (0)
        LD8(wa0, wc + c8); LD8(wa1, wc + NUP + c8); LD8(wa2, wc + 2 * NUP + c8); LD8(wv0, wc + DFF + c8); LD8(wv1, wc + NUP + DFF + c8); LD8(wv2, wc + 2 * NUP + DFF + c8); LD8(ba, bc + c8); LD8(bv, bc + DFF + c8);
        float a0[8], v0[8], a1[8], v1[8], a2[8], v2[8], a3[8], v3[8];
        const bool samp = r0 >= RP; const int tl = samp ? 0 : r0 % SLAB_T, b = samp ? (r0 - RP) / DSEQ : r0 / SLAB_T;
        if (tl > 0) { ub_row8(UB + ((size_t)(g - 1) * 4 + 2) * NUP + 256 * j + cc, a0, v0); ub_row8(UB + ((size_t)(g - 1) * 4 + 3) * NUP + 256 * j + cc, a1, v1); }
        else if (samp) { const float* st = F.A.in[5] + (size_t)b * 2 * NUP;
#pragma unroll
            for (int i = 0; i < 8; ++i) { a0[i] = st[c8 + i]; v0[i] = st[DFF + c8 + i]; a1[i] = st[NUP + c8 + i]; v1[i] = st[NUP + DFF + c8 + i]; } }
        else if (s == 0) {
#pragma unroll
            for (int i = 0; i < 8; ++i) { a0[i] = 0.f; v0[i] = 0.f; a1[i] = 0.f; v1[i] = 0.f; } }
        else { const float* cf = (const float*)(F.ws + WS_CARRY_FFN) + ((size_t)(s & 1) * NB + b) * 2 * NUP + 256 * j + cc;
#pragma unroll
            for (int i = 0; i < 8; ++i) { a0[i] = cf[i]; v0[i] = cf[128 + i]; a1[i] = cf[NUP + i]; v1[i] = cf[NUP + 128 + i]; } }
        ub_row8(UB + ((size_t)g * 4 + 0) * NUP + 256 * j + cc, a2, v2); ub_row8(UB + ((size_t)g * 4 + 1) * NUP + 256 * j + cc, a3, v3);
        float o0[8], o1[8];
#pragma unroll
        for (int i = 0; i < 8; ++i) {
            o0[i] = siluf_(ba[i] + wa0[i] * a0[i] + wa1[i] * a1[i] + wa2[i] * a2[i]) * (bv[i] + wv0[i] * v0[i] + wv1[i] * v1[i] + wv2[i] * v2[i]);
            o1[i] = siluf_(ba[i] + wa0[i] * a1[i] + wa1[i] * a2[i] + wa2[i] * a3[i]) * (bv[i] + wv0[i] * v1[i] + wv1[i] * v2[i] + wv2[i] * v3[i]); }
        v4u w; w.x = pk2(o0[0], o0[1]); w.y = pk2(o0[2], o0[3]); w.z = pk2(o0[4], o0[5]); w.w = pk2(o0[6], o0[7]); *(GAS v4u*)(ACT + (size_t)r0 * DFF + c8) = w;
        w.x = pk2(o1[0], o1[1]); w.y = pk2(o1[2], o1[3]); w.z = pk2(o1[4], o1[5]); w.w = pk2(o1[6], o1[7]); *(GAS v4u*)(ACT + (size_t)(r0 + 1) * DFF + c8) = w;
#undef LD8
    }
    asm volatile("s_waitcnt vmcnt(0)" ::: "memory");
    __syncthreads();
}
__device__ __forceinline__ void phase_convact(Frame& F, int s, int part, int nparts) {
    const bf16* UB = (const bf16*)GENP(F.ws, WS_U, SZ_U, G_U, s);
    float* cfn = (float*)(F.ws + WS_CARRY_FFN) + (size_t)((s + 1) & 1) * NB * 2 * NUP;
    for (int idx = part * NTHR + F.tid; idx < NB * 2 * NUP; idx += nparts * NTHR) {
        const int b = idx / (2 * NUP), i = (idx / NUP) % 2, c = idx % NUP; const int gg = (b * SLAB_T + SLAB_T - 64) >> 6;
        const float v = bf2f(UB[((size_t)gg * 4 + 2 + i) * NUP + c]); cfn[idx] = v;
        if (s == NSLAB - 1) { const int j = c >> 8, cc = c & 255; const int oc = cc < 128 ? 128 * j + cc : DFF + 128 * j + (cc - 128); F.out[O_CFP + ((size_t)b * 2 + i) * NUP + oc] = v; }
    }
    if (s == DSLAB) for (int idx = part * NTHR + F.tid; idx < DB * 2 * NUP; idx += nparts * NTHR) {
        const int b = idx / (2 * NUP), i = (idx / NUP) % 2, c = idx % NUP; const int gg = (RP + b * DSEQ) >> 6;
        const int j = c >> 8, cc = c & 255; const int oc = cc < 128 ? 128 * j + cc : DFF + 128 * j + (cc - 128);
        F.out[O_CFS + ((size_t)b * 2 + i) * NUP + oc] = bf2f(UB[((size_t)gg * 4 + 2 + i) * NUP + c]);
    }
}
__device__ __forceinline__ void phase_mix_carry(Frame& F, int s, int part, int nparts) {
    const bf16* P = (const bf16*)GENP(F.ws, WS_XC, SZ_XC, G_XC, s);
    float* cmn = (float*)(F.ws + WS_CARRY_MIX) + (size_t)((s + 1) & 1) * NB * 3 * CONV_CH;
    for (int idx = part * NTHR + F.tid; idx < NB * 3 * CONV_CH; idx += nparts * NTHR) {
        const int b = idx / (3 * CONV_CH), i = (idx / CONV_CH) % 3, c = idx % CONV_CH; const int r = b * SLAB_T + SLAB_T - 3 + i;
        const float v = bf2f(P[(size_t)r * NXC + c]); cmn[idx] = v;
        if (s == NSLAB - 1) F.out[O_CMP + idx] = v;
    }
    if (s == DSLAB) for (int idx = part * NTHR + F.tid; idx < DB * 3 * CONV_CH; idx += nparts * NTHR) {
        const int b = idx / (3 * CONV_CH), i = (idx / CONV_CH) % 3, c = idx % CONV_CH; const int r = RP + b * DSEQ + DSEQ - 3 + i;
        F.out[O_CMS + idx] = bf2f(P[(size_t)r * NXC + c]);
    }
}
namespace epi {
using pg8::f32x4; using pg8::Unit; using pg8::BM; using pg8::HALF; using pg8::cvt_pk_bf16; using pg8::u32x4; using pg8::u32x2;
struct EpiProj {
    static constexpr bool PERM = true;
    bf16* XC; bf16* ZG; bf16* GT; float* SM;
    __device__ __forceinline__ void operator()(const f32x4 (&acc)[2][2][4][2], const Unit& u, int wr, int wc, int fr, int fq) const {
        const int row0 = u.pm * BM + wr * 64 + fr;
        if (u.pn == 48) {
            if (wc < 2) {
#pragma unroll
                for (int ai = 0; ai < 2; ++ai)
#pragma unroll
                    for (int m = 0; m < 4; ++m) { float* rp = SM + (size_t)(row0 + ai * HALF + m * 16) * 64 + wc * 32 + 8 * fq;
                        *(f32x4*)rp = acc[ai][0][m][0]; *(f32x4*)(rp + 4) = acc[ai][0][m][1]; }
            }
            return;
        }
        const bool sg = u.pn >= 40;
        bf16* base; int ld, col0;
        if (u.pn < 28) { base = XC; ld = NXC; col0 = u.pn * BM; } else if (u.pn < 40) { base = ZG; ld = NZG; col0 = (u.pn - 28) * BM; } else { base = GT; ld = NGT; col0 = (u.pn - 40) * BM; }
        col0 += wc * 32 + 8 * fq;
#pragma unroll
        for (int ai = 0; ai < 2; ++ai)
#pragma unroll
            for (int m = 0; m < 4; ++m) { bf16* rowp = base + (size_t)(row0 + ai * HALF + m * 16) * ld + col0;
#pragma unroll
                for (int bj = 0; bj < 2; ++bj) { f32x4 v0 = acc[ai][bj][m][0], v1 = acc[ai][bj][m][1];
                    if (sg) {
#pragma unroll
                        for (int i = 0; i < 4; ++i) { v0[i] = sigmoidf_(v0[i]); v1[i] = sigmoidf_(v1[i]); } }
                    u32x4 w; w.x = cvt_pk_bf16(v0[0], v0[1]); w.y = cvt_pk_bf16(v0[2], v0[3]); w.z = cvt_pk_bf16(v1[0], v1[1]); w.w = cvt_pk_bf16(v1[2], v1[3]);
                    *(u32x4*)(rowp + bj * HALF) = w; } }
    }
};
__device__ __forceinline__ u32x4 gate8(const u32x4 g, const f32x4 a0, const f32x4 a1) {
    u32x4 o; o.x = cvt_pk_bf16(a0.x * bflo(g.x), a0.y * bfhi(g.x)); o.y = cvt_pk_bf16(a0.z * bflo(g.y), a0.w * bfhi(g.y)); o.z = cvt_pk_bf16(a1.x * bflo(g.z), a1.y * bfhi(g.z)); o.w = cvt_pk_bf16(a1.z * bflo(g.w), a1.w * bfhi(g.w)); return o; }
__device__ __forceinline__ u32x4 gate8add(const u32x4 g, const f32x4 a0, const f32x4 a1, const u32x4 t) {
    u32x4 o; o.x = cvt_pk_bf16(bflo(t.x) + a0.x * bflo(g.x), bfhi(t.x) + a0.y * bfhi(g.x)); o.y = cvt_pk_bf16(bflo(t.y) + a0.z * bflo(g.y), bfhi(t.y) + a0.w * bfhi(g.y));
    o.z = cvt_pk_bf16(bflo(t.z) + a1.x * bflo(g.z), bfhi(t.z) + a1.y * bfhi(g.z)); o.w = cvt_pk_bf16(bflo(t.w) + a1.z * bflo(g.w), bfhi(t.w) + a1.w * bfhi(g.w)); return o; }
__device__ __forceinline__ u32x4 gate8add2(const u32x4 g, const f32x4 a0, const f32x4 a1, const u32x4 t, const u32x4 t2) {
    u32x4 o; o.x = cvt_pk_bf16(bflo(t.x) + bflo(t2.x) + a0.x * bflo(g.x), bfhi(t.x) + bfhi(t2.x) + a0.y * bfhi(g.x)); o.y = cvt_pk_bf16(bflo(t.y) + bflo(t2.y) + a0.z * bflo(g.y), bfhi(t.y) + bfhi(t2.y) + a0.w * bfhi(g.y));
    o.z = cvt_pk_bf16(bflo(t.z) + bflo(t2.z) + a1.x * bflo(g.z), bfhi(t.z) + bfhi(t2.z) + a1.y * bfhi(g.z)); o.w = cvt_pk_bf16(bflo(t.w) + bflo(t2.w) + a1.z * bflo(g.w), bfhi(t.w) + bfhi(t2.w) + a1.w * bfhi(g.w)); return o; }
struct EpiGate1 {
    static constexpr bool PERM = true;
    const bf16* P; bf16* T1; int wt;
    __device__ __forceinline__ void operator()(const f32x4 (&acc)[2][2][4][2], const Unit& u, int wr, int wc, int fr, int fq) const {
        const int row0 = u.pm * BM + wr * 64 + fr, col0 = u.pn * BM + wc * 32 + 8 * fq;
        u32x4 g0[4][2], g1[4][2];
#pragma unroll
        for (int m = 0; m < 4; ++m)
#pragma unroll
            for (int bj = 0; bj < 2; ++bj) g0[m][bj] = *(const u32x4*)(P + (size_t)(row0 + m * 16) * NGT + col0 + bj * HALF);
#pragma unroll
        for (int m = 0; m < 4; ++m)
#pragma unroll
            for (int bj = 0; bj < 2; ++bj) g1[m][bj] = *(const u32x4*)(P + (size_t)(row0 + HALF + m * 16) * NGT + col0 + bj * HALF);
#pragma unroll
        for (int q = 0; q < 8; ++q) { const int ai = q >> 2, m = q & 3; const size_t r = (size_t)(row0 + ai * HALF + m * 16);
#pragma unroll
            for (int bj = 0; bj < 2; ++bj) *(u32x4*)(T1 + r * D + col0 + bj * HALF) = gate8(ai == 0 ? g0[m][bj] : g1[m][bj], acc[ai][bj][m][0], acc[ai][bj][m][1]); }
    }
};
struct EpiGate2 {
    static constexpr bool PERM = true;
    const bf16* P; const bf16* T1; bf16* MIX;
    __device__ __forceinline__ void operator()(const f32x4 (&acc)[2][2][4][2], const Unit& u, int wr, int wc, int fr, int fq) const {
        const int row0 = u.pm * BM + wr * 64 + fr, col0 = u.pn * BM + wc * 32 + 8 * fq;
        u32x4 gv[2], gn[2], tv[2], tn[2];
#pragma unroll
        for (int bj = 0; bj < 2; ++bj) { const int c = col0 + bj * HALF; gv[bj] = *(const u32x4*)(P + (size_t)row0 * NGT + 1024 + c); tv[bj] = *(const u32x4*)(T1 + (size_t)row0 * D + c); }
#pragma unroll
        for (int q = 0; q < 8; ++q) { const int ai = q >> 2, m = q & 3; const size_t r = (size_t)(row0 + ai * HALF + m * 16);
            if (q < 7) { const size_t r2 = (size_t)(row0 + ((q + 1) >> 2) * HALF + ((q + 1) & 3) * 16);
#pragma unroll
                for (int bj = 0; bj < 2; ++bj) { const int c = col0 + bj * HALF; gn[bj] = *(const u32x4*)(P + r2 * NGT + 1024 + c); tn[bj] = *(const u32x4*)(T1 + r2 * D + c); } }
#pragma unroll
            for (int bj = 0; bj < 2; ++bj) *(u32x4*)(MIX + r * D + col0 + bj * HALF) = gate8add(gv[bj], acc[ai][bj][m][0], acc[ai][bj][m][1], tv[bj]);
            if (q < 7) {
#pragma unroll
                for (int bj = 0; bj < 2; ++bj) { gv[bj] = gn[bj]; tv[bj] = tn[bj]; } } }
    }
};
struct EpiGate2S {
    static constexpr bool PERM = true;
    const bf16* P; const bf16* T1; const bf16* T2; bf16* MIX; const unsigned* wflag; const unsigned* wflag2;
    __device__ __forceinline__ void operator()(const f32x4 (&acc)[2][2][4][2], const Unit& u, int wr, int wc, int fr, int fq) const {
        { unsigned sp = 0; while ((__hip_atomic_load(wflag, __ATOMIC_RELAXED, __HIP_MEMORY_SCOPE_AGENT) == 0u || __hip_atomic_load(wflag2, __ATOMIC_RELAXED, __HIP_MEMORY_SCOPE_AGENT) == 0u) && ++sp < (1u << 17)) __builtin_amdgcn_s_sleep(4);
          __builtin_amdgcn_fence(__ATOMIC_ACQUIRE, "agent"); }
        const int row0 = u.pm * BM + wr * 64 + fr, col0 = u.pn * BM + wc * 32 + 8 * fq;
        u32x4 gv[2], gn[2], tv[2], tn[2], sv[2], sn[2];
#pragma unroll
        for (int bj = 0; bj < 2; ++bj) { const int c = col0 + bj * HALF; gv[bj] = *(const u32x4*)(P + (size_t)row0 * NGT + 1024 + c); tv[bj] = *(const u32x4*)(T1 + (size_t)row0 * D + c); sv[bj] = *(const u32x4*)(T2 + (size_t)row0 * D + c); }
#pragma unroll
        for (int q = 0; q < 8; ++q) { const int ai = q >> 2, m = q & 3; const size_t r = (size_t)(row0 + ai * HALF + m * 16);
            if (q < 7) { const size_t r2 = (size_t)(row0 + ((q + 1) >> 2) * HALF + ((q + 1) & 3) * 16);
#pragma unroll
                for (int bj = 0; bj < 2; ++bj) { const int c = col0 + bj * HALF; gn[bj] = *(const u32x4*)(P + r2 * NGT + 1024 + c); tn[bj] = *(const u32x4*)(T1 + r2 * D + c); sn[bj] = *(const u32x4*)(T2 + r2 * D + c); } }
#pragma unroll
            for (int bj = 0; bj < 2; ++bj) *(u32x4*)(MIX + r * D + col0 + bj * HALF) = gate8add2(gv[bj], acc[ai][bj][m][0], acc[ai][bj][m][1], tv[bj], sv[bj]);
            if (q < 7) {
#pragma unroll
                for (int bj = 0; bj < 2; ++bj) { gv[bj] = gn[bj]; tv[bj] = tn[bj]; sv[bj] = sn[bj]; } } }
    }
};
struct EpiOut {
    static constexpr bool PERM = true;
    const float* xp; const float* xs; const float* modv; const float* g2; float* yp; float* ys; bf16* X1G; float* SS; int slab; LAS unsigned char* lds; unsigned long long* prof;
    __device__ __forceinline__ void operator()(const f32x4 (&acc)[2][2][4][2], const Unit& u, int wr, int wc, int fr, int fq) const {
        const int col0 = u.pn * BM + wc * 32 + 8 * fq;
        LAS unsigned char* wl = lds + (wr * 4 + wc) * 16384; const int lane16 = (fq * 16 + fr) * 16;
        unsigned long long pt0_ = 0; if (PROF_SEL == 32) pt0_ = __builtin_amdgcn_s_memrealtime();
        asm volatile("s_waitcnt vmcnt(0)" ::: "memory"); __builtin_amdgcn_s_barrier();
#pragma unroll
        for (int ai = 0; ai < 2; ++ai) {
            const int rb = u.pm * BM + ai * HALF + wr * 64; const int mb = row_mb(rb);
            f32x4 gtv[2][2], ggv[2][2];
#pragma unroll
            for (int bj = 0; bj < 2; ++bj)
#pragma unroll
                for (int n = 0; n < 2; ++n) { const int c = col0 + bj * HALF + n * 4; gtv[bj][n] = *(const f32x4*)(modv + mb * 6144 + 2048 + c); ggv[bj][n] = *(const f32x4*)(g2 + mb * D + c); }
            if (ai == 1) asm volatile("s_waitcnt lgkmcnt(0)" ::: "memory");
#pragma unroll
            for (int m = 0; m < 4; ++m) { const int r = rb + m * 16 + fr; const float* xr = (r < RP ? xp : xs) + row_goff(slab, r);
#pragma unroll
                for (int bj = 0; bj < 2; ++bj)
#pragma unroll
                    for (int n = 0; n < 2; ++n) __builtin_amdgcn_global_load_lds((const unsigned*)(xr + col0 + bj * HALF + n * 4), (LAS unsigned*)(wl + ((m * 2 + bj) * 2 + n) * 1024), 16, 0, 0); }
            asm volatile("s_waitcnt vmcnt(0)" ::: "memory");
#pragma unroll
            for (int m = 0; m < 4; ++m) { const int r = rb + m * 16 + fr; const size_t go = row_goff(slab, r); float* x1row = (r < RP ? yp : ys) + go; float sq = 0.f;
#pragma unroll
                for (int bj = 0; bj < 2; ++bj) { u32x4 w;
#pragma unroll
                    for (int n = 0; n < 2; ++n) { const int c = col0 + bj * HALF + n * 4; const f32x4 a = acc[ai][bj][m][n];
                        const f32x4 xv = *(const LAS f32x4*)(wl + ((m * 2 + bj) * 2 + n) * 1024 + lane16);
                        f32x4 o = xv + gtv[bj][n] * a; *(f32x4*)(x1row + c) = o; sq += (o.x * o.x + o.y * o.y) + (o.z * o.z + o.w * o.w);
                        const f32x4 gg = ggv[bj][n]; if (n == 0) { w.x = cvt_pk_bf16(o.x * gg.x, o.y * gg.y); w.y = cvt_pk_bf16(o.z * gg.z, o.w * gg.w); } else { w.z = cvt_pk_bf16(o.x * gg.x, o.y * gg.y); w.w = cvt_pk_bf16(o.z * gg.z, o.w * gg.w); } }
                    *(u32x4*)(X1G + (size_t)r * D + col0 + bj * HALF) = w; }
                sq += __shfl_xor(sq, 16); sq += __shfl_xor(sq, 32);
                if (fq == 0) SS[(size_t)r * 16 + u.pn * 4 + wc] = sq; }
        }
        if (PROF_SEL == 32) { asm volatile("s_waitcnt vmcnt(0)" ::: "memory"); *prof += __builtin_amdgcn_s_memrealtime() - pt0_; }
    }
};
struct EpiUp {
    static constexpr bool PERM = true;
    const float* SS; const float* shw; bf16* U;
    __device__ __forceinline__ void operator()(const f32x4 (&acc)[2][2][4][2], const Unit& u, int wr, int wc, int fr, int fq) const {
        const int col0 = u.pn * BM + wc * 32 + 8 * fq;
        f32x4 pq[2][4];
#pragma unroll
        for (int ai = 0; ai < 2; ++ai)
#pragma unroll
            for (int m = 0; m < 4; ++m) pq[ai][m] = *(const f32x4*)(SS + (size_t)(u.pm * BM + ai * HALF + wr * 64 + m * 16 + fr) * 16 + 4 * fq);
#pragma unroll
        for (int ai = 0; ai < 2; ++ai) {
            const int rb = u.pm * BM + ai * HALF + wr * 64; const int mb = row_mb(rb);
            f32x4 sv[2][2];
#pragma unroll
            for (int bj = 0; bj < 2; ++bj)
#pragma unroll
                for (int n = 0; n < 2; ++n) sv[bj][n] = *(const f32x4*)(shw + mb * NUP + col0 + bj * HALF + 4 * n);
#pragma unroll
            for (int m = 0; m < 4; ++m) { const int r = rb + m * 16 + fr;
                float tot = (pq[ai][m].x + pq[ai][m].y) + (pq[ai][m].z + pq[ai][m].w); tot += __shfl_xor(tot, 16); tot += __shfl_xor(tot, 32);
                const float rs = rsqrtf(tot * (1.f / D) + EPS);
#pragma unroll
                for (int bj = 0; bj < 2; ++bj) { const f32x4 v0 = acc[ai][bj][m][0] * rs + sv[bj][0], v1 = acc[ai][bj][m][1] * rs + sv[bj][1];
                    u32x4 w; w.x = cvt_pk_bf16(v0[0], v0[1]); w.y = cvt_pk_bf16(v0[2], v0[3]); w.z = cvt_pk_bf16(v1[0], v1[1]); w.w = cvt_pk_bf16(v1[2], v1[3]);
                    *(u32x4*)(U + (size_t)r * NUP + col0 + bj * HALF) = w; } }
        }
    }
};
template <int CTRL> __device__ __forceinline__ unsigned dppmov(unsigned v) { return (unsigned)__builtin_amdgcn_mov_dpp((int)v, CTRL, 0xF, 0xF, true); }
struct EpiUpAct {
    static constexpr bool PERM = true;
    const float* SS; const float* shw; const float* wcv; const float* bcv; bf16* ACT; bf16* UB;
    __device__ __forceinline__ void operator()(const f32x4 (&acc)[2][2][4][2], const Unit& u, int wr, int wc, int fr, int fq) const {
        const int ch0 = u.pn * 128 + wc * 32 + 8 * fq, ucol0 = u.pn * BM + wc * 32 + 8 * fq;
        u32x2 U2[2][2][4][2];
        {
            f32x4 pq[2][4];
#pragma unroll
            for (int ai = 0; ai < 2; ++ai)
#pragma unroll
                for (int m = 0; m < 4; ++m) pq[ai][m] = *(const f32x4*)(SS + (size_t)(u.pm * BM + ai * HALF + wr * 64 + m * 16 + fr) * 16 + 4 * fq);
#pragma unroll
            for (int ai = 0; ai < 2; ++ai) {
                const int rb = u.pm * BM + ai * HALF + wr * 64; const int mb = row_mb(rb); const int g = rb >> 6;
                f32x4 sv[2][2];
#pragma unroll
                for (int bj = 0; bj < 2; ++bj)
#pragma unroll
                    for (int n = 0; n < 2; ++n) sv[bj][n] = *(const f32x4*)(shw + mb * NUP + ucol0 + bj * HALF + 4 * n);
#pragma unroll
                for (int m = 0; m < 4; ++m) {
                    float tot = (pq[ai][m].x + pq[ai][m].y) + (pq[ai][m].z + pq[ai][m].w); tot += __shfl_xor(tot, 16); tot += __shfl_xor(tot, 32);
                    const float rs = rsqrtf(tot * (1.f / D) + EPS);
#pragma unroll
                    for (int bj = 0; bj < 2; ++bj)
#pragma unroll
                        for (int n = 0; n < 2; ++n) { const f32x4 v = acc[ai][bj][m][n] * rs + sv[bj][n]; u32x2 w; w.x = cvt_pk_bf16(v.x, v.y); w.y = cvt_pk_bf16(v.z, v.w); U2[ai][bj][m][n] = w; }
                    if ((m == 0 && fr < 2) || (m == 3 && fr >= 14)) { bf16* ub = UB + ((size_t)g * 4 + (m == 0 ? fr : fr - 12)) * NUP + ucol0;
                        u32x4 wa; wa.x = U2[ai][0][m][0].x; wa.y = U2[ai][0][m][0].y; wa.z = U2[ai][0][m][1].x; wa.w = U2[ai][0][m][1].y; *(u32x4*)ub = wa;
                        u32x4 wb; wb.x = U2[ai][1][m][0].x; wb.y = U2[ai][1][m][0].y; wb.z = U2[ai][1][m][1].x; wb.w = U2[ai][1][m][1].y; *(u32x4*)(ub + HALF) = wb; }
                }
            }
        }
        asm volatile("" ::: "memory");
#pragma unroll
        for (int n = 0; n < 2; ++n) {
            const int ch = ch0 + 4 * n;
            const f32x4 wa0 = *(const f32x4*)(wcv + ch), wa1 = *(const f32x4*)(wcv + NUP + ch), wa2 = *(const f32x4*)(wcv + 2 * NUP + ch), ba = *(const f32x4*)(bcv + ch);
            const f32x4 wv0 = *(const f32x4*)(wcv + DFF + ch), wv1 = *(const f32x4*)(wcv + NUP + DFF + ch), wv2 = *(const f32x4*)(wcv + 2 * NUP + DFF + ch), bv = *(const f32x4*)(bcv + DFF + ch);
#pragma unroll
            for (int ai = 0; ai < 2; ++ai) {
                const int rb = u.pm * BM + ai * HALF + wr * 64;
                u32x2 a1p = U2[ai][0][0][n], a2p = a1p, v1p = a1p, v2p = a1p;
#pragma unroll
                for (int m = 0; m < 4; ++m) {
                    const u32x2 ca = U2[ai][0][m][n], cv = U2[ai][1][m][n];
                    u32x2 a1c, a2c, v1c, v2c;
                    a1c.x = dppmov<0x121>(ca.x); a1c.y = dppmov<0x121>(ca.y); a2c.x = dppmov<0x122>(ca.x); a2c.y = dppmov<0x122>(ca.y);
                    v1c.x = dppmov<0x121>(cv.x); v1c.y = dppmov<0x121>(cv.y); v2c.x = dppmov<0x122>(cv.x); v2c.y = dppmov<0x122>(cv.y);
                    const u32x2 p1a = fr == 0 ? a1p : a1c, p2a = fr < 2 ? a2p : a2c, p1v = fr == 0 ? v1p : v1c, p2v = fr < 2 ? v2p : v2c;
                    f32x4 xa, xv;
                    xa.x = ba.x + wa0.x * bflo(p2a.x) + wa1.x * bflo(p1a.x) + wa2.x * bflo(ca.x); xa.y = ba.y + wa0.y * bfhi(p2a.x) + wa1.y * bfhi(p1a.x) + wa2.y * bfhi(ca.x);
                    xa.z = ba.z + wa0.z * bflo(p2a.y) + wa1.z * bflo(p1a.y) + wa2.z * bflo(ca.y); xa.w = ba.w + wa0.w * bfhi(p2a.y) + wa1.w * bfhi(p1a.y) + wa2.w * bfhi(ca.y);
                    xv.x = bv.x + wv0.x * bflo(p2v.x) + wv1.x * bflo(p1v.x) + wv2.x * bflo(cv.x); xv.y = bv.y + wv0.y * bfhi(p2v.x) + wv1.y * bfhi(p1v.x) + wv2.y * bfhi(cv.x);
                    xv.z = bv.z + wv0.z * bflo(p2v.y) + wv1.z * bflo(p1v.y) + wv2.z * bflo(cv.y); xv.w = bv.w + wv0.w * bfhi(p2v.y) + wv1.w * bfhi(p1v.y) + wv2.w * bfhi(cv.y);
                    u32x2 o; o.x = cvt_pk_bf16(siluf_(xa.x) * xv.x, siluf_(xa.y) * xv.y); o.y = cvt_pk_bf16(siluf_(xa.z) * xv.z, siluf_(xa.w) * xv.w);
                    if (!(m == 0 && fr < 2)) *(u32x2*)(ACT + (size_t)(rb + m * 16 + fr) * DFF + ch) = o;
                    a1p = a1c; a2p = a2c; v1p = v1c; v2p = v2c;
                }
            }
            asm volatile("" ::: "memory");
        }
    }
};
struct EpiDown0 {
    static constexpr bool PERM = false;
    const float* modv; float* yp; float* ys; int slab;
    __device__ __forceinline__ void operator()(const f32x4 (&acc)[2][2][4][2], const Unit& u, int wr, int wc, int fr, int fq) const {
        const int col0 = u.pn * BM + wc * 32 + 4 * fq;
#pragma unroll
        for (int ai = 0; ai < 2; ++ai) {
            const int rb = u.pm * BM + ai * HALF + wr * 64; const int mb = row_mb(rb);
            f32x4 gtv[2][2], xv[4][2][2];
#pragma unroll
            for (int bj = 0; bj < 2; ++bj)
#pragma unroll
                for (int n = 0; n < 2; ++n) gtv[bj][n] = *(const f32x4*)(modv + mb * 6144 + 5120 + col0 + bj * HALF + n * 16);
#pragma unroll
            for (int m = 0; m < 4; ++m) { const int r = rb + m * 16 + fr; const float* yrow = (r < RP ? yp : ys) + row_goff(slab, r);
#pragma unroll
                for (int bj = 0; bj < 2; ++bj)
#pragma unroll
                    for (int n = 0; n < 2; ++n) xv[m][bj][n] = *(const f32x4*)(yrow + col0 + bj * HALF + n * 16); }
#pragma unroll
            for (int m = 0; m < 4; ++m) { const int r = rb + m * 16 + fr; float* yrow = (r < RP ? yp : ys) + row_goff(slab, r);
#pragma unroll
                for (int bj = 0; bj < 2; ++bj)
#pragma unroll
                    for (int n = 0; n < 2; ++n) *(f32x4*)(yrow + col0 + bj * HALF + n * 16) = xv[m][bj][n] + gtv[bj][n] * acc[ai][bj][m][n]; }
        }
    }
};
struct EpiDown1 {
    static constexpr bool PERM = true;
    bf16* PD;
    __device__ __forceinline__ void operator()(const f32x4 (&acc)[2][2][4][2], const Unit& u, int wr, int wc, int fr, int fq) const {
        const int row0 = u.pm * BM + wr * 64 + fr, col0 = u.pn * BM + wc * 32 + 8 * fq;
#pragma unroll
        for (int ai = 0; ai < 2; ++ai)
#pragma unroll
            for (int m = 0; m < 4; ++m) { const size_t r = (size_t)(row0 + ai * HALF + m * 16);
#pragma unroll
                for (int bj = 0; bj < 2; ++bj) { const f32x4 a0 = acc[ai][bj][m][0], a1 = acc[ai][bj][m][1];
                    u32x4 o; o.x = cvt_pk_bf16(a0.x, a0.y); o.y = cvt_pk_bf16(a0.z, a0.w); o.z = cvt_pk_bf16(a1.x, a1.y); o.w = cvt_pk_bf16(a1.z, a1.w); *(u32x4*)(PD + r * D + col0 + bj * HALF) = o; } }
    }
};
}
typedef short bf16x8 __attribute__((ext_vector_type(8)));
#define MFMA16(a, b, c) __builtin_amdgcn_mfma_f32_16x16x32_bf16((a), (b), (c), 0, 0, 0)
__device__ __forceinline__ bf16x8 ldfrag(const LAS bf16* base, int ld, int row0, int k0, int lane) {
    return *(const LAS bf16x8*)(base + (row0 + (lane & 15)) * ld + k0 + 8 * (lane >> 4));
}
__device__ __forceinline__ bf16x8 ldfrag_perm(const LAS bf16* base, int ld, int row0, int k0, int lane) {
    const LAS v2u* p = (const LAS v2u*)(base + (row0 + (lane & 15)) * ld + k0 + 4 * (lane >> 4));
    const v2u a = p[0], b = p[4];
    v4u w; w.x = a.x; w.y = a.y; w.z = b.x; w.w = b.y; return __builtin_bit_cast(bf16x8, w);
}
__device__ __forceinline__ bf16x8 acc2frag(f32x4 t0, f32x4 t1) {
    v4u w; w.x = pg8::cvt_pk_bf16(t0.x, t0.y); w.y = pg8::cvt_pk_bf16(t0.z, t0.w); w.z = pg8::cvt_pk_bf16(t1.x, t1.y); w.w = pg8::cvt_pk_bf16(t1.z, t1.w); return __builtin_bit_cast(bf16x8, w);
}
__device__ __forceinline__ int kpos(int o) { return (o & ~31) | (8 * ((o >> 2) & 3) + 4 * ((o >> 4) & 1) + (o & 3)); }
__device__ __forceinline__ float wave_incl_scan(float v, int lane) {
#pragma unroll
    for (int o = 1; o < 64; o <<= 1) { const float t = __shfl_up(v, o); if (lane >= o) v += t; }
    return v;
}
__device__ __forceinline__ float dpp_f(float v, int ctrl_sel) {
    const int x = __builtin_bit_cast(int, v); int r;
    switch (ctrl_sel) { case 0: r = __builtin_amdgcn_mov_dpp(x, 0xB1, 0xF, 0xF, true); break; case 1: r = __builtin_amdgcn_mov_dpp(x, 0x4E, 0xF, 0xF, true); break;
                        case 2: r = __builtin_amdgcn_mov_dpp(x, 0x141, 0xF, 0xF, true); break; default: r = __builtin_amdgcn_mov_dpp(x, 0x140, 0xF, 0xF, true); break; }
    return __builtin_bit_cast(float, r);
}
__device__ __forceinline__ float row16_sum(float v) { v += dpp_f(v, 0); v += dpp_f(v, 1); v += dpp_f(v, 2); v += dpp_f(v, 3); return v; }

constexpr int GI_WKN = 0, GI_QG = 17408, GI_KT = 34816, GI_QKM = 53248, GI_IMG = 62464, GI_WV = GI_IMG, GI_SC = GI_IMG + 16384, GI_STRIDE = GI_SC + 256;
constexpr int GDN_ITEMS_MAX = GDN_ITEMS;
static_assert(GI_STRIDE == GI_STRIDE_C, "image stride");
constexpr int GP_QS = 0, GP_KS = 17408, GP_LS = 34816, GP_SC = 51200, GP_HALF = 52736;

__device__ __forceinline__ void gdn_pre_pair(Frame& F, int s, int pair) {
    const bf16* P = (const bf16*)GENP(F.ws, WS_XC, SZ_XC, G_XC, s); const float* SM = (const float*)GENP(F.ws, WS_SM, SZ_SM, G_SM, s);
    const int tid = F.tid, hb = tid >> 8, ht = tid & 255, wl = (tid >> 6) & 3;
    int lane = F.lane; asm volatile("" : "+v"(lane)); const int quad = lane >> 4, l15 = lane & 15;
    const int it = 2 * pair + hb;
    int bsel, h, r0, c; bool samp;
    if (it < NCH * NB * GH) { samp = false; const int bh = it / NCH; c = it % NCH; bsel = bh >> 3; h = bh & 7; r0 = bsel * SLAB_T + 64 * c; }
    else { samp = true; const int q = it - NCH * NB * GH; bsel = q >> 3; h = q & 7; c = 0; r0 = RP + bsel * DSEQ; }
    unsigned char* img = GENP(F.ws, WS_GDN, SZ_GIMG, G_IMG, s) + (size_t)it * GI_STRIDE;
    LAS unsigned char* hbase = F.lds + hb * GP_HALF;
    LAS bf16* QS = (LAS bf16*)(hbase + GP_QS); LAS bf16* KS = (LAS bf16*)(hbase + GP_KS); LAS float* LS = (LAS float*)(hbase + GP_LS);
    LAS float* NQ = (LAS float*)(hbase + GP_SC); LAS float* NK = NQ + 64; LAS float* GAMS = NK + 64; LAS float* BTS = GAMS + 64; LAS float* EG = BTS + 64; LAS float* EL = EG + 64;
    if (ht < 64) { const size_t r = (size_t)(r0 + lane); const float beta = sigmoidf_(SM[r * 64 + h]); const float g = -__expf(F.A.in[14][h]) * softplusf_(SM[r * 64 + 8 + h] + F.A.in[15][h]);
        const float ga = wave_incl_scan(g, lane); const float la = __shfl(ga, 63); GAMS[lane] = ga; BTS[lane] = beta; EG[lane] = __expf(ga); EL[lane] = __expf(la - ga); }
    float y[64];
    {
        const float* wcv = F.A.in[12]; const float* bcv = F.A.in[13];
        LAS bf16* RAW0 = (LAS bf16*)(hbase + GP_LS); LAS bf16* RAW1 = (LAS bf16*)(hbase + GP_KS);
#pragma unroll
        for (int rnd = 0; rnd < 2; ++rnd) {
#pragma unroll
            for (int i = 0; i < 4; ++i) { const int id = ht + 256 * i, row = id >> 4, c16 = id & 15;
                *(LAS v4u*)(RAW0 + row * 128 + 8 * c16) = __builtin_nontemporal_load((const GAS v4u*)(P + (size_t)(r0 + row) * NXC + (rnd == 0 ? 0 : 1024) + h * 128 + 8 * c16));
                if (rnd == 0) *(LAS v4u*)(RAW1 + row * 128 + 8 * c16) = __builtin_nontemporal_load((const GAS v4u*)(P + (size_t)(r0 + row) * NXC + 2048 + h * 128 + 8 * c16)); }
            __syncthreads();
            if (rnd == 0 || ht < 128) {
                const int role = rnd == 1 ? 1 : (ht < 128 ? 0 : 2), ch = ht & 127;
                const int cidx = role * 1024 + h * 128 + ch;
                const float w0 = wcv[cidx], w1 = wcv[CONV_CH + cidx], w2 = wcv[2 * CONV_CH + cidx], w3 = wcv[3 * CONV_CH + cidx], bias = bcv[cidx];
                float h0 = 0.f, h1 = 0.f, h2 = 0.f;
                if (c > 0) { const bf16* pp = P + (size_t)(r0 - 3) * NXC + cidx; h0 = bf2f(pp[0]); h1 = bf2f(pp[NXC]); h2 = bf2f(pp[2 * NXC]); }
                else if (samp) { const float* st = F.A.in[2] + (size_t)bsel * 3 * CONV_CH + cidx; h0 = st[0]; h1 = st[CONV_CH]; h2 = st[2 * CONV_CH]; }
                else if (s > 0) { const float* st = (const float*)(F.ws + WS_CARRY_MIX) + ((size_t)(s & 1) * NB + bsel) * 3 * CONV_CH + cidx; h0 = st[0]; h1 = st[CONV_CH]; h2 = st[2 * CONV_CH]; }
                const LAS bf16* src = (role == 2 ? RAW1 : RAW0) + ch;
                LAS bf16* dst = (role == 0 ? QS : KS) + ch;
#pragma unroll
                for (int t = 0; t < 64; ++t) { const float raw = bf2f(src[t * 128]); float val = bias + w0 * h0 + w1 * h1 + w2 * h2 + w3 * raw; h0 = h1; h1 = h2; h2 = raw; val = siluf_(val);
                    if (role == 0) dst[t * 136] = (bf16)f2bf(val); else y[t] = val; }
            }
            __syncthreads();
            if (rnd == 1 && ht < 128) {
#pragma unroll
                for (int t = 0; t < 64; ++t) KS[t * 136 + ht] = (bf16)f2bf(y[t]);
            }
        }
    }
    __syncthreads();
    f32x4 kk[4], qk[4];
    {
        bf16x8 ak[4], aq[4];
#pragma unroll
        for (int ks = 0; ks < 4; ++ks) { ak[ks] = ldfrag(KS, 136, 16 * wl, 32 * ks, lane); aq[ks] = ldfrag(QS, 136, 16 * wl, 32 * ks, lane); }
        f32x4 qq = {0.f, 0.f, 0.f, 0.f};
#pragma unroll
        for (int ks = 0; ks < 4; ++ks) qq = MFMA16(aq[ks], aq[ks], qq);
#pragma unroll
        for (int nt = 0; nt < 4; ++nt) {
            if (nt <= wl) { f32x4 a0 = {0.f, 0.f, 0.f, 0.f}, a1 = {0.f, 0.f, 0.f, 0.f};
#pragma unroll
                for (int ks = 0; ks < 4; ++ks) { const bf16x8 bk = ldfrag(KS, 136, 16 * nt, 32 * ks, lane); a0 = MFMA16(ak[ks], bk, a0); a1 = MFMA16(aq[ks], bk, a1); }
                kk[nt] = a0; qk[nt] = a1; } else { kk[nt] = qq; qk[nt] = qq; } }
        float dk = 0.f, dq = 0.f;
#pragma unroll
        for (int nt = 0; nt < 4; ++nt) if (nt == wl) {
#pragma unroll
            for (int r = 0; r < 4; ++r) if (4 * quad + r == l15) { dk = kk[nt][r]; dq = qq[r]; } }
        if ((l15 >> 2) == quad) { NK[16 * wl + l15] = rsqrtf(dk + EPS); NQ[16 * wl + l15] = rsqrtf(dq + EPS) * 0.08838834764831845f; }
    }
    __syncthreads();
    {
        bf16* QKM = (bf16*)(img + GI_QKM);
#pragma unroll
        for (int nt = 0; nt < 4; ++nt) { const int j = 16 * nt + l15; const float nkj = NK[j], gj = GAMS[j];
#pragma unroll
            for (int r = 0; r < 4; ++r) { const int i = 16 * wl + 4 * quad + r; const float e = __expf(GAMS[i] - gj);
                LS[i * 64 + j] = i > j ? kk[nt][r] * NK[i] * nkj * e * BTS[i] : 0.f;
                QKM[i * 72 + kpos(j)] = (bf16)f2bf(i >= j ? qk[nt][r] * NQ[i] * nkj * e : 0.f); } }
    }
    const float last = GAMS[63];
    if (ht < 128) {
        bf16* KT = (bf16*)(img + GI_KT) + ht * 72;
#pragma unroll
        for (int i8 = 0; i8 < 8; ++i8) { float t[8];
#pragma unroll
            for (int e = 0; e < 8; ++e) { const int j = 32 * (i8 >> 2) + 16 * (e >> 2) + 4 * (i8 & 3) + (e & 3); const float kh = y[j] * NK[j]; t[e] = kh * EL[j]; y[j] = kh * BTS[j] * EG[j]; }
            v4u o; o.x = pk2(t[0], t[1]); o.y = pk2(t[2], t[3]); o.z = pk2(t[4], t[5]); o.w = pk2(t[6], t[7]); *(GAS v4u*)(KT + 8 * i8) = o; }
    } else {
#pragma unroll
        for (int j = 0; j < 64; ++j) y[j] *= BTS[j];
    }
    __syncthreads();
#pragma unroll
    for (int i = 1; i < 64; ++i) { float acc = y[i];
#pragma unroll
        for (int j4 = 0; j4 < (i + 3) / 4; ++j4) { const f32x4 l = *(const LAS f32x4*)(LS + i * 64 + 4 * j4);
            acc -= l.x * y[4 * j4]; if (4 * j4 + 1 < i) acc -= l.y * y[4 * j4 + 1]; if (4 * j4 + 2 < i) acc -= l.z * y[4 * j4 + 2]; if (4 * j4 + 3 < i) acc -= l.w * y[4 * j4 + 3]; }
        y[i] = acc; }
    if (ht < 128) { LAS bf16* WS_ = KS + kpos(ht);
#pragma unroll
        for (int i = 0; i < 64; ++i) WS_[i * 136] = (bf16)f2bf(-y[i]); }
    else { const int v = ht - 128; bf16* WV = (bf16*)(img + GI_WV) + ((v >> 4) * 64 + (v & 15)) * 16;
#pragma unroll
        for (int i = 0; i < 64; i += 4) { v2u o; o.x = pk2(y[i], y[i + 1]); o.y = pk2(y[i + 2], y[i + 3]); *(GAS v2u*)(WV + (((i >> 2) & 3) << 4) * 16 + (i >> 4) * 4) = o; } }
    {
        bf16* QG = (bf16*)(img + GI_QG);
#pragma unroll
        for (int q = 0; q < 4; ++q) { const int idx = ht + 256 * q, i = idx >> 4, d8 = (idx & 15) * 8; const int o0 = (d8 & ~31) + 4 * ((d8 >> 3) & 3);
            const v2u xa = *(const LAS v2u*)(QS + i * 136 + o0), xb = *(const LAS v2u*)(QS + i * 136 + o0 + 16); v4u x; x.x = xa.x; x.y = xa.y; x.z = xb.x; x.w = xb.y; const float sc = NQ[i] * EG[i];
            v4u o; o.x = pk2(bflo(x.x) * sc, bfhi(x.x) * sc); o.y = pk2(bflo(x.y) * sc, bfhi(x.y) * sc); o.z = pk2(bflo(x.z) * sc, bfhi(x.z) * sc); o.w = pk2(bflo(x.w) * sc, bfhi(x.w) * sc);
            *(GAS v4u*)(QG + i * 136 + d8) = o; }
        if (ht == 0) *(float*)(img + GI_SC) = EG[63];
    }
    __syncthreads();
    for (int i = ht; i < 17408 / 16; i += 256) *(GAS v4u*)(img + GI_WKN + 16 * i) = *(const LAS v4u*)(hbase + GP_KS + 16 * i);
    __syncthreads();
}
__device__ __forceinline__ void phase_gdn_pre(Frame& F, int s) {
    const int npairs = (s == DSLAB ? GDN_ITEMS_MAX : NCH * NB * GH) / 2;
    for (int p = F.bid; p < npairs; p += F.G) gdn_pre_pair(F, s, p);
}

constexpr int GS_BUF = 0, GS_PSQ = 2 * GI_IMG, GS_ZS = GS_PSQ + 4096, GS_RS = GS_ZS + 8 * 2048;
static_assert(GS_RS + 256 <= RING_BYTES, "GDN sequential LDS map fits");
__device__ __forceinline__ void gdn_seq_job(Frame& F, int s, bool samp, int bb, int h, bool dry = false) {
    const bf16* ZGp = (const bf16*)GENP(F.ws, WS_ZG, SZ_ZG, G_ZG, s); bf16* OG = (bf16*)GENP(F.ws, WS_OG, SZ_OG, G_OG, s);
    const int w = F.wave;
    int lane = F.lane; asm volatile("" : "+v"(lane)); int quad = lane >> 4, l15 = lane & 15;
    const int nchunk = samp ? 1 : NCH, row0 = samp ? RP + bb * DSEQ : bb * SLAB_T;
    const int item0 = samp ? NCH * NB * GH + bb * GH + h : (bb * GH + h) * NCH;
    const unsigned char* img0 = GENP(F.ws, WS_GDN, SZ_GIMG, G_IMG, s) + (size_t)item0 * GI_STRIDE;
    LAS float* PSQ = (LAS float*)(F.lds + GS_PSQ); LAS bf16* ZS = (LAS bf16*)(F.lds + GS_ZS) + w * 1024; LAS float* RS = (LAS float*)(F.lds + GS_RS);
    f32x4 Sacc[8];
    {
        const float* st = samp ? F.A.in[3] : F.out + O_GP; const size_t sb = (size_t)(bb * GH + h) * GDK * GDV;
#pragma unroll
        for (int mt = 0; mt < 8; ++mt)
#pragma unroll
            for (int r = 0; r < 4; ++r) Sacc[mt][r] = (samp || s > 0) ? st[sb + (size_t)(16 * mt + 4 * quad + r) * GDV + 16 * w + l15] : 0.f;
    }
    const float gn = F.A.in[16][16 * w + l15];
#define GDN_STAGE(imgp, bufi) do { for (int pc_ = w; pc_ < GI_IMG / 1024; pc_ += 8) \
        __builtin_amdgcn_global_load_lds((const unsigned*)((imgp) + pc_ * 1024 + lane * 16), (LAS unsigned*)(F.lds + GS_BUF + (bufi) * GI_IMG + pc_ * 1024), 16, 0, 0); } while (0)
    PROF_BEGIN(1);
    GDN_STAGE(img0, 0);
    v4u wv[2];
    { const GAS v4u* WV = (const GAS v4u*)(img0 + GI_WV) + (w * 64 + lane) * 2; wv[0] = WV[0]; wv[1] = WV[1]; }
#define WVF(q, mt) ((f32x4){bflo((mt) & 1 ? q[(mt) >> 1].z : q[(mt) >> 1].x), bfhi((mt) & 1 ? q[(mt) >> 1].z : q[(mt) >> 1].x), bflo((mt) & 1 ? q[(mt) >> 1].w : q[(mt) >> 1].y), bfhi((mt) & 1 ? q[(mt) >> 1].w : q[(mt) >> 1].y)})
    v4u zr0, zr1;
    { const GAS v4u* zp = (const GAS v4u*)(ZGp + (size_t)(row0 + lane) * NZG + h * 128 + 16 * w); zr0 = zp[0]; zr1 = zp[1]; }
    float el_next = *(const float*)(img0 + GI_SC);
    f32x4 Oprev[4];
#pragma unroll
    for (int mt = 0; mt < 4; ++mt) Oprev[mt] = WVF(wv, mt);
#define GDN_FINISH(cc) do { const LAS float* ps = PSQ + ((cc) & 1) * 512; const int rb = row0 + 64 * (cc); \
        { const f32x4 p0 = *(const LAS f32x4*)(ps + lane * 8), p1 = *(const LAS f32x4*)(ps + lane * 8 + 4);     \
          RS[lane] = rsqrtf((((p0.x + p0.y) + (p0.z + p0.w)) + ((p1.x + p1.y) + (p1.z + p1.w))) * (1.f / GDV) + EPS); } \
        _Pragma("unroll") for (int mt = 0; mt < 4; ++mt) { const f32x4 rs4 = *(const LAS f32x4*)(RS + 16 * mt + 4 * quad); \
            _Pragma("unroll") for (int r = 0; r < 4; ++r) { const int i = 16 * mt + 4 * quad + r; const float z = bf2f(ZS[i * 16 + l15]); \
            ZS[i * 16 + l15] = (bf16)f2bf(Oprev[mt][r] * rs4[r] * gn * siluf_(z)); } } \
        { const v4u o0_ = *(const LAS v4u*)(ZS + lane * 16), o1_ = *(const LAS v4u*)(ZS + lane * 16 + 8); GAS v4u* op_ = (GAS v4u*)(OG + (size_t)(rb + lane) * D + h * 128 + 16 * w); op_[0] = o0_; op_[1] = o1_; } } while (0)
    for (int c = 0; c < nchunk; ++c) {
        asm volatile("" : "+v"(lane)); quad = lane >> 4; l15 = lane & 15;
        PROF_BEGIN(2);
        asm volatile("s_waitcnt vmcnt(0)" ::: "memory");
        __syncthreads();
        PROF_END(2);
        PROF_BEGIN(3);
        const unsigned char* img = img0 + (size_t)c * GI_STRIDE;
        v4u wvn[2];
        const float el = el_next;
        if (c + 1 < nchunk) { GDN_STAGE(img + GI_STRIDE, (c + 1) & 1); el_next = *(const float*)(img + GI_STRIDE + GI_SC);
            const GAS v4u* WV = (const GAS v4u*)(img + GI_STRIDE + GI_WV) + (w * 64 + lane) * 2; wvn[0] = WV[0]; wvn[1] = WV[1]; }
        else { wvn[0] = wv[0]; wvn[1] = wv[1]; }
        if (c > 0) GDN_FINISH(c - 1);
        PROF_END(3);
        PROF_BEGIN(4);
        *(LAS v4u*)(ZS + lane * 16) = zr0; *(LAS v4u*)(ZS + lane * 16 + 8) = zr1;
        if (c + 1 < nchunk) { const GAS v4u* zp = (const GAS v4u*)(ZGp + (size_t)(row0 + 64 * (c + 1) + lane) * NZG + h * 128 + 16 * w); zr0 = zp[0]; zr1 = zp[1]; }
        const LAS unsigned char* buf = F.lds + GS_BUF + (c & 1) * GI_IMG;
        const LAS bf16* WKN = (const LAS bf16*)(buf + GI_WKN); const LAS bf16* QG = (const LAS bf16*)(buf + GI_QG); const LAS bf16* KT = (const LAS bf16*)(buf + GI_KT); const LAS bf16* QKM = (const LAS bf16*)(buf + GI_QKM);
        f32x4 U[4], O[4];
#pragma unroll
        for (int mt = 0; mt < 4; ++mt) { U[mt] = WVF(wv, mt); O[mt] = (f32x4){0.f, 0.f, 0.f, 0.f}; }
#pragma unroll
        for (int ks = 0; ks < 4; ++ks) { const bf16x8 Sb = acc2frag(Sacc[2 * ks], Sacc[2 * ks + 1]);
#pragma unroll
            for (int mt = 0; mt < 4; ++mt) { U[mt] = MFMA16(ldfrag(WKN, 136, 16 * mt, 32 * ks, lane), Sb, U[mt]); O[mt] = MFMA16(ldfrag(QG, 136, 16 * mt, 32 * ks, lane), Sb, O[mt]); } }
        bf16x8 Ub[2];
#pragma unroll
        for (int ks = 0; ks < 2; ++ks) Ub[ks] = acc2frag(U[2 * ks], U[2 * ks + 1]);
#pragma unroll
        for (int ks = 0; ks < 2; ++ks)
#pragma unroll
            for (int mt = 0; mt < 4; ++mt) O[mt] = MFMA16(ldfrag(QKM, 72, 16 * mt, 32 * ks, lane), Ub[ks], O[mt]);
#pragma unroll
        for (int mt = 0; mt < 8; ++mt) { Sacc[mt] = Sacc[mt] * el;
#pragma unroll
            for (int ks = 0; ks < 2; ++ks) Sacc[mt] = MFMA16(ldfrag(KT, 72, 16 * mt, 32 * ks, lane), Ub[ks], Sacc[mt]); }
        { LAS float* ps = PSQ + (c & 1) * 512;
#pragma unroll
          for (int mt = 0; mt < 4; ++mt)
#pragma unroll
              for (int r = 0; r < 4; ++r) { const float sq = row16_sum(O[mt][r] * O[mt][r]); if (l15 == 0) ps[(16 * mt + 4 * quad + r) * 8 + w] = sq; Oprev[mt][r] = O[mt][r]; } }
        PROF_END(4);
        wv[0] = wvn[0]; wv[1] = wvn[1];
    }
    __syncthreads();
    GDN_FINISH(nchunk - 1);
    PROF_END(1);
#undef GDN_FINISH
#undef WVF
#undef GDN_STAGE
    {
        float* so = (dry ? (float*)(F.ws + WS_T1) : F.out) + (samp ? O_GS : O_GP) - (dry ? O_GP : 0) + (size_t)(bb * GH + h) * GDK * GDV;
#pragma unroll
        for (int mt = 0; mt < 8; ++mt)
#pragma unroll
            for (int r = 0; r < 4; ++r) so[(size_t)(16 * mt + 4 * quad + r) * GDV + 16 * w + l15] = Sacc[mt][r];
    }
    __syncthreads();
}
constexpr int SI_CS = 0, SI_BT = 17408, SI_CB = 35840, SI_DT = 45056, SI_GAM = 46080, SI_IMG = 47104, SI_XT = SI_IMG, SI_STRIDE = SI_IMG + 32768;
constexpr int SSD_ITEMS_MAX = SSD_ITEMS;
static_assert(SI_STRIDE == SI_STRIDE_C, "image stride");
constexpr int SP_CS = 0, SP_BS = 17408, SP_DT = 34816, SP_GAM = 35840, SP_RAW = 40960;
static_assert(SP_RAW + 65536 <= RING_BYTES, "SSD precompute LDS map fits");

__device__ __forceinline__ void ssd_pre_item(Frame& F, int s, int it) {
    const bf16* P = (const bf16*)GENP(F.ws, WS_XC, SZ_XC, G_XC, s); const float* SM = (const float*)GENP(F.ws, WS_SM, SZ_SM, G_SM, s);
    const int tid = F.tid, w = F.wave;
    int lane = F.lane; asm volatile("" : "+v"(lane)); const int quad = lane >> 4, l15 = lane & 15;
    int bsel, g, r0, c; bool samp;
    if (it < NCH * NB * SG) { samp = false; const int bg = it / NCH; c = it % NCH; bsel = bg >> 3; g = bg & 7; r0 = bsel * SLAB_T + 64 * c; }
    else { samp = true; const int q = it - NCH * NB * SG; bsel = q >> 3; g = q & 7; c = 0; r0 = RP + bsel * DSEQ; }
    unsigned char* img = GENP(F.ws, WS_SSD, SZ_SIMG, G_IMG, s) + (size_t)it * SI_STRIDE;
    LAS bf16* CS = (LAS bf16*)(F.lds + SP_CS); LAS bf16* BS = (LAS bf16*)(F.lds + SP_BS); LAS float* DTV = (LAS float*)(F.lds + SP_DT); LAS float* GAM = (LAS float*)(F.lds + SP_GAM);
    v4u rawr[8];
#pragma unroll
    for (int i = 0; i < 8; ++i) { const int id = tid + NTHR * i, row = id >> 6, j = id & 63;
        const int col = j < 32 ? 3072 + g * 256 + 8 * j : (j < 48 ? 5120 + g * 128 + 8 * (j - 32) : 6144 + g * 128 + 8 * (j - 48));
        rawr[i] = __builtin_nontemporal_load((const GAS v4u*)(P + (size_t)(r0 + row) * NXC + col)); }
    const int cidx = tid < 256 ? 3072 + g * 256 + tid : (tid < 384 ? 5120 + g * 128 + (tid - 256) : 6144 + g * 128 + (tid - 384));
    const float* wcv = F.A.in[12]; const float w0 = wcv[cidx], w1 = wcv[CONV_CH + cidx], w2 = wcv[2 * CONV_CH + cidx], w3 = wcv[3 * CONV_CH + cidx], bias = F.A.in[13][cidx];
    float h0 = 0.f, h1 = 0.f, h2 = 0.f;
    if (c > 0) { const bf16* pp = P + (size_t)(r0 - 3) * NXC + cidx; h0 = bf2f(pp[0]); h1 = bf2f(pp[NXC]); h2 = bf2f(pp[2 * NXC]); }
    else if (samp) { const float* st = F.A.in[2] + (size_t)bsel * 3 * CONV_CH + cidx; h0 = st[0]; h1 = st[CONV_CH]; h2 = st[2 * CONV_CH]; }
    else if (s > 0) { const float* st = (const float*)(F.ws + WS_CARRY_MIX) + ((size_t)(s & 1) * NB + bsel) * 3 * CONV_CH + cidx; h0 = st[0]; h1 = st[CONV_CH]; h2 = st[2 * CONV_CH]; }
    if (tid < 256) { const int hh = 4 * g + (tid >> 6); const float dt = softplusf_(SM[(size_t)(r0 + lane) * 64 + 16 + hh] + F.A.in[18][hh]);
        const float ga = wave_incl_scan(dt * (-__expf(F.A.in[17][hh])), lane); DTV[(tid >> 6) * 64 + lane] = dt; GAM[(tid >> 6) * 64 + lane] = ga;
        ((float*)(img + SI_DT))[(tid >> 6) * 64 + lane] = dt; ((float*)(img + SI_GAM))[(tid >> 6) * 64 + lane] = ga; }
    { LAS bf16* RAW = (LAS bf16*)(F.lds + SP_RAW);
#pragma unroll
      for (int i = 0; i < 8; ++i) { const int id = tid + NTHR * i, row = id >> 6, j = id & 63; *(LAS v4u*)(RAW + row * 512 + 8 * j) = rawr[i]; } }
    __syncthreads();
    {
        unsigned colp2[32];
        LAS bf16* RAW = (LAS bf16*)(F.lds + SP_RAW);
        const LAS float* dtp = DTV + (tid < 256 ? (tid >> 6) * 64 : 0);
#pragma unroll
        for (int t = 0; t < 64; t += 2) { const float ra = bf2f(RAW[t * 512 + tid]), rb = bf2f(RAW[(t + 1) * 512 + tid]);
            float va = bias + w0 * h0 + w1 * h1 + w2 * h2 + w3 * ra; float vb = bias + w0 * h1 + w1 * h2 + w2 * ra + w3 * rb; h0 = h2; h1 = ra; h2 = rb;
            va = siluf_(va); vb = siluf_(vb); if (tid < 256) { va *= dtp[t]; vb *= dtp[t + 1]; }
            colp2[t >> 1] = pk2(va, vb); }
        if (tid < 384) {
            bf16* rowp = tid < 256 ? (bf16*)(img + SI_XT) + tid * 64 : (bf16*)(img + SI_BT) + (tid - 256) * 72;
#pragma unroll
            for (int i = 0; i < 8; ++i) { v4u o; o.x = colp2[4 * i]; o.y = colp2[4 * i + 1]; o.z = colp2[4 * i + 2]; o.w = colp2[4 * i + 3]; *(GAS v4u*)(rowp + 8 * i) = o; }
        }
        if (tid >= 256) {
            LAS bf16* colp = tid < 384 ? BS + kpos(tid - 256) : CS + kpos(tid - 384);
#pragma unroll
            for (int t = 0; t < 32; ++t) { colp[(2 * t) * 136] = (bf16)(colp2[t] & 0xffffu); colp[(2 * t + 1) * 136] = (bf16)(colp2[t] >> 16); }
        }
    }
    __syncthreads();
    {
        const int mt = w >> 1; bf16* CBG = (bf16*)(img + SI_CB);
#pragma unroll
        for (int q = 0; q < 2; ++q) { const int nt = 2 * (w & 1) + q; f32x4 acc = {0.f, 0.f, 0.f, 0.f};
#pragma unroll
            for (int ks = 0; ks < 4; ++ks) acc = MFMA16(ldfrag(CS, 136, 16 * mt, 32 * ks, lane), ldfrag(BS, 136, 16 * nt, 32 * ks, lane), acc);
#pragma unroll
            for (int r = 0; r < 4; ++r) CBG[(16 * mt + 4 * quad + r) * 72 + 16 * nt + l15] = (bf16)f2bf(acc[r]); }
    }
    for (int i = tid; i < 17408 / 16; i += NTHR) *(GAS v4u*)(img + SI_CS + 16 * i) = *(const LAS v4u*)(F.lds + SP_CS + 16 * i);
    __syncthreads();
}
__device__ __forceinline__ void phase_ssd_pre(Frame& F, int s) {
    const int nitems = s == DSLAB ? SSD_ITEMS_MAX : NCH * NB * SG;
    for (int it = F.bid; it < nitems; it += F.G) ssd_pre_item(F, s, it);
}

constexpr int SQ_BUF = 0, SQ_PS = 2 * SI_IMG, SQ_ZS = SQ_PS + 2048, SQ_RS = SQ_ZS + 8 * 4096;
static_assert(SQ_RS + 256 <= RING_BYTES, "SSD sequential LDS map fits");
__device__ __forceinline__ void ssd_seq_job(Frame& F, int s, bool samp, int bb, int g, bool dry = false) {
    const bf16* ZGp = (const bf16*)GENP(F.ws, WS_ZG, SZ_ZG, G_ZG, s); bf16* YS = (bf16*)GENP(F.ws, WS_YS, SZ_YS, G_YS, s);
    const int w = F.wave;
    int lane = F.lane; asm volatile("" : "+v"(lane)); int quad = lane >> 4, l15 = lane & 15;
    const int hl = w >> 1, ph = w & 1, head = 4 * g + hl;
    const int nchunk = samp ? 1 : NCH, row0 = samp ? RP + bb * DSEQ : bb * SLAB_T;
    const int item0 = samp ? NCH * NB * SG + bb * SG + g : (bb * SG + g) * NCH;
    const unsigned char* img0 = GENP(F.ws, WS_SSD, SZ_SIMG, G_IMG, s) + (size_t)item0 * SI_STRIDE;
    LAS float* PS = (LAS float*)(F.lds + SQ_PS); LAS bf16* ZS = (LAS bf16*)(F.lds + SQ_ZS) + w * 2048; LAS float* RS = (LAS float*)(F.lds + SQ_RS);
    f32x4 hacc[8][2];
    {
        const float* st = samp ? F.A.in[4] : F.out + O_SP;
        const size_t sb = (size_t)(bb * SH + head) * SN * SP;
#pragma unroll
        for (int mt = 0; mt < 8; ++mt)
#pragma unroll
            for (int nt = 0; nt < 2; ++nt)
#pragma unroll
                for (int r = 0; r < 4; ++r) { const int n = 16 * mt + 4 * quad + r, p = 32 * ph + 16 * nt + l15; hacc[mt][nt][r] = (samp || s > 0) ? st[sb + (size_t)n * SP + p] : 0.f; }
    }
    const float Dh = F.A.in[19][head];
    const int prow = hl * 64 + 32 * ph;
#define SSD_STAGE(imgp, bufi) do { for (int pc_ = w; pc_ < SI_IMG / 1024; pc_ += 8) \
        __builtin_amdgcn_global_load_lds((const unsigned*)((imgp) + pc_ * 1024 + lane * 16), (LAS unsigned*)(F.lds + SQ_BUF + (bufi) * SI_IMG + pc_ * 1024), 16, 0, 0); } while (0)
#define SSD_LOADXT(dst, imgp) do { const bf16* xb_ = (const bf16*)((imgp) + SI_XT); _Pragma("unroll") for (int nt = 0; nt < 2; ++nt) _Pragma("unroll") for (int ks = 0; ks < 2; ++ks) \
        dst[nt][ks] = *(const GAS v4u*)(xb_ + (prow + 16 * nt + l15) * 64 + 32 * ks + 8 * quad); } while (0)
    PROF_BEGIN(5);
    SSD_STAGE(img0, 0);
    v4u xt[2][2];
    SSD_LOADXT(xt, img0);
    v4u zr[4];
    { const GAS v4u* zp = (const GAS v4u*)(ZGp + (size_t)(row0 + lane) * NZG + 1024 + head * 64 + 32 * ph);
#pragma unroll
      for (int i = 0; i < 4; ++i) zr[i] = zp[i]; }
    const float nw0 = F.A.in[20][head * 64 + 32 * ph + l15], nw1 = F.A.in[20][head * 64 + 32 * ph + 16 + l15];
    for (int c = 0; c < nchunk; ++c) {
        asm volatile("" : "+v"(lane)); quad = lane >> 4; l15 = lane & 15;
        PROF_BEGIN(6);
        asm volatile("s_waitcnt vmcnt(0)" ::: "memory");
        __syncthreads();
        PROF_END(6);
        PROF_BEGIN(7);
        const unsigned char* img = img0 + (size_t)c * SI_STRIDE;
        const int r0 = row0 + 64 * c;
        v4u xtn[2][2];
        if (c + 1 < nchunk) { SSD_STAGE(img + SI_STRIDE, (c + 1) & 1); SSD_LOADXT(xtn, img + SI_STRIDE); }
        else {
#pragma unroll
            for (int nt = 0; nt < 2; ++nt)
#pragma unroll
                for (int ks = 0; ks < 2; ++ks) xtn[nt][ks] = xt[nt][ks]; }
#pragma unroll
        for (int i = 0; i < 4; ++i) *(LAS v4u*)(ZS + lane * 32 + 8 * i) = zr[i];
        if (c + 1 < nchunk) { const GAS v4u* zp = (const GAS v4u*)(ZGp + (size_t)(r0 + 64 + lane) * NZG + 1024 + head * 64 + 32 * ph);
#pragma unroll
          for (int i = 0; i < 4; ++i) zr[i] = zp[i]; }
        const LAS unsigned char* buf = F.lds + SQ_BUF + (c & 1) * SI_IMG;
        const LAS bf16* CS = (const LAS bf16*)(buf + SI_CS); const LAS bf16* BT = (const LAS bf16*)(buf + SI_BT); const LAS bf16* CBS = (const LAS bf16*)(buf + SI_CB);
        const LAS float* gm = (const LAS float*)(buf + SI_GAM) + hl * 64; const LAS float* dv = (const LAS float*)(buf + SI_DT) + hl * 64;
        const float last = gm[63];
        f32x4 y[4][2];
#pragma unroll
        for (int mt = 0; mt < 4; ++mt)
#pragma unroll
            for (int nt = 0; nt < 2; ++nt) y[mt][nt] = (f32x4){0.f, 0.f, 0.f, 0.f};
#pragma unroll
        for (int ks = 0; ks < 4; ++ks) { const bf16x8 hb0 = acc2frag(hacc[2 * ks][0], hacc[2 * ks + 1][0]), hb1 = acc2frag(hacc[2 * ks][1], hacc[2 * ks + 1][1]);
#pragma unroll
            for (int mt = 0; mt < 4; ++mt) { const bf16x8 a = ldfrag(CS, 136, 16 * mt, 32 * ks, lane); y[mt][0] = MFMA16(a, hb0, y[mt][0]); y[mt][1] = MFMA16(a, hb1, y[mt][1]); }
            __builtin_amdgcn_sched_barrier(0); }
#pragma unroll
        for (int mt = 0; mt < 4; ++mt)
#pragma unroll
            for (int r = 0; r < 4; ++r) { const float eg = __expf(gm[16 * mt + 4 * quad + r]); y[mt][0][r] *= eg; y[mt][1][r] *= eg; }
        PROF_END(7);
        PROF_BEGIN(8);
#pragma unroll
        for (int mt = 0; mt < 4; ++mt) { const int i = 16 * mt + l15; const float gi = gm[i], dti = dv[i], ddt = dti > 1e-30f ? Dh * __builtin_amdgcn_rcpf(dti) : 0.f;
#pragma unroll
            for (int ks = 0; ks < 2; ++ks) { if (32 * ks > 16 * mt + 15) continue;
                const v4u aw = __builtin_bit_cast(v4u, ldfrag(CBS, 72, 16 * mt, 32 * ks, lane));
                const f32x4 g0 = *(const LAS f32x4*)(gm + 32 * ks + 8 * quad), g1 = *(const LAS f32x4*)(gm + 32 * ks + 8 * quad + 4);
                float cv[8] = {bflo(aw.x), bfhi(aw.x), bflo(aw.y), bfhi(aw.y), bflo(aw.z), bfhi(aw.z), bflo(aw.w), bfhi(aw.w)};
                const float gj[8] = {g0.x, g0.y, g0.z, g0.w, g1.x, g1.y, g1.z, g1.w};
#pragma unroll
                for (int jj = 0; jj < 8; ++jj) { const int j = 32 * ks + 8 * quad + jj; float v = i >= j ? cv[jj] * __expf(gi - gj[jj]) : 0.f; if (i == j) v += ddt; cv[jj] = v; }
                v4u bw; bw.x = pk2(cv[0], cv[1]); bw.y = pk2(cv[2], cv[3]); bw.z = pk2(cv[4], cv[5]); bw.w = pk2(cv[6], cv[7]); const bf16x8 a1 = __builtin_bit_cast(bf16x8, bw);
#pragma unroll
                for (int nt = 0; nt < 2; ++nt) y[mt][nt] = MFMA16(a1, __builtin_bit_cast(bf16x8, xt[nt][ks]), y[mt][nt]); }
            __builtin_amdgcn_sched_barrier(0); }
        PROF_END(8);
        PROF_BEGIN(9);
#pragma unroll
        for (int mt = 0; mt < 4; ++mt)
#pragma unroll
            for (int r = 0; r < 4; ++r) { const int i = 16 * mt + 4 * quad + r; float sq = 0.f;
#pragma unroll
                for (int nt = 0; nt < 2; ++nt) { const float z = bf2f(ZS[i * 32 + 16 * nt + l15]); const float yz = y[mt][nt][r] * siluf_(z); y[mt][nt][r] = yz; sq += yz * yz; }
                sq = row16_sum(sq); if (l15 == 0) PS[i * 8 + w] = sq; }
        PROF_END(9);
        PROF_BEGIN(10);
        {
            const float el = __expf(last);
#pragma unroll
            for (int mt = 0; mt < 8; ++mt)
#pragma unroll
                for (int nt = 0; nt < 2; ++nt) hacc[mt][nt] = hacc[mt][nt] * el;
#pragma unroll
            for (int ks = 0; ks < 2; ++ks) { const f32x4 g0 = *(const LAS f32x4*)(gm + 32 * ks + 8 * quad), g1 = *(const LAS f32x4*)(gm + 32 * ks + 8 * quad + 4);
                const float ed[8] = {__expf(last - g0.x), __expf(last - g0.y), __expf(last - g0.z), __expf(last - g0.w), __expf(last - g1.x), __expf(last - g1.y), __expf(last - g1.z), __expf(last - g1.w)};
                bf16x8 xw[2];
#pragma unroll
                for (int nt = 0; nt < 2; ++nt) { const v4u xv = xt[nt][ks];
                    v4u o; o.x = pk2(bflo(xv.x) * ed[0], bfhi(xv.x) * ed[1]); o.y = pk2(bflo(xv.y) * ed[2], bfhi(xv.y) * ed[3]); o.z = pk2(bflo(xv.z) * ed[4], bfhi(xv.z) * ed[5]); o.w = pk2(bflo(xv.w) * ed[6], bfhi(xv.w) * ed[7]);
                    xw[nt] = __builtin_bit_cast(bf16x8, o); }
#pragma unroll
                for (int mt = 0; mt < 8; ++mt) { const bf16x8 a = ldfrag(BT, 72, 16 * mt, 32 * ks, lane); hacc[mt][0] = MFMA16(a, xw[0], hacc[mt][0]); hacc[mt][1] = MFMA16(a, xw[1], hacc[mt][1]); }
                __builtin_amdgcn_sched_barrier(0); }
        }
        PROF_END(10);
        PROF_BEGIN(11);
        __syncthreads();
        { const f32x4 p0 = *(const LAS f32x4*)(PS + lane * 8), p1 = *(const LAS f32x4*)(PS + lane * 8 + 4);
          RS[lane] = rsqrtf((((p0.x + p0.y) + (p0.z + p0.w)) + ((p1.x + p1.y) + (p1.z + p1.w))) * (1.f / 256.f) + EPS); }
#pragma unroll
        for (int mt = 0; mt < 4; ++mt) { const f32x4 rs4 = *(const LAS f32x4*)(RS + 16 * mt + 4 * quad);
#pragma unroll
            for (int r = 0; r < 4; ++r) { const int i = 16 * mt + 4 * quad + r;
#pragma unroll
                for (int nt = 0; nt < 2; ++nt) ZS[i * 32 + 16 * nt + l15] = (bf16)f2bf(y[mt][nt][r] * rs4[r] * (nt ? nw1 : nw0)); } }
        { GAS v4u* op = (GAS v4u*)(YS + (size_t)(r0 + lane) * 2048 + head * 64 + 32 * ph);
#pragma unroll
          for (int i = 0; i < 4; ++i) op[i] = *(const LAS v4u*)(ZS + lane * 32 + 8 * i); }
        PROF_END(11);
#pragma unroll
        for (int nt = 0; nt < 2; ++nt)
#pragma unroll
            for (int ks = 0; ks < 2; ++ks) xt[nt][ks] = xtn[nt][ks];
    }
    PROF_END(5);
#undef SSD_STAGE
#undef SSD_LOADXT
    {
        float* so = (dry ? (float*)(F.ws + WS_T1) : F.out) + (samp ? O_SS : O_SP) - (dry ? O_GP : 0) + (size_t)(bb * SH + head) * SN * SP;
#pragma unroll
        for (int mt = 0; mt < 8; ++mt)
#pragma unroll
            for (int nt = 0; nt < 2; ++nt)
#pragma unroll
                for (int r = 0; r < 4; ++r) so[(size_t)(16 * mt + 4 * quad + r) * SP + 32 * ph + 16 * nt + l15] = hacc[mt][nt][r];
    }
    __syncthreads();
}
#ifndef SCAN_REP_GDN
#define SCAN_REP_GDN 0
#endif
#ifndef SCAN_REP_SSD
#define SCAN_REP_SSD 0
#endif
__device__ __forceinline__ void scan_job(Frame& F, int s, int j) {
    if (j < 32) {
#if SCAN_REP_GDN
        gdn_seq_job(F, s, false, j >> 3, j & 7, true);
#endif
        gdn_seq_job(F, s, false, j >> 3, j & 7);
    } else if (j < 64) {
#if SCAN_REP_SSD
        ssd_seq_job(F, s, false, (j - 32) >> 3, (j - 32) & 7, true);
#endif
        ssd_seq_job(F, s, false, (j - 32) >> 3, (j - 32) & 7);
    } else if (j < 128) gdn_seq_job(F, s, true, (j - 64) >> 3, (j - 64) & 7);
    else ssd_seq_job(F, s, true, (j - 128) >> 3, (j - 128) & 7);
}
__device__ __forceinline__ void phase_scan(Frame& F, int s) {
    const int njobs = s == DSLAB ? 192 : 64;
    for (int j = F.bid; j < njobs; j += F.G) scan_job(F, s, j);
}
#define XB_TMO      128
#define XB_XCNT(j)  (256  + 64 * (j))
#define XB_XSUB(j)  (1280 + 64 * (j))
#define XB_XGEN(j)  (2304 + 64 * (j))
#define XB_TOP      3328
#define XB_TOPGEN   3392
#define XCD_BAR_WORDS 3456
#define XB_SPIN_CAP (1u << 18)
__device__ __forceinline__ unsigned xb_ld(unsigned* p)              { return __hip_atomic_load(p, __ATOMIC_RELAXED, __HIP_MEMORY_SCOPE_AGENT); }
__device__ __forceinline__ unsigned xb_add(unsigned* p, unsigned v) { return __hip_atomic_fetch_add(p, v, __ATOMIC_RELAXED, __HIP_MEMORY_SCOPE_AGENT); }
__device__ __forceinline__ unsigned xb_xcc_id() { return (unsigned)__builtin_amdgcn_s_getreg((3 << 11) | 20) & 0xFu; }
#define XB_SPIN(cond, bar) do { unsigned _sp = 0; while (cond) { __builtin_amdgcn_s_sleep(1); \
    if ((++_sp & 255u) == 0u) { if (xb_ld(&(bar)[XB_TMO])) break; if (_sp > XB_SPIN_CAP) { atomicAdd(&(bar)[XB_TMO], 1u); break; } } } } while (0)
struct XcdBarrier { unsigned* bar; unsigned x; volatile LAS unsigned* st; };
__device__ __forceinline__ XcdBarrier xcd_barrier_post(unsigned* bar, volatile LAS unsigned* st) {
    XcdBarrier b; b.bar = bar; b.x = xb_xcc_id(); b.st = st;
    if (threadIdx.x == 0) (void)xb_add(&bar[XB_XCNT(b.x)], 1u);
    return b;
}
__device__ __forceinline__ void xcd_barrier_complete(unsigned* bar, unsigned x, unsigned& nloc, unsigned& nx) {
    const unsigned G = gridDim.x * gridDim.y * gridDim.z;
    unsigned sum, cnt, mine, sp = 0u;
    for (;;) {
        sum = 0u; cnt = 0u; mine = 0u;
#pragma unroll
        for (unsigned j = 0; j < 16; ++j) { const unsigned c = xb_ld(&bar[XB_XCNT(j)]); sum += c; cnt += (c > 0u) ? 1u : 0u; mine = (j == x) ? c : mine; }
        if (sum == G) break;
        __builtin_amdgcn_s_sleep(1);
        if ((++sp & 255u) == 0u) { if (xb_ld(&bar[XB_TMO])) break; if (sp > XB_SPIN_CAP) { atomicAdd(&bar[XB_TMO], 1u); break; } }
    }
    nloc = mine > 0u ? mine : 1u; nx = cnt > 0u ? cnt : 1u;
}
__device__ __forceinline__ void xcd_barrier(const XcdBarrier& b) {
    asm volatile("s_waitcnt vmcnt(0)" ::: "memory");
    __syncthreads();
    if (threadIdx.x == 0) {
        unsigned* bar = b.bar;
        __builtin_amdgcn_s_waitcnt(0);
        unsigned nloc = b.st[0], nx = b.st[1];
        if (nloc == 0u) { xcd_barrier_complete(bar, b.x, nloc, nx); b.st[0] = nloc; b.st[1] = nx; }
        const unsigned old = xb_add(&bar[XB_XSUB(b.x)], 1u);
        const unsigned gen = old / nloc;
        if (old + 1u == (gen + 1u) * nloc) {
            __builtin_amdgcn_fence(__ATOMIC_RELEASE, "agent");
            asm volatile("s_waitcnt vmcnt(0)" ::: "memory");
            const unsigned og = xb_add(&bar[XB_TOP], 1u);
            const unsigned tg = og / nx;
            if (og + 1u == (tg + 1u) * nx) xb_add(&bar[XB_TOPGEN], 1u);
            else XB_SPIN(xb_ld(&bar[XB_TOPGEN]) == tg, bar);
            __builtin_amdgcn_fence(__ATOMIC_ACQUIRE, "agent");
            xb_add(&bar[XB_XGEN(b.x)], 1u);
            asm volatile("s_waitcnt vmcnt(0)" ::: "memory");
        } else {
            XB_SPIN(xb_ld(&bar[XB_XGEN(b.x)]) == gen, bar);
            __builtin_amdgcn_fence(__ATOMIC_ACQUIRE, "agent");
            asm volatile("s_waitcnt vmcnt(0)" ::: "memory");
        }
    }
    __syncthreads();
}
constexpr int CW_BAR = 4096;
#ifndef PHASE_MASK
#define PHASE_MASK 0xFFF
#endif
#define PM(k) ((PHASE_MASK >> (k)) & 1)
#ifndef GEMM_REPS
#define GEMM_REPS 1
#endif
#ifndef LIGHT_REPS
#define LIGHT_REPS 1
#endif
#ifndef BAR_REPS
#define BAR_REPS 1
#endif
#ifndef PROF_MAX
#define PROF_MAX 0
#endif
#ifndef PROF_PH
#define PROF_PH 0
#endif
#ifndef PROF_ONLY_PH
#define PROF_ONLY_PH -1
#endif
#ifndef GU_STEADY
#define GU_STEADY 1
#endif
#ifndef GSPLIT_P0
#define GSPLIT_P0 18
#endif
#ifndef GU1_P0
#define GU1_P0 18
#endif
#ifndef PRE_REPS
#define PRE_REPS 1
#endif

#define GEMM_PHASE(EPI_T, APTR, BOFF, N_, K_, ...) do { pg8::Gemm g{(const pg8::bf16_t*)(APTR), (const pg8::bf16_t*)(F.ws + (BOFF)), R, (N_), (K_), (K_)}; \
    pg8::ListOrder S; S.init(R, (N_), j0, j1, j1 > 1 ? 8 : 1); epi::EPI_T E{__VA_ARGS__}; pg8::gemm_phase<epi::EPI_T, pg8::ListOrder, true, true>(F.lds, g, S, E, F.tid); if (GEMM_REPS > 1) { __syncthreads(); pg8::gemm_phase<epi::EPI_T, pg8::ListOrder, true, true>(F.lds, g, S, E, F.tid); } } while (0)
#define GP(name, s) GENP(ws, WS_##name, SZ_##name, G_##name, s)
__device__ __forceinline__ void stage_inproj(Frame& F, int s, int j0, int j1) { unsigned char* ws = F.ws; const int R = slab_rows(s);
    GEMM_PHASE(EpiProj, GP(HB, s), WS_WIN, NIN, D, (bf16*)GP(XC, s), (bf16*)GP(ZG, s), (bf16*)GP(GT, s), (float*)GP(SM, s)); }
__device__ __forceinline__ void stage_gate(Frame& F, int s, int j0, int j1) { unsigned char* ws = F.ws; const int R = slab_rows(s);
    GEMM_PHASE(EpiGate1, GP(OG, s), WS_WG, D, D, (const bf16*)GP(GT, s), (bf16*)GP(T1, s));
    __syncthreads();
    GEMM_PHASE(EpiGate2, GP(YS, s), WS_WS, D, 2048, (const bf16*)GP(GT, s), (const bf16*)GP(T1, s), (bf16*)GP(MIX, s)); }
__device__ __forceinline__ void stage_out(Frame& F, int s, int j0, int j1) { unsigned char* ws = F.ws; const int R = slab_rows(s);
    GEMM_PHASE(EpiOut, GP(MIX, s), WS_WOUT, D, D, F.A.in[0], F.A.in[1], (const float*)(ws + WS_MODV), (const float*)(ws + WS_G2), F.out + O_YP, F.out + O_YS, (bf16*)GP(X1G, s), (float*)GENP(ws, WS_SS1, SZ_SS, G_SS, s), s, F.lds, &F.prof); }
__device__ __forceinline__ void stage_up(Frame& F, int s, int j0, int j1) { unsigned char* ws = F.ws; const int R = slab_rows(s);
    GEMM_PHASE(EpiUpAct, GP(X1G, s), WS_WUP, NUP, D, (const float*)GENP(ws, WS_SS1, SZ_SS, G_SS, s), (const float*)(ws + WS_SHW), F.A.in[26], F.A.in[27], (bf16*)GP(ACT, s), (bf16*)GP(U, s)); }
constexpr int CW_GFLAG = 65536;
__device__ __forceinline__ void gate_set_flag(Frame& F, gu32* flag) {
    asm volatile("s_waitcnt vmcnt(0)" ::: "memory"); __syncthreads();
    if (F.tid == 0) { __builtin_amdgcn_fence(__ATOMIC_RELEASE, "agent"); __hip_atomic_store(flag, 1u, __ATOMIC_RELAXED, __HIP_MEMORY_SCOPE_AGENT); }
}
__device__ __forceinline__ void stage_gate_split(Frame& F, int s, int p, int T) { unsigned char* ws = F.ws; const int R = slab_rows(s); const int nun = (R / 256) * 4, part = T / nun, j = T % nun;
    gu32* flA = F.ctl + CW_GFLAG + ((p * 2 + 0) * 64 + j) * 32; gu32* flB = F.ctl + CW_GFLAG + ((p * 2 + 1) * 64 + j) * 32;
    bf16* t1 = (bf16*)GP(T1, s); bf16* t2 = t1 + (size_t)RMAX * D;
    if (part < 2) {
        pg8::Gemm g{part == 0 ? (const pg8::bf16_t*)GP(OG, s) : (const pg8::bf16_t*)GP(YS, s), part == 0 ? (const pg8::bf16_t*)(ws + WS_WG) : (const pg8::bf16_t*)(ws + WS_WS), R, D, 1024, part == 0 ? 1024 : 2048};
        pg8::ListOrder S; S.init(R, D, j, 1); epi::EpiGate1 E{(const bf16*)GP(GT, s) + (part == 0 ? 0 : 1024), part == 0 ? t1 : t2};
        pg8::gemm_phase<epi::EpiGate1, pg8::ListOrder, true, true>(F.lds, g, S, E, F.tid); gate_set_flag(F, part == 0 ? flA : flB); }
    else { pg8::Gemm g{(const pg8::bf16_t*)GP(YS, s) + 1024, (const pg8::bf16_t*)(ws + WS_WS) + 1024, R, D, 1024, 2048};
        pg8::ListOrder S; S.init(R, D, j, 1); epi::EpiGate2S E{(const bf16*)GP(GT, s), (const bf16*)t1, (const bf16*)t2, (bf16*)GP(MIX, s), (const unsigned*)flA, (const unsigned*)flB};
        pg8::gemm_phase<epi::EpiGate2S, pg8::ListOrder, true, true>(F.lds, g, S, E, F.tid); } }
__device__ __forceinline__ void stage_down(Frame& F, int s, int j, int nper) { unsigned char* ws = F.ws; const int R = slab_rows(s); constexpr int KP = DFF / 2;
    { pg8::ListOrder S0; S0.init(R, D, j < nper ? j : j - nper, 1); pg8::Unit u0; if (S0.next(0, u0)) ffn_fixup_tile(F, s, u0.pm, (j < nper ? 0 : 1) * (DFF / 2), DFF / 16); }
    if (j < nper) { pg8::Gemm g{(const pg8::bf16_t*)GP(ACT, s), (const pg8::bf16_t*)(ws + WS_WDN), R, D, KP, DFF};
        pg8::ListOrder S; S.init(R, D, j, 1); epi::EpiDown1 E{(bf16*)GP(PD, s) + (size_t)RMAX * D}; pg8::gemm_phase<epi::EpiDown1, pg8::ListOrder, true, true>(F.lds, g, S, E, F.tid); }
    else { pg8::Gemm g{(const pg8::bf16_t*)GP(ACT, s) + KP, (const pg8::bf16_t*)(ws + WS_WDN) + KP, R, D, KP, DFF};
        pg8::ListOrder S; S.init(R, D, j - nper, 1); epi::EpiDown1 E{(bf16*)GP(PD, s)}; pg8::gemm_phase<epi::EpiDown1, pg8::ListOrder, true, true>(F.lds, g, S, E, F.tid); } }
__device__ __forceinline__ void stage_down4(Frame& F, int s, int T) { unsigned char* ws = F.ws; const int R = slab_rows(s); const int nun = (R / 256) * 4, part = T / nun, j = T % nun;
    const int KP = part < 2 ? 768 : 640, ko = part < 2 ? part * 768 : 1536 + (part - 2) * 640;
    { pg8::ListOrder S0; S0.init(R, D, j, 1); pg8::Unit u0; if (S0.next(0, u0)) ffn_fixup_tile(F, s, u0.pm, ko, KP / 8); }
    bf16* dst = part == 0 ? (bf16*)GP(PD, s) + (size_t)RMAX * D : part == 1 ? (bf16*)GP(PD, s) : part == 2 ? (bf16*)GENP(ws, WS_PX, SZ_PD, 2, s) : (bf16*)GENP(ws, WS_PX, SZ_PD, 2, s) + (size_t)RMAX * D;
    pg8::Gemm g{(const pg8::bf16_t*)GP(ACT, s) + ko, (const pg8::bf16_t*)(ws + WS_WDN) + ko, R, D, KP, DFF};
    pg8::ListOrder S; S.init(R, D, j, 1); epi::EpiDown1 E{dst}; pg8::gemm_phase<epi::EpiDown1, pg8::ListOrder, true, true>(F.lds, g, S, E, F.tid); }
constexpr int NSTAGE = 9, NPHASE = NSLAB + NSTAGE - 1, NSTEPS = 1 + NPHASE;
constexpr int CW_TICKET = 16384;
#define SV(k) ((p - (k)) >= 0 && (p - (k)) < NSLAB)
__device__ __forceinline__ int rup8(int n) { return (n + 7) & ~7; }
__device__ __forceinline__ void run_phase(Frame& F, int p) {
    const int n_scan = SV(3) ? ((p - 3) == DSLAB ? 192 : 64) : 0;
    const bool dn4 = DOWN4 && SV(7) && (p - 7) >= DOWN4_S0; const int nper_dn = SV(7) ? rup8((slab_rows(p - 7) / 256) * 4) : 0, n_dn = dn4 ? 4 * ((slab_rows(p - 7) / 256) * 4) : 2 * nper_dn;
    const bool gsplit = p >= GSPLIT_P0; const int n_g2 = SV(4) ? (gsplit ? 3 * ((slab_rows(p - 4) / 256) * 4) : rup8((slab_rows(p - 4) / 256) * 4)) : 0;
    const int n_gp = SV(2) ? ((p - 2) == DSLAB ? GDN_ITEMS : NCH * NB * GH) / 2 : 0;
    const int GA = p >= 4 ? 4 : 1; const int GU = p >= GU1_P0 ? 1 : GU_STEADY;
    const int n_in = SV(1) ? 8 * (((((slab_rows(p - 1) / 256) * (NIN / 256) + 7) / 8) + GA - 1) / GA) : 0;
    const int n_up = SV(6) ? 8 * (((((slab_rows(p - 6) / 256) * (NUP / 256) + 7) / 8) + GU - 1) / GU) : 0;
    const int n_g1 = 0;
    const int n_ou = SV(5) ? rup8((slab_rows(p - 5) / 256) * 4) : 0;
    const int n_sp = SV(2) ? ((p - 2) == DSLAB ? SSD_ITEMS : NCH * NB * SG) : 0;
    constexpr int P_CA = 256, P_N1 = 256, P_FI = 256, P_MC = 16, P_P1 = 88, P_CV = 512;
    const int n_ca = SV(7) ? 16 : 0, n_n1 = SV(0) ? P_N1 : 0, n_fi = SV(8) ? P_FI : 0, n_mc = SV(2) ? P_MC : 0, n_p1 = p == 1 ? P_P1 : 0, n_cv = p == 0 ? P_CV : 0;
    const int oA = n_scan + n_ou;
    const int o1 = n_scan, o2 = oA + n_dn, o3 = o2 + n_g2, o4 = o3 + n_gp, o5 = o4 + n_in, o6 = o5 + n_up, o7 = o6 + n_g1, o8 = o7, o9 = o8 + n_sp,
              o10 = o9 + n_ca, o11 = o10 + n_n1, o12 = o11 + n_fi, o13 = o12 + n_mc, o14 = o13 + n_p1, total = o14 + n_cv;
    const int d0 = o10, d1 = d0 + n_mc, d2 = d1 + n_p1, d3 = d2 + n_cv, d4 = d3 + n_fi;
#define REMAP(T_) do { const int t_ = (T_); (T_) = (t_ < d0 || t_ >= total) ? t_ : t_ < d1 ? o12 + (t_ - d0) : t_ < d2 ? o13 + (t_ - d1) : t_ < d3 ? o14 + (t_ - d2) : t_ < d4 ? o11 + (t_ - d3) : o10 + (t_ - d4); } while (0)
    const int label = F.bid & 7;
    gu32* ctr = F.ctl + CW_TICKET + (p * 8 + label) * 64;
    volatile LAS unsigned* slot = F.MISC + 16;
    PROF_BEGIN(12);
#define NEXT_TASK(T_, it_) do { if (F.tid == 0) slot[(it_) & 1] = __hip_atomic_fetch_add(ctr, 1u, __ATOMIC_RELAXED, __HIP_MEMORY_SCOPE_AGENT); __syncthreads(); \
        T_ = (int)__builtin_amdgcn_readfirstlane(slot[(it_) & 1]) * 8 + label; } while (0)
    int T, it = 0;
    NEXT_TASK(T, it); REMAP(T);
    while (T < total) {
        { int t_ = F.tid; unsigned char* w_ = F.ws; float* o_ = F.out; asm volatile("" : "+v"(t_), "+s"(w_), "+s"(o_));
          F.tid = t_; F.lane = t_ & 63; F.wave = __builtin_amdgcn_readfirstlane(t_ >> 6); F.ws = w_; F.out = o_; }
        const int kind_ = T < o1 ? 20 : T < oA ? 27 : T < o2 ? 21 : T < o3 ? 22 : T < o4 ? 23 : T < o5 ? 24 : T < o6 ? 25 : T < o7 ? 26 : T < o8 ? 27 : T < o9 ? 28 : 30;
        unsigned long long tk0_ = 0; if (PROF_SEL >= 20 && PROF_SEL <= 30) tk0_ = __builtin_amdgcn_s_memrealtime();
        if (T < o1) scan_job(F, p - 3, T);
        else if (T < oA) stage_out(F, p - 5, T - o1, 1);
        else if (T < o2) { if (dn4) stage_down4(F, p - 7, T - oA); else stage_down(F, p - 7, T - oA, nper_dn); }
        else if (T < o3) { if (gsplit) stage_gate_split(F, p - 4, p, T - o2); else stage_gate(F, p - 4, T - o2, 1); }
        else if (T < o4) gdn_pre_pair(F, p - 2, T - o3);
        else if (T < o5) stage_inproj(F, p - 1, ((T - o4) & 7) + 8 * GA * ((T - o4) >> 3), GA);
        else if (T < o6) stage_up(F, p - 6, ((T - o5) & 7) + 8 * GU * ((T - o5) >> 3), GU);
        else if (T < o7) { }
        else if (T < o9) ssd_pre_item(F, p - 2, T - o8);
        else if (T < o10) phase_convact(F, p - 7, T - o9, n_ca);
        else if (T < o11) phase_norm1(F, p, T - o10, P_N1);
        else if (T < o12) phase_final(F, p - 8, T - o11, P_FI);
        else if (T < o13) phase_mix_carry(F, p - 2, T - o12, P_MC);
        else if (T < o14) phase_prologue1(F, T - o13, P_P1);
        else phase_convert_rest(F, T - o14, P_CV);
        if (PROF_SEL >= 20 && PROF_SEL <= 30 && kind_ == PROF_SEL && (PROF_ONLY_PH < 0 || p == PROF_ONLY_PH)) F.prof += __builtin_amdgcn_s_memrealtime() - tk0_;
        ++it; { PROF_BEGIN(29); NEXT_TASK(T, it); PROF_END(29); } REMAP(T);
    }
#undef NEXT_TASK
#undef REMAP
    PROF_END(12);
}
__device__ __forceinline__ void run_step(Frame& F, int st) {
    if (st == 0) { PROF_BEGIN(17); phase_prologue0(F); PROF_END(17); return; }
    run_phase(F, st - 1);
}
__global__ void __launch_bounds__(NTHR, 2) mk_fwd(Args a) {
    extern __shared__ __attribute__((aligned(16))) unsigned char lds[];
    Frame F(a); F.prof = 0;
    F.lds = (LAS unsigned char*)lds; F.MISC = (volatile LAS unsigned*)(F.lds + MISC_OFF);
    F.tid = threadIdx.x; F.lane = F.tid & 63; F.wave = __builtin_amdgcn_readfirstlane(F.tid >> 6); F.G = gridDim.x; F.bid = blockIdx.x;
    F.out = a.out; F.ws = a.ws; F.ctl = (gu32*)(a.ws + WS_CTL);
    for (int u = F.tid; u < (LDS_BYTES - LDSCTL_OFF) / 4; u += NTHR) ((LAS unsigned*)(F.lds + LDSCTL_OFF))[u] = 0u;
    __syncthreads();
    XcdBarrier bar; bar.bar = (unsigned*)(F.ctl + CW_BAR); bar.x = 0; bar.st = nullptr;
    const bool multi = (a.ph_hi - a.ph_lo) > 1;
    if (multi) bar = xcd_barrier_post((unsigned*)(F.ctl + CW_BAR), F.MISC + 8);
    for (int st = a.ph_lo; st < a.ph_hi; ++st) {
        { int t_ = threadIdx.x, b_ = blockIdx.x; unsigned char* w_ = a.ws; float* o_ = a.out; asm volatile("" : "+v"(t_), "+s"(b_), "+s"(w_), "+s"(o_));
          F.tid = t_; F.lane = t_ & 63; F.wave = __builtin_amdgcn_readfirstlane(t_ >> 6); F.bid = b_; F.ws = w_; F.out = o_; }
        unsigned long long tph_ = 0; if (PROF_SEL >= 39) tph_ = __builtin_amdgcn_s_memrealtime();
        run_step(F, st);
        if (st + 1 < a.ph_hi) { if (st == a.ph_lo) cooperative_groups::this_grid().sync(); else { PROF_BEGIN(16); xcd_barrier(bar); if (BAR_REPS > 1) xcd_barrier(bar); PROF_END(16); } }
        if (PROF_SEL == 39 && st - 1 == PROF_PH) F.prof += __builtin_amdgcn_s_memrealtime() - tph_;
        if (PROF_SEL >= 40) { const int ph_ = st - 1; const int grp_ = st < 1 ? 0 : ph_ < 4 ? 1 : ph_ < 10 ? 2 : ph_ < 16 ? 3 : ph_ < 20 ? 4 : 5; if (PROF_SEL - 40 == grp_) F.prof += __builtin_amdgcn_s_memrealtime() - tph_; }
    }
    if (PROF_SEL != 0) {
#if PROF_MAX
        if (F.tid == 0) __hip_atomic_fetch_max((unsigned long long*)(F.ctl + 8192), F.prof * F.G, __ATOMIC_RELAXED, __HIP_MEMORY_SCOPE_AGENT);
#else
        if (F.tid == 0) __hip_atomic_fetch_add((unsigned long long*)(F.ctl + 8192), F.prof, __ATOMIC_RELAXED, __HIP_MEMORY_SCOPE_AGENT);
#endif
        xcd_barrier(bar);
        const unsigned long long tot = __hip_atomic_load((unsigned long long*)(F.ctl + 8192), __ATOMIC_RELAXED, __HIP_MEMORY_SCOPE_AGENT);
        const unsigned long long t0 = __builtin_amdgcn_s_memrealtime(), dur = tot * PROF_MULT / F.G; while (__builtin_amdgcn_s_memrealtime() - t0 < dur) __builtin_amdgcn_s_sleep(8); }
}
#ifndef MK_SINGLE
#define MK_SINGLE 1
#endif
extern "C" void kernel_launch(void* const* d_in, const int* in_sizes, int n_in, void* d_out, int out_size, void* d_ws, size_t ws_size, hipStream_t stream) {
    static int grid = 0;
    if (grid == 0) {
        if (n_in != 30 || (size_t)out_size != O_END || ws_size < WS_END) { fprintf(stderr, "kernel_launch: unexpected shapes: n_in %d out %d ws %zu (need %zu)\n", n_in, out_size, ws_size, (size_t)WS_END); grid = -1; return; }
        int dev = 0, cus = 0;
        if (hipGetDevice(&dev) != hipSuccess || hipDeviceGetAttribute(&cus, hipDeviceAttributeMultiprocessorCount, dev) != hipSuccess) { grid = -1; return; }
        if (hipFuncSetAttribute((const void*)mk_fwd, hipFuncAttributeMaxDynamicSharedMemorySize, LDS_BYTES) != hipSuccess) { fprintf(stderr, "kernel_launch: hipFuncSetAttribute failed\n"); grid = -1; return; }
        int per_cu = 0;
        if (hipOccupancyMaxActiveBlocksPerMultiprocessor(&per_cu, (const void*)mk_fwd, NTHR, LDS_BYTES) != hipSuccess || per_cu < 1) fprintf(stderr, "kernel_launch: occupancy query says %d\n", per_cu);
        (void)hipGetLastError();
        grid = cus * (per_cu < 1 ? 1 : per_cu);
    }
    if (grid < 0) return;
    (void)hipMemsetAsync((char*)d_ws + WS_CTL, 0, CTL_ZERO_BYTES, stream);
    Args a{};
    for (int i = 0; i < 30; ++i) a.in[i] = (const float*)d_in[i];
    a.out = (float*)d_out; a.ws = (unsigned char*)d_ws;
#if MK_SINGLE
    a.ph_lo = 0; a.ph_hi = NSTEPS;
    void* kargs[] = {(void*)&a};
    hipError_t le = hipLaunchCooperativeKernel((const void*)mk_fwd, dim3(grid), dim3(NTHR), kargs, LDS_BYTES, stream);
    if (le != hipSuccess) fprintf(stderr, "kernel_launch: cooperative launch failed: %s (grid %d)\n", hipGetErrorString(le), grid);
#else
    for (int st = 0; st < NSTEPS; ++st) { a.ph_lo = st; a.ph_hi = st + 1; hipLaunchKernelGGL(mk_fwd, dim3(grid), dim3(NTHR), LDS_BYTES, stream, a); }
#endif
}
```
